# Optimizing an MI355X kernel written in HIP

```python
import jax, jax.numpy as jnp
from jax import lax
import numpy as np

D_MODEL = 1024
BATCH = 2
SEQ = 16384
DEPTH = 2

HEAD_DIM = 64
RWKV_WIDTH = D_MODEL // 2
FOX_WIDTH = D_MODEL - RWKV_WIDTH
MIX_WIDTH = RWKV_WIDTH + FOX_WIDTH
RWKV_HEADS = RWKV_WIDTH // HEAD_DIM
FOX_HEADS = FOX_WIDTH // HEAD_DIM
DECAY_LORA = 64
ICLR_LORA = 64
Q_BLOCK = 128
LN_EPS = 1e-5
GN_EPS = 64e-5
DEEPNORM_ALPHA = (2 * DEPTH) ** 0.25
DEEPNORM_BETA = (8 * DEPTH) ** -0.25

RW_R0 = 0
RW_K0 = RW_R0 + RWKV_WIDTH
RW_V0 = RW_K0 + RWKV_WIDTH
RW_WD0 = RW_V0 + RWKV_WIDTH
RW_AD0 = RW_WD0 + DECAY_LORA
RW_END = RW_AD0 + ICLR_LORA
FX_Q0 = RW_END
FX_K0 = FX_Q0 + FOX_WIDTH
FX_V0 = FX_K0 + FOX_WIDTH
FX_F0 = FX_V0 + FOX_WIDTH
FX_END = FX_F0 + FOX_HEADS
GATE0 = FX_END
P_TOTAL = GATE0 + MIX_WIDTH

kernel_name = "hymba_rwkv7_fox_deepnorm_adaln"


def _layer_norm(x, g, b, eps=LN_EPS):
    x32 = x.astype(jnp.float32)
    mu = jnp.mean(x32, axis=-1, keepdims=True)
    var = jnp.mean(jnp.square(x32 - mu), axis=-1, keepdims=True)
    return ((x32 - mu) * lax.rsqrt(var + eps)).astype(x.dtype) * g + b


def _rwkv7_scan(r, decay, k, v, kk, kka):
    B, T, H, N = r.shape

    def step(S, inp):
        r_t, w_t, k_t, v_t, kk_t, b_t = inp
        sa = jnp.einsum('bhvk,bhk->bhv', S, kk_t)
        S = (S * w_t[:, :, None, :]
             - sa[..., None] * b_t[:, :, None, :]
             + v_t[..., None] * k_t[:, :, None, :])
        y = jnp.einsum('bhvk,bhk->bhv', S, r_t)
        return S, y

    S0 = jnp.zeros((B, H, N, N), jnp.float32)
    xs = (jnp.moveaxis(r, 1, 0), jnp.moveaxis(decay, 1, 0), jnp.moveaxis(k, 1, 0),
          jnp.moveaxis(v, 1, 0), jnp.moveaxis(kk, 1, 0), jnp.moveaxis(kka, 1, 0))
    _, ys = lax.scan(step, S0, xs)
    return jnp.moveaxis(ys, 0, 1)


def _fox_attention(q, k, v, log_f):
    B, T, H, D = q.shape
    qh = q.transpose(0, 2, 1, 3)
    kh = k.transpose(0, 2, 1, 3)
    vh = v.transpose(0, 2, 1, 3)
    cum = jnp.cumsum(log_f, axis=1).transpose(0, 2, 1)
    key_pos = jnp.arange(T)
    scale = D ** -0.5

    def block(i):
        start = i * Q_BLOCK
        qb = lax.dynamic_slice_in_dim(qh, start, Q_BLOCK, axis=2)
        cb = lax.dynamic_slice_in_dim(cum, start, Q_BLOCK, axis=2)
        s = (jnp.einsum('bhqd,bhkd->bhqk', qb, kh).astype(jnp.float32) * scale
             + cb[..., None] - cum[:, :, None, :])
        q_pos = start + jnp.arange(Q_BLOCK)
        s = jnp.where(q_pos[:, None] >= key_pos[None, :], s, -jnp.inf)
        p = jax.nn.softmax(s, axis=-1)
        return jnp.einsum('bhqk,bhkd->bhqd', p.astype(vh.dtype), vh)

    out = lax.map(block, jnp.arange(T // Q_BLOCK))
    return out.transpose(1, 0, 3, 2, 4).reshape(B, T, H * D)


def _hybrid_layer(x, c, w_ada, b_ada, w_in, rwkv_mix, w0, w_up, a0, a_up, k_k, k_a, r_k,
                  gn_g, gn_b, fox_bf, w_out, ln_g, ln_b):
    B, T, _ = x.shape
    mod = c @ w_ada + b_ada
    shift, scale, gate = jnp.split(mod, 3, axis=-1)
    h = x * (1.0 + scale[:, None, :]) + shift[:, None, :]

    proj = h @ w_in

    rw = proj[..., :RW_END]
    rw_prev = jnp.pad(rw, ((0, 0), (1, 0), (0, 0)))[:, :-1]
    rw = rw + (rw_prev - rw) * rwkv_mix
    hs = (B, T, RWKV_HEADS, HEAD_DIM)
    r = rw[..., RW_R0:RW_K0].astype(jnp.float32)
    k = rw[..., RW_K0:RW_V0].astype(jnp.float32)
    v = rw[..., RW_V0:RW_WD0].astype(jnp.float32)
    w_low = rw[..., RW_WD0:RW_AD0].astype(jnp.float32)
    a_low = rw[..., RW_AD0:RW_END].astype(jnp.float32)
    w_log = -jax.nn.softplus(-(w0 + jnp.tanh(w_low) @ w_up)) - 0.5
    decay = jnp.exp(-jnp.exp(w_log))
    a = jax.nn.sigmoid(a0 + a_low @ a_up)
    kk = (k * k_k).reshape(hs)
    kk = kk / jnp.maximum(jnp.sqrt(jnp.sum(kk * kk, axis=-1, keepdims=True)), 1e-12)
    k = k * (1.0 + (a - 1.0) * k_a)
    r_h, k_h, v_h, a_h = r.reshape(hs), k.reshape(hs), v.reshape(hs), a.reshape(hs)
    y_a = _rwkv7_scan(r_h, decay.reshape(hs), k_h, v_h, kk, kk * a_h)
    mu = jnp.mean(y_a, axis=-1, keepdims=True)
    var = jnp.mean(jnp.square(y_a - mu), axis=-1, keepdims=True)
    y_a = ((y_a - mu) * lax.rsqrt(var + GN_EPS)).reshape(B, T, RWKV_WIDTH) * gn_g + gn_b
    bonus = jnp.sum(r_h * k_h * r_k.reshape(RWKV_HEADS, HEAD_DIM), axis=-1, keepdims=True) * v_h
    y_a = (y_a + bonus.reshape(B, T, RWKV_WIDTH)).astype(x.dtype)

    fs = (B, T, FOX_HEADS, HEAD_DIM)
    q_f = proj[..., FX_Q0:FX_K0].reshape(fs)
    k_f = proj[..., FX_K0:FX_V0].reshape(fs)
    v_f = proj[..., FX_V0:FX_F0].reshape(fs)
    log_f = jax.nn.log_sigmoid(proj[..., FX_F0:FX_END].astype(jnp.float32) + fox_bf)
    y_b = _fox_attention(q_f, k_f, v_f, log_f).astype(x.dtype)

    g_path = jax.nn.silu(proj[..., GATE0:P_TOTAL])
    y = jnp.concatenate([y_a, y_b], axis=-1) * g_path
    out = y @ w_out

    return _layer_norm(DEEPNORM_ALPHA * x + (1.0 + gate[:, None, :]) * out, ln_g, ln_b)


def setup_inputs(seed: int = 0) -> dict:
    key = jax.random.key(seed)
    ks = jax.random.split(key, 24)
    f32 = jnp.float32
    nrm = lambda k, shape, s: (jax.random.normal(k, shape, f32) * s)

    x = jax.random.normal(ks[0], (BATCH, SEQ, D_MODEL), f32)
    c = jax.random.normal(ks[1], (BATCH, D_MODEL), f32)
    emb_ln_g = 1.0 + nrm(ks[2], (D_MODEL,), 0.02)
    emb_ln_b = nrm(ks[3], (D_MODEL,), 0.02)

    w_ada = nrm(ks[4], (DEPTH, D_MODEL, 3 * D_MODEL), 0.1 * D_MODEL ** -0.5)
    b_ada = nrm(ks[5], (DEPTH, 3 * D_MODEL), 0.01)
    col_scale = (jnp.ones((P_TOTAL,), f32)
                 .at[RW_V0:RW_WD0].set(DEEPNORM_BETA)
                 .at[FX_V0:FX_F0].set(DEEPNORM_BETA))
    w_in = nrm(ks[6], (DEPTH, D_MODEL, P_TOTAL), D_MODEL ** -0.5) * col_scale
    rwkv_mix = jax.random.uniform(ks[7], (DEPTH, RW_END), f32)
    w0 = jax.random.uniform(ks[8], (DEPTH, RWKV_WIDTH), f32, -6.0, -1.0)
    w_up = nrm(ks[9], (DEPTH, DECAY_LORA, RWKV_WIDTH), 0.1 * DECAY_LORA ** -0.5)
    a0 = nrm(ks[10], (DEPTH, RWKV_WIDTH), 0.1)
    a_up = nrm(ks[11], (DEPTH, ICLR_LORA, RWKV_WIDTH), 0.1 * ICLR_LORA ** -0.5)
    k_k = 0.85 + nrm(ks[12], (DEPTH, RWKV_WIDTH), 0.02)
    k_a = 1.0 + nrm(ks[13], (DEPTH, RWKV_WIDTH), 0.02)
    r_k = nrm(ks[14], (DEPTH, RWKV_WIDTH), 0.1)
    gn_g = 1.0 + nrm(ks[15], (DEPTH, RWKV_WIDTH), 0.02)
    gn_b = nrm(ks[16], (DEPTH, RWKV_WIDTH), 0.02)
    fox_bf = 3.0 + nrm(ks[17], (DEPTH, FOX_HEADS), 0.5)
    w_out = nrm(ks[18], (DEPTH, MIX_WIDTH, D_MODEL), MIX_WIDTH ** -0.5) * DEEPNORM_BETA
    ln_g = 1.0 + nrm(ks[19], (DEPTH, D_MODEL), 0.02)
    ln_b = nrm(ks[20], (DEPTH, D_MODEL), 0.02)
    return {"x": x, "c": c, "emb_ln_g": emb_ln_g, "emb_ln_b": emb_ln_b,
            "w_ada": w_ada, "b_ada": b_ada, "w_in": w_in, "rwkv_mix": rwkv_mix,
            "w0": w0, "w_up": w_up, "a0": a0, "a_up": a_up, "k_k": k_k, "k_a": k_a,
            "r_k": r_k, "gn_g": gn_g, "gn_b": gn_b, "fox_bf": fox_bf, "w_out": w_out,
            "ln_g": ln_g, "ln_b": ln_b}


def reference(x, c, emb_ln_g, emb_ln_b, w_ada, b_ada, w_in, rwkv_mix, w0, w_up, a0, a_up,
              k_k, k_a, r_k, gn_g, gn_b, fox_bf, w_out, ln_g, ln_b):
    h = _layer_norm(x, emb_ln_g, emb_ln_b)
    for l in range(DEPTH):
        h = _hybrid_layer(h, c, w_ada[l], b_ada[l], w_in[l], rwkv_mix[l], w0[l], w_up[l],
                          a0[l], a_up[l], k_k[l], k_a[l], r_k[l], gn_g[l], gn_b[l],
                          fox_bf[l], w_out[l], ln_g[l], ln_b[l])
    return h
```

```cpp
#include <hip/hip_runtime.h>
#include <cstdio>
#include <cstdint>
namespace pg8 {
#define PG8_LAS __attribute__((address_space(3)))
typedef unsigned short bf16_t;
typedef short bf16x8 __attribute__((ext_vector_type(8)));
typedef float f32x4 __attribute__((ext_vector_type(4)));
typedef unsigned u32x4 __attribute__((ext_vector_type(4)));
constexpr int BM = 256, BK = 64, HALF = 128, HTB = HALF * BK * 2  , STAGE_BYTES = 8 * HTB, NXCD = 8, WGM = 8;

__host__ __device__ __forceinline__ int lds_byte(int r, int c) { const int st = (r >> 4) * 2 + (c >> 5), rr = r & 15, cc = c & 31, ob = rr * 64 + cc * 2; return st * 1024 + (ob ^ (((ob >> 9) & 1) << 5)); }
__host__ __device__ __forceinline__ void stage_rc(int b, int& R, int& C) { const int st = b / 1024, sb = b % 1024, swz = sb ^ (((sb >> 9) & 1) << 5); R = (st >> 1) * 16 + swz / 64; C = (st & 1) * 32 + (swz % 64) / 2; }
__host__ __device__ __forceinline__ int perm32(int rho) { const int n = rho >> 4, i = rho & 15; return 8 * (i >> 2) + 4 * n + (i & 3); }

struct Unit { int pm, pn; };
struct Gemm { const bf16_t* A; const bf16_t* Bt; int M, N, K; };

struct StaticOrder {
    int nM, nN, nwg, G, c;
    __host__ __device__ void init(int M, int N, int G_, int c_) { nM = M / BM; nN = N / BM; nwg = nM * nN; G = G_; c = c_; }
    __host__ __device__ bool next(int i, Unit& u) const {
        const long L = (long)i * G + c; if (L >= nwg) return false;
        int wgid = (int)L; { const int q = nwg / NXCD, r = nwg % NXCD, xcd = wgid % NXCD, off = wgid / NXCD; wgid = (xcd < r ? xcd * (q + 1) : r * (q + 1) + (xcd - r) * q) + off; }
        const int nig = WGM * nN, gid = wgid / nig, fm = gid * WGM, gsz = (nM - fm) < WGM ? (nM - fm) : WGM;
        u.pm = fm + ((wgid % nig) % gsz); u.pn = (wgid % nig) / gsz; return true;
    }
    __device__ __forceinline__ void a_ready(const Unit&) const {}
    __device__ __forceinline__ void done(const Unit&) const {}
};

__device__ __forceinline__ unsigned cvt_pk_bf16(float lo, float hi) { unsigned r; asm volatile("v_cvt_pk_bf16_f32 %0, %1, %2" : "=v"(r) : "v"(lo), "v"(hi)); return r; }
typedef float f32x2 __attribute__((ext_vector_type(2)));
__device__ __forceinline__ f32x2 gelu_pk(f32x2 v) {
    const f32x2 av = __builtin_elementwise_abs(v), d = av * 0.2316418882f + 1.0f;
    f32x2 t; t.x = __builtin_amdgcn_rcpf(d.x); t.y = __builtin_amdgcn_rcpf(d.y);
    f32x2 q = t * 0.5307027145f + (-0.7265760135f); q = q * t + 0.7107068705f; q = q * t + (-0.142248368f); q = q * t + 0.127414796f; q = q * t;
    const f32x2 s = (v * v) * (-0.72134752044f);
    f32x2 e; e.x = __builtin_amdgcn_exp2f(s.x); e.y = __builtin_amdgcn_exp2f(s.y);
    const f32x2 m = v * (q * e), r = v - m;
    f32x2 o; o.x = v.x < 0.f ? m.x : r.x; o.y = v.y < 0.f ? m.y : r.y; return o;
}

template <int ACT  > struct EpiBf16 {
    static constexpr bool PERM = true, AFTER_DRAIN = false; static_assert(ACT == 0 || ACT == 1, "EpiBf16: ACT is 0 (none) or 1 (gelu_pk)");
    bf16_t* O; int ldc; const float* bias; int split_cols; size_t split_stride; float scale0;
    __device__ __forceinline__ void operator()(const f32x4 (&acc)[2][2][4][2], const Unit& u, int wr, int wc, int fr, int fq) const {
        const int row0 = u.pm * BM + wr * 64 + fr; int colt = u.pn * BM; bf16_t* base = O;
        float sc = 1.f; if (split_cols) { const int t = colt / split_cols; base += (size_t)t * split_stride; colt -= t * split_cols; if (t == 0) sc = scale0; }
        const int col0 = colt + wc * 32 + 8 * fq, bcol0 = u.pn * BM + wc * 32 + 8 * fq;
        f32x4 bv[2][2];
#pragma unroll
        for (int bj = 0; bj < 2; ++bj)
#pragma unroll
            for (int n = 0; n < 2; ++n) bv[bj][n] = bias ? *(const f32x4*)(bias + bcol0 + bj * HALF + 4 * n) : (f32x4){0.f, 0.f, 0.f, 0.f};
#pragma unroll
        for (int ai = 0; ai < 2; ++ai)
#pragma unroll
            for (int m = 0; m < 4; ++m) { bf16_t* rowp = base + (size_t)(row0 + ai * HALF + m * 16) * ldc + col0;
#pragma unroll
                for (int bj = 0; bj < 2; ++bj) { f32x4 v0 = acc[ai][bj][m][0] + bv[bj][0], v1 = acc[ai][bj][m][1] + bv[bj][1];
                    if (ACT == 1) { f32x2 a = gelu_pk((f32x2){v0[0], v0[1]}), b = gelu_pk((f32x2){v0[2], v0[3]}), c = gelu_pk((f32x2){v1[0], v1[1]}), d = gelu_pk((f32x2){v1[2], v1[3]});
                        v0 = (f32x4){a.x, a.y, b.x, b.y}; v1 = (f32x4){c.x, c.y, d.x, d.y}; }
                    v0 = v0 * sc; v1 = v1 * sc; u32x4 w; w.x = cvt_pk_bf16(v0[0], v0[1]); w.y = cvt_pk_bf16(v0[2], v0[3]); w.z = cvt_pk_bf16(v1[0], v1[1]); w.w = cvt_pk_bf16(v1[2], v1[3]);
                    *(u32x4*)(rowp + bj * HALF) = w; } }
    }
};

template <class Epi, class Sched, bool ALIGN_EPI = false, bool SP2 = false>
__device__ __forceinline__ void gemm_phase(PG8_LAS unsigned char* lds, const Gemm g, const Sched& S, const Epi& E) {
    int tid = threadIdx.x; asm volatile("" : "+v"(tid));
    const int wid = __builtin_amdgcn_readfirstlane(tid >> 6), lane = tid & 63, wr = wid >> 2, wc = wid & 3, fr = lane & 15, fq = lane >> 4;
    const int K = g.K, nt = K / BK;
    unsigned voffA[2], voffB[2];
#pragma unroll
    for (int i = 0; i < 2; ++i) { int R, C; stage_rc(tid * 16 + i * 8192, R, C); const int Rb = Epi::PERM ? ((R & ~31) + perm32(R & 31)) : R;
        voffA[i] = (unsigned)(R * K + C) * 2u; voffB[i] = (unsigned)(Rb * K + C) * 2u; }
    const size_t kstep = (size_t)(BK * 2);
    const size_t hstep = (size_t)HALF * K * 2;
    const size_t tstep = 2 * hstep;
    const unsigned ldsw = (unsigned)wid * 1024u;
    const int aoff = lds_byte(wr * 64 + fr, fq * 8), boff = lds_byte(wc * 32 + fr, fq * 8);
#define PG8_SA(b, h) (((b) * 2 + (h)) * HTB)
#define PG8_SB(b, h) ((4 + (b) * 2 + (h)) * HTB)
#define PG8_STAGE(bufoff, gbase, voff) do { _Pragma("unroll") for (int _i = 0; _i < 2; ++_i) \
        __builtin_amdgcn_global_load_lds((const unsigned*)((const char*)(gbase) + (voff)[_i]), (PG8_LAS unsigned*)(lds + (bufoff) + ldsw + _i * 8192), 16, 0, 0); } while (0)
#define PG8_LDA(dst, b, h) do { _Pragma("unroll") for (int m = 0; m < 4; ++m) _Pragma("unroll") for (int k = 0; k < 2; ++k) dst[m][k] = *(const PG8_LAS bf16x8*)(lds + PG8_SA(b, h) + aoff + m * 2048 + k * 1024); } while (0)
#define PG8_LDB(dst, b, h) do { _Pragma("unroll") for (int n = 0; n < 2; ++n) _Pragma("unroll") for (int k = 0; k < 2; ++k) dst[n][k] = *(const PG8_LAS bf16x8*)(lds + PG8_SB(b, h) + boff + n * 2048 + k * 1024); } while (0)
#define PG8_MMA(ai, bj, At, Bt) do { __builtin_amdgcn_s_setprio(1); _Pragma("unroll") for (int m = 0; m < 4; ++m) _Pragma("unroll") for (int n = 0; n < 2; ++n) _Pragma("unroll") for (int k = 0; k < 2; ++k) \
        acc[ai][bj][m][n] = __builtin_amdgcn_mfma_f32_16x16x32_bf16(Bt[n][k], At[m][k], acc[ai][bj][m][n], 0, 0, 0); __builtin_amdgcn_s_setprio(0); } while (0)
#define PG8_WAIT_V(n) asm volatile("s_waitcnt vmcnt(" #n ")" ::: "memory")
#define PG8_WAIT_L(n) asm volatile("s_waitcnt lgkmcnt(" #n ")" ::: "memory")
#define PG8_BAR __builtin_amdgcn_s_barrier()
#define PG8_SCHED __builtin_amdgcn_sched_barrier(0)
    Unit cur, nxt; int ui = 0;
    if (!S.next(0, cur)) return;
    f32x4 acc[2][2][4][2];
#pragma unroll
    for (int a = 0; a < 2; ++a)
#pragma unroll
        for (int b = 0; b < 2; ++b)
#pragma unroll
            for (int m = 0; m < 4; ++m)
#pragma unroll
                for (int n = 0; n < 2; ++n) acc[a][b][m][n] = (f32x4){0.f, 0.f, 0.f, 0.f};
    bf16x8 At[4][2], B0[2][2], B1[2][2];
    const char* cA = (const char*)g.A + (size_t)cur.pm * tstep; const char* cB = (const char*)g.Bt + (size_t)cur.pn * tstep;
    S.a_ready(cur);
    if constexpr (SP2) {
        PG8_STAGE(PG8_SB(0, 0), cB, voffB); PG8_STAGE(PG8_SB(0, 1), cB + hstep, voffB); PG8_STAGE(PG8_SA(0, 0), cA, voffA); PG8_STAGE(PG8_SA(0, 1), cA + hstep, voffA);
        if (wr == 1) PG8_BAR;
        PG8_WAIT_V(2); PG8_BAR;
        PG8_STAGE(PG8_SB(1, 0), cB + kstep, voffB); PG8_STAGE(PG8_SA(1, 0), cA + kstep, voffA); PG8_STAGE(PG8_SB(1, 1), cB + hstep + kstep, voffB);
        PG8_WAIT_V(6); PG8_BAR;
    } else {
        PG8_STAGE(PG8_SB(0, 0), cB, voffB); PG8_STAGE(PG8_SA(0, 0), cA, voffA); PG8_STAGE(PG8_SB(0, 1), cB + hstep, voffB); PG8_STAGE(PG8_SA(0, 1), cA + hstep, voffA);
        if (wr == 1) PG8_BAR;
        PG8_WAIT_V(4); PG8_BAR;
        PG8_STAGE(PG8_SB(1, 0), cB + kstep, voffB); PG8_STAGE(PG8_SA(1, 0), cA + kstep, voffA); PG8_STAGE(PG8_SB(1, 1), cB + hstep + kstep, voffB);
        PG8_WAIT_V(6); PG8_BAR;
    }
    for (;;) {
        const bool has_next = S.next(ui + 1, nxt);
        const char* nA = has_next ? (const char*)g.A + (size_t)nxt.pm * tstep : cA; const char* nB = has_next ? (const char*)g.Bt + (size_t)nxt.pn * tstep : cB;
        for (int t = 0; t < nt; t += 2) {
            const bool last = (t == nt - 2);
            const char* a1 = cA + (size_t)(t + 1) * kstep;
            const char* a2 = last ? nA : cA + (size_t)(t + 2) * kstep; const char* b2 = last ? nB : cB + (size_t)(t + 2) * kstep;
            const char* a3 = a2 + kstep; const char* b3 = b2 + kstep;
            if (last && has_next) S.a_ready(nxt);
            if constexpr (SP2) {
            PG8_LDB(B0, 0, 0); PG8_LDB(B1, 0, 1); PG8_SCHED; PG8_LDA(At, 0, 0); PG8_STAGE(PG8_SA(1, 1), a1 + hstep, voffA);
            PG8_WAIT_V(8); PG8_WAIT_L(0); PG8_BAR; PG8_MMA(0, 0, At, B0); PG8_MMA(0, 1, At, B1); PG8_BAR; PG8_SCHED;
            PG8_LDA(At, 0, 1); PG8_STAGE(PG8_SB(0, 0), b2, voffB); PG8_STAGE(PG8_SB(0, 1), b2 + hstep, voffB); PG8_STAGE(PG8_SA(0, 0), a2, voffA);
            PG8_WAIT_V(8); PG8_WAIT_L(0); PG8_BAR; PG8_MMA(1, 0, At, B0); PG8_MMA(1, 1, At, B1); PG8_BAR; PG8_SCHED;
            PG8_LDB(B0, 1, 0); PG8_LDB(B1, 1, 1); PG8_SCHED; PG8_LDA(At, 1, 0); PG8_STAGE(PG8_SA(0, 1), a2 + hstep, voffA);
            PG8_WAIT_V(8); PG8_WAIT_L(0); PG8_BAR; PG8_MMA(0, 0, At, B0); PG8_MMA(0, 1, At, B1); PG8_BAR; PG8_SCHED;
            PG8_LDA(At, 1, 1); PG8_STAGE(PG8_SB(1, 0), b3, voffB); PG8_STAGE(PG8_SB(1, 1), b3 + hstep, voffB); PG8_STAGE(PG8_SA(1, 0), a3, voffA);
            PG8_WAIT_V(8); PG8_WAIT_L(0); PG8_BAR; PG8_MMA(1, 0, At, B0); PG8_MMA(1, 1, At, B1); PG8_BAR; PG8_SCHED;
            } else {
            PG8_LDB(B0, 0, 0); PG8_SCHED; PG8_LDA(At, 0, 0); PG8_STAGE(PG8_SA(1, 1), a1 + hstep, voffA);
            PG8_WAIT_L(8); PG8_BAR; PG8_WAIT_L(0); PG8_MMA(0, 0, At, B0); PG8_BAR; PG8_SCHED;
            PG8_LDB(B1, 0, 1); PG8_STAGE(PG8_SB(0, 0), b2, voffB);
            PG8_BAR; PG8_WAIT_L(0); PG8_MMA(0, 1, At, B1); PG8_BAR;
            PG8_LDA(At, 0, 1); PG8_STAGE(PG8_SA(0, 0), a2, voffA);
            PG8_BAR; PG8_WAIT_L(0); PG8_MMA(1, 0, At, B0); PG8_BAR; PG8_SCHED;
            PG8_STAGE(PG8_SB(0, 1), b2 + hstep, voffB);
            PG8_WAIT_V(6); PG8_BAR; PG8_MMA(1, 1, At, B1); PG8_BAR;
            PG8_LDB(B0, 1, 0); PG8_SCHED; PG8_LDA(At, 1, 0); PG8_STAGE(PG8_SA(0, 1), a2 + hstep, voffA);
            PG8_WAIT_L(8); PG8_BAR; PG8_WAIT_L(0); PG8_MMA(0, 0, At, B0); PG8_BAR; PG8_SCHED;
            PG8_LDB(B1, 1, 1); PG8_STAGE(PG8_SB(1, 0), b3, voffB);
            PG8_BAR; PG8_WAIT_L(0); PG8_MMA(0, 1, At, B1); PG8_BAR;
            PG8_LDA(At, 1, 1); PG8_STAGE(PG8_SA(1, 0), a3, voffA);
            PG8_BAR; PG8_WAIT_L(0); PG8_MMA(1, 0, At, B0); PG8_BAR; PG8_SCHED;
            PG8_STAGE(PG8_SB(1, 1), b3 + hstep, voffB);
            PG8_WAIT_V(6); PG8_BAR; PG8_MMA(1, 1, At, B1); PG8_BAR;
            }
        }
        if constexpr (ALIGN_EPI) { if (wr == 0) PG8_BAR; }
        if constexpr (!Epi::AFTER_DRAIN) { E(acc, cur, wr, wc, fr, fq); S.done(cur); }
        if (!has_next) break;
#pragma unroll
        for (int a = 0; a < 2; ++a)
#pragma unroll
            for (int b = 0; b < 2; ++b)
#pragma unroll
                for (int m = 0; m < 4; ++m)
#pragma unroll
                    for (int n = 0; n < 2; ++n) acc[a][b][m][n] = (f32x4){0.f, 0.f, 0.f, 0.f};
        cur = nxt; cA = nA; cB = nB; ++ui;
        if constexpr (ALIGN_EPI) { if (wr == 1) PG8_BAR; }
    }
    PG8_WAIT_V(0);
    if constexpr (!ALIGN_EPI) { if (wr == 0) PG8_BAR; }
    PG8_BAR;
    if constexpr (Epi::AFTER_DRAIN) { E.fused(acc, cur, wr, wc, fr, fq, lds, wid, lane); S.done(cur); }
#undef PG8_SA
#undef PG8_SB
#undef PG8_STAGE
#undef PG8_LDA
#undef PG8_LDB
#undef PG8_MMA
#undef PG8_WAIT_V
#undef PG8_WAIT_L
#undef PG8_BAR
#undef PG8_SCHED
}
}
#include <hip/hip_cooperative_groups.h>
namespace cg = cooperative_groups;
#define LAS __attribute__((address_space(3)))
typedef unsigned short bf16;
typedef float f32x4 __attribute__((ext_vector_type(4)));
typedef float f32x2 __attribute__((ext_vector_type(2)));
typedef float f32x16 __attribute__((ext_vector_type(16)));
typedef short bf16x8 __attribute__((ext_vector_type(8)));
typedef short s16x4 __attribute__((ext_vector_type(4)));
typedef unsigned u32x4 __attribute__((ext_vector_type(4)));
typedef unsigned u32x2 __attribute__((ext_vector_type(2)));
typedef __bf16 bf16x2_t __attribute__((ext_vector_type(2)));

constexpr int BATCH = 2, T = 16384, D = 1024, M = BATCH * T, DEPTH = 2;
constexpr int NPROJ = 4352, NSRC = 4232;
constexpr int LDA = 1280, LDV = 512, LDB = 2560;
constexpr float LN_EPS = 1e-5f, GN_EPS = 64e-5f;
constexpr float DN_ALPHA = 1.41421356237f;
constexpr float C2 = 0.125f * 1.4426950408889634f;
constexpr float L2E = 1.4426950408889634f;
constexpr size_t MiB = 1u << 20;
constexpr size_t WS_CTL = 0, CTL_ZERO_BYTES = 1 * MiB;
constexpr size_t WS_WIN = 2 * MiB, WS_WOUT = 20 * MiB, WS_CUM = 24 * MiB, WS_SCS = 25 * MiB, WS_SCN = 30 * MiB;
constexpr size_t WS_XN = WS_SCN, WS_YM = WS_SCN;
constexpr size_t WS_PA = 190 * MiB, WS_YA = WS_PA, WS_PV = 270 * MiB, WS_PB = 302 * MiB, WS_VS = 462 * MiB, WS_END = 494 * MiB;
constexpr int CW_QUEUE = 64;
constexpr int CW_KMAX = 1024;
constexpr int CW_MOD = 16384;
constexpr int LDS_BYTES = 147456;

__device__ __forceinline__ unsigned f2bf(float f) { unsigned u = __builtin_bit_cast(unsigned, f); return (u + 0x7fffu + ((u >> 16) & 1u)) >> 16; }
__device__ __forceinline__ unsigned pk2(float lo, float hi) { return f2bf(lo) | (f2bf(hi) << 16); }
__device__ __forceinline__ float bf2f(unsigned short v) { return __uint_as_float(((unsigned)v) << 16); }
__device__ __forceinline__ float bflo(unsigned w) { return __uint_as_float(w << 16); }
__device__ __forceinline__ float bfhi(unsigned w) { return __uint_as_float(w & 0xffff0000u); }
__device__ __forceinline__ unsigned cvtpk(float lo, float hi) { f32x2 v = {lo, hi}; bf16x2_t b = __builtin_convertvector(v, bf16x2_t); return __builtin_bit_cast(unsigned, b); }
__device__ __forceinline__ float wave_sum(float v) {
#pragma unroll
    for (int o = 1; o < 64; o <<= 1) v += __shfl_xor(v, o);
    return v;
}
__device__ __forceinline__ float fast_sigmoid(float x) { return 1.f / (1.f + __expf(-x)); }

struct Args { const float* in[21]; float* out; unsigned char* ws; };

struct EpiProj {
    static constexpr bool PERM = true, AFTER_DRAIN = false;
    bf16 *PA, *PVb, *PB;
    __device__ __forceinline__ void operator()(const pg8::f32x4 (&acc)[2][2][4][2], const pg8::Unit& u, int wr, int wc, int fr, int fq) const {
        const int row0 = u.pm * 256 + wr * 64 + fr; const int pn = u.pn;
        bf16* base; int ldc, colt; float sc = 1.f; bool act = false;
        if (pn < 4) { base = PA; ldc = LDA; colt = pn * 256; }
        else if (pn < 6) { base = PVb; ldc = LDV; colt = (pn - 4) * 256; }
        else if (pn == 6) { base = PA; ldc = LDA; colt = 1024; }
        else { base = PB; ldc = LDB; colt = (pn - 7) * 256; if (pn < 9) sc = C2; if (pn >= 13) act = true; }
        const int col0 = colt + wc * 32 + 8 * fq;
#pragma unroll
        for (int ai = 0; ai < 2; ++ai)
#pragma unroll
            for (int m = 0; m < 4; ++m) { bf16* rowp = base + (size_t)(row0 + ai * 128 + m * 16) * ldc + col0;
#pragma unroll
                for (int bj = 0; bj < 2; ++bj) { pg8::f32x4 v0 = acc[ai][bj][m][0], v1 = acc[ai][bj][m][1];
                    if (act) {
#pragma unroll
                        for (int e = 0; e < 4; ++e) { v0[e] = v0[e] * fast_sigmoid(v0[e]); v1[e] = v1[e] * fast_sigmoid(v1[e]); } }
                    v0 = v0 * sc; v1 = v1 * sc; u32x4 w; w.x = cvtpk(v0[0], v0[1]); w.y = cvtpk(v0[2], v0[3]); w.z = cvtpk(v1[0], v1[1]); w.w = cvtpk(v1[2], v1[3]);
                    *(u32x4*)(rowp + bj * 128) = w; } }
    }
};
struct EpiOut {
    static constexpr bool PERM = false, AFTER_DRAIN = false;
    float* hz; const float* modl;
    __device__ __forceinline__ void operator()(const pg8::f32x4 (&acc)[2][2][4][2], const pg8::Unit& u, int wr, int wc, int fr, int fq) const {
        const int col0 = u.pn * 256 + wc * 32 + 4 * fq; const int b = (u.pm * 256) >= T ? 1 : 0; const float* gate = modl + b * 3072 + 2048;
#pragma unroll
        for (int bj = 0; bj < 2; ++bj)
#pragma unroll
            for (int n = 0; n < 2; ++n) { const int c = col0 + bj * 128 + n * 16; const f32x4 g = *(const f32x4*)(gate + c) + 1.0f;
#pragma unroll
                for (int ai = 0; ai < 2; ++ai)
#pragma unroll
                    for (int m = 0; m < 4; ++m) { const int r = u.pm * 256 + ai * 128 + wr * 64 + m * 16 + fr; float* p = hz + (size_t)r * D + c;
                        const f32x4 hx = *(const f32x4*)p; f32x4 a; a[0] = acc[ai][bj][m][n][0]; a[1] = acc[ai][bj][m][n][1]; a[2] = acc[ai][bj][m][n][2]; a[3] = acc[ai][bj][m][n][3];
                        *(f32x4*)p = hx * DN_ALPHA + g * a; } }
    }
};

__device__ __forceinline__ int win_map(int n) { if (n < 1664) return n; if (n < 1672) return 3200 + n - 1664; if (n < 1792) return -1; if (n < 3328) return n - 128; return n - 120; }
template <bool MAP> __device__ __forceinline__ void transpose_item(const float* W, int Nsrc, int Ndst, bf16* WT, LAS float* scr, int item, int lane) {
    const int nblk = Ndst / 32, kb = item / nblk, nb = item % nblk, k0 = 64 * kb, n0 = 32 * nb;
    const int src = MAP ? win_map(n0 + (lane & 31)) : n0 + (lane & 31);
#pragma unroll 8
    for (int i = 0; i < 32; ++i) { const int kk = 2 * i + (lane >> 5); scr[kk * 33 + (lane & 31)] = src >= 0 ? W[(size_t)(k0 + kk) * Nsrc + src] : 0.f; }
    asm volatile("s_waitcnt lgkmcnt(0)" ::: "memory");
    const int c = lane & 7;
#pragma unroll
    for (int j = 0; j < 4; ++j) { const int n = (lane >> 3) + 8 * j; const LAS float* s = scr + (8 * c) * 33 + n;
        u32x4 o; o.x = pk2(s[0 * 33], s[1 * 33]); o.y = pk2(s[2 * 33], s[3 * 33]); o.z = pk2(s[4 * 33], s[5 * 33]); o.w = pk2(s[6 * 33], s[7 * 33]);
        *(u32x4*)(WT + (size_t)(n0 + n) * 1024 + k0 + 8 * c) = o; }
    asm volatile("s_waitcnt lgkmcnt(0)" ::: "memory");
}
__device__ __forceinline__ void p0a(const Args& a, LAS unsigned char* lds, int tid, int lane, int wave, int G) {
    LAS float* scr = (LAS float*)(lds + wave * 16384);
    const int gw = blockIdx.x * 8 + wave, NGW = G * 8;
    constexpr int I_IN = 16 * (NPROJ / 32), I_OUT = 16 * 32;
    for (int it = gw; it < 2 * (I_IN + I_OUT); it += NGW) {
        int r = it; const int l = r / (I_IN + I_OUT); r -= l * (I_IN + I_OUT);
        if (r < I_IN) transpose_item<true>(a.in[6] + (size_t)l * 1024 * NSRC, NSRC, NPROJ, (bf16*)(a.ws + WS_WIN) + (size_t)l * NPROJ * 1024, scr, r, lane);
        else transpose_item<false>(a.in[18] + (size_t)l * 1024 * 1024, 1024, 1024, (bf16*)(a.ws + WS_WOUT) + (size_t)l * 1024 * 1024, scr, r - I_IN, lane);
    }
    float* mod = (float*)(a.ws + WS_CTL) + CW_MOD;
    const float* cvec = a.in[1];
    for (int w = blockIdx.x * 512 + tid; w < 2 * 16 * 3072; w += G * 512) {
        const int j = w % 3072, sl = (w / 3072) % 16, l = w / (3072 * 16);
        const float* wa = a.in[4] + (size_t)l * 1024 * 3072 + (size_t)(sl * 64) * 3072 + j;
        float s0 = 0.f, s1 = 0.f;
#pragma unroll 8
        for (int i = 0; i < 64; ++i) { const float wv = wa[(size_t)i * 3072]; s0 += cvec[sl * 64 + i] * wv; s1 += cvec[1024 + sl * 64 + i] * wv; }
        if (sl == 0) { const float bb = a.in[5][l * 3072 + j]; s0 += bb; s1 += bb; }
        atomicAdd(mod + (l * 2 + 0) * 3072 + j, s0); atomicAdd(mod + (l * 2 + 1) * 3072 + j, s1);
    }
}
__device__ __forceinline__ void ln_rows(const float* src, const float* g, const float* bb, float* dst, bf16* xn, const float* modn, int lane, int wave, int G) {
    const int gw = blockIdx.x * 8 + wave, NGW = G * 8;
    f32x4 gv[4], bv[4];
#pragma unroll
    for (int j = 0; j < 4; ++j) { gv[j] = ((const f32x4*)g)[lane + 64 * j]; bv[j] = ((const f32x4*)bb)[lane + 64 * j]; }
    for (int m = gw; m < M; m += NGW) {
        const f32x4* xr = (const f32x4*)(src + (size_t)m * D) + lane;
        f32x4 v[4]; float s = 0.f;
#pragma unroll
        for (int j = 0; j < 4; ++j) { v[j] = xr[64 * j]; s += (v[j].x + v[j].y) + (v[j].z + v[j].w); }
        const float mean = wave_sum(s) * (1.f / D); float s2 = 0.f;
#pragma unroll
        for (int j = 0; j < 4; ++j) { v[j] = v[j] - mean; s2 += (v[j].x * v[j].x + v[j].y * v[j].y) + (v[j].z * v[j].z + v[j].w * v[j].w); }
        const float rstd = 1.f / sqrtf(wave_sum(s2) * (1.f / D) + LN_EPS);
        f32x4* o = (f32x4*)(dst + (size_t)m * D) + lane;
        const int b = m >= T ? 1 : 0;
#pragma unroll
        for (int j = 0; j < 4; ++j) { const f32x4 hv = v[j] * rstd * gv[j] + bv[j]; o[64 * j] = hv;
            if (modn) { const f32x4 sh = ((const f32x4*)(modn + b * 3072))[lane + 64 * j], sc = ((const f32x4*)(modn + b * 3072 + 1024))[lane + 64 * j];
                const f32x4 y = hv * (sc + 1.0f) + sh; u32x2 w; w.x = pk2(y.x, y.y); w.y = pk2(y.z, y.w);
                *((u32x2*)(xn + (size_t)m * D) + lane + 64 * j) = w; } }
    }
}
__device__ __forceinline__ float tanh_fast(float x) { const float e = __expf(2.f * x); return 1.f - 2.f / (e + 1.f); }
__device__ __forceinline__ void cum_kmax(const Args& a, LAS unsigned char* lds, int l, int bh, int tid, int lane, int wave) {
    const int b = bh >> 3, h = bh & 7;
    const bf16* PA = (const bf16*)(a.ws + WS_PA); const bf16* PB = (const bf16*)(a.ws + WS_PB);
    float* cum = (float*)(a.ws + WS_CUM) + (size_t)bh * T;
    const float bf = a.in[17][l * 8 + h];
    LAS float* red = (LAS float*)lds;
    const int t0 = tid * 32;
    float s = 0.f, kmx = 0.f;
#pragma unroll 1
    for (int i = 0; i < 32; ++i) { const size_t m = (size_t)b * T + t0 + i;
        const float z = bf2f(PA[m * LDA + 1152 + h]) + bf;
        const float lf = fminf(z, 0.f) - log1pf(__expf(-fabsf(z)));
        s += lf; cum[t0 + i] = s;
        const u32x4* kr = (const u32x4*)(PB + m * LDB + 512 + h * 64); float q = 0.f;
#pragma unroll
        for (int c = 0; c < 8; ++c) { const u32x4 w = kr[c];
            q += bflo(w.x) * bflo(w.x) + bfhi(w.x) * bfhi(w.x) + bflo(w.y) * bflo(w.y) + bfhi(w.y) * bfhi(w.y) + bflo(w.z) * bflo(w.z) + bfhi(w.z) * bfhi(w.z) + bflo(w.w) * bflo(w.w) + bfhi(w.w) * bfhi(w.w); }
        kmx = fmaxf(kmx, q); }
    red[tid] = s;
#pragma unroll
    for (int o = 1; o < 64; o <<= 1) kmx = fmaxf(kmx, __shfl_xor(kmx, o));
    if (lane == 0) red[512 + wave] = kmx;
    __syncthreads();
    if (tid == 0) { float run = 0.f; for (int i = 0; i < 512; ++i) { const float v = red[i]; red[i] = run; run += v; }
        float k = 0.f; for (int i = 0; i < 8; ++i) k = fmaxf(k, red[512 + i]);
        ((float*)(a.ws + WS_CTL))[CW_KMAX + 16 * l + bh] = sqrtf(k); }
    __syncthreads();
    const float off = red[tid];
#pragma unroll 1
    for (int i = 0; i < 32; ++i) cum[t0 + i] += off;
    __syncthreads();
}
__device__ __forceinline__ void prep_phase(const Args& a, LAS unsigned char* lds, int l, int tid, int lane, int wave, int G) {
    const bf16* PA = (const bf16*)(a.ws + WS_PA); const bf16* PV = (const bf16*)(a.ws + WS_PV);
    bf16* SCN = (bf16*)(a.ws + WS_SCN); float* SCS = (float*)(a.ws + WS_SCS); bf16* VS = (bf16*)(a.ws + WS_VS);
    LAS unsigned* Wl = (LAS unsigned*)lds;
    LAS float* low = (LAS float*)(lds + 131072);
    const int c = tid, h = wave;
    { const float* wu = a.in[9] + (size_t)l * 64 * 512 + c; const float* au = a.in[11] + (size_t)l * 64 * 512 + c;
#pragma unroll 8
      for (int i = 0; i < 64; ++i) Wl[i * 512 + c] = pk2(wu[i * 512], au[i * 512]); }
    const float* mix = a.in[7] + l * 1664;
    const float mix_r = mix[c], mix_k = mix[512 + c], mix_v = mix[1024 + c];
    const float mlow0 = mix[1536 + (tid & 127)];
    const float w0c = a.in[8][l * 512 + c], a0c = a.in[10][l * 512 + c], kkc = a.in[12][l * 512 + c], kac = a.in[13][l * 512 + c], rkc = a.in[14][l * 512 + c];
    __syncthreads();
    for (int chunk = blockIdx.x; chunk < M / 64; chunk += G) {
        const int m0 = chunk * 64, b = m0 >= T ? 1 : 0, t0 = m0 - b * T; const int bh = b * 8 + h;
        float pr = 0.f, pk = 0.f, pv = 0.f;
        if (t0 > 0) { pr = bf2f(PA[(size_t)(m0 - 1) * LDA + c]); pk = bf2f(PA[(size_t)(m0 - 1) * LDA + 512 + c]); pv = bf2f(PV[(size_t)(m0 - 1) * LDV + c]); }
#pragma unroll 1
        for (int g = 0; g < 8; ++g) {
#pragma unroll
            for (int e = 0; e < 2; ++e) { const int idx = tid + 512 * e, tt = idx >> 7, i = idx & 127; const int m = m0 + g * 8 + tt, t = t0 + g * 8 + tt;
                const float cur = bf2f(PA[(size_t)m * LDA + 1024 + i]); const float prev = t > 0 ? bf2f(PA[(size_t)(m - 1) * LDA + 1024 + i]) : 0.f;
                float val = cur + (prev - cur) * mlow0; if (i < 64) val = tanh_fast(val);
                low[i * 8 + tt] = val; }
            __syncthreads();
            f32x4 wlA = {0.f, 0.f, 0.f, 0.f}, wlB = wlA, alA = wlA, alB = wlA;
#pragma unroll 4
            for (int i = 0; i < 64; ++i) { const unsigned wp = Wl[i * 512 + c]; const float wv = bflo(wp), av = bfhi(wp);
                const LAS f32x4* lx = (const LAS f32x4*)(low + i * 8); const LAS f32x4* ly = (const LAS f32x4*)(low + (64 + i) * 8);
                wlA += lx[0] * wv; wlB += lx[1] * wv; alA += ly[0] * av; alB += ly[1] * av; }
#pragma unroll
            for (int tt = 0; tt < 8; ++tt) {
                const int m = m0 + g * 8 + tt, t = t0 + g * 8 + tt;
                const float cr = bf2f(PA[(size_t)m * LDA + c]), ck = bf2f(PA[(size_t)m * LDA + 512 + c]), cv = bf2f(PV[(size_t)m * LDV + c]);
                const float r = cr + (pr - cr) * mix_r, k = ck + (pk - ck) * mix_k, v = cv + (pv - cv) * mix_v; pr = cr; pk = ck; pv = cv;
                const float wl = w0c + (tt < 4 ? wlA[tt & 3] : wlB[tt & 3]), al = a0c + (tt < 4 ? alA[tt & 3] : alB[tt & 3]);
                const float z = -wl; const float sp = fmaxf(z, 0.f) + log1pf(__expf(-fabsf(z)));
                const float e = __expf(-sp - 0.5f); const float omw = -expm1f(-e);
                const float av = fast_sigmoid(al);
                const float kkr = k * kkc; const float ss = wave_sum(kkr * kkr); const float kk = kkr / fmaxf(sqrtf(ss), 1e-12f);
                const float kp = k * (1.f + (av - 1.f) * kac); const float bbv = kk * av; const float wr = (1.f - omw) * r;
                const float br = wave_sum(bbv * r), kr = wave_sum(kp * r), rkr = wave_sum(r * kp * rkc);
                bf16* rec = SCN + ((size_t)bh * T + t) * 320 + lane;
                rec[0] = (bf16)f2bf(kk); rec[64] = (bf16)f2bf(wr); rec[128] = (bf16)f2bf(omw); rec[192] = (bf16)f2bf(bbv); rec[256] = (bf16)f2bf(kp);
                VS[(size_t)m * 512 + c] = (bf16)f2bf(v);
                if (lane == 0) { f32x4 sc = {br, kr, rkr, 0.f}; *(f32x4*)(SCS + ((size_t)bh * T + t) * 4) = sc; }
                __builtin_amdgcn_sched_barrier(0);
            }
            __syncthreads();
        }
    }
    __syncthreads();
    asm volatile("" ::: "memory");
#ifndef NOCUM
    if (blockIdx.x < 16) cum_kmax(a, lds, l, blockIdx.x, tid, lane, wave);
#endif
}

__device__ __forceinline__ float dppf(float x, const int ctrl_sel) {
    unsigned u = __float_as_uint(x), r;
    if (ctrl_sel == 0) r = __builtin_amdgcn_update_dpp(0, u, 0xB1, 0xF, 0xF, true);
    else if (ctrl_sel == 1) r = __builtin_amdgcn_update_dpp(0, u, 0x4E, 0xF, 0xF, true);
    else r = __builtin_amdgcn_update_dpp(0, u, 0x141, 0xF, 0xF, true);
    return __uint_as_float(r);
}
__device__ __forceinline__ float red8(float x) { x += dppf(x, 0); x += dppf(x, 1); x += dppf(x, 2); return x; }
constexpr int SC_CH = 32, SC_BUF = SC_CH * 320 * 4, SC_VOFF = 2 * SC_BUF, SC_SOFF = SC_VOFF + 2 * SC_CH * 32 * 4;
__device__ __forceinline__ void scan_wg(const Args& a, LAS unsigned char* lds, int bh, int half, int tid, int lane, int wave) {
    const int b = bh >> 3, h = bh & 7;
    const bf16* SCN = (const bf16*)(a.ws + WS_SCN) + (size_t)bh * T * 320;
    const float* SCS = (const float*)(a.ws + WS_SCS) + (size_t)bh * T * 4;
    const bf16* VS = (const bf16*)(a.ws + WS_VS) + (size_t)b * T * 512 + h * 64 + half * 32;
    float* YA = (float*)(a.ws + WS_YA) + (size_t)b * T * 512 + h * 64 + half * 32;
    constexpr int NCH = T / SC_CH;
    __syncthreads();
    if (wave >= 4) {
        const int lt = tid - 256;
        u32x4 mreg[5]; u32x4 vreg; f32x4 sreg;
        auto gload = [&](int c) {
            const u32x4* src = (const u32x4*)(SCN + (size_t)c * SC_CH * 320);
#pragma unroll
            for (int i = 0; i < 5; ++i) mreg[i] = src[lt + 256 * i];
            if (lt < 128) { const int st = lt >> 2, pc = lt & 3; vreg = *(const u32x4*)(VS + (size_t)(c * SC_CH + st) * 512 + pc * 8); }
            else if (lt < 160) { sreg = *(const f32x4*)(SCS + (size_t)(c * SC_CH + (lt - 128)) * 4); }
        };
        auto lwrite = [&](int c) {
            LAS unsigned char* bp = lds + (c & 1) * SC_BUF;
#pragma unroll
            for (int i = 0; i < 5; ++i) { const int p = lt + 256 * i; const int arr = (p >> 3) % 5;
                const u32x4 w = mreg[i]; f32x4 lo, hi;
                lo[0] = bflo(w.x); lo[1] = bfhi(w.x); lo[2] = bflo(w.y); lo[3] = bfhi(w.y); hi[0] = bflo(w.z); hi[1] = bfhi(w.z); hi[2] = bflo(w.w); hi[3] = bfhi(w.w);
                if (arr == 2) { lo = 1.0f - lo; hi = 1.0f - hi; }
                LAS f32x4* d = (LAS f32x4*)(bp + (size_t)p * 32); d[0] = lo; d[1] = hi; }
            if (lt < 128) { const u32x4 w = vreg; f32x4 lo, hi;
                lo[0] = bflo(w.x); lo[1] = bfhi(w.x); lo[2] = bflo(w.y); lo[3] = bfhi(w.y); hi[0] = bflo(w.z); hi[1] = bfhi(w.z); hi[2] = bflo(w.w); hi[3] = bfhi(w.w);
                LAS f32x4* d = (LAS f32x4*)(lds + SC_VOFF + (c & 1) * (SC_CH * 32 * 4) + lt * 32); d[0] = lo; d[1] = hi; }
            else if (lt < 160) { *(LAS f32x4*)(lds + SC_SOFF + (c & 1) * (SC_CH * 16) + (lt - 128) * 16) = sreg; }
        };
        gload(0); lwrite(0); gload(1);
        __syncthreads();
        for (int c = 0; c < NCH; ++c) {
            if (c + 1 < NCH) lwrite(c + 1);
            if (c + 2 < NCH) gload(c + 2);
            __syncthreads();
        }
    } else {
        const int rg = lane >> 3, j = lane & 7, rowl = wave * 8 + rg;
        f32x2 S[4]; S[0] = S[1] = S[2] = S[3] = (f32x2){0.f, 0.f};
        float ykeep = 0.f;
        __syncthreads();
        for (int c = 0; c < NCH; ++c) {
            const LAS unsigned char* bp = lds + (c & 1) * SC_BUF + j * 32;
            const LAS float* vb = (const LAS float*)(lds + SC_VOFF + (c & 1) * (SC_CH * 32 * 4)) + rowl;
            const LAS float* sb = (const LAS float*)(lds + SC_SOFF + (c & 1) * (SC_CH * 16));
#pragma unroll 4
            for (int s = 0; s < SC_CH; ++s) {
                const LAS f32x2* op = (const LAS f32x2*)(bp + s * 1280);
                f32x2 kk[4], wr[4], w[4], bb[4], kp[4];
#pragma unroll
                for (int i = 0; i < 4; ++i) { kk[i] = op[i]; wr[i] = op[32 + i]; w[i] = op[64 + i]; bb[i] = op[96 + i]; kp[i] = op[128 + i]; }
                const float v = vb[s * 32]; const f32x2 brkr = *(const LAS f32x2*)(sb + s * 4);
                f32x2 pa = S[0] * kk[0] + S[1] * kk[1]; pa = pa + S[2] * kk[2] + S[3] * kk[3];
                f32x2 py = S[0] * wr[0] + S[1] * wr[1]; py = py + S[2] * wr[2] + S[3] * wr[3];
                f32x2 sp[4];
#pragma unroll
                for (int i = 0; i < 4; ++i) sp[i] = S[i] * w[i] + kp[i] * v;
                const float sa = red8(pa.x + pa.y);
                const float ys = red8(py.x + py.y);
#pragma unroll
                for (int i = 0; i < 4; ++i) S[i] = sp[i] - bb[i] * sa;
                const float y = ys - sa * brkr.x + v * brkr.y;
                ykeep = ((s & 7) == j) ? y : ykeep;
                if ((s & 7) == 7) YA[(size_t)(c * SC_CH + (s - 7) + j) * 512 + rowl] = ykeep;
            }
            __syncthreads();
        }
    }
}

__device__ __forceinline__ int crow(int r, int hi) { return (r & 3) + 8 * (r >> 2) + 4 * hi; }
typedef short v4i16_t __attribute__((ext_vector_type(4)));
__device__ __forceinline__ s16x4 vtr(const LAS unsigned char* p) { return __builtin_bit_cast(s16x4, __builtin_amdgcn_ds_read_tr16_b64_v4i16((LAS v4i16_t*)p)); }
constexpr int AT_KS = 0, AT_VS = 9216, AT_BIAS = 18432, AT_WSF = 18688, AT_FLAG = 19712, AT_TASK = 19744;
__device__ __forceinline__ void attn_unit(const Args& a, LAS unsigned char* lds, int l, int bh, int qb, int tid, int lane, int wid) {
    const int b = bh >> 3, h = bh & 7, r32 = lane & 31, hi = lane >> 5;
    const int q0 = qb * 256;
    bf16* PB = (bf16*)(a.ws + WS_PB);
    const float* cumh = (const float*)(a.ws + WS_CUM) + (size_t)bh * T;
    const float kmax = ((const float*)(a.ws + WS_CTL))[CW_KMAX + 16 * l + bh];
    const size_t rowbase = (size_t)b * T;
    const bf16* Qp = PB + (rowbase + q0 + wid * 32 + r32) * LDB + h * 64;
    bf16x8 qr[4]; float qs = 0.f;
#pragma unroll
    for (int d0 = 0; d0 < 4; ++d0) { const u32x4 w = *(const u32x4*)(Qp + d0 * 16 + hi * 8); qr[d0] = __builtin_bit_cast(bf16x8, w);
        qs += bflo(w.x) * bflo(w.x) + bfhi(w.x) * bfhi(w.x) + bflo(w.y) * bflo(w.y) + bfhi(w.y) * bfhi(w.y) + bflo(w.z) * bflo(w.z) + bfhi(w.z) * bfhi(w.z) + bflo(w.w) * bflo(w.w) + bfhi(w.w) * bfhi(w.w); }
    qs += __shfl_xor(qs, 32);
    const float qbound = sqrtf(qs) * kmax * 1.01f + 0.01f;
    const float ref = cumh[q0 + 255];
    const int srow = tid >> 3, sch = tid & 7;
    const bf16* Kg = PB + rowbase * LDB + 512 + h * 64 + sch * 8; const bf16* Vg = Kg + 512;
    LAS unsigned char* Ks = lds + AT_KS; LAS unsigned char* Vs = lds + AT_VS; LAS float* biasL = (LAS float*)(lds + AT_BIAS);
    LAS float* wsf = (LAS float*)(lds + AT_WSF) + wid * 32; volatile LAS unsigned* flag = (volatile LAS unsigned*)(lds + AT_FLAG);
    if (tid < 3) flag[tid] = 0u;
    float m = -INFINITY, lsum = 0.f; f32x16 o0 = {}, o1 = {};
    u32x4 kreg, vreg; float breg = 0.f, bnx = 0.f;
    int j = qb * 4 + 3;
    { kreg = *(const u32x4*)(Kg + (size_t)(64 * j + srow) * LDB); vreg = *(const u32x4*)(Vg + (size_t)(64 * j + srow) * LDB);
      if (tid < 64) breg = (ref - cumh[64 * j + tid]) * L2E; bnx = j > 0 ? (ref - cumh[64 * j - 1]) * L2E : 0.f; }
    const int q4 = (lane & 15) >> 2, p4 = lane & 3, blk = (lane >> 4) & 1;
    const int qrow = q0 + wid * 32 + r32;
    int it = 0;
    __syncthreads();
    for (;;) {
        *(LAS u32x4*)(Ks + srow * 144 + sch * 16) = kreg; *(LAS u32x4*)(Vs + srow * 144 + sch * 16) = vreg; if (tid < 64) biasL[tid] = breg;
        const float bnx_cur = bnx;
        __syncthreads();
        if (j > 0) { const int jn = j - 1;
            kreg = *(const u32x4*)(Kg + (size_t)(64 * jn + srow) * LDB); vreg = *(const u32x4*)(Vg + (size_t)(64 * jn + srow) * LDB);
            if (tid < 64) breg = (ref - cumh[64 * jn + tid]) * L2E; bnx = jn > 0 ? (ref - cumh[64 * jn - 1]) * L2E : 0.f; }
        if (64 * j <= q0 + 32 * wid + 31) {
            f32x16 p0 = {}, p1 = {};
#pragma unroll
            for (int d0 = 0; d0 < 4; ++d0) {
                const bf16x8 k0 = *(const LAS bf16x8*)(Ks + r32 * 144 + d0 * 32 + hi * 16);
                const bf16x8 k1 = *(const LAS bf16x8*)(Ks + (32 + r32) * 144 + d0 * 32 + hi * 16);
                p0 = __builtin_amdgcn_mfma_f32_32x32x16_bf16(k0, qr[d0], p0, 0, 0, 0);
                p1 = __builtin_amdgcn_mfma_f32_32x32x16_bf16(k1, qr[d0], p1, 0, 0, 0); }
#pragma unroll
            for (int g = 0; g < 4; ++g) { const f32x4 b0 = *(const LAS f32x4*)(biasL + 8 * g + 4 * hi), b1 = *(const LAS f32x4*)(biasL + 32 + 8 * g + 4 * hi);
#pragma unroll
                for (int e = 0; e < 4; ++e) { p0[4 * g + e] += b0[e]; p1[4 * g + e] += b1[e]; } }
            if (64 * j + 63 > q0 + 32 * wid) {
#pragma unroll
                for (int r = 0; r < 16; ++r) { const int kv = 64 * j + crow(r, hi); if (kv > qrow) p0[r] = -INFINITY; if (kv + 32 > qrow) p1[r] = -INFINITY; } }
            float mx = fmaxf(p0[0], p1[0]);
#pragma unroll
            for (int r = 1; r < 16; ++r) mx = fmaxf(mx, fmaxf(p0[r], p1[r]));
            mx = fmaxf(mx, __shfl_xor(mx, 32));
            const float mnew = fmaxf(m, mx); const float f = __builtin_amdgcn_exp2f(m - mnew); m = mnew;
            float rs = 0.f;
#pragma unroll
            for (int r = 0; r < 16; ++r) { p0[r] = __builtin_amdgcn_exp2f(p0[r] - mnew); p1[r] = __builtin_amdgcn_exp2f(p1[r] - mnew); rs += p0[r] + p1[r]; }
            lsum = lsum * f + rs;
            if (__any(f != 1.f)) {
                if (hi == 0) wsf[r32] = f;
                asm volatile("s_waitcnt lgkmcnt(0)" ::: "memory");
#pragma unroll
                for (int r = 0; r < 16; ++r) { const float fr = wsf[crow(r, hi)]; o0[r] *= fr; o1[r] *= fr; }
            }
            u32x4 pw[4];
            pw[0] = (u32x4){cvtpk(p0[0], p0[1]), cvtpk(p0[2], p0[3]), cvtpk(p0[4], p0[5]), cvtpk(p0[6], p0[7])};
            pw[1] = (u32x4){cvtpk(p0[8], p0[9]), cvtpk(p0[10], p0[11]), cvtpk(p0[12], p0[13]), cvtpk(p0[14], p0[15])};
            pw[2] = (u32x4){cvtpk(p1[0], p1[1]), cvtpk(p1[2], p1[3]), cvtpk(p1[4], p1[5]), cvtpk(p1[6], p1[7])};
            pw[3] = (u32x4){cvtpk(p1[8], p1[9]), cvtpk(p1[10], p1[11]), cvtpk(p1[12], p1[13]), cvtpk(p1[14], p1[15])};
#pragma unroll
            for (int s = 0; s < 4; ++s) { const int kvb = 16 * (s & 1) + 32 * (s >> 1);
                const LAS unsigned char* va = Vs + (kvb + 4 * hi + q4) * 144 + (16 * blk + 4 * p4) * 2;
                const s16x4 l0 = vtr(va), h0 = vtr(va + 8 * 144), l1 = vtr(va + 64), h1 = vtr(va + 8 * 144 + 64);
                const bf16x8 vf0 = {l0[0], l0[1], l0[2], l0[3], h0[0], h0[1], h0[2], h0[3]}, vf1 = {l1[0], l1[1], l1[2], l1[3], h1[0], h1[1], h1[2], h1[3]};
                const bf16x8 pa = __builtin_bit_cast(bf16x8, pw[s]);
                o0 = __builtin_amdgcn_mfma_f32_32x32x16_bf16(pa, vf0, o0, 0, 0, 0);
                o1 = __builtin_amdgcn_mfma_f32_32x32x16_bf16(pa, vf1, o1, 0, 0, 0); }
        }
        if (j == 0) break;
        const bool need = (qbound + bnx_cur > m - 40.f);
        if (tid == 0) flag[(it + 1) % 3] = 0u;
        if (__any(need) && lane == 0) flag[it % 3] = 1u;
        __syncthreads();
        const unsigned cont = flag[it % 3];
        if (!cont) break;
        --j; ++it;
    }
    lsum += __shfl_xor(lsum, 32);
    if (hi == 0) wsf[r32] = 1.f / lsum;
    asm volatile("s_waitcnt lgkmcnt(0)" ::: "memory");
    bf16* Ow = PB + (rowbase + q0 + wid * 32) * LDB + h * 64 + r32;
#pragma unroll
    for (int r = 0; r < 16; ++r) { const float inv = wsf[crow(r, hi)]; bf16* op = Ow + (size_t)crow(r, hi) * LDB;
        op[0] = (bf16)f2bf(o0[r] * inv); op[32] = (bf16)f2bf(o1[r] * inv); }
    __syncthreads();
}
__device__ __forceinline__ void p3_phase(const Args& a, LAS unsigned char* lds, int l, int tid, int lane, int wave) {
    unsigned* ctr = (unsigned*)(a.ws + WS_CTL) + CW_QUEUE + 64 * l;
    volatile LAS unsigned* task = (volatile LAS unsigned*)(lds + AT_TASK);
    for (;;) {
        __syncthreads();
        if (tid == 0) task[0] = atomicAdd(ctr, 1u);
        __syncthreads();
        const unsigned tk = task[0];
        if (tk >= 32u + 1024u) break;
        if (tk < 32u) scan_wg(a, lds, (int)(tk >> 1), (int)(tk & 1), tid, lane, wave);
        else { const unsigned u = tk - 32u; attn_unit(a, lds, l, (int)(u & 15), 63 - (int)(u >> 4), tid, lane, wave); }
    }
}

__device__ __forceinline__ void merge_phase(const Args& a, int l, int tid, int lane, int wave, int G) {
    const float* YA = (const float*)(a.ws + WS_YA); const bf16* VS = (const bf16*)(a.ws + WS_VS); const bf16* PB = (const bf16*)(a.ws + WS_PB);
    const float* SCS = (const float*)(a.ws + WS_SCS); bf16* YM = (bf16*)(a.ws + WS_YM);
    const int c = tid, h = wave;
    const float gg = a.in[15][l * 512 + c], gb = a.in[16][l * 512 + c];
    for (int m = blockIdx.x; m < M; m += G) {
        const int b = m >= T ? 1 : 0, t = m - b * T;
        const float ya = YA[(size_t)m * 512 + c];
        const float v = bf2f(VS[(size_t)m * 512 + c]);
        const float g1 = bf2f(PB[(size_t)m * LDB + 1536 + c]), g2 = bf2f(PB[(size_t)m * LDB + 2048 + c]);
        const float yb = bf2f(PB[(size_t)m * LDB + c]);
        const float rkr = SCS[((size_t)(b * 8 + h) * T + t) * 4 + 2];
        const float mean = wave_sum(ya) * (1.f / 64.f); const float d = ya - mean; const float var = wave_sum(d * d) * (1.f / 64.f);
        const float yn = d * rsqrtf(var + GN_EPS) * gg + gb + rkr * v;
        YM[(size_t)m * D + c] = (bf16)f2bf(yn * g1); YM[(size_t)m * D + 512 + c] = (bf16)f2bf(yb * g2);
    }
}

#ifndef N_LAUNCH_MODE
#define N_LAUNCH_MODE 1
#endif
template <int MASK, bool COOP> __device__ __forceinline__ void run_phases(const Args& a, LAS unsigned char* lds, int l0, int l1) {
    const int G = gridDim.x;
#define LAUNDER() int tid = threadIdx.x; asm volatile("" : "+v"(tid)); const int lane = tid & 63, wave = __builtin_amdgcn_readfirstlane(tid >> 6); (void)lane; (void)wave
    float* hbuf = a.out;
    const float* mod = (const float*)(a.ws + WS_CTL) + CW_MOD;
    bf16* XN = (bf16*)(a.ws + WS_XN);
#define GSYNC() do { if constexpr (COOP) cg::this_grid().sync(); } while (0)
    if constexpr (MASK & 1) { LAUNDER(); p0a(a, lds, tid, lane, wave, G); GSYNC(); }
    if constexpr (MASK & 2) { LAUNDER(); ln_rows(a.in[0], a.in[2], a.in[3], hbuf, XN, mod, lane, wave, G); GSYNC(); }
#pragma unroll 1
    for (int l = l0; l < l1; ++l) {
        if constexpr (MASK & 4) { pg8::Gemm g{XN, (const bf16*)(a.ws + WS_WIN) + (size_t)l * NPROJ * 1024, M, NPROJ, 1024}; pg8::StaticOrder S; S.init(M, NPROJ, G, (int)blockIdx.x);
          EpiProj E{(bf16*)(a.ws + WS_PA), (bf16*)(a.ws + WS_PV), (bf16*)(a.ws + WS_PB)};
          pg8::gemm_phase<EpiProj, pg8::StaticOrder, true, true>(lds, g, S, E); GSYNC(); }
        if constexpr (MASK & 8) { LAUNDER(); prep_phase(a, lds, l, tid, lane, wave, G); GSYNC(); }
        if constexpr (MASK & 16) { LAUNDER(); p3_phase(a, lds, l, tid, lane, wave); GSYNC(); }
        if constexpr (MASK & 32) { LAUNDER(); merge_phase(a, l, tid, lane, wave, G); GSYNC(); }
        if constexpr (MASK & 64) { pg8::Gemm g{(const bf16*)(a.ws + WS_YM), (const bf16*)(a.ws + WS_WOUT) + (size_t)l * 1024 * 1024, M, D, D}; pg8::StaticOrder S; S.init(M, D, G, (int)blockIdx.x);
          EpiOut E{hbuf, mod + l * 2 * 3072};
          pg8::gemm_phase<EpiOut, pg8::StaticOrder, true, true>(lds, g, S, E); GSYNC(); }
        if constexpr (MASK & 128) { LAUNDER(); ln_rows(hbuf, a.in[19] + l * D, a.in[20] + l * D, hbuf, XN, (l + 1 < DEPTH) ? mod + (l + 1) * 2 * 3072 : nullptr, lane, wave, G);
          if (l + 1 < l1) GSYNC(); }
    }
#undef GSYNC
#undef LAUNDER
}
#ifndef FMASK
#define FMASK 0xFF
#endif
#if N_LAUNCH_MODE == 1
__global__ void __launch_bounds__(512, 2) hymba_fwd(Args a) {
    extern __shared__ __attribute__((aligned(16))) unsigned char lds_raw[];
    run_phases<FMASK, true>(a, (LAS unsigned char*)lds_raw, 0, DEPTH);
}
#else
template <int MASK> __global__ void __launch_bounds__(512, 2) hymba_phase(Args a, int l) {
    extern __shared__ __attribute__((aligned(16))) unsigned char lds_raw[];
    run_phases<MASK, false>(a, (LAS unsigned char*)lds_raw, l, l + 1);
}
template <int MASK> static void launch_phase(const Args& a, int l, hipStream_t stream) {
    static bool attr = false;
    if (!attr) { (void)hipFuncSetAttribute((const void*)hymba_phase<MASK>, hipFuncAttributeMaxDynamicSharedMemorySize, LDS_BYTES); attr = true; }
    hipLaunchKernelGGL(hymba_phase<MASK>, dim3(256), dim3(512), LDS_BYTES, stream, a, l);
}
#endif

extern "C" void kernel_launch(void* const* d_in, const int* in_sizes, int n_in, void* d_out, int out_size, void* d_ws, size_t ws_size, hipStream_t stream) {
    if (n_in != 21 || ws_size < WS_END) { fprintf(stderr, "kernel_launch: unexpected n_in %d / ws %zu\n", n_in, ws_size); return; }
    (void)hipMemsetAsync((char*)d_ws + WS_CTL, 0, CTL_ZERO_BYTES, stream);
    Args a{};
    for (int i = 0; i < 21; ++i) a.in[i] = (const float*)d_in[i];
    a.out = (float*)d_out; a.ws = (unsigned char*)d_ws;
#if N_LAUNCH_MODE == 1
    static int grid = 0;
    if (grid == 0) {
        int dev = 0, cus = 0, per_cu = 0;
        (void)hipGetDevice(&dev); (void)hipDeviceGetAttribute(&cus, hipDeviceAttributeMultiprocessorCount, dev);
        (void)hipFuncSetAttribute((const void*)hymba_fwd, hipFuncAttributeMaxDynamicSharedMemorySize, LDS_BYTES);
        (void)hipOccupancyMaxActiveBlocksPerMultiprocessor(&per_cu, (const void*)hymba_fwd, 512, LDS_BYTES);
        if (per_cu < 1) per_cu = 1;
        (void)hipGetLastError();
        grid = cus * per_cu;
    }
    void* args[] = {&a};
    hipError_t e = hipLaunchCooperativeKernel((const void*)hymba_fwd, dim3(grid), dim3(512), args, LDS_BYTES, stream);
    if (e != hipSuccess) fprintf(stderr, "cooperative launch failed: %s (grid %d)\n", hipGetErrorString(e), grid);
#else
    launch_phase<1>(a, 0, stream); launch_phase<2>(a, 0, stream);
    for (int l = 0; l < DEPTH; ++l) { launch_phase<4>(a, l, stream); launch_phase<8>(a, l, stream); launch_phase<16>(a, l, stream); launch_phase<32>(a, l, stream); launch_phase<64>(a, l, stream); launch_phase<128>(a, l, stream); }
#endif
}
```

```cpp
#include <hip/hip_runtime.h>
#include <cstdio>
#include <cstdint>
namespace pg8 {
#define PG8_LAS __attribute__((address_space(3)))
typedef unsigned short bf16_t;
typedef short bf16x8 __attribute__((ext_vector_type(8)));
typedef float f32x4 __attribute__((ext_vector_type(4)));
typedef unsigned u32x4 __attribute__((ext_vector_type(4)));
constexpr int BM = 256, BK = 64, HALF = 128, HTB = HALF * BK * 2  , STAGE_BYTES = 8 * HTB, NXCD = 8, WGM = 8;

__host__ __device__ __forceinline__ int lds_byte(int r, int c) { const int st = (r >> 4) * 2 + (c >> 5), rr = r & 15, cc = c & 31, ob = rr * 64 + cc * 2; return st * 1024 + (ob ^ (((ob >> 9) & 1) << 5)); }
__host__ __device__ __forceinline__ void stage_rc(int b, int& R, int& C) { const int st = b / 1024, sb = b % 1024, swz = sb ^ (((sb >> 9) & 1) << 5); R = (st >> 1) * 16 + swz / 64; C = (st & 1) * 32 + (swz % 64) / 2; }
__host__ __device__ __forceinline__ int perm32(int rho) { const int n = rho >> 4, i = rho & 15; return 8 * (i >> 2) + 4 * n + (i & 3); }

struct Unit { int pm, pn; };
struct Gemm { const bf16_t* A; const bf16_t* Bt; int M, N, K; };

struct StaticOrder {
    int nM, nN, nwg, G, c;
    __host__ __device__ void init(int M, int N, int G_, int c_) { nM = M / BM; nN = N / BM; nwg = nM * nN; G = G_; c = c_; }
    __host__ __device__ bool next(int i, Unit& u) const {
        const long L = (long)i * G + c; if (L >= nwg) return false;
        int wgid = (int)L; { const int q = nwg / NXCD, r = nwg % NXCD, xcd = wgid % NXCD, off = wgid / NXCD; wgid = (xcd < r ? xcd * (q + 1) : r * (q + 1) + (xcd - r) * q) + off; }
        const int nig = WGM * nN, gid = wgid / nig, fm = gid * WGM, gsz = (nM - fm) < WGM ? (nM - fm) : WGM;
        u.pm = fm + ((wgid % nig) % gsz); u.pn = (wgid % nig) / gsz; return true;
    }
    __device__ __forceinline__ void a_ready(const Unit&) const {}
    __device__ __forceinline__ void done(const Unit&) const {}
};

__device__ __forceinline__ unsigned cvt_pk_bf16(float lo, float hi) { unsigned r; asm volatile("v_cvt_pk_bf16_f32 %0, %1, %2" : "=v"(r) : "v"(lo), "v"(hi)); return r; }
typedef float f32x2 __attribute__((ext_vector_type(2)));
__device__ __forceinline__ f32x2 gelu_pk(f32x2 v) {
    const f32x2 av = __builtin_elementwise_abs(v), d = av * 0.2316418882f + 1.0f;
    f32x2 t; t.x = __builtin_amdgcn_rcpf(d.x); t.y = __builtin_amdgcn_rcpf(d.y);
    f32x2 q = t * 0.5307027145f + (-0.7265760135f); q = q * t + 0.7107068705f; q = q * t + (-0.142248368f); q = q * t + 0.127414796f; q = q * t;
    const f32x2 s = (v * v) * (-0.72134752044f);
    f32x2 e; e.x = __builtin_amdgcn_exp2f(s.x); e.y = __builtin_amdgcn_exp2f(s.y);
    const f32x2 m = v * (q * e), r = v - m;
    f32x2 o; o.x = v.x < 0.f ? m.x : r.x; o.y = v.y < 0.f ? m.y : r.y; return o;
}

template <int ACT  > struct EpiBf16 {
    static constexpr bool PERM = true, AFTER_DRAIN = false; static_assert(ACT == 0 || ACT == 1, "EpiBf16: ACT is 0 (none) or 1 (gelu_pk)");
    bf16_t* O; int ldc; const float* bias; int split_cols; size_t split_stride; float scale0;
    __device__ __forceinline__ void operator()(const f32x4 (&acc)[2][2][4][2], const Unit& u, int wr, int wc, int fr, int fq) const {
        const int row0 = u.pm * BM + wr * 64 + fr; int colt = u.pn * BM; bf16_t* base = O;
        float sc = 1.f; if (split_cols) { const int t = colt / split_cols; base += (size_t)t * split_stride; colt -= t * split_cols; if (t == 0) sc = scale0; }
        const int col0 = colt + wc * 32 + 8 * fq, bcol0 = u.pn * BM + wc * 32 + 8 * fq;
        f32x4 bv[2][2];
#pragma unroll
        for (int bj = 0; bj < 2; ++bj)
#pragma unroll
            for (int n = 0; n < 2; ++n) bv[bj][n] = bias ? *(const f32x4*)(bias + bcol0 + bj * HALF + 4 * n) : (f32x4){0.f, 0.f, 0.f, 0.f};
#pragma unroll
        for (int ai = 0; ai < 2; ++ai)
#pragma unroll
            for (int m = 0; m < 4; ++m) { bf16_t* rowp = base + (size_t)(row0 + ai * HALF + m * 16) * ldc + col0;
#pragma unroll
                for (int bj = 0; bj < 2; ++bj) { f32x4 v0 = acc[ai][bj][m][0] + bv[bj][0], v1 = acc[ai][bj][m][1] + bv[bj][1];
                    if (ACT == 1) { f32x2 a = gelu_pk((f32x2){v0[0], v0[1]}), b = gelu_pk((f32x2){v0[2], v0[3]}), c = gelu_pk((f32x2){v1[0], v1[1]}), d = gelu_pk((f32x2){v1[2], v1[3]});
                        v0 = (f32x4){a.x, a.y, b.x, b.y}; v1 = (f32x4){c.x, c.y, d.x, d.y}; }
                    v0 = v0 * sc; v1 = v1 * sc; u32x4 w; w.x = cvt_pk_bf16(v0[0], v0[1]); w.y = cvt_pk_bf16(v0[2], v0[3]); w.z = cvt_pk_bf16(v1[0], v1[1]); w.w = cvt_pk_bf16(v1[2], v1[3]);
                    *(u32x4*)(rowp + bj * HALF) = w; } }
    }
};

template <class Epi, class Sched, bool ALIGN_EPI = false, bool SP2 = false>
__device__ __forceinline__ void gemm_phase(PG8_LAS unsigned char* lds, const Gemm g, const Sched& S, const Epi& E) {
    int tid = threadIdx.x; asm volatile("" : "+v"(tid));
    const int wid = __builtin_amdgcn_readfirstlane(tid >> 6), lane = tid & 63, wr = wid >> 2, wc = wid & 3, fr = lane & 15, fq = lane >> 4;
    const int K = g.K, nt = K / BK;
    unsigned voffA[2], voffB[2];
#pragma unroll
    for (int i = 0; i < 2; ++i) { int R, C; stage_rc(tid * 16 + i * 8192, R, C); const int Rb = Epi::PERM ? ((R & ~31) + perm32(R & 31)) : R;
        voffA[i] = (unsigned)(R * K + C) * 2u; voffB[i] = (unsigned)(Rb * K + C) * 2u; }
    const size_t kstep = (size_t)(BK * 2);
    const size_t hstep = (size_t)HALF * K * 2;
    const size_t tstep = 2 * hstep;
    const unsigned ldsw = (unsigned)wid * 1024u;
    const int aoff = lds_byte(wr * 64 + fr, fq * 8), boff = lds_byte(wc * 32 + fr, fq * 8);
#define PG8_SA(b, h) (((b) * 2 + (h)) * HTB)
#define PG8_SB(b, h) ((4 + (b) * 2 + (h)) * HTB)
#define PG8_STAGE(bufoff, gbase, voff) do { _Pragma("unroll") for (int _i = 0; _i < 2; ++_i) \
        __builtin_amdgcn_global_load_lds((const unsigned*)((const char*)(gbase) + (voff)[_i]), (PG8_LAS unsigned*)(lds + (bufoff) + ldsw + _i * 8192), 16, 0, 0); } while (0)
#define PG8_LDA(dst, b, h) do { _Pragma("unroll") for (int m = 0; m < 4; ++m) _Pragma("unroll") for (int k = 0; k < 2; ++k) dst[m][k] = *(const PG8_LAS bf16x8*)(lds + PG8_SA(b, h) + aoff + m * 2048 + k * 1024); } while (0)
#define PG8_LDB(dst, b, h) do { _Pragma("unroll") for (int n = 0; n < 2; ++n) _Pragma("unroll") for (int k = 0; k < 2; ++k) dst[n][k] = *(const PG8_LAS bf16x8*)(lds + PG8_SB(b, h) + boff + n * 2048 + k * 1024); } while (0)
#define PG8_MMA(ai, bj, At, Bt) do { __builtin_amdgcn_s_setprio(1); _Pragma("unroll") for (int m = 0; m < 4; ++m) _Pragma("unroll") for (int n = 0; n < 2; ++n) _Pragma("unroll") for (int k = 0; k < 2; ++k) \
        acc[ai][bj][m][n] = __builtin_amdgcn_mfma_f32_16x16x32_bf16(Bt[n][k], At[m][k], acc[ai][bj][m][n], 0, 0, 0); __builtin_amdgcn_s_setprio(0); } while (0)
#define PG8_WAIT_V(n) asm volatile("s_waitcnt vmcnt(" #n ")" ::: "memory")
#define PG8_WAIT_L(n) asm volatile("s_waitcnt lgkmcnt(" #n ")" ::: "memory")
#define PG8_BAR __builtin_amdgcn_s_barrier()
#define PG8_SCHED __builtin_amdgcn_sched_barrier(0)
    Unit cur, nxt; int ui = 0;
    if (!S.next(0, cur)) return;
    f32x4 acc[2][2][4][2];
#pragma unroll
    for (int a = 0; a < 2; ++a)
#pragma unroll
        for (int b = 0; b < 2; ++b)
#pragma unroll
            for (int m = 0; m < 4; ++m)
#pragma unroll
                for (int n = 0; n < 2; ++n) acc[a][b][m][n] = (f32x4){0.f, 0.f, 0.f, 0.f};
    bf16x8 At[4][2], B0[2][2], B1[2][2];
    const char* cA = (const char*)g.A + (size_t)cur.pm * tstep; const char* cB = (const char*)g.Bt + (size_t)cur.pn * tstep;
    S.a_ready(cur);
    if constexpr (SP2) {
        PG8_STAGE(PG8_SB(0, 0), cB, voffB); PG8_STAGE(PG8_SB(0, 1), cB + hstep, voffB); PG8_STAGE(PG8_SA(0, 0), cA, voffA); PG8_STAGE(PG8_SA(0, 1), cA + hstep, voffA);
        if (wr == 1) PG8_BAR;
        PG8_WAIT_V(2); PG8_BAR;
        PG8_STAGE(PG8_SB(1, 0), cB + kstep, voffB); PG8_STAGE(PG8_SA(1, 0), cA + kstep, voffA); PG8_STAGE(PG8_SB(1, 1), cB + hstep + kstep, voffB);
        PG8_WAIT_V(6); PG8_BAR;
    } else {
        PG8_STAGE(PG8_SB(0, 0), cB, voffB); PG8_STAGE(PG8_SA(0, 0), cA, voffA); PG8_STAGE(PG8_SB(0, 1), cB + hstep, voffB); PG8_STAGE(PG8_SA(0, 1), cA + hstep, voffA);
        if (wr == 1) PG8_BAR;
        PG8_WAIT_V(4); PG8_BAR;
        PG8_STAGE(PG8_SB(1, 0), cB + kstep, voffB); PG8_STAGE(PG8_SA(1, 0), cA + kstep, voffA); PG8_STAGE(PG8_SB(1, 1), cB + hstep + kstep, voffB);
        PG8_WAIT_V(6); PG8_BAR;
    }
    for (;;) {
        const bool has_next = S.next(ui + 1, nxt);
        const char* nA = has_next ? (const char*)g.A + (size_t)nxt.pm * tstep : cA; const char* nB = has_next ? (const char*)g.Bt + (size_t)nxt.pn * tstep : cB;
        for (int t = 0; t < nt; t += 2) {
            const bool last = (t == nt - 2);
            const char* a1 = cA + (size_t)(t + 1) * kstep;
            const char* a2 = last ? nA : cA + (size_t)(t + 2) * kstep; const char* b2 = last ? nB : cB + (size_t)(t + 2) * kstep;
            const char* a3 = a2 + kstep; const char* b3 = b2 + kstep;
            if (last && has_next) S.a_ready(nxt);
            if constexpr (SP2) {
            PG8_LDB(B0, 0, 0); PG8_LDB(B1, 0, 1); PG8_SCHED; PG8_LDA(At, 0, 0); PG8_STAGE(PG8_SA(1, 1), a1 + hstep, voffA);
            PG8_WAIT_V(8); PG8_WAIT_L(0); PG8_BAR; PG8_MMA(0, 0, At, B0); PG8_MMA(0, 1, At, B1); PG8_BAR; PG8_SCHED;
            PG8_LDA(At, 0, 1); PG8_STAGE(PG8_SB(0, 0), b2, voffB); PG8_STAGE(PG8_SB(0, 1), b2 + hstep, voffB); PG8_STAGE(PG8_SA(0, 0), a2, voffA);
            PG8_WAIT_V(8); PG8_WAIT_L(0); PG8_BAR; PG8_MMA(1, 0, At, B0); PG8_MMA(1, 1, At, B1); PG8_BAR; PG8_SCHED;
            PG8_LDB(B0, 1, 0); PG8_LDB(B1, 1, 1); PG8_SCHED; PG8_LDA(At, 1, 0); PG8_STAGE(PG8_SA(0, 1), a2 + hstep, voffA);
            PG8_WAIT_V(8); PG8_WAIT_L(0); PG8_BAR; PG8_MMA(0, 0, At, B0); PG8_MMA(0, 1, At, B1); PG8_BAR; PG8_SCHED;
            PG8_LDA(At, 1, 1); PG8_STAGE(PG8_SB(1, 0), b3, voffB); PG8_STAGE(PG8_SB(1, 1), b3 + hstep, voffB); PG8_STAGE(PG8_SA(1, 0), a3, voffA);
            PG8_WAIT_V(8); PG8_WAIT_L(0); PG8_BAR; PG8_MMA(1, 0, At, B0); PG8_MMA(1, 1, At, B1); PG8_BAR; PG8_SCHED;
            } else {
            PG8_LDB(B0, 0, 0); PG8_SCHED; PG8_LDA(At, 0, 0); PG8_STAGE(PG8_SA(1, 1), a1 + hstep, voffA);
            PG8_WAIT_L(8); PG8_BAR; PG8_WAIT_L(0); PG8_MMA(0, 0, At, B0); PG8_BAR; PG8_SCHED;
            PG8_LDB(B1, 0, 1); PG8_STAGE(PG8_SB(0, 0), b2, voffB);
            PG8_BAR; PG8_WAIT_L(0); PG8_MMA(0, 1, At, B1); PG8_BAR;
            PG8_LDA(At, 0, 1); PG8_STAGE(PG8_SA(0, 0), a2, voffA);
            PG8_BAR; PG8_WAIT_L(0); PG8_MMA(1, 0, At, B0); PG8_BAR; PG8_SCHED;
            PG8_STAGE(PG8_SB(0, 1), b2 + hstep, voffB);
            PG8_WAIT_V(6); PG8_BAR; PG8_MMA(1, 1, At, B1); PG8_BAR;
            PG8_LDB(B0, 1, 0); PG8_SCHED; PG8_LDA(At, 1, 0); PG8_STAGE(PG8_SA(0, 1), a2 + hstep, voffA);
            PG8_WAIT_L(8); PG8_BAR; PG8_WAIT_L(0); PG8_MMA(0, 0, At, B0); PG8_BAR; PG8_SCHED;
            PG8_LDB(B1, 1, 1); PG8_STAGE(PG8_SB(1, 0), b3, voffB);
            PG8_BAR; PG8_WAIT_L(0); PG8_MMA(0, 1, At, B1); PG8_BAR;
            PG8_LDA(At, 1, 1); PG8_STAGE(PG8_SA(1, 0), a3, voffA);
            PG8_BAR; PG8_WAIT_L(0); PG8_MMA(1, 0, At, B0); PG8_BAR; PG8_SCHED;
            PG8_STAGE(PG8_SB(1, 1), b3 + hstep, voffB);
            PG8_WAIT_V(6); PG8_BAR; PG8_MMA(1, 1, At, B1); PG8_BAR;
            }
        }
        if constexpr (ALIGN_EPI) { if (wr == 0) PG8_BAR; }
        if constexpr (!Epi::AFTER_DRAIN) { E(acc, cur, wr, wc, fr, fq); S.done(cur); }
        if (!has_next) break;
#pragma unroll
        for (int a = 0; a < 2; ++a)
#pragma unroll
            for (int b = 0; b < 2; ++b)
#pragma unroll
                for (int m = 0; m < 4; ++m)
#pragma unroll
                    for (int n = 0; n < 2; ++n) acc[a][b][m][n] = (f32x4){0.f, 0.f, 0.f, 0.f};
        cur = nxt; cA = nA; cB = nB; ++ui;
        if constexpr (ALIGN_EPI) { if (wr == 1) PG8_BAR; }
    }
    PG8_WAIT_V(0);
    if constexpr (!ALIGN_EPI) { if (wr == 0) PG8_BAR; }
    PG8_BAR;
    if constexpr (Epi::AFTER_DRAIN) { E.fused(acc, cur, wr, wc, fr, fq, lds, wid, lane); S.done(cur); }
#undef PG8_SA
#undef PG8_SB
#undef PG8_STAGE
#undef PG8_LDA
#undef PG8_LDB
#undef PG8_MMA
#undef PG8_WAIT_V
#undef PG8_WAIT_L
#undef PG8_BAR
#undef PG8_SCHED
}
}
#include <hip/hip_cooperative_groups.h>
namespace cg = cooperative_groups;
#define LAS __attribute__((address_space(3)))
typedef unsigned short bf16;
typedef float f32x4 __attribute__((ext_vector_type(4)));
typedef float f32x2 __attribute__((ext_vector_type(2)));
typedef float f32x16 __attribute__((ext_vector_type(16)));
typedef short bf16x8 __attribute__((ext_vector_type(8)));
typedef short s16x4 __attribute__((ext_vector_type(4)));
typedef unsigned u32x4 __attribute__((ext_vector_type(4)));
typedef unsigned u32x2 __attribute__((ext_vector_type(2)));
typedef __bf16 bf16x2_t __attribute__((ext_vector_type(2)));

constexpr int BATCH = 2, T = 16384, D = 1024, M = BATCH * T, DEPTH = 2;
constexpr int NPROJ = 4352, NSRC = 4232;
constexpr int LDA = 1280, LDV = 512, LDB = 2560;
constexpr float LN_EPS = 1e-5f, GN_EPS = 64e-5f;
constexpr float DN_ALPHA = 1.41421356237f;
constexpr float C2 = 0.125f * 1.4426950408889634f;
constexpr float L2E = 1.4426950408889634f;
constexpr size_t MiB = 1u << 20;
constexpr size_t WS_CTL = 0, CTL_ZERO_BYTES = 1 * MiB;
constexpr size_t WS_WIN = 2 * MiB, WS_WOUT = 20 * MiB, WS_CUM = 24 * MiB, WS_SCS = 25 * MiB, WS_SCN = 30 * MiB;
constexpr size_t WS_XN = WS_SCN, WS_YM = WS_SCN;
constexpr size_t WS_PA = 190 * MiB, WS_YA = WS_PA, WS_PV = 270 * MiB, WS_PB = 302 * MiB, WS_VS = 462 * MiB, WS_FS = 494 * MiB, WS_END = 498 * MiB;
constexpr int CW_QUEUE = 64;
constexpr int CW_KMAX = 1024;
constexpr int CW_MOD = 16384;
constexpr int LDS_BYTES = 147456;
#ifndef PROBE_REP
#define PROBE_REP 0
#endif

__device__ __forceinline__ unsigned f2bf(float f) { unsigned u = __builtin_bit_cast(unsigned, f); return (u + 0x7fffu + ((u >> 16) & 1u)) >> 16; }
__device__ __forceinline__ unsigned pk2(float lo, float hi) { return f2bf(lo) | (f2bf(hi) << 16); }
__device__ __forceinline__ float bf2f(unsigned short v) { return __uint_as_float(((unsigned)v) << 16); }
__device__ __forceinline__ float bflo(unsigned w) { return __uint_as_float(w << 16); }
__device__ __forceinline__ float bfhi(unsigned w) { return __uint_as_float(w & 0xffff0000u); }
__device__ __forceinline__ unsigned cvtpk(float lo, float hi) { f32x2 v = {lo, hi}; bf16x2_t b = __builtin_convertvector(v, bf16x2_t); return __builtin_bit_cast(unsigned, b); }
__device__ __forceinline__ float wave_sum(float v) {
#pragma unroll
    for (int o = 1; o < 64; o <<= 1) v += __shfl_xor(v, o);
    return v;
}
__device__ __forceinline__ float fast_sigmoid(float x) { return 1.f / (1.f + __expf(-x)); }

struct Args { const float* in[21]; float* out; unsigned char* ws; };

struct EpiProj {
    static constexpr bool PERM = true, AFTER_DRAIN = false;
    bf16 *PA, *PVb, *PB;
    __device__ __forceinline__ void operator()(const pg8::f32x4 (&acc)[2][2][4][2], const pg8::Unit& u, int wr, int wc, int fr, int fq) const {
        const int row0 = u.pm * 256 + wr * 64 + fr; const int pn = u.pn;
        bf16* base; int ldc, colt; float sc = 1.f; bool act = false;
        if (pn < 4) { base = PA; ldc = LDA; colt = pn * 256; }
        else if (pn < 6) { base = PVb; ldc = LDV; colt = (pn - 4) * 256; }
        else if (pn == 6) { base = PA; ldc = LDA; colt = 1024; }
        else { base = PB; ldc = LDB; colt = (pn - 7) * 256; if (pn < 9) sc = C2; if (pn >= 13) act = true; }
        const int col0 = colt + wc * 32 + 8 * fq;
#pragma unroll
        for (int ai = 0; ai < 2; ++ai)
#pragma unroll
            for (int m = 0; m < 4; ++m) { bf16* rowp = base + (size_t)(row0 + ai * 128 + m * 16) * ldc + col0;
#pragma unroll
                for (int bj = 0; bj < 2; ++bj) { pg8::f32x4 v0 = acc[ai][bj][m][0], v1 = acc[ai][bj][m][1];
                    if (act) {
#pragma unroll
                        for (int e = 0; e < 4; ++e) { v0[e] = v0[e] * fast_sigmoid(v0[e]); v1[e] = v1[e] * fast_sigmoid(v1[e]); } }
                    v0 = v0 * sc; v1 = v1 * sc; u32x4 w; w.x = cvtpk(v0[0], v0[1]); w.y = cvtpk(v0[2], v0[3]); w.z = cvtpk(v1[0], v1[1]); w.w = cvtpk(v1[2], v1[3]);
                    *(u32x4*)(rowp + bj * 128) = w; } }
    }
};
struct EpiOut {
    static constexpr bool PERM = false, AFTER_DRAIN = false;
    float* hz; const float* modl;
    __device__ __forceinline__ void operator()(const pg8::f32x4 (&acc)[2][2][4][2], const pg8::Unit& u, int wr, int wc, int fr, int fq) const {
        const int col0 = u.pn * 256 + wc * 32 + 4 * fq; const int b = (u.pm * 256) >= T ? 1 : 0; const float* gate = modl + b * 3072 + 2048;
#pragma unroll
        for (int bj = 0; bj < 2; ++bj)
#pragma unroll
            for (int n = 0; n < 2; ++n) { const int c = col0 + bj * 128 + n * 16; const f32x4 g = *(const f32x4*)(gate + c) + 1.0f;
#pragma unroll
                for (int ai = 0; ai < 2; ++ai)
#pragma unroll
                    for (int m = 0; m < 4; ++m) { const int r = u.pm * 256 + ai * 128 + wr * 64 + m * 16 + fr; float* p = hz + (size_t)r * D + c;
                        const f32x4 hx = *(const f32x4*)p; f32x4 a; a[0] = acc[ai][bj][m][n][0]; a[1] = acc[ai][bj][m][n][1]; a[2] = acc[ai][bj][m][n][2]; a[3] = acc[ai][bj][m][n][3];
                        *(f32x4*)p = hx * DN_ALPHA + g * a; } }
    }
};

__device__ __forceinline__ int win_map(int n) { if (n < 1664) return n; if (n < 1672) return 3200 + n - 1664; if (n < 1792) return -1; if (n < 3328) return n - 128; return n - 120; }
template <bool MAP> __device__ __forceinline__ void transpose_item(const float* W, int Nsrc, int Ndst, bf16* WT, LAS float* scr, int item, int lane) {
    const int nblk = Ndst / 32, kb = item / nblk, nb = item % nblk, k0 = 64 * kb, n0 = 32 * nb;
    const int src = MAP ? win_map(n0 + (lane & 31)) : n0 + (lane & 31);
#pragma unroll 8
    for (int i = 0; i < 32; ++i) { const int kk = 2 * i + (lane >> 5); scr[kk * 33 + (lane & 31)] = src >= 0 ? W[(size_t)(k0 + kk) * Nsrc + src] : 0.f; }
    asm volatile("s_waitcnt lgkmcnt(0)" ::: "memory");
    const int c = lane & 7;
#pragma unroll
    for (int j = 0; j < 4; ++j) { const int n = (lane >> 3) + 8 * j; const LAS float* s = scr + (8 * c) * 33 + n;
        u32x4 o; o.x = pk2(s[0 * 33], s[1 * 33]); o.y = pk2(s[2 * 33], s[3 * 33]); o.z = pk2(s[4 * 33], s[5 * 33]); o.w = pk2(s[6 * 33], s[7 * 33]);
        *(u32x4*)(WT + (size_t)(n0 + n) * 1024 + k0 + 8 * c) = o; }
    asm volatile("s_waitcnt lgkmcnt(0)" ::: "memory");
}
__device__ __forceinline__ void p0a(const Args& a, LAS unsigned char* lds, int tid, int lane, int wave, int G) {
    LAS float* scr = (LAS float*)(lds + wave * 16384);
    const int gw = blockIdx.x * 8 + wave, NGW = G * 8;
    constexpr int I_IN = 16 * (NPROJ / 32), I_OUT = 16 * 32;
    for (int it = gw; it < 2 * (I_IN + I_OUT); it += NGW) {
        int r = it; const int l = r / (I_IN + I_OUT); r -= l * (I_IN + I_OUT);
        if (r < I_IN) transpose_item<true>(a.in[6] + (size_t)l * 1024 * NSRC, NSRC, NPROJ, (bf16*)(a.ws + WS_WIN) + (size_t)l * NPROJ * 1024, scr, r, lane);
        else transpose_item<false>(a.in[18] + (size_t)l * 1024 * 1024, 1024, 1024, (bf16*)(a.ws + WS_WOUT) + (size_t)l * 1024 * 1024, scr, r - I_IN, lane);
    }
    float* mod = (float*)(a.ws + WS_CTL) + CW_MOD;
    const float* cvec = a.in[1];
    for (int w = blockIdx.x * 512 + tid; w < 2 * 16 * 3072; w += G * 512) {
        const int j = w % 3072, sl = (w / 3072) % 16, l = w / (3072 * 16);
        const float* wa = a.in[4] + (size_t)l * 1024 * 3072 + (size_t)(sl * 64) * 3072 + j;
        float s0 = 0.f, s1 = 0.f;
#pragma unroll 8
        for (int i = 0; i < 64; ++i) { const float wv = wa[(size_t)i * 3072]; s0 += cvec[sl * 64 + i] * wv; s1 += cvec[1024 + sl * 64 + i] * wv; }
        if (sl == 0) { const float bb = a.in[5][l * 3072 + j]; s0 += bb; s1 += bb; }
        atomicAdd(mod + (l * 2 + 0) * 3072 + j, s0); atomicAdd(mod + (l * 2 + 1) * 3072 + j, s1);
    }
}
__device__ __forceinline__ void ln_rows(const float* src, const float* g, const float* bb, float* dst, bf16* xn, const float* modn, int lane, int wave, int G) {
    const int gw = blockIdx.x * 8 + wave, NGW = G * 8;
    f32x4 gv[4], bv[4];
#pragma unroll
    for (int j = 0; j < 4; ++j) { gv[j] = ((const f32x4*)g)[lane + 64 * j]; bv[j] = ((const f32x4*)bb)[lane + 64 * j]; }
    for (int m = gw; m < M; m += NGW) {
        const f32x4* xr = (const f32x4*)(src + (size_t)m * D) + lane;
        f32x4 v[4]; float s = 0.f;
#pragma unroll
        for (int j = 0; j < 4; ++j) { v[j] = xr[64 * j]; s += (v[j].x + v[j].y) + (v[j].z + v[j].w); }
        const float mean = wave_sum(s) * (1.f / D); float s2 = 0.f;
#pragma unroll
        for (int j = 0; j < 4; ++j) { v[j] = v[j] - mean; s2 += (v[j].x * v[j].x + v[j].y * v[j].y) + (v[j].z * v[j].z + v[j].w * v[j].w); }
        const float rstd = 1.f / sqrtf(wave_sum(s2) * (1.f / D) + LN_EPS);
        f32x4* o = (f32x4*)(dst + (size_t)m * D) + lane;
        const int b = m >= T ? 1 : 0;
#pragma unroll
        for (int j = 0; j < 4; ++j) { const f32x4 hv = v[j] * rstd * gv[j] + bv[j]; o[64 * j] = hv;
            if (modn) { const f32x4 sh = ((const f32x4*)(modn + b * 3072))[lane + 64 * j], sc = ((const f32x4*)(modn + b * 3072 + 1024))[lane + 64 * j];
                const f32x4 y = hv * (sc + 1.0f) + sh; u32x2 w; w.x = pk2(y.x, y.y); w.y = pk2(y.z, y.w);
                *((u32x2*)(xn + (size_t)m * D) + lane + 64 * j) = w; } }
    }
}
__device__ __forceinline__ float tanh_fast(float x) { const float e = __expf(2.f * x); return 1.f - 2.f / (e + 1.f); }
__device__ __forceinline__ void cum_kmax(const Args& a, LAS unsigned char* lds, int l, int bh, int tid, int lane, int wave) {
    const int b = bh >> 3, h = bh & 7;
    const bf16* PA = (const bf16*)(a.ws + WS_PA); const bf16* PB = (const bf16*)(a.ws + WS_PB);
    float* cum = (float*)(a.ws + WS_CUM) + (size_t)bh * T;
    const float bf = a.in[17][l * 8 + h];
    LAS float* red = (LAS float*)lds;
    const int t0 = tid * 32;
    float s = 0.f, kmx = 0.f;
#pragma unroll 1
    for (int i = 0; i < 32; ++i) { const size_t m = (size_t)b * T + t0 + i;
        const float z = bf2f(PA[m * LDA + 1152 + h]) + bf;
        const float lf = fminf(z, 0.f) - log1pf(__expf(-fabsf(z)));
        s += lf; cum[t0 + i] = s;
        const u32x4* kr = (const u32x4*)(PB + m * LDB + 512 + h * 64); float q = 0.f;
#pragma unroll
        for (int c = 0; c < 8; ++c) { const u32x4 w = kr[c];
            q += bflo(w.x) * bflo(w.x) + bfhi(w.x) * bfhi(w.x) + bflo(w.y) * bflo(w.y) + bfhi(w.y) * bfhi(w.y) + bflo(w.z) * bflo(w.z) + bfhi(w.z) * bfhi(w.z) + bflo(w.w) * bflo(w.w) + bfhi(w.w) * bfhi(w.w); }
        kmx = fmaxf(kmx, q); }
    red[tid] = s;
#pragma unroll
    for (int o = 1; o < 64; o <<= 1) kmx = fmaxf(kmx, __shfl_xor(kmx, o));
    if (lane == 0) red[512 + wave] = kmx;
    __syncthreads();
    if (tid == 0) { float run = 0.f; for (int i = 0; i < 512; ++i) { const float v = red[i]; red[i] = run; run += v; }
        float k = 0.f; for (int i = 0; i < 8; ++i) k = fmaxf(k, red[512 + i]);
        ((float*)(a.ws + WS_CTL))[CW_KMAX + 16 * l + bh] = sqrtf(k); }
    __syncthreads();
    const float off = red[tid];
#pragma unroll 1
    for (int i = 0; i < 32; ++i) cum[t0 + i] += off;
    __syncthreads();
}
__device__ __forceinline__ void prep_phase(const Args& a, LAS unsigned char* lds, int l, int tid, int lane, int wave, int G) {
    const bf16* PA = (const bf16*)(a.ws + WS_PA); const bf16* PV = (const bf16*)(a.ws + WS_PV);
    bf16* SCN = (bf16*)(a.ws + WS_SCN); float* SCS = (float*)(a.ws + WS_SCS); bf16* VS = (bf16*)(a.ws + WS_VS);
    LAS unsigned* Wl = (LAS unsigned*)lds;
    LAS float* low = (LAS float*)(lds + 131072);
    const int c = tid, h = wave;
    { const float* wu = a.in[9] + (size_t)l * 64 * 512 + c; const float* au = a.in[11] + (size_t)l * 64 * 512 + c;
#pragma unroll 8
      for (int i = 0; i < 64; ++i) Wl[i * 512 + c] = pk2(wu[i * 512], au[i * 512]); }
    const float* mix = a.in[7] + l * 1664;
    const float mix_r = mix[c], mix_k = mix[512 + c], mix_v = mix[1024 + c];
    const float mlow0 = mix[1536 + (tid & 127)];
    const float w0c = a.in[8][l * 512 + c], a0c = a.in[10][l * 512 + c], kkc = a.in[12][l * 512 + c], kac = a.in[13][l * 512 + c], rkc = a.in[14][l * 512 + c];
    __syncthreads();
    for (int chunk = blockIdx.x; chunk < M / 64; chunk += G) {
        const int m0 = chunk * 64, b = m0 >= T ? 1 : 0, t0 = m0 - b * T; const int bh = b * 8 + h;
        float pr = 0.f, pk = 0.f, pv = 0.f;
        if (t0 > 0) { pr = bf2f(PA[(size_t)(m0 - 1) * LDA + c]); pk = bf2f(PA[(size_t)(m0 - 1) * LDA + 512 + c]); pv = bf2f(PV[(size_t)(m0 - 1) * LDV + c]); }
#pragma unroll 1
        for (int g = 0; g < 8; ++g) {
#pragma unroll
            for (int e = 0; e < 2; ++e) { const int idx = tid + 512 * e, tt = idx >> 7, i = idx & 127; const int m = m0 + g * 8 + tt, t = t0 + g * 8 + tt;
                const float cur = bf2f(PA[(size_t)m * LDA + 1024 + i]); const float prev = t > 0 ? bf2f(PA[(size_t)(m - 1) * LDA + 1024 + i]) : 0.f;
                float val = cur + (prev - cur) * mlow0; if (i < 64) val = tanh_fast(val);
                low[i * 8 + tt] = val; }
            __syncthreads();
            f32x4 wlA = {0.f, 0.f, 0.f, 0.f}, wlB = wlA, alA = wlA, alB = wlA;
#pragma unroll 4
            for (int i = 0; i < 64; ++i) { const unsigned wp = Wl[i * 512 + c]; const float wv = bflo(wp), av = bfhi(wp);
                const LAS f32x4* lx = (const LAS f32x4*)(low + i * 8); const LAS f32x4* ly = (const LAS f32x4*)(low + (64 + i) * 8);
                wlA += lx[0] * wv; wlB += lx[1] * wv; alA += ly[0] * av; alB += ly[1] * av; }
#pragma unroll
            for (int tt = 0; tt < 8; ++tt) {
                const int m = m0 + g * 8 + tt, t = t0 + g * 8 + tt;
                const float cr = bf2f(PA[(size_t)m * LDA + c]), ck = bf2f(PA[(size_t)m * LDA + 512 + c]), cv = bf2f(PV[(size_t)m * LDV + c]);
                const float r = cr + (pr - cr) * mix_r, k = ck + (pk - ck) * mix_k, v = cv + (pv - cv) * mix_v; pr = cr; pk = ck; pv = cv;
                const float wl = w0c + (tt < 4 ? wlA[tt & 3] : wlB[tt & 3]), al = a0c + (tt < 4 ? alA[tt & 3] : alB[tt & 3]);
                const float z = -wl; const float sp = fmaxf(z, 0.f) + log1pf(__expf(-fabsf(z)));
                const float e = __expf(-sp - 0.5f); const float omw = -expm1f(-e);
                const float av = fast_sigmoid(al);
                const float kkr = k * kkc; const float ss = wave_sum(kkr * kkr); const float kk = kkr / fmaxf(sqrtf(ss), 1e-12f);
                const float kp = k * (1.f + (av - 1.f) * kac); const float bbv = kk * av; const float wr = (1.f - omw) * r;
                const float br = wave_sum(bbv * r), kr = wave_sum(kp * r), rkr = wave_sum(r * kp * rkc);
                bf16* rec = SCN + ((size_t)bh * T + t) * 320 + lane;
                rec[0] = (bf16)f2bf(kk); rec[64] = (bf16)f2bf(wr); rec[128] = (bf16)f2bf(omw); rec[192] = (bf16)f2bf(bbv); rec[256] = (bf16)f2bf(kp);
                VS[(size_t)m * 512 + c] = (bf16)f2bf(v);
                if (lane == 0) { f32x4 sc = {br, kr, rkr, 0.f}; *(f32x4*)(SCS + ((size_t)bh * T + t) * 4) = sc; }
                __builtin_amdgcn_sched_barrier(0);
            }
            __syncthreads();
        }
    }
    __syncthreads();
    asm volatile("" ::: "memory");
#ifndef NOCUM
    if (blockIdx.x < 16) cum_kmax(a, lds, l, blockIdx.x, tid, lane, wave);
#endif
}

__device__ __forceinline__ float dppf(float x, const int ctrl_sel) {
    unsigned u = __float_as_uint(x), r;
    if (ctrl_sel == 0) r = __builtin_amdgcn_update_dpp(0, u, 0xB1, 0xF, 0xF, true);
    else if (ctrl_sel == 1) r = __builtin_amdgcn_update_dpp(0, u, 0x4E, 0xF, 0xF, true);
    else r = __builtin_amdgcn_update_dpp(0, u, 0x141, 0xF, 0xF, true);
    return __uint_as_float(r);
}
__device__ __forceinline__ float red8(float x) { x += dppf(x, 0); x += dppf(x, 1); x += dppf(x, 2); return x; }
constexpr int SC_CH = 32, SC_BUF = SC_CH * 320 * 4, SC_VOFF = 2 * SC_BUF, SC_SOFF = SC_VOFF + 2 * SC_CH * 32 * 4, SC_ROWB = SC_SOFF + 2 * SC_CH * 16;
constexpr int NSEG = 8, SEGLEN = T / NSEG;
struct ScanOps { f32x4 kk, wr, w, bb, kp; float v; f32x2 brkr; };
__device__ __forceinline__ void scan_ld(ScanOps& o, const LAS unsigned char* bp, const LAS float* vb, const LAS float* sb, int s) {
    const LAS f32x4* op = (const LAS f32x4*)(bp + s * 1280);
    o.kk = op[0]; o.wr = op[16]; o.w = op[32]; o.bb = op[48]; o.kp = op[64];
    o.v = vb[s * 32]; o.brkr = *(const LAS f32x2*)(sb + s * 4);
}
__device__ __forceinline__ float red16(float x) {
    x += __uint_as_float(__builtin_amdgcn_update_dpp(0, __float_as_uint(x), 0xB1, 0xF, 0xF, true));
    x += __uint_as_float(__builtin_amdgcn_update_dpp(0, __float_as_uint(x), 0x4E, 0xF, 0xF, true));
    x += __uint_as_float(__builtin_amdgcn_update_dpp(0, __float_as_uint(x), 0x141, 0xF, 0xF, true));
    x += __uint_as_float(__builtin_amdgcn_update_dpp(0, __float_as_uint(x), 0x140, 0xF, 0xF, true));
    return x;
}
template <bool PASSC> __device__ __forceinline__ void scan_task(const Args& a, LAS unsigned char* lds, int bh, int seg, int rb, int tid, int lane, int wave) {
    const int b = bh >> 3, h = bh & 7;
    const bool ident = !PASSC && rb >= 2; const int row0 = (rb & 1) * 32;
    const int t0 = seg * SEGLEN;
    const bf16* SCN = (const bf16*)(a.ws + WS_SCN) + ((size_t)bh * T + t0) * 320;
    const float* SCS = (const float*)(a.ws + WS_SCS) + ((size_t)bh * T + t0) * 4;
    const bf16* VS = (const bf16*)(a.ws + WS_VS) + ((size_t)b * T + t0) * 512 + h * 64 + row0;
    float* YA = (float*)(a.ws + WS_YA) + ((size_t)b * T + t0) * 512 + h * 64 + row0;
    float* FSb = (float*)(a.ws + WS_FS) + (size_t)bh * NSEG * 128 * 64;
    constexpr int NCH = SEGLEN / SC_CH;
    const int rowl = tid >> 4, j = lane & 15;
    f32x4 S = {0.f, 0.f, 0.f, 0.f};
    __syncthreads();
    if constexpr (PASSC) {
        LAS float* rowb = (LAS float*)(lds + SC_ROWB);
        for (int k = 0; k < seg; ++k) {
            const float* Pk = FSb + ((size_t)k * 128 + 64) * 64; const float* Uk = FSb + ((size_t)k * 128 + row0 + rowl) * 64;
            *(LAS f32x4*)(rowb + rowl * 64 + 4 * j) = S;
            __syncthreads();
            f32x4 acc = *(const f32x4*)(Uk + 4 * j);
#pragma unroll 8
            for (int jj = 0; jj < 64; ++jj) acc += *(const f32x4*)(Pk + jj * 64 + 4 * j) * rowb[rowl * 64 + jj];
            S = acc;
            __syncthreads();
        }
    } else if (ident) {
#pragma unroll
        for (int e = 0; e < 4; ++e) S[e] = (4 * j + e == row0 + rowl) ? 1.f : 0.f;
    }
    u32x4 mreg[3]; u32x4 vreg = {0u, 0u, 0u, 0u}; f32x4 sreg;
    auto gload = [&](int c) {
        const u32x4* src = (const u32x4*)(SCN + (size_t)c * SC_CH * 320);
#pragma unroll
        for (int i = 0; i < 3; ++i) { const int p = tid + 512 * i; if (p < 1280) mreg[i] = src[p]; }
        if (tid < 128) { if (!ident) vreg = *(const u32x4*)(VS + (size_t)(c * SC_CH + (tid >> 2)) * 512 + (tid & 3) * 8); }
        else if (tid < 160) { sreg = *(const f32x4*)(SCS + (size_t)(c * SC_CH + (tid - 128)) * 4); }
    };
    auto lwrite = [&](int c) {
        LAS unsigned char* bp = lds + (c & 1) * SC_BUF;
#pragma unroll
        for (int i = 0; i < 3; ++i) { const int p = tid + 512 * i; const int arr = (p >> 3) % 5;
            if (p < 1280) { const u32x4 w = mreg[i]; f32x4 lo, hi;
                lo[0] = bflo(w.x); lo[1] = bfhi(w.x); lo[2] = bflo(w.y); lo[3] = bfhi(w.y); hi[0] = bflo(w.z); hi[1] = bfhi(w.z); hi[2] = bflo(w.w); hi[3] = bfhi(w.w);
                if (arr == 2) { lo = 1.0f - lo; hi = 1.0f - hi; }
                LAS f32x4* d = (LAS f32x4*)(bp + (size_t)p * 32); d[0] = lo; d[1] = hi; } }
        if (tid < 128) { const u32x4 w = vreg; f32x4 lo, hi;
            lo[0] = bflo(w.x); lo[1] = bfhi(w.x); lo[2] = bflo(w.y); lo[3] = bfhi(w.y); hi[0] = bflo(w.z); hi[1] = bfhi(w.z); hi[2] = bflo(w.w); hi[3] = bfhi(w.w);
            LAS f32x4* d = (LAS f32x4*)(lds + SC_VOFF + (c & 1) * (SC_CH * 32 * 4) + tid * 32); d[0] = lo; d[1] = hi; }
        else if (tid < 160) { *(LAS f32x4*)(lds + SC_SOFF + (c & 1) * (SC_CH * 16) + (tid - 128) * 16) = sreg; }
    };
    gload(0); lwrite(0); gload(1);
    __syncthreads();
    float ykeep = 0.f;
    for (int c = 0; c < NCH; ++c) {
        if (c + 1 < NCH) lwrite(c + 1);
        if (c + 2 < NCH) gload(c + 2);
        const LAS unsigned char* bp = lds + (c & 1) * SC_BUF + j * 16;
        const LAS float* vb = (const LAS float*)(lds + SC_VOFF + (c & 1) * (SC_CH * 32 * 4)) + rowl;
        const LAS float* sb = (const LAS float*)(lds + SC_SOFF + (c & 1) * (SC_CH * 16));
        ScanOps nx; scan_ld(nx, bp, vb, sb, 0);
#pragma unroll 4
        for (int s = 0; s < SC_CH; ++s) {
            const ScanOps o = nx;
            if (s + 1 < SC_CH) scan_ld(nx, bp, vb, sb, s + 1);
            const f32x4 pa4 = S * o.kk;
            const f32x4 sp = S * o.w + o.kp * o.v;
            const float sa = red16((pa4[0] + pa4[1]) + (pa4[2] + pa4[3]));
            if constexpr (PASSC) {
                const f32x4 py4 = S * o.wr;
                const float ys = red16((py4[0] + py4[1]) + (py4[2] + py4[3]));
                const float y = ys - sa * o.brkr.x + o.v * o.brkr.y;
                ykeep = ((s & 15) == j) ? y : ykeep;
                if ((s & 15) == 15) YA[(size_t)(c * SC_CH + (s - 15) + j) * 512 + rowl] = ykeep;
            }
            S = sp - o.bb * sa;
        }
        __syncthreads();
    }
    if constexpr (!PASSC) *(f32x4*)(FSb + ((size_t)seg * 128 + (ident ? 64 : 0) + row0 + rowl) * 64 + 4 * j) = S;
}

__device__ __forceinline__ int crow(int r, int hi) { return (r & 3) + 8 * (r >> 2) + 4 * hi; }
typedef short v4i16_t __attribute__((ext_vector_type(4)));
__device__ __forceinline__ s16x4 vtr(const LAS unsigned char* p) { return __builtin_bit_cast(s16x4, __builtin_amdgcn_ds_read_tr16_b64_v4i16((LAS v4i16_t*)p)); }
constexpr int AT_KS = 0, AT_VS = 9216, AT_BIAS = 18432, AT_WSF = 18688, AT_FLAG = 19712, AT_TASK = 140000;
__device__ __forceinline__ void attn_unit(const Args& a, LAS unsigned char* lds, int l, int bh, int qb, int tid, int lane, int wid) {
    const int b = bh >> 3, h = bh & 7, r32 = lane & 31, hi = lane >> 5;
    const int q0 = qb * 256;
    bf16* PB = (bf16*)(a.ws + WS_PB);
    const float* cumh = (const float*)(a.ws + WS_CUM) + (size_t)bh * T;
    const float kmax = ((const float*)(a.ws + WS_CTL))[CW_KMAX + 16 * l + bh];
    const size_t rowbase = (size_t)b * T;
    const bf16* Qp = PB + (rowbase + q0 + wid * 32 + r32) * LDB + h * 64;
    bf16x8 qr[4]; float qs = 0.f;
#pragma unroll
    for (int d0 = 0; d0 < 4; ++d0) { const u32x4 w = *(const u32x4*)(Qp + d0 * 16 + hi * 8); qr[d0] = __builtin_bit_cast(bf16x8, w);
        qs += bflo(w.x) * bflo(w.x) + bfhi(w.x) * bfhi(w.x) + bflo(w.y) * bflo(w.y) + bfhi(w.y) * bfhi(w.y) + bflo(w.z) * bflo(w.z) + bfhi(w.z) * bfhi(w.z) + bflo(w.w) * bflo(w.w) + bfhi(w.w) * bfhi(w.w); }
    qs += __shfl_xor(qs, 32);
    const float qbound = sqrtf(qs) * kmax * 1.01f + 0.01f;
    const float ref = cumh[q0 + 255];
    const int srow = tid >> 3, sch = tid & 7;
    const bf16* Kg = PB + rowbase * LDB + 512 + h * 64 + sch * 8; const bf16* Vg = Kg + 512;
    LAS unsigned char* Ks = lds + AT_KS; LAS unsigned char* Vs = lds + AT_VS; LAS float* biasL = (LAS float*)(lds + AT_BIAS);
    LAS float* wsf = (LAS float*)(lds + AT_WSF) + wid * 32; volatile LAS unsigned* flag = (volatile LAS unsigned*)(lds + AT_FLAG);
    if (tid < 3) flag[tid] = 0u;
    float m = -INFINITY, lsum = 0.f; f32x16 o0 = {}, o1 = {};
    u32x4 kreg, vreg; float breg = 0.f, bnx = 0.f;
    int j = qb * 4 + 3;
    { kreg = *(const u32x4*)(Kg + (size_t)(64 * j + srow) * LDB); vreg = *(const u32x4*)(Vg + (size_t)(64 * j + srow) * LDB);
      if (tid < 64) breg = (ref - cumh[64 * j + tid]) * L2E; bnx = j > 0 ? (ref - cumh[64 * j - 1]) * L2E : 0.f; }
    const int q4 = (lane & 15) >> 2, p4 = lane & 3, blk = (lane >> 4) & 1;
    const int qrow = q0 + wid * 32 + r32;
    int it = 0;
    __syncthreads();
    for (;;) {
        *(LAS u32x4*)(Ks + srow * 144 + sch * 16) = kreg; *(LAS u32x4*)(Vs + srow * 144 + sch * 16) = vreg; if (tid < 64) biasL[tid] = breg;
        const float bnx_cur = bnx;
        __syncthreads();
        if (j > 0) { const int jn = j - 1;
            kreg = *(const u32x4*)(Kg + (size_t)(64 * jn + srow) * LDB); vreg = *(const u32x4*)(Vg + (size_t)(64 * jn + srow) * LDB);
            if (tid < 64) breg = (ref - cumh[64 * jn + tid]) * L2E; bnx = jn > 0 ? (ref - cumh[64 * jn - 1]) * L2E : 0.f; }
        if (64 * j <= q0 + 32 * wid + 31) {
            f32x16 p0 = {}, p1 = {};
#pragma unroll
            for (int d0 = 0; d0 < 4; ++d0) {
                const bf16x8 k0 = *(const LAS bf16x8*)(Ks + r32 * 144 + d0 * 32 + hi * 16);
                const bf16x8 k1 = *(const LAS bf16x8*)(Ks + (32 + r32) * 144 + d0 * 32 + hi * 16);
                p0 = __builtin_amdgcn_mfma_f32_32x32x16_bf16(k0, qr[d0], p0, 0, 0, 0);
                p1 = __builtin_amdgcn_mfma_f32_32x32x16_bf16(k1, qr[d0], p1, 0, 0, 0); }
#pragma unroll
            for (int g = 0; g < 4; ++g) { const f32x4 b0 = *(const LAS f32x4*)(biasL + 8 * g + 4 * hi), b1 = *(const LAS f32x4*)(biasL + 32 + 8 * g + 4 * hi);
#pragma unroll
                for (int e = 0; e < 4; ++e) { p0[4 * g + e] += b0[e]; p1[4 * g + e] += b1[e]; } }
            if (64 * j + 63 > q0 + 32 * wid) {
#pragma unroll
                for (int r = 0; r < 16; ++r) { const int kv = 64 * j + crow(r, hi); if (kv > qrow) p0[r] = -INFINITY; if (kv + 32 > qrow) p1[r] = -INFINITY; } }
            float mx = fmaxf(p0[0], p1[0]);
#pragma unroll
            for (int r = 1; r < 16; ++r) mx = fmaxf(mx, fmaxf(p0[r], p1[r]));
            mx = fmaxf(mx, __shfl_xor(mx, 32));
            const float mnew = fmaxf(m, mx); const float f = __builtin_amdgcn_exp2f(m - mnew); m = mnew;
            float rs = 0.f;
#pragma unroll
            for (int r = 0; r < 16; ++r) { p0[r] = __builtin_amdgcn_exp2f(p0[r] - mnew); p1[r] = __builtin_amdgcn_exp2f(p1[r] - mnew); rs += p0[r] + p1[r]; }
            lsum = lsum * f + rs;
            if (__any(f != 1.f)) {
                if (hi == 0) wsf[r32] = f;
                asm volatile("s_waitcnt lgkmcnt(0)" ::: "memory");
#pragma unroll
                for (int r = 0; r < 16; ++r) { const float fr = wsf[crow(r, hi)]; o0[r] *= fr; o1[r] *= fr; }
            }
            u32x4 pw[4];
            pw[0] = (u32x4){cvtpk(p0[0], p0[1]), cvtpk(p0[2], p0[3]), cvtpk(p0[4], p0[5]), cvtpk(p0[6], p0[7])};
            pw[1] = (u32x4){cvtpk(p0[8], p0[9]), cvtpk(p0[10], p0[11]), cvtpk(p0[12], p0[13]), cvtpk(p0[14], p0[15])};
            pw[2] = (u32x4){cvtpk(p1[0], p1[1]), cvtpk(p1[2], p1[3]), cvtpk(p1[4], p1[5]), cvtpk(p1[6], p1[7])};
            pw[3] = (u32x4){cvtpk(p1[8], p1[9]), cvtpk(p1[10], p1[11]), cvtpk(p1[12], p1[13]), cvtpk(p1[14], p1[15])};
#pragma unroll
            for (int s = 0; s < 4; ++s) { const int kvb = 16 * (s & 1) + 32 * (s >> 1);
                const LAS unsigned char* va = Vs + (kvb + 4 * hi + q4) * 144 + (16 * blk + 4 * p4) * 2;
                const s16x4 l0 = vtr(va), h0 = vtr(va + 8 * 144), l1 = vtr(va + 64), h1 = vtr(va + 8 * 144 + 64);
                const bf16x8 vf0 = {l0[0], l0[1], l0[2], l0[3], h0[0], h0[1], h0[2], h0[3]}, vf1 = {l1[0], l1[1], l1[2], l1[3], h1[0], h1[1], h1[2], h1[3]};
                const bf16x8 pa = __builtin_bit_cast(bf16x8, pw[s]);
                o0 = __builtin_amdgcn_mfma_f32_32x32x16_bf16(pa, vf0, o0, 0, 0, 0);
                o1 = __builtin_amdgcn_mfma_f32_32x32x16_bf16(pa, vf1, o1, 0, 0, 0); }
        }
        if (j == 0) break;
        const bool need = (qbound + bnx_cur > m - 40.f);
        if (tid == 0) flag[(it + 1) % 3] = 0u;
        if (__any(need) && lane == 0) flag[it % 3] = 1u;
        __syncthreads();
        const unsigned cont = flag[it % 3];
        if (!cont) break;
        --j; ++it;
    }
    lsum += __shfl_xor(lsum, 32);
    if (hi == 0) wsf[r32] = 1.f / lsum;
    asm volatile("s_waitcnt lgkmcnt(0)" ::: "memory");
    bf16* Ow = (bf16*)(a.ws + WS_PV) + (rowbase + q0 + wid * 32) * LDV + h * 64 + r32;
#pragma unroll
    for (int r = 0; r < 16; ++r) { const float inv = wsf[crow(r, hi)]; bf16* op = Ow + (size_t)crow(r, hi) * LDV;
        op[0] = (bf16)f2bf(o0[r] * inv); op[32] = (bf16)f2bf(o1[r] * inv); }
    __syncthreads();
}
__device__ __forceinline__ void p3a_phase(const Args& a, LAS unsigned char* lds, int l, int tid, int lane, int wave) {
    unsigned* ctr = (unsigned*)(a.ws + WS_CTL) + CW_QUEUE + 64 * l;
    volatile LAS unsigned* task = (volatile LAS unsigned*)(lds + AT_TASK);
    for (;;) {
        __syncthreads();
        if (tid == 0) task[0] = atomicAdd(ctr, 1u);
        __syncthreads();
        const unsigned tk = task[0];
        if (tk >= 512u + 1024u) break;
        if (tk < 512u) { const int bh = (int)(tk >> 5), seg = (int)((tk >> 2) & 7), rb = (int)(tk & 3);
            if (seg == NSEG - 1 || (seg == 0 && rb >= 2)) continue;
            scan_task<false>(a, lds, bh, seg, rb, tid, lane, wave); }
        else { const unsigned u = tk - 512u; attn_unit(a, lds, l, (int)(u & 15), 63 - (int)(u >> 4), tid, lane, wave); }
    }
}
__device__ __forceinline__ void p3b_phase(const Args& a, LAS unsigned char* lds, int l, int tid, int lane, int wave) {
    unsigned* ctr = (unsigned*)(a.ws + WS_CTL) + CW_QUEUE + 512 + 64 * l;
    volatile LAS unsigned* task = (volatile LAS unsigned*)(lds + AT_TASK);
    for (;;) {
        __syncthreads();
        if (tid == 0) task[0] = atomicAdd(ctr, 1u);
        __syncthreads();
        const unsigned tk = task[0];
        if (tk >= 256u) break;
        scan_task<true>(a, lds, (int)(tk >> 4), (int)((tk >> 1) & 7), (int)(tk & 1), tid, lane, wave);
    }
}

__device__ __forceinline__ void merge_phase(const Args& a, int l, int tid, int lane, int wave, int G) {
    const float* YA = (const float*)(a.ws + WS_YA); const bf16* VS = (const bf16*)(a.ws + WS_VS); const bf16* PB = (const bf16*)(a.ws + WS_PB);
    const float* SCS = (const float*)(a.ws + WS_SCS); bf16* YM = (bf16*)(a.ws + WS_YM);
    const int c = tid, h = wave;
    const float gg = a.in[15][l * 512 + c], gb = a.in[16][l * 512 + c];
    for (int m = blockIdx.x; m < M; m += G) {
        const int b = m >= T ? 1 : 0, t = m - b * T;
        const float ya = YA[(size_t)m * 512 + c];
        const float v = bf2f(VS[(size_t)m * 512 + c]);
        const float g1 = bf2f(PB[(size_t)m * LDB + 1536 + c]), g2 = bf2f(PB[(size_t)m * LDB + 2048 + c]);
        const float yb = bf2f(((const bf16*)(a.ws + WS_PV))[(size_t)m * LDV + c]);
        const float rkr = SCS[((size_t)(b * 8 + h) * T + t) * 4 + 2];
        const float mean = wave_sum(ya) * (1.f / 64.f); const float d = ya - mean; const float var = wave_sum(d * d) * (1.f / 64.f);
        const float yn = d * rsqrtf(var + GN_EPS) * gg + gb + rkr * v;
        YM[(size_t)m * D + c] = (bf16)f2bf(yn * g1); YM[(size_t)m * D + 512 + c] = (bf16)f2bf(yb * g2);
    }
}

#ifndef N_LAUNCH_MODE
#define N_LAUNCH_MODE 1
#endif
template <int MASK, bool COOP> __device__ __forceinline__ void run_phases(const Args& a, LAS unsigned char* lds, int l0, int l1) {
    const int G = gridDim.x;
#define LAUNDER() int tid = threadIdx.x; asm volatile("" : "+v"(tid)); const int lane = tid & 63, wave = __builtin_amdgcn_readfirstlane(tid >> 6); (void)lane; (void)wave
    float* hbuf = a.out;
    const float* mod = (const float*)(a.ws + WS_CTL) + CW_MOD;
    bf16* XN = (bf16*)(a.ws + WS_XN);
#define GSYNC() do { if constexpr (COOP) cg::this_grid().sync(); } while (0)
    if constexpr (MASK & 1) { LAUNDER(); p0a(a, lds, tid, lane, wave, G); GSYNC(); }
    if constexpr (MASK & 2) { LAUNDER(); ln_rows(a.in[0], a.in[2], a.in[3], hbuf, XN, mod, lane, wave, G); GSYNC(); }
#pragma unroll 1
    for (int l = l0; l < l1; ++l) {
        for (int rep = 0; rep < ((PROBE_REP & 4) ? 2 : 1); ++rep)
        if constexpr (MASK & 4) { pg8::Gemm g{XN, (const bf16*)(a.ws + WS_WIN) + (size_t)l * NPROJ * 1024, M, NPROJ, 1024}; pg8::StaticOrder S; S.init(M, NPROJ, G, (int)blockIdx.x);
          EpiProj E{(bf16*)(a.ws + WS_PA), (bf16*)(a.ws + WS_PV), (bf16*)(a.ws + WS_PB)};
          pg8::gemm_phase<EpiProj, pg8::StaticOrder, true, true>(lds, g, S, E); GSYNC(); }
        for (int rep = 0; rep < ((PROBE_REP & 8) ? 2 : 1); ++rep)
        if constexpr (MASK & 8) { LAUNDER(); prep_phase(a, lds, l, tid, lane, wave, G); GSYNC(); }
        if constexpr (MASK & 16) { { LAUNDER(); p3a_phase(a, lds, l, tid, lane, wave); } GSYNC(); { LAUNDER(); p3b_phase(a, lds, l, tid, lane, wave); } GSYNC(); }
        for (int rep = 0; rep < ((PROBE_REP & 32) ? 2 : 1); ++rep)
        if constexpr (MASK & 32) { LAUNDER(); merge_phase(a, l, tid, lane, wave, G); GSYNC(); }
        if constexpr (MASK & 64) { pg8::Gemm g{(const bf16*)(a.ws + WS_YM), (const bf16*)(a.ws + WS_WOUT) + (size_t)l * 1024 * 1024, M, D, D}; pg8::StaticOrder S; S.init(M, D, G, (int)blockIdx.x);
          EpiOut E{hbuf, mod + l * 2 * 3072};
          pg8::gemm_phase<EpiOut, pg8::StaticOrder, true, true>(lds, g, S, E); GSYNC(); }
        if constexpr (MASK & 128) { LAUNDER(); ln_rows(hbuf, a.in[19] + l * D, a.in[20] + l * D, hbuf, XN, (l + 1 < DEPTH) ? mod + (l + 1) * 2 * 3072 : nullptr, lane, wave, G);
          if (l + 1 < l1) GSYNC(); }
    }
#undef GSYNC
#undef LAUNDER
}
#ifndef FMASK
#define FMASK 0xFF
#endif
#if N_LAUNCH_MODE == 1
__global__ void __launch_bounds__(512, 2) hymba_fwd(Args a) {
    extern __shared__ __attribute__((aligned(16))) unsigned char lds_raw[];
    run_phases<FMASK, true>(a, (LAS unsigned char*)lds_raw, 0, DEPTH);
}
#else
template <int MASK> __global__ void __launch_bounds__(512, 2) hymba_phase(Args a, int l) {
    extern __shared__ __attribute__((aligned(16))) unsigned char lds_raw[];
    run_phases<MASK, false>(a, (LAS unsigned char*)lds_raw, l, l + 1);
}
template <int MASK> static void launch_phase(const Args& a, int l, hipStream_t stream) {
    static bool attr = false;
    if (!attr) { (void)hipFuncSetAttribute((const void*)hymba_phase<MASK>, hipFuncAttributeMaxDynamicSharedMemorySize, LDS_BYTES); attr = true; }
    hipLaunchKernelGGL(hymba_phase<MASK>, dim3(256), dim3(512), LDS_BYTES, stream, a, l);
}
#endif

extern "C" void kernel_launch(void* const* d_in, const int* in_sizes, int n_in, void* d_out, int out_size, void* d_ws, size_t ws_size, hipStream_t stream) {
    if (n_in != 21 || ws_size < WS_END) { fprintf(stderr, "kernel_launch: unexpected n_in %d / ws %zu\n", n_in, ws_size); return; }
    (void)hipMemsetAsync((char*)d_ws + WS_CTL, 0, CTL_ZERO_BYTES, stream);
    Args a{};
    for (int i = 0; i < 21; ++i) a.in[i] = (const float*)d_in[i];
    a.out = (float*)d_out; a.ws = (unsigned char*)d_ws;
#if N_LAUNCH_MODE == 1
    static int grid = 0;
    if (grid == 0) {
        int dev = 0, cus = 0, per_cu = 0;
        (void)hipGetDevice(&dev); (void)hipDeviceGetAttribute(&cus, hipDeviceAttributeMultiprocessorCount, dev);
        (void)hipFuncSetAttribute((const void*)hymba_fwd, hipFuncAttributeMaxDynamicSharedMemorySize, LDS_BYTES);
        (void)hipOccupancyMaxActiveBlocksPerMultiprocessor(&per_cu, (const void*)hymba_fwd, 512, LDS_BYTES);
        if (per_cu < 1) per_cu = 1;
        (void)hipGetLastError();
        grid = cus * per_cu;
    }
    void* args[] = {&a};
    hipError_t e = hipLaunchCooperativeKernel((const void*)hymba_fwd, dim3(grid), dim3(512), args, LDS_BYTES, stream);
    if (e != hipSuccess) fprintf(stderr, "cooperative launch failed: %s (grid %d)\n", hipGetErrorString(e), grid);
#else
    launch_phase<1>(a, 0, stream); launch_phase<2>(a, 0, stream);
    for (int l = 0; l < DEPTH; ++l) { launch_phase<4>(a, l, stream); launch_phase<8>(a, l, stream); launch_phase<16>(a, l, stream); launch_phase<32>(a, l, stream); launch_phase<64>(a, l, stream); launch_phase<128>(a, l, stream); }
#endif
}
```

```cpp
#include <hip/hip_runtime.h>
#include <cstdio>
#include <cstdint>
namespace pg8 {
#define PG8_LAS __attribute__((address_space(3)))
typedef unsigned short bf16_t;
typedef short bf16x8 __attribute__((ext_vector_type(8)));
typedef float f32x4 __attribute__((ext_vector_type(4)));
typedef unsigned u32x4 __attribute__((ext_vector_type(4)));
constexpr int BM = 256, BK = 64, HALF = 128, HTB = HALF * BK * 2  , STAGE_BYTES = 8 * HTB, NXCD = 8, WGM = 8;

__host__ __device__ __forceinline__ int lds_byte(int r, int c) { const int st = (r >> 4) * 2 + (c >> 5), rr = r & 15, cc = c & 31, ob = rr * 64 + cc * 2; return st * 1024 + (ob ^ (((ob >> 9) & 1) << 5)); }
__host__ __device__ __forceinline__ void stage_rc(int b, int& R, int& C) { const int st = b / 1024, sb = b % 1024, swz = sb ^ (((sb >> 9) & 1) << 5); R = (st >> 1) * 16 + swz / 64; C = (st & 1) * 32 + (swz % 64) / 2; }
__host__ __device__ __forceinline__ int perm32(int rho) { const int n = rho >> 4, i = rho & 15; return 8 * (i >> 2) + 4 * n + (i & 3); }

struct Unit { int pm, pn; };
struct Gemm { const bf16_t* A; const bf16_t* Bt; int M, N, K; };

struct StaticOrder {
    int nM, nN, nwg, G, c;
    __host__ __device__ void init(int M, int N, int G_, int c_) { nM = M / BM; nN = N / BM; nwg = nM * nN; G = G_; c = c_; }
    __host__ __device__ bool next(int i, Unit& u) const {
        const long L = (long)i * G + c; if (L >= nwg) return false;
        int wgid = (int)L; { const int q = nwg / NXCD, r = nwg % NXCD, xcd = wgid % NXCD, off = wgid / NXCD; wgid = (xcd < r ? xcd * (q + 1) : r * (q + 1) + (xcd - r) * q) + off; }
        const int nig = WGM * nN, gid = wgid / nig, fm = gid * WGM, gsz = (nM - fm) < WGM ? (nM - fm) : WGM;
        u.pm = fm + ((wgid % nig) % gsz); u.pn = (wgid % nig) / gsz; return true;
    }
    __device__ __forceinline__ void a_ready(const Unit&) const {}
    __device__ __forceinline__ void done(const Unit&) const {}
};

__device__ __forceinline__ unsigned cvt_pk_bf16(float lo, float hi) { unsigned r; asm volatile("v_cvt_pk_bf16_f32 %0, %1, %2" : "=v"(r) : "v"(lo), "v"(hi)); return r; }
typedef float f32x2 __attribute__((ext_vector_type(2)));
__device__ __forceinline__ f32x2 gelu_pk(f32x2 v) {
    const f32x2 av = __builtin_elementwise_abs(v), d = av * 0.2316418882f + 1.0f;
    f32x2 t; t.x = __builtin_amdgcn_rcpf(d.x); t.y = __builtin_amdgcn_rcpf(d.y);
    f32x2 q = t * 0.5307027145f + (-0.7265760135f); q = q * t + 0.7107068705f; q = q * t + (-0.142248368f); q = q * t + 0.127414796f; q = q * t;
    const f32x2 s = (v * v) * (-0.72134752044f);
    f32x2 e; e.x = __builtin_amdgcn_exp2f(s.x); e.y = __builtin_amdgcn_exp2f(s.y);
    const f32x2 m = v * (q * e), r = v - m;
    f32x2 o; o.x = v.x < 0.f ? m.x : r.x; o.y = v.y < 0.f ? m.y : r.y; return o;
}

template <int ACT  > struct EpiBf16 {
    static constexpr bool PERM = true, AFTER_DRAIN = false; static_assert(ACT == 0 || ACT == 1, "EpiBf16: ACT is 0 (none) or 1 (gelu_pk)");
    bf16_t* O; int ldc; const float* bias; int split_cols; size_t split_stride; float scale0;
    __device__ __forceinline__ void operator()(const f32x4 (&acc)[2][2][4][2], const Unit& u, int wr, int wc, int fr, int fq) const {
        const int row0 = u.pm * BM + wr * 64 + fr; int colt = u.pn * BM; bf16_t* base = O;
        float sc = 1.f; if (split_cols) { const int t = colt / split_cols; base += (size_t)t * split_stride; colt -= t * split_cols; if (t == 0) sc = scale0; }
        const int col0 = colt + wc * 32 + 8 * fq, bcol0 = u.pn * BM + wc * 32 + 8 * fq;
        f32x4 bv[2][2];
#pragma unroll
        for (int bj = 0; bj < 2; ++bj)
#pragma unroll
            for (int n = 0; n < 2; ++n) bv[bj][n] = bias ? *(const f32x4*)(bias + bcol0 + bj * HALF + 4 * n) : (f32x4){0.f, 0.f, 0.f, 0.f};
#pragma unroll
        for (int ai = 0; ai < 2; ++ai)
#pragma unroll
            for (int m = 0; m < 4; ++m) { bf16_t* rowp = base + (size_t)(row0 + ai * HALF + m * 16) * ldc + col0;
#pragma unroll
                for (int bj = 0; bj < 2; ++bj) { f32x4 v0 = acc[ai][bj][m][0] + bv[bj][0], v1 = acc[ai][bj][m][1] + bv[bj][1];
                    if (ACT == 1) { f32x2 a = gelu_pk((f32x2){v0[0], v0[1]}), b = gelu_pk((f32x2){v0[2], v0[3]}), c = gelu_pk((f32x2){v1[0], v1[1]}), d = gelu_pk((f32x2){v1[2], v1[3]});
                        v0 = (f32x4){a.x, a.y, b.x, b.y}; v1 = (f32x4){c.x, c.y, d.x, d.y}; }
                    v0 = v0 * sc; v1 = v1 * sc; u32x4 w; w.x = cvt_pk_bf16(v0[0], v0[1]); w.y = cvt_pk_bf16(v0[2], v0[3]); w.z = cvt_pk_bf16(v1[0], v1[1]); w.w = cvt_pk_bf16(v1[2], v1[3]);
                    *(u32x4*)(rowp + bj * HALF) = w; } }
    }
};

template <class Epi, class Sched, bool ALIGN_EPI = false, bool SP2 = false>
__device__ __forceinline__ void gemm_phase(PG8_LAS unsigned char* lds, const Gemm g, const Sched& S, const Epi& E) {
    int tid = threadIdx.x; asm volatile("" : "+v"(tid));
    const int wid = __builtin_amdgcn_readfirstlane(tid >> 6), lane = tid & 63, wr = wid >> 2, wc = wid & 3, fr = lane & 15, fq = lane >> 4;
    const int K = g.K, nt = K / BK;
    unsigned voffA[2], voffB[2];
#pragma unroll
    for (int i = 0; i < 2; ++i) { int R, C; stage_rc(tid * 16 + i * 8192, R, C); const int Rb = Epi::PERM ? ((R & ~31) + perm32(R & 31)) : R;
        voffA[i] = (unsigned)(R * K + C) * 2u; voffB[i] = (unsigned)(Rb * K + C) * 2u; }
    const size_t kstep = (size_t)(BK * 2);
    const size_t hstep = (size_t)HALF * K * 2;
    const size_t tstep = 2 * hstep;
    const unsigned ldsw = (unsigned)wid * 1024u;
    const int aoff = lds_byte(wr * 64 + fr, fq * 8), boff = lds_byte(wc * 32 + fr, fq * 8);
#define PG8_SA(b, h) (((b) * 2 + (h)) * HTB)
#define PG8_SB(b, h) ((4 + (b) * 2 + (h)) * HTB)
#define PG8_STAGE(bufoff, gbase, voff) do { _Pragma("unroll") for (int _i = 0; _i < 2; ++_i) \
        __builtin_amdgcn_global_load_lds((const unsigned*)((const char*)(gbase) + (voff)[_i]), (PG8_LAS unsigned*)(lds + (bufoff) + ldsw + _i * 8192), 16, 0, 0); } while (0)
#define PG8_LDA(dst, b, h) do { _Pragma("unroll") for (int m = 0; m < 4; ++m) _Pragma("unroll") for (int k = 0; k < 2; ++k) dst[m][k] = *(const PG8_LAS bf16x8*)(lds + PG8_SA(b, h) + aoff + m * 2048 + k * 1024); } while (0)
#define PG8_LDB(dst, b, h) do { _Pragma("unroll") for (int n = 0; n < 2; ++n) _Pragma("unroll") for (int k = 0; k < 2; ++k) dst[n][k] = *(const PG8_LAS bf16x8*)(lds + PG8_SB(b, h) + boff + n * 2048 + k * 1024); } while (0)
#define PG8_MMA(ai, bj, At, Bt) do { __builtin_amdgcn_s_setprio(1); _Pragma("unroll") for (int m = 0; m < 4; ++m) _Pragma("unroll") for (int n = 0; n < 2; ++n) _Pragma("unroll") for (int k = 0; k < 2; ++k) \
        acc[ai][bj][m][n] = __builtin_amdgcn_mfma_f32_16x16x32_bf16(Bt[n][k], At[m][k], acc[ai][bj][m][n], 0, 0, 0); __builtin_amdgcn_s_setprio(0); } while (0)
#define PG8_WAIT_V(n) asm volatile("s_waitcnt vmcnt(" #n ")" ::: "memory")
#define PG8_WAIT_L(n) asm volatile("s_waitcnt lgkmcnt(" #n ")" ::: "memory")
#define PG8_BAR __builtin_amdgcn_s_barrier()
#define PG8_SCHED __builtin_amdgcn_sched_barrier(0)
    Unit cur, nxt; int ui = 0;
    if (!S.next(0, cur)) return;
    f32x4 acc[2][2][4][2];
#pragma unroll
    for (int a = 0; a < 2; ++a)
#pragma unroll
        for (int b = 0; b < 2; ++b)
#pragma unroll
            for (int m = 0; m < 4; ++m)
#pragma unroll
                for (int n = 0; n < 2; ++n) acc[a][b][m][n] = (f32x4){0.f, 0.f, 0.f, 0.f};
    bf16x8 At[4][2], B0[2][2], B1[2][2];
    const char* cA = (const char*)g.A + (size_t)cur.pm * tstep; const char* cB = (const char*)g.Bt + (size_t)cur.pn * tstep;
    S.a_ready(cur);
    if constexpr (SP2) {
        PG8_STAGE(PG8_SB(0, 0), cB, voffB); PG8_STAGE(PG8_SB(0, 1), cB + hstep, voffB); PG8_STAGE(PG8_SA(0, 0), cA, voffA); PG8_STAGE(PG8_SA(0, 1), cA + hstep, voffA);
        if (wr == 1) PG8_BAR;
        PG8_WAIT_V(2); PG8_BAR;
        PG8_STAGE(PG8_SB(1, 0), cB + kstep, voffB); PG8_STAGE(PG8_SA(1, 0), cA + kstep, voffA); PG8_STAGE(PG8_SB(1, 1), cB + hstep + kstep, voffB);
        PG8_WAIT_V(6); PG8_BAR;
    } else {
        PG8_STAGE(PG8_SB(0, 0), cB, voffB); PG8_STAGE(PG8_SA(0, 0), cA, voffA); PG8_STAGE(PG8_SB(0, 1), cB + hstep, voffB); PG8_STAGE(PG8_SA(0, 1), cA + hstep, voffA);
        if (wr == 1) PG8_BAR;
        PG8_WAIT_V(4); PG8_BAR;
        PG8_STAGE(PG8_SB(1, 0), cB + kstep, voffB); PG8_STAGE(PG8_SA(1, 0), cA + kstep, voffA); PG8_STAGE(PG8_SB(1, 1), cB + hstep + kstep, voffB);
        PG8_WAIT_V(6); PG8_BAR;
    }
    for (;;) {
        const bool has_next = S.next(ui + 1, nxt);
        const char* nA = has_next ? (const char*)g.A + (size_t)nxt.pm * tstep : cA; const char* nB = has_next ? (const char*)g.Bt + (size_t)nxt.pn * tstep : cB;
        for (int t = 0; t < nt; t += 2) {
            const bool last = (t == nt - 2);
            const char* a1 = cA + (size_t)(t + 1) * kstep;
            const char* a2 = last ? nA : cA + (size_t)(t + 2) * kstep; const char* b2 = last ? nB : cB + (size_t)(t + 2) * kstep;
            const char* a3 = a2 + kstep; const char* b3 = b2 + kstep;
            if (last && has_next) S.a_ready(nxt);
            if constexpr (SP2) {
            PG8_LDB(B0, 0, 0); PG8_LDB(B1, 0, 1); PG8_SCHED; PG8_LDA(At, 0, 0); PG8_STAGE(PG8_SA(1, 1), a1 + hstep, voffA);
            PG8_WAIT_V(8); PG8_WAIT_L(0); PG8_BAR; PG8_MMA(0, 0, At, B0); PG8_MMA(0, 1, At, B1); PG8_BAR; PG8_SCHED;
            PG8_LDA(At, 0, 1); PG8_STAGE(PG8_SB(0, 0), b2, voffB); PG8_STAGE(PG8_SB(0, 1), b2 + hstep, voffB); PG8_STAGE(PG8_SA(0, 0), a2, voffA);
            PG8_WAIT_V(8); PG8_WAIT_L(0); PG8_BAR; PG8_MMA(1, 0, At, B0); PG8_MMA(1, 1, At, B1); PG8_BAR; PG8_SCHED;
            PG8_LDB(B0, 1, 0); PG8_LDB(B1, 1, 1); PG8_SCHED; PG8_LDA(At, 1, 0); PG8_STAGE(PG8_SA(0, 1), a2 + hstep, voffA);
            PG8_WAIT_V(8); PG8_WAIT_L(0); PG8_BAR; PG8_MMA(0, 0, At, B0); PG8_MMA(0, 1, At, B1); PG8_BAR; PG8_SCHED;
            PG8_LDA(At, 1, 1); PG8_STAGE(PG8_SB(1, 0), b3, voffB); PG8_STAGE(PG8_SB(1, 1), b3 + hstep, voffB); PG8_STAGE(PG8_SA(1, 0), a3, voffA);
            PG8_WAIT_V(8); PG8_WAIT_L(0); PG8_BAR; PG8_MMA(1, 0, At, B0); PG8_MMA(1, 1, At, B1); PG8_BAR; PG8_SCHED;
            } else {
            PG8_LDB(B0, 0, 0); PG8_SCHED; PG8_LDA(At, 0, 0); PG8_STAGE(PG8_SA(1, 1), a1 + hstep, voffA);
            PG8_WAIT_L(8); PG8_BAR; PG8_WAIT_L(0); PG8_MMA(0, 0, At, B0); PG8_BAR; PG8_SCHED;
            PG8_LDB(B1, 0, 1); PG8_STAGE(PG8_SB(0, 0), b2, voffB);
            PG8_BAR; PG8_WAIT_L(0); PG8_MMA(0, 1, At, B1); PG8_BAR;
            PG8_LDA(At, 0, 1); PG8_STAGE(PG8_SA(0, 0), a2, voffA);
            PG8_BAR; PG8_WAIT_L(0); PG8_MMA(1, 0, At, B0); PG8_BAR; PG8_SCHED;
            PG8_STAGE(PG8_SB(0, 1), b2 + hstep, voffB);
            PG8_WAIT_V(6); PG8_BAR; PG8_MMA(1, 1, At, B1); PG8_BAR;
            PG8_LDB(B0, 1, 0); PG8_SCHED; PG8_LDA(At, 1, 0); PG8_STAGE(PG8_SA(0, 1), a2 + hstep, voffA);
            PG8_WAIT_L(8); PG8_BAR; PG8_WAIT_L(0); PG8_MMA(0, 0, At, B0); PG8_BAR; PG8_SCHED;
            PG8_LDB(B1, 1, 1); PG8_STAGE(PG8_SB(1, 0), b3, voffB);
            PG8_BAR; PG8_WAIT_L(0); PG8_MMA(0, 1, At, B1); PG8_BAR;
            PG8_LDA(At, 1, 1); PG8_STAGE(PG8_SA(1, 0), a3, voffA);
            PG8_BAR; PG8_WAIT_L(0); PG8_MMA(1, 0, At, B0); PG8_BAR; PG8_SCHED;
            PG8_STAGE(PG8_SB(1, 1), b3 + hstep, voffB);
            PG8_WAIT_V(6); PG8_BAR; PG8_MMA(1, 1, At, B1); PG8_BAR;
            }
        }
        if constexpr (ALIGN_EPI) { if (wr == 0) PG8_BAR; }
        if constexpr (!Epi::AFTER_DRAIN) { E(acc, cur, wr, wc, fr, fq); S.done(cur); }
        if (!has_next) break;
#pragma unroll
        for (int a = 0; a < 2; ++a)
#pragma unroll
            for (int b = 0; b < 2; ++b)
#pragma unroll
                for (int m = 0; m < 4; ++m)
#pragma unroll
                    for (int n = 0; n < 2; ++n) acc[a][b][m][n] = (f32x4){0.f, 0.f, 0.f, 0.f};
        cur = nxt; cA = nA; cB = nB; ++ui;
        if constexpr (ALIGN_EPI) { if (wr == 1) PG8_BAR; }
    }
    PG8_WAIT_V(0);
    if constexpr (!ALIGN_EPI) { if (wr == 0) PG8_BAR; }
    PG8_BAR;
    if constexpr (Epi::AFTER_DRAIN) { E.fused(acc, cur, wr, wc, fr, fq, lds, wid, lane); S.done(cur); }
#undef PG8_SA
#undef PG8_SB
#undef PG8_STAGE
#undef PG8_LDA
#undef PG8_LDB
#undef PG8_MMA
#undef PG8_WAIT_V
#undef PG8_WAIT_L
#undef PG8_BAR
#undef PG8_SCHED
}
}
#include <hip/hip_cooperative_groups.h>
namespace cg = cooperative_groups;
#define LAS __attribute__((address_space(3)))
typedef unsigned short bf16;
typedef float f32x4 __attribute__((ext_vector_type(4)));
typedef float f32x2 __attribute__((ext_vector_type(2)));
typedef float f32x16 __attribute__((ext_vector_type(16)));
typedef short bf16x8 __attribute__((ext_vector_type(8)));
typedef short s16x4 __attribute__((ext_vector_type(4)));
typedef unsigned u32x4 __attribute__((ext_vector_type(4)));
typedef unsigned u32x2 __attribute__((ext_vector_type(2)));
typedef __bf16 bf16x2_t __attribute__((ext_vector_type(2)));

constexpr int BATCH = 2, T = 16384, D = 1024, M = BATCH * T, DEPTH = 2;
constexpr int NPROJ = 4352, NSRC = 4232;
constexpr int LDA = 1280, LDV = 512, LDB = 2560;
constexpr float LN_EPS = 1e-5f, GN_EPS = 64e-5f;
constexpr float DN_ALPHA = 1.41421356237f;
constexpr float C2 = 0.125f * 1.4426950408889634f;
constexpr float L2E = 1.4426950408889634f;
constexpr size_t MiB = 1u << 20;
constexpr size_t WS_CTL = 0, CTL_ZERO_BYTES = 1 * MiB;
constexpr size_t WS_WIN = 2 * MiB, WS_WOUT = 20 * MiB, WS_CUM = 24 * MiB, WS_SCS = 25 * MiB, WS_SCN = 30 * MiB;
constexpr size_t WS_XN = WS_SCN, WS_YM = WS_SCN;
constexpr size_t WS_PA = 190 * MiB, WS_YA = WS_PA, WS_PV = 270 * MiB, WS_PB = 302 * MiB, WS_VS = 462 * MiB, WS_FS = 494 * MiB, WS_END = 498 * MiB;
constexpr int CW_QUEUE = 64;
constexpr int CW_KMAX = 1024;
constexpr int CW_MOD = 16384;
constexpr int LDS_BYTES = 147456;
#ifndef PROBE_REP
#define PROBE_REP 0
#endif

__device__ __forceinline__ unsigned f2bf(float f) { unsigned u = __builtin_bit_cast(unsigned, f); return (u + 0x7fffu + ((u >> 16) & 1u)) >> 16; }
__device__ __forceinline__ unsigned pk2(float lo, float hi) { return f2bf(lo) | (f2bf(hi) << 16); }
__device__ __forceinline__ float bf2f(unsigned short v) { return __uint_as_float(((unsigned)v) << 16); }
__device__ __forceinline__ float bflo(unsigned w) { return __uint_as_float(w << 16); }
__device__ __forceinline__ float bfhi(unsigned w) { return __uint_as_float(w & 0xffff0000u); }
__device__ __forceinline__ unsigned cvtpk(float lo, float hi) { f32x2 v = {lo, hi}; bf16x2_t b = __builtin_convertvector(v, bf16x2_t); return __builtin_bit_cast(unsigned, b); }
__device__ __forceinline__ float wave_sum(float v) {
#pragma unroll
    for (int o = 1; o < 64; o <<= 1) v += __shfl_xor(v, o);
    return v;
}
__device__ __forceinline__ float fast_sigmoid(float x) { return 1.f / (1.f + __expf(-x)); }

struct Args { const float* in[21]; float* out; unsigned char* ws; };

struct EpiProj {
    static constexpr bool PERM = true, AFTER_DRAIN = false;
    bf16 *PA, *PVb, *PB;
    __device__ __forceinline__ void operator()(const pg8::f32x4 (&acc)[2][2][4][2], const pg8::Unit& u, int wr, int wc, int fr, int fq) const {
        const int row0 = u.pm * 256 + wr * 64 + fr; const int pn = u.pn;
        bf16* base; int ldc, colt; float sc = 1.f; bool act = false;
        if (pn < 4) { base = PA; ldc = LDA; colt = pn * 256; }
        else if (pn < 6) { base = PVb; ldc = LDV; colt = (pn - 4) * 256; }
        else if (pn == 6) { base = PA; ldc = LDA; colt = 1024; }
        else { base = PB; ldc = LDB; colt = (pn - 7) * 256; if (pn < 9) sc = C2; if (pn >= 13) act = true; }
        const int col0 = colt + wc * 32 + 8 * fq;
#pragma unroll
        for (int ai = 0; ai < 2; ++ai)
#pragma unroll
            for (int m = 0; m < 4; ++m) { bf16* rowp = base + (size_t)(row0 + ai * 128 + m * 16) * ldc + col0;
#pragma unroll
                for (int bj = 0; bj < 2; ++bj) { pg8::f32x4 v0 = acc[ai][bj][m][0], v1 = acc[ai][bj][m][1];
                    if (act) {
#pragma unroll
                        for (int e = 0; e < 4; ++e) { v0[e] = v0[e] * fast_sigmoid(v0[e]); v1[e] = v1[e] * fast_sigmoid(v1[e]); } }
                    v0 = v0 * sc; v1 = v1 * sc; u32x4 w; w.x = cvtpk(v0[0], v0[1]); w.y = cvtpk(v0[2], v0[3]); w.z = cvtpk(v1[0], v1[1]); w.w = cvtpk(v1[2], v1[3]);
                    *(u32x4*)(rowp + bj * 128) = w; } }
    }
};
struct EpiOut {
    static constexpr bool PERM = false, AFTER_DRAIN = false;
    float* hz; const float* modl;
    __device__ __forceinline__ void operator()(const pg8::f32x4 (&acc)[2][2][4][2], const pg8::Unit& u, int wr, int wc, int fr, int fq) const {
        const int col0 = u.pn * 256 + wc * 32 + 4 * fq; const int b = (u.pm * 256) >= T ? 1 : 0; const float* gate = modl + b * 3072 + 2048;
#pragma unroll
        for (int bj = 0; bj < 2; ++bj)
#pragma unroll
            for (int n = 0; n < 2; ++n) { const int c = col0 + bj * 128 + n * 16; const f32x4 g = *(const f32x4*)(gate + c) + 1.0f;
#pragma unroll
                for (int ai = 0; ai < 2; ++ai)
#pragma unroll
                    for (int m = 0; m < 4; ++m) { const int r = u.pm * 256 + ai * 128 + wr * 64 + m * 16 + fr; float* p = hz + (size_t)r * D + c;
                        const f32x4 hx = *(const f32x4*)p; f32x4 a; a[0] = acc[ai][bj][m][n][0]; a[1] = acc[ai][bj][m][n][1]; a[2] = acc[ai][bj][m][n][2]; a[3] = acc[ai][bj][m][n][3];
                        *(f32x4*)p = hx * DN_ALPHA + g * a; } }
    }
};

__device__ __forceinline__ int win_map(int n) { if (n < 1664) return n; if (n < 1672) return 3200 + n - 1664; if (n < 1792) return -1; if (n < 3328) return n - 128; return n - 120; }
template <bool MAP> __device__ __forceinline__ void transpose_item(const float* W, int Nsrc, int Ndst, bf16* WT, LAS float* scr, int item, int lane) {
    const int nblk = Ndst / 32, kb = item / nblk, nb = item % nblk, k0 = 64 * kb, n0 = 32 * nb;
    const int src = MAP ? win_map(n0 + (lane & 31)) : n0 + (lane & 31);
#pragma unroll 8
    for (int i = 0; i < 32; ++i) { const int kk = 2 * i + (lane >> 5); scr[kk * 33 + (lane & 31)] = src >= 0 ? W[(size_t)(k0 + kk) * Nsrc + src] : 0.f; }
    asm volatile("s_waitcnt lgkmcnt(0)" ::: "memory");
    const int c = lane & 7;
#pragma unroll
    for (int j = 0; j < 4; ++j) { const int n = (lane >> 3) + 8 * j; const LAS float* s = scr + (8 * c) * 33 + n;
        u32x4 o; o.x = pk2(s[0 * 33], s[1 * 33]); o.y = pk2(s[2 * 33], s[3 * 33]); o.z = pk2(s[4 * 33], s[5 * 33]); o.w = pk2(s[6 * 33], s[7 * 33]);
        *(u32x4*)(WT + (size_t)(n0 + n) * 1024 + k0 + 8 * c) = o; }
    asm volatile("s_waitcnt lgkmcnt(0)" ::: "memory");
}
__device__ __forceinline__ void p0a(const Args& a, LAS unsigned char* lds, int tid, int lane, int wave, int G) {
    LAS float* scr = (LAS float*)(lds + wave * 16384);
    const int gw = blockIdx.x * 8 + wave, NGW = G * 8;
    constexpr int I_IN = 16 * (NPROJ / 32), I_OUT = 16 * 32;
    for (int it = gw; it < 2 * (I_IN + I_OUT); it += NGW) {
        int r = it; const int l = r / (I_IN + I_OUT); r -= l * (I_IN + I_OUT);
        if (r < I_IN) transpose_item<true>(a.in[6] + (size_t)l * 1024 * NSRC, NSRC, NPROJ, (bf16*)(a.ws + WS_WIN) + (size_t)l * NPROJ * 1024, scr, r, lane);
        else transpose_item<false>(a.in[18] + (size_t)l * 1024 * 1024, 1024, 1024, (bf16*)(a.ws + WS_WOUT) + (size_t)l * 1024 * 1024, scr, r - I_IN, lane);
    }
    float* mod = (float*)(a.ws + WS_CTL) + CW_MOD;
    const float* cvec = a.in[1];
    for (int w = blockIdx.x * 512 + tid; w < 2 * 16 * 3072; w += G * 512) {
        const int j = w % 3072, sl = (w / 3072) % 16, l = w / (3072 * 16);
        const float* wa = a.in[4] + (size_t)l * 1024 * 3072 + (size_t)(sl * 64) * 3072 + j;
        float s0 = 0.f, s1 = 0.f;
#pragma unroll 8
        for (int i = 0; i < 64; ++i) { const float wv = wa[(size_t)i * 3072]; s0 += cvec[sl * 64 + i] * wv; s1 += cvec[1024 + sl * 64 + i] * wv; }
        if (sl == 0) { const float bb = a.in[5][l * 3072 + j]; s0 += bb; s1 += bb; }
        atomicAdd(mod + (l * 2 + 0) * 3072 + j, s0); atomicAdd(mod + (l * 2 + 1) * 3072 + j, s1);
    }
}
__device__ __forceinline__ void ln_rows(const float* src, const float* g, const float* bb, float* dst, bf16* xn, const float* modn, int lane, int wave, int G) {
    const int gw = blockIdx.x * 8 + wave, NGW = G * 8;
    f32x4 gv[4], bv[4];
#pragma unroll
    for (int j = 0; j < 4; ++j) { gv[j] = ((const f32x4*)g)[lane + 64 * j]; bv[j] = ((const f32x4*)bb)[lane + 64 * j]; }
    for (int m = gw; m < M; m += NGW) {
        const f32x4* xr = (const f32x4*)(src + (size_t)m * D) + lane;
        f32x4 v[4]; float s = 0.f;
#pragma unroll
        for (int j = 0; j < 4; ++j) { v[j] = xr[64 * j]; s += (v[j].x + v[j].y) + (v[j].z + v[j].w); }
        const float mean = wave_sum(s) * (1.f / D); float s2 = 0.f;
#pragma unroll
        for (int j = 0; j < 4; ++j) { v[j] = v[j] - mean; s2 += (v[j].x * v[j].x + v[j].y * v[j].y) + (v[j].z * v[j].z + v[j].w * v[j].w); }
        const float rstd = 1.f / sqrtf(wave_sum(s2) * (1.f / D) + LN_EPS);
        f32x4* o = (f32x4*)(dst + (size_t)m * D) + lane;
        const int b = m >= T ? 1 : 0;
#pragma unroll
        for (int j = 0; j < 4; ++j) { const f32x4 hv = v[j] * rstd * gv[j] + bv[j]; o[64 * j] = hv;
            if (modn) { const f32x4 sh = ((const f32x4*)(modn + b * 3072))[lane + 64 * j], sc = ((const f32x4*)(modn + b * 3072 + 1024))[lane + 64 * j];
                const f32x4 y = hv * (sc + 1.0f) + sh; u32x2 w; w.x = pk2(y.x, y.y); w.y = pk2(y.z, y.w);
                *((u32x2*)(xn + (size_t)m * D) + lane + 64 * j) = w; } }
    }
}
__device__ __forceinline__ float tanh_fast(float x) { const float e = __expf(2.f * x); return 1.f - 2.f / (e + 1.f); }
__device__ __forceinline__ void cum_kmax(const Args& a, LAS unsigned char* lds, int l, int bh, int tid, int lane, int wave) {
    const int b = bh >> 3, h = bh & 7;
    const bf16* PA = (const bf16*)(a.ws + WS_PA); const bf16* PB = (const bf16*)(a.ws + WS_PB);
    float* cum = (float*)(a.ws + WS_CUM) + (size_t)bh * T;
    const float bf = a.in[17][l * 8 + h];
    LAS float* red = (LAS float*)lds;
    const int t0 = tid * 32;
    float s = 0.f, kmx = 0.f;
#pragma unroll 1
    for (int i = 0; i < 32; ++i) { const size_t m = (size_t)b * T + t0 + i;
        const float z = bf2f(PA[m * LDA + 1152 + h]) + bf;
        const float lf = fminf(z, 0.f) - log1pf(__expf(-fabsf(z)));
        s += lf; cum[t0 + i] = s;
        const u32x4* kr = (const u32x4*)(PB + m * LDB + 512 + h * 64); float q = 0.f;
#pragma unroll
        for (int c = 0; c < 8; ++c) { const u32x4 w = kr[c];
            q += bflo(w.x) * bflo(w.x) + bfhi(w.x) * bfhi(w.x) + bflo(w.y) * bflo(w.y) + bfhi(w.y) * bfhi(w.y) + bflo(w.z) * bflo(w.z) + bfhi(w.z) * bfhi(w.z) + bflo(w.w) * bflo(w.w) + bfhi(w.w) * bfhi(w.w); }
        kmx = fmaxf(kmx, q); }
    red[tid] = s;
#pragma unroll
    for (int o = 1; o < 64; o <<= 1) kmx = fmaxf(kmx, __shfl_xor(kmx, o));
    if (lane == 0) red[512 + wave] = kmx;
    __syncthreads();
    if (tid == 0) { float run = 0.f; for (int i = 0; i < 512; ++i) { const float v = red[i]; red[i] = run; run += v; }
        float k = 0.f; for (int i = 0; i < 8; ++i) k = fmaxf(k, red[512 + i]);
        ((float*)(a.ws + WS_CTL))[CW_KMAX + 16 * l + bh] = sqrtf(k); }
    __syncthreads();
    const float off = red[tid];
#pragma unroll 1
    for (int i = 0; i < 32; ++i) cum[t0 + i] += off;
    __syncthreads();
}
__device__ __forceinline__ void prep_phase(const Args& a, LAS unsigned char* lds, int l, int tid, int lane, int wave, int G) {
    const bf16* PA = (const bf16*)(a.ws + WS_PA); const bf16* PV = (const bf16*)(a.ws + WS_PV);
    bf16* SCN = (bf16*)(a.ws + WS_SCN); float* SCS = (float*)(a.ws + WS_SCS); bf16* VS = (bf16*)(a.ws + WS_VS);
    LAS unsigned* Wl = (LAS unsigned*)lds;
    LAS float* low = (LAS float*)(lds + 131072);
    const int c = tid, h = wave;
    { const float* wu = a.in[9] + (size_t)l * 64 * 512 + c; const float* au = a.in[11] + (size_t)l * 64 * 512 + c;
#pragma unroll 8
      for (int i = 0; i < 64; ++i) Wl[i * 512 + c] = pk2(wu[i * 512], au[i * 512]); }
    const float* mix = a.in[7] + l * 1664;
    const float mix_r = mix[c], mix_k = mix[512 + c], mix_v = mix[1024 + c];
    const float mlow0 = mix[1536 + (tid & 127)];
    const float w0c = a.in[8][l * 512 + c], a0c = a.in[10][l * 512 + c], kkc = a.in[12][l * 512 + c], kac = a.in[13][l * 512 + c], rkc = a.in[14][l * 512 + c];
    __syncthreads();
    unsigned* pq = (unsigned*)(a.ws + WS_CTL) + CW_QUEUE + 1024 + 64 * l;
    volatile LAS unsigned* ptask = (volatile LAS unsigned*)(lds + 140000);
    for (;;) {
        __syncthreads();
        if (tid == 0) ptask[0] = atomicAdd(pq, 1u);
        __syncthreads();
        const unsigned ptk = ptask[0];
        if (ptk >= 16u + (unsigned)(M / 64)) break;
        if (ptk < 16u) { cum_kmax(a, lds + 135168, l, (int)ptk, tid, lane, wave); continue; }
        const int chunk = (int)ptk - 16;
        const int m0 = chunk * 64, b = m0 >= T ? 1 : 0, t0 = m0 - b * T; const int bh = b * 8 + h;
        float pr = 0.f, pk = 0.f, pv = 0.f;
        if (t0 > 0) { pr = bf2f(PA[(size_t)(m0 - 1) * LDA + c]); pk = bf2f(PA[(size_t)(m0 - 1) * LDA + 512 + c]); pv = bf2f(PV[(size_t)(m0 - 1) * LDV + c]); }
#pragma unroll 1
        for (int g = 0; g < 8; ++g) {
#pragma unroll
            for (int e = 0; e < 2; ++e) { const int idx = tid + 512 * e, tt = idx >> 7, i = idx & 127; const int m = m0 + g * 8 + tt, t = t0 + g * 8 + tt;
                const float cur = bf2f(PA[(size_t)m * LDA + 1024 + i]); const float prev = t > 0 ? bf2f(PA[(size_t)(m - 1) * LDA + 1024 + i]) : 0.f;
                float val = cur + (prev - cur) * mlow0; if (i < 64) val = tanh_fast(val);
                low[i * 8 + tt] = val; }
            __syncthreads();
            f32x4 wlA = {0.f, 0.f, 0.f, 0.f}, wlB = wlA, alA = wlA, alB = wlA;
#pragma unroll 4
            for (int i = 0; i < 64; ++i) { const unsigned wp = Wl[i * 512 + c]; const float wv = bflo(wp), av = bfhi(wp);
                const LAS f32x4* lx = (const LAS f32x4*)(low + i * 8); const LAS f32x4* ly = (const LAS f32x4*)(low + (64 + i) * 8);
                wlA += lx[0] * wv; wlB += lx[1] * wv; alA += ly[0] * av; alB += ly[1] * av; }
            {
                const int mg = m0 + g * 8, tg = t0 + g * 8;
                float cr[8], ck[8], cv[8];
#pragma unroll
                for (int tt = 0; tt < 8; ++tt) { cr[tt] = bf2f(PA[(size_t)(mg + tt) * LDA + c]); ck[tt] = bf2f(PA[(size_t)(mg + tt) * LDA + 512 + c]); cv[tt] = bf2f(PV[(size_t)(mg + tt) * LDV + c]); }
                float rr[8], kkr[8], kp[8], vv[8], av[8], omw[8], red[32];
#pragma unroll
                for (int tt = 0; tt < 8; ++tt) {
                    const float prr = tt ? cr[tt - 1] : pr, prk = tt ? ck[tt - 1] : pk, prv = tt ? cv[tt - 1] : pv;
                    const float r = cr[tt] + (prr - cr[tt]) * mix_r, k = ck[tt] + (prk - ck[tt]) * mix_k; vv[tt] = cv[tt] + (prv - cv[tt]) * mix_v;
                    const float wl = w0c + (tt < 4 ? wlA[tt & 3] : wlB[tt & 3]), al = a0c + (tt < 4 ? alA[tt & 3] : alB[tt & 3]);
                    const float z = -wl; const float sp = fmaxf(z, 0.f) + __logf(1.f + __expf(-fabsf(z)));
                    const float e = __expf(-sp - 0.5f); omw[tt] = 1.f - __expf(-e);
                    av[tt] = fast_sigmoid(al);
                    kkr[tt] = k * kkc; kp[tt] = k * (1.f + (av[tt] - 1.f) * kac); rr[tt] = r;
                    red[tt] = kkr[tt] * kkr[tt]; red[8 + tt] = kkr[tt] * av[tt] * r; red[16 + tt] = kp[tt] * r; red[24 + tt] = r * kp[tt] * rkc;
                }
                pr = cr[7]; pk = ck[7]; pv = cv[7];
#pragma unroll
                for (int o = 1; o < 64; o <<= 1) {
#pragma unroll
                    for (int i = 0; i < 32; ++i) red[i] += __shfl_xor(red[i], o); }
#pragma unroll
                for (int tt = 0; tt < 8; ++tt) {
                    const float inv = 1.f / fmaxf(sqrtf(red[tt]), 1e-12f);
                    const float kk = kkr[tt] * inv, bbv = kk * av[tt], wr = (1.f - omw[tt]) * rr[tt];
                    bf16* rec = SCN + ((size_t)bh * T + tg + tt) * 320 + lane;
                    rec[0] = (bf16)f2bf(kk); rec[64] = (bf16)f2bf(wr); rec[128] = (bf16)f2bf(omw[tt]); rec[192] = (bf16)f2bf(bbv); rec[256] = (bf16)f2bf(kp[tt]);
                    VS[(size_t)(mg + tt) * 512 + c] = (bf16)f2bf(vv[tt]);
                    if (lane == 0) { f32x4 sc = {red[8 + tt] * inv, red[16 + tt], red[24 + tt], 0.f}; *(f32x4*)(SCS + ((size_t)bh * T + tg + tt) * 4) = sc; }
                }
            }
            __syncthreads();
        }
    }
    __syncthreads();
}

__device__ __forceinline__ float dppf(float x, const int ctrl_sel) {
    unsigned u = __float_as_uint(x), r;
    if (ctrl_sel == 0) r = __builtin_amdgcn_update_dpp(0, u, 0xB1, 0xF, 0xF, true);
    else if (ctrl_sel == 1) r = __builtin_amdgcn_update_dpp(0, u, 0x4E, 0xF, 0xF, true);
    else r = __builtin_amdgcn_update_dpp(0, u, 0x141, 0xF, 0xF, true);
    return __uint_as_float(r);
}
__device__ __forceinline__ float red8(float x) { x += dppf(x, 0); x += dppf(x, 1); x += dppf(x, 2); return x; }
constexpr int SC_CH = 32, SC_BUF = SC_CH * 320 * 4, SC_VOFF = 2 * SC_BUF, SC_SOFF = SC_VOFF + 2 * SC_CH * 32 * 4, SC_ROWB = SC_SOFF + 2 * SC_CH * 16;
constexpr int NSEG = 8, SEGLEN = T / NSEG;
struct ScanOps { f32x4 kk, wr, w, bb, kp; float v; f32x2 brkr; };
__device__ __forceinline__ void scan_ld(ScanOps& o, const LAS unsigned char* bp, const LAS float* vb, const LAS float* sb, int s) {
    const LAS f32x4* op = (const LAS f32x4*)(bp + s * 1280);
    o.kk = op[0]; o.wr = op[16]; o.w = op[32]; o.bb = op[48]; o.kp = op[64];
    o.v = vb[s * 32]; o.brkr = *(const LAS f32x2*)(sb + s * 4);
}
__device__ __forceinline__ float red16(float x) {
    x += __uint_as_float(__builtin_amdgcn_update_dpp(0, __float_as_uint(x), 0xB1, 0xF, 0xF, true));
    x += __uint_as_float(__builtin_amdgcn_update_dpp(0, __float_as_uint(x), 0x4E, 0xF, 0xF, true));
    x += __uint_as_float(__builtin_amdgcn_update_dpp(0, __float_as_uint(x), 0x141, 0xF, 0xF, true));
    x += __uint_as_float(__builtin_amdgcn_update_dpp(0, __float_as_uint(x), 0x140, 0xF, 0xF, true));
    return x;
}
template <bool PASSC> __device__ __forceinline__ void scan_task(const Args& a, LAS unsigned char* lds, int bh, int seg, int rb, int tid, int lane, int wave) {
    const int b = bh >> 3, h = bh & 7;
    const bool ident = !PASSC && rb >= 2; const int row0 = (rb & 1) * 32;
    const int t0 = seg * SEGLEN;
    const bf16* SCN = (const bf16*)(a.ws + WS_SCN) + ((size_t)bh * T + t0) * 320;
    const float* SCS = (const float*)(a.ws + WS_SCS) + ((size_t)bh * T + t0) * 4;
    const bf16* VS = (const bf16*)(a.ws + WS_VS) + ((size_t)b * T + t0) * 512 + h * 64 + row0;
    float* YA = (float*)(a.ws + WS_YA) + ((size_t)b * T + t0) * 512 + h * 64 + row0;
    float* FSb = (float*)(a.ws + WS_FS) + (size_t)bh * NSEG * 128 * 64;
    constexpr int NCH = SEGLEN / SC_CH;
    const int rowl = tid >> 4, j = lane & 15;
    f32x4 S = {0.f, 0.f, 0.f, 0.f};
    __syncthreads();
    if constexpr (PASSC) {
        LAS float* rowb = (LAS float*)(lds + SC_ROWB);
        for (int k = 0; k < seg; ++k) {
            const float* Pk = FSb + ((size_t)k * 128 + 64) * 64; const float* Uk = FSb + ((size_t)k * 128 + row0 + rowl) * 64;
            *(LAS f32x4*)(rowb + rowl * 64 + 4 * j) = S;
            __syncthreads();
            f32x4 acc = *(const f32x4*)(Uk + 4 * j);
#pragma unroll 8
            for (int jj = 0; jj < 64; ++jj) acc += *(const f32x4*)(Pk + jj * 64 + 4 * j) * rowb[rowl * 64 + jj];
            S = acc;
            __syncthreads();
        }
    } else if (ident) {
#pragma unroll
        for (int e = 0; e < 4; ++e) S[e] = (4 * j + e == row0 + rowl) ? 1.f : 0.f;
    }
    u32x4 mreg[3]; u32x4 vreg = {0u, 0u, 0u, 0u}; f32x4 sreg;
    auto gload = [&](int c) {
        const u32x4* src = (const u32x4*)(SCN + (size_t)c * SC_CH * 320);
#pragma unroll
        for (int i = 0; i < 3; ++i) { const int p = tid + 512 * i; if (p < 1280) mreg[i] = src[p]; }
        if (tid < 128) { if (!ident) vreg = *(const u32x4*)(VS + (size_t)(c * SC_CH + (tid >> 2)) * 512 + (tid & 3) * 8); }
        else if (tid < 160) { sreg = *(const f32x4*)(SCS + (size_t)(c * SC_CH + (tid - 128)) * 4); }
    };
    auto lwrite = [&](int c) {
        LAS unsigned char* bp = lds + (c & 1) * SC_BUF;
#pragma unroll
        for (int i = 0; i < 3; ++i) { const int p = tid + 512 * i; const int arr = (p >> 3) % 5;
            if (p < 1280) { const u32x4 w = mreg[i]; f32x4 lo, hi;
                lo[0] = bflo(w.x); lo[1] = bfhi(w.x); lo[2] = bflo(w.y); lo[3] = bfhi(w.y); hi[0] = bflo(w.z); hi[1] = bfhi(w.z); hi[2] = bflo(w.w); hi[3] = bfhi(w.w);
                if (arr == 2) { lo = 1.0f - lo; hi = 1.0f - hi; }
                LAS f32x4* d = (LAS f32x4*)(bp + (size_t)p * 32); d[0] = lo; d[1] = hi; } }
        if (tid < 128) { const u32x4 w = vreg; f32x4 lo, hi;
            lo[0] = bflo(w.x); lo[1] = bfhi(w.x); lo[2] = bflo(w.y); lo[3] = bfhi(w.y); hi[0] = bflo(w.z); hi[1] = bfhi(w.z); hi[2] = bflo(w.w); hi[3] = bfhi(w.w);
            LAS f32x4* d = (LAS f32x4*)(lds + SC_VOFF + (c & 1) * (SC_CH * 32 * 4) + tid * 32); d[0] = lo; d[1] = hi; }
        else if (tid < 160) { *(LAS f32x4*)(lds + SC_SOFF + (c & 1) * (SC_CH * 16) + (tid - 128) * 16) = sreg; }
    };
    gload(0); lwrite(0); gload(1);
    __syncthreads();
    float ykeep = 0.f;
    for (int c = 0; c < NCH; ++c) {
        if (c + 1 < NCH) lwrite(c + 1);
        if (c + 2 < NCH) gload(c + 2);
        const LAS unsigned char* bp = lds + (c & 1) * SC_BUF + j * 16;
        const LAS float* vb = (const LAS float*)(lds + SC_VOFF + (c & 1) * (SC_CH * 32 * 4)) + rowl;
        const LAS float* sb = (const LAS float*)(lds + SC_SOFF + (c & 1) * (SC_CH * 16));
        ScanOps nx; scan_ld(nx, bp, vb, sb, 0);
#pragma unroll 4
        for (int s = 0; s < SC_CH; ++s) {
            const ScanOps o = nx;
            if (s + 1 < SC_CH) scan_ld(nx, bp, vb, sb, s + 1);
            const f32x4 pa4 = S * o.kk;
            const f32x4 sp = S * o.w + o.kp * o.v;
            const float sa = red16((pa4[0] + pa4[1]) + (pa4[2] + pa4[3]));
            if constexpr (PASSC) {
                const f32x4 py4 = S * o.wr;
                const float ys = red16((py4[0] + py4[1]) + (py4[2] + py4[3]));
                const float y = ys - sa * o.brkr.x + o.v * o.brkr.y;
                ykeep = ((s & 15) == j) ? y : ykeep;
                if ((s & 15) == 15) YA[(size_t)(c * SC_CH + (s - 15) + j) * 512 + rowl] = ykeep;
            }
            S = sp - o.bb * sa;
        }
        __syncthreads();
    }
    if constexpr (!PASSC) *(f32x4*)(FSb + ((size_t)seg * 128 + (ident ? 64 : 0) + row0 + rowl) * 64 + 4 * j) = S;
}

__device__ __forceinline__ int crow(int r, int hi) { return (r & 3) + 8 * (r >> 2) + 4 * hi; }
typedef short v4i16_t __attribute__((ext_vector_type(4)));
__device__ __forceinline__ s16x4 vtr(const LAS unsigned char* p) { return __builtin_bit_cast(s16x4, __builtin_amdgcn_ds_read_tr16_b64_v4i16((LAS v4i16_t*)p)); }
constexpr int AT_KS = 0, AT_VS = 9216, AT_BIAS = 18432, AT_WSF = 18688, AT_FLAG = 19712, AT_TASK = 140000;
__device__ __forceinline__ void attn_unit(const Args& a, LAS unsigned char* lds, int l, int bh, int qb, int tid, int lane, int wid) {
    const int b = bh >> 3, h = bh & 7, r32 = lane & 31, hi = lane >> 5;
    const int q0 = qb * 256;
    bf16* PB = (bf16*)(a.ws + WS_PB);
    const float* cumh = (const float*)(a.ws + WS_CUM) + (size_t)bh * T;
    const float kmax = ((const float*)(a.ws + WS_CTL))[CW_KMAX + 16 * l + bh];
    const size_t rowbase = (size_t)b * T;
    const bf16* Qp = PB + (rowbase + q0 + wid * 32 + r32) * LDB + h * 64;
    bf16x8 qr[4]; float qs = 0.f;
#pragma unroll
    for (int d0 = 0; d0 < 4; ++d0) { const u32x4 w = *(const u32x4*)(Qp + d0 * 16 + hi * 8); qr[d0] = __builtin_bit_cast(bf16x8, w);
        qs += bflo(w.x) * bflo(w.x) + bfhi(w.x) * bfhi(w.x) + bflo(w.y) * bflo(w.y) + bfhi(w.y) * bfhi(w.y) + bflo(w.z) * bflo(w.z) + bfhi(w.z) * bfhi(w.z) + bflo(w.w) * bflo(w.w) + bfhi(w.w) * bfhi(w.w); }
    qs += __shfl_xor(qs, 32);
    const float qbound = sqrtf(qs) * kmax * 1.01f + 0.01f;
    const float ref = cumh[q0 + 255];
    const int srow = tid >> 3, sch = tid & 7;
    const bf16* Kg = PB + rowbase * LDB + 512 + h * 64 + sch * 8; const bf16* Vg = Kg + 512;
    LAS unsigned char* Ks = lds + AT_KS; LAS unsigned char* Vs = lds + AT_VS; LAS float* biasL = (LAS float*)(lds + AT_BIAS);
    LAS float* wsf = (LAS float*)(lds + AT_WSF) + wid * 32; volatile LAS unsigned* flag = (volatile LAS unsigned*)(lds + AT_FLAG);
    if (tid < 3) flag[tid] = 0u;
    float m = -INFINITY, lsum = 0.f; f32x16 o0 = {}, o1 = {};
    u32x4 kreg, vreg; float breg = 0.f, bnx = 0.f;
    int j = qb * 4 + 3;
    { kreg = *(const u32x4*)(Kg + (size_t)(64 * j + srow) * LDB); vreg = *(const u32x4*)(Vg + (size_t)(64 * j + srow) * LDB);
      if (tid < 64) breg = (ref - cumh[64 * j + tid]) * L2E; bnx = j > 0 ? (ref - cumh[64 * j - 1]) * L2E : 0.f; }
    const int q4 = (lane & 15) >> 2, p4 = lane & 3, blk = (lane >> 4) & 1;
    const int qrow = q0 + wid * 32 + r32;
    int it = 0;
    __syncthreads();
    for (;;) {
        *(LAS u32x4*)(Ks + srow * 144 + sch * 16) = kreg; *(LAS u32x4*)(Vs + srow * 144 + sch * 16) = vreg; if (tid < 64) biasL[tid] = breg;
        const float bnx_cur = bnx;
        __syncthreads();
        if (j > 0) { const int jn = j - 1;
            kreg = *(const u32x4*)(Kg + (size_t)(64 * jn + srow) * LDB); vreg = *(const u32x4*)(Vg + (size_t)(64 * jn + srow) * LDB);
            if (tid < 64) breg = (ref - cumh[64 * jn + tid]) * L2E; bnx = jn > 0 ? (ref - cumh[64 * jn - 1]) * L2E : 0.f; }
        if (64 * j <= q0 + 32 * wid + 31) {
            f32x16 p0 = {}, p1 = {};
#pragma unroll
            for (int d0 = 0; d0 < 4; ++d0) {
                const bf16x8 k0 = *(const LAS bf16x8*)(Ks + r32 * 144 + d0 * 32 + hi * 16);
                const bf16x8 k1 = *(const LAS bf16x8*)(Ks + (32 + r32) * 144 + d0 * 32 + hi * 16);
                p0 = __builtin_amdgcn_mfma_f32_32x32x16_bf16(k0, qr[d0], p0, 0, 0, 0);
                p1 = __builtin_amdgcn_mfma_f32_32x32x16_bf16(k1, qr[d0], p1, 0, 0, 0); }
#pragma unroll
            for (int g = 0; g < 4; ++g) { const f32x4 b0 = *(const LAS f32x4*)(biasL + 8 * g + 4 * hi), b1 = *(const LAS f32x4*)(biasL + 32 + 8 * g + 4 * hi);
#pragma unroll
                for (int e = 0; e < 4; ++e) { p0[4 * g + e] += b0[e]; p1[4 * g + e] += b1[e]; } }
            if (64 * j + 63 > q0 + 32 * wid) {
#pragma unroll
                for (int r = 0; r < 16; ++r) { const int kv = 64 * j + crow(r, hi); if (kv > qrow) p0[r] = -INFINITY; if (kv + 32 > qrow) p1[r] = -INFINITY; } }
            float mx = fmaxf(p0[0], p1[0]);
#pragma unroll
            for (int r = 1; r < 16; ++r) mx = fmaxf(mx, fmaxf(p0[r], p1[r]));
            mx = fmaxf(mx, __shfl_xor(mx, 32));
            const float mnew = fmaxf(m, mx); const float f = __builtin_amdgcn_exp2f(m - mnew); m = mnew;
            float rs = 0.f;
#pragma unroll
            for (int r = 0; r < 16; ++r) { p0[r] = __builtin_amdgcn_exp2f(p0[r] - mnew); p1[r] = __builtin_amdgcn_exp2f(p1[r] - mnew); rs += p0[r] + p1[r]; }
            lsum = lsum * f + rs;
            if (__any(f != 1.f)) {
                if (hi == 0) wsf[r32] = f;
                asm volatile("s_waitcnt lgkmcnt(0)" ::: "memory");
#pragma unroll
                for (int r = 0; r < 16; ++r) { const float fr = wsf[crow(r, hi)]; o0[r] *= fr; o1[r] *= fr; }
            }
            u32x4 pw[4];
            pw[0] = (u32x4){cvtpk(p0[0], p0[1]), cvtpk(p0[2], p0[3]), cvtpk(p0[4], p0[5]), cvtpk(p0[6], p0[7])};
            pw[1] = (u32x4){cvtpk(p0[8], p0[9]), cvtpk(p0[10], p0[11]), cvtpk(p0[12], p0[13]), cvtpk(p0[14], p0[15])};
            pw[2] = (u32x4){cvtpk(p1[0], p1[1]), cvtpk(p1[2], p1[3]), cvtpk(p1[4], p1[5]), cvtpk(p1[6], p1[7])};
            pw[3] = (u32x4){cvtpk(p1[8], p1[9]), cvtpk(p1[10], p1[11]), cvtpk(p1[12], p1[13]), cvtpk(p1[14], p1[15])};
#pragma unroll
            for (int s = 0; s < 4; ++s) { const int kvb = 16 * (s & 1) + 32 * (s >> 1);
                const LAS unsigned char* va = Vs + (kvb + 4 * hi + q4) * 144 + (16 * blk + 4 * p4) * 2;
                const s16x4 l0 = vtr(va), h0 = vtr(va + 8 * 144), l1 = vtr(va + 64), h1 = vtr(va + 8 * 144 + 64);
                const bf16x8 vf0 = {l0[0], l0[1], l0[2], l0[3], h0[0], h0[1], h0[2], h0[3]}, vf1 = {l1[0], l1[1], l1[2], l1[3], h1[0], h1[1], h1[2], h1[3]};
                const bf16x8 pa = __builtin_bit_cast(bf16x8, pw[s]);
                o0 = __builtin_amdgcn_mfma_f32_32x32x16_bf16(pa, vf0, o0, 0, 0, 0);
                o1 = __builtin_amdgcn_mfma_f32_32x32x16_bf16(pa, vf1, o1, 0, 0, 0); }
        }
        if (j == 0) break;
        const bool need = (qbound + bnx_cur > m - 40.f);
        if (tid == 0) flag[(it + 1) % 3] = 0u;
        if (__any(need) && lane == 0) flag[it % 3] = 1u;
        __syncthreads();
        const unsigned cont = flag[it % 3];
        if (!cont) break;
        --j; ++it;
    }
    lsum += __shfl_xor(lsum, 32);
    if (hi == 0) wsf[r32] = 1.f / lsum;
    asm volatile("s_waitcnt lgkmcnt(0)" ::: "memory");
    bf16* Ow = (bf16*)(a.ws + WS_PV) + (rowbase + q0 + wid * 32) * LDV + h * 64 + r32;
#pragma unroll
    for (int r = 0; r < 16; ++r) { const float inv = wsf[crow(r, hi)]; bf16* op = Ow + (size_t)crow(r, hi) * LDV;
        op[0] = (bf16)f2bf(o0[r] * inv); op[32] = (bf16)f2bf(o1[r] * inv); }
    __syncthreads();
}
__device__ __forceinline__ void p3a_phase(const Args& a, LAS unsigned char* lds, int l, int tid, int lane, int wave) {
    unsigned* ctr = (unsigned*)(a.ws + WS_CTL) + CW_QUEUE + 64 * l;
    volatile LAS unsigned* task = (volatile LAS unsigned*)(lds + AT_TASK);
    for (;;) {
        __syncthreads();
        if (tid == 0) task[0] = atomicAdd(ctr, 1u);
        __syncthreads();
        const unsigned tk = task[0];
        if (tk >= 512u + 1024u) break;
        if (tk < 512u) { const int bh = (int)(tk >> 5), seg = (int)((tk >> 2) & 7), rb = (int)(tk & 3);
            if (seg == NSEG - 1 || (seg == 0 && rb >= 2)) continue;
            scan_task<false>(a, lds, bh, seg, rb, tid, lane, wave); }
        else { const unsigned u = tk - 512u; attn_unit(a, lds, l, (int)(u & 15), 63 - (int)(u >> 4), tid, lane, wave); }
    }
}
__device__ __forceinline__ void p3b_phase(const Args& a, LAS unsigned char* lds, int l, int tid, int lane, int wave) {
    unsigned* ctr = (unsigned*)(a.ws + WS_CTL) + CW_QUEUE + 512 + 64 * l;
    volatile LAS unsigned* task = (volatile LAS unsigned*)(lds + AT_TASK);
    for (;;) {
        __syncthreads();
        if (tid == 0) task[0] = atomicAdd(ctr, 1u);
        __syncthreads();
        const unsigned tk = task[0];
        if (tk >= 256u) break;
        scan_task<true>(a, lds, (int)(tk >> 4), (int)((tk >> 1) & 7), (int)(tk & 1), tid, lane, wave);
    }
}

__device__ __forceinline__ void merge_phase(const Args& a, int l, int tid, int lane, int wave, int G) {
    const float* YA = (const float*)(a.ws + WS_YA); const bf16* VS = (const bf16*)(a.ws + WS_VS); const bf16* PB = (const bf16*)(a.ws + WS_PB);
    const float* SCS = (const float*)(a.ws + WS_SCS); bf16* YM = (bf16*)(a.ws + WS_YM);
    const int c = tid, h = wave;
    const float gg = a.in[15][l * 512 + c], gb = a.in[16][l * 512 + c];
    constexpr int MT = 8;
    for (int m0 = blockIdx.x * MT; m0 < M; m0 += G * MT) {
        float ya[MT], v[MT], g1[MT], g2[MT], yb[MT], rkr[MT], mean[MT], var[MT];
#pragma unroll
        for (int u = 0; u < MT; ++u) { const int m = m0 + u; const int b = m >= T ? 1 : 0, t = m - b * T;
            ya[u] = YA[(size_t)m * 512 + c]; v[u] = bf2f(VS[(size_t)m * 512 + c]);
            g1[u] = bf2f(PB[(size_t)m * LDB + 1536 + c]); g2[u] = bf2f(PB[(size_t)m * LDB + 2048 + c]);
            yb[u] = bf2f(((const bf16*)(a.ws + WS_PV))[(size_t)m * LDV + c]);
            rkr[u] = SCS[((size_t)(b * 8 + h) * T + t) * 4 + 2]; mean[u] = ya[u]; }
#pragma unroll
        for (int o = 1; o < 64; o <<= 1) {
#pragma unroll
            for (int u = 0; u < MT; ++u) mean[u] += __shfl_xor(mean[u], o); }
#pragma unroll
        for (int u = 0; u < MT; ++u) { mean[u] *= (1.f / 64.f); const float d = ya[u] - mean[u]; var[u] = d * d; }
#pragma unroll
        for (int o = 1; o < 64; o <<= 1) {
#pragma unroll
            for (int u = 0; u < MT; ++u) var[u] += __shfl_xor(var[u], o); }
#pragma unroll
        for (int u = 0; u < MT; ++u) { const int m = m0 + u;
            const float yn = (ya[u] - mean[u]) * rsqrtf(var[u] * (1.f / 64.f) + GN_EPS) * gg + gb + rkr[u] * v[u];
            YM[(size_t)m * D + c] = (bf16)f2bf(yn * g1[u]); YM[(size_t)m * D + 512 + c] = (bf16)f2bf(yb[u] * g2[u]); }
    }
}

#ifndef N_LAUNCH_MODE
#define N_LAUNCH_MODE 1
#endif
template <int MASK, bool COOP> __device__ __forceinline__ void run_phases(const Args& a, LAS unsigned char* lds, int l0, int l1) {
    const int G = gridDim.x;
#define LAUNDER() int tid = threadIdx.x; asm volatile("" : "+v"(tid)); const int lane = tid & 63, wave = __builtin_amdgcn_readfirstlane(tid >> 6); (void)lane; (void)wave
    float* hbuf = a.out;
    const float* mod = (const float*)(a.ws + WS_CTL) + CW_MOD;
    bf16* XN = (bf16*)(a.ws + WS_XN);
#define GSYNC() do { if constexpr (COOP) cg::this_grid().sync(); } while (0)
    if constexpr (MASK & 1) { LAUNDER(); p0a(a, lds, tid, lane, wave, G); GSYNC(); }
    if constexpr (MASK & 2) { LAUNDER(); ln_rows(a.in[0], a.in[2], a.in[3], hbuf, XN, mod, lane, wave, G); GSYNC(); }
#pragma unroll 1
    for (int l = l0; l < l1; ++l) {
        for (int rep = 0; rep < ((PROBE_REP & 4) ? 2 : 1); ++rep)
        if constexpr (MASK & 4) { pg8::Gemm g{XN, (const bf16*)(a.ws + WS_WIN) + (size_t)l * NPROJ * 1024, M, NPROJ, 1024}; pg8::StaticOrder S; S.init(M, NPROJ, G, (int)blockIdx.x);
          EpiProj E{(bf16*)(a.ws + WS_PA), (bf16*)(a.ws + WS_PV), (bf16*)(a.ws + WS_PB)};
          pg8::gemm_phase<EpiProj, pg8::StaticOrder, true, true>(lds, g, S, E); GSYNC(); }
        for (int rep = 0; rep < ((PROBE_REP & 8) ? 2 : 1); ++rep)
        if constexpr (MASK & 8) { LAUNDER(); prep_phase(a, lds, l, tid, lane, wave, G); GSYNC(); }
        if constexpr (MASK & 16) { { LAUNDER(); p3a_phase(a, lds, l, tid, lane, wave); } GSYNC(); { LAUNDER(); p3b_phase(a, lds, l, tid, lane, wave); } GSYNC(); }
        for (int rep = 0; rep < ((PROBE_REP & 32) ? 2 : 1); ++rep)
        if constexpr (MASK & 32) { LAUNDER(); merge_phase(a, l, tid, lane, wave, G); GSYNC(); }
        if constexpr (MASK & 64) { pg8::Gemm g{(const bf16*)(a.ws + WS_YM), (const bf16*)(a.ws + WS_WOUT) + (size_t)l * 1024 * 1024, M, D, D}; pg8::StaticOrder S; S.init(M, D, G, (int)blockIdx.x);
          EpiOut E{hbuf, mod + l * 2 * 3072};
          pg8::gemm_phase<EpiOut, pg8::StaticOrder, true, true>(lds, g, S, E); GSYNC(); }
        if constexpr (MASK & 128) { LAUNDER(); ln_rows(hbuf, a.in[19] + l * D, a.in[20] + l * D, hbuf, XN, (l + 1 < DEPTH) ? mod + (l + 1) * 2 * 3072 : nullptr, lane, wave, G);
          if (l + 1 < l1) GSYNC(); }
    }
#undef GSYNC
#undef LAUNDER
}
#ifndef FMASK
#define FMASK 0xFF
#endif
#if N_LAUNCH_MODE == 1
__global__ void __launch_bounds__(512, 2) hymba_fwd(Args a) {
    extern __shared__ __attribute__((aligned(16))) unsigned char lds_raw[];
    run_phases<FMASK, true>(a, (LAS unsigned char*)lds_raw, 0, DEPTH);
}
#else
template <int MASK> __global__ void __launch_bounds__(512, 2) hymba_phase(Args a, int l) {
    extern __shared__ __attribute__((aligned(16))) unsigned char lds_raw[];
    run_phases<MASK, false>(a, (LAS unsigned char*)lds_raw, l, l + 1);
}
template <int MASK> static void launch_phase(const Args& a, int l, hipStream_t stream) {
    static bool attr = false;
    if (!attr) { (void)hipFuncSetAttribute((const void*)hymba_phase<MASK>, hipFuncAttributeMaxDynamicSharedMemorySize, LDS_BYTES); attr = true; }
    hipLaunchKernelGGL(hymba_phase<MASK>, dim3(256), dim3(512), LDS_BYTES, stream, a, l);
}
#endif

extern "C" void kernel_launch(void* const* d_in, const int* in_sizes, int n_in, void* d_out, int out_size, void* d_ws, size_t ws_size, hipStream_t stream) {
    if (n_in != 21 || ws_size < WS_END) { fprintf(stderr, "kernel_launch: unexpected n_in %d / ws %zu\n", n_in, ws_size); return; }
    (void)hipMemsetAsync((char*)d_ws + WS_CTL, 0, CTL_ZERO_BYTES, stream);
    Args a{};
    for (int i = 0; i < 21; ++i) a.in[i] = (const float*)d_in[i];
    a.out = (float*)d_out; a.ws = (unsigned char*)d_ws;
#if N_LAUNCH_MODE == 1
    static int grid = 0;
    if (grid == 0) {
        int dev = 0, cus = 0, per_cu = 0;
        (void)hipGetDevice(&dev); (void)hipDeviceGetAttribute(&cus, hipDeviceAttributeMultiprocessorCount, dev);
        (void)hipFuncSetAttribute((const void*)hymba_fwd, hipFuncAttributeMaxDynamicSharedMemorySize, LDS_BYTES);
        (void)hipOccupancyMaxActiveBlocksPerMultiprocessor(&per_cu, (const void*)hymba_fwd, 512, LDS_BYTES);
        if (per_cu < 1) per_cu = 1;
        (void)hipGetLastError();
        grid = cus * per_cu;
    }
    void* args[] = {&a};
    hipError_t e = hipLaunchCooperativeKernel((const void*)hymba_fwd, dim3(grid), dim3(512), args, LDS_BYTES, stream);
    if (e != hipSuccess) fprintf(stderr, "cooperative launch failed: %s (grid %d)\n", hipGetErrorString(e), grid);
#else
    launch_phase<1>(a, 0, stream); launch_phase<2>(a, 0, stream);
    for (int l = 0; l < DEPTH; ++l) { launch_phase<4>(a, l, stream); launch_phase<8>(a, l, stream); launch_phase<16>(a, l, stream); launch_phase<32>(a, l, stream); launch_phase<64>(a, l, stream); launch_phase<128>(a, l, stream); }
#endif
}
```

```cpp
#include <hip/hip_runtime.h>
#include <cstdio>
#include <cstdint>
namespace pg8 {
#define PG8_LAS __attribute__((address_space(3)))
typedef unsigned short bf16_t;
typedef short bf16x8 __attribute__((ext_vector_type(8)));
typedef float f32x4 __attribute__((ext_vector_type(4)));
typedef unsigned u32x4 __attribute__((ext_vector_type(4)));
constexpr int BM = 256, BK = 64, HALF = 128, HTB = HALF * BK * 2  , STAGE_BYTES = 8 * HTB, NXCD = 8, WGM = 8;

__host__ __device__ __forceinline__ int lds_byte(int r, int c) { const int st = (r >> 4) * 2 + (c >> 5), rr = r & 15, cc = c & 31, ob = rr * 64 + cc * 2; return st * 1024 + (ob ^ (((ob >> 9) & 1) << 5)); }
__host__ __device__ __forceinline__ void stage_rc(int b, int& R, int& C) { const int st = b / 1024, sb = b % 1024, swz = sb ^ (((sb >> 9) & 1) << 5); R = (st >> 1) * 16 + swz / 64; C = (st & 1) * 32 + (swz % 64) / 2; }
__host__ __device__ __forceinline__ int perm32(int rho) { const int n = rho >> 4, i = rho & 15; return 8 * (i >> 2) + 4 * n + (i & 3); }

struct Unit { int pm, pn; };
struct Gemm { const bf16_t* A; const bf16_t* Bt; int M, N, K; };

struct StaticOrder {
    int nM, nN, nwg, G, c;
    __host__ __device__ void init(int M, int N, int G_, int c_) { nM = M / BM; nN = N / BM; nwg = nM * nN; G = G_; c = c_; }
    __host__ __device__ bool next(int i, Unit& u) const {
        const long L = (long)i * G + c; if (L >= nwg) return false;
        int wgid = (int)L; { const int q = nwg / NXCD, r = nwg % NXCD, xcd = wgid % NXCD, off = wgid / NXCD; wgid = (xcd < r ? xcd * (q + 1) : r * (q + 1) + (xcd - r) * q) + off; }
        const int nig = WGM * nN, gid = wgid / nig, fm = gid * WGM, gsz = (nM - fm) < WGM ? (nM - fm) : WGM;
        u.pm = fm + ((wgid % nig) % gsz); u.pn = (wgid % nig) / gsz; return true;
    }
    __device__ __forceinline__ void a_ready(const Unit&) const {}
    __device__ __forceinline__ void done(const Unit&) const {}
};

__device__ __forceinline__ unsigned cvt_pk_bf16(float lo, float hi) { unsigned r; asm volatile("v_cvt_pk_bf16_f32 %0, %1, %2" : "=v"(r) : "v"(lo), "v"(hi)); return r; }
typedef float f32x2 __attribute__((ext_vector_type(2)));
__device__ __forceinline__ f32x2 gelu_pk(f32x2 v) {
    const f32x2 av = __builtin_elementwise_abs(v), d = av * 0.2316418882f + 1.0f;
    f32x2 t; t.x = __builtin_amdgcn_rcpf(d.x); t.y = __builtin_amdgcn_rcpf(d.y);
    f32x2 q = t * 0.5307027145f + (-0.7265760135f); q = q * t + 0.7107068705f; q = q * t + (-0.142248368f); q = q * t + 0.127414796f; q = q * t;
    const f32x2 s = (v * v) * (-0.72134752044f);
    f32x2 e; e.x = __builtin_amdgcn_exp2f(s.x); e.y = __builtin_amdgcn_exp2f(s.y);
    const f32x2 m = v * (q * e), r = v - m;
    f32x2 o; o.x = v.x < 0.f ? m.x : r.x; o.y = v.y < 0.f ? m.y : r.y; return o;
}

template <int ACT  > struct EpiBf16 {
    static constexpr bool PERM = true, AFTER_DRAIN = false; static_assert(ACT == 0 || ACT == 1, "EpiBf16: ACT is 0 (none) or 1 (gelu_pk)");
    bf16_t* O; int ldc; const float* bias; int split_cols; size_t split_stride; float scale0;
    __device__ __forceinline__ void operator()(const f32x4 (&acc)[2][2][4][2], const Unit& u, int wr, int wc, int fr, int fq) const {
        const int row0 = u.pm * BM + wr * 64 + fr; int colt = u.pn * BM; bf16_t* base = O;
        float sc = 1.f; if (split_cols) { const int t = colt / split_cols; base += (size_t)t * split_stride; colt -= t * split_cols; if (t == 0) sc = scale0; }
        const int col0 = colt + wc * 32 + 8 * fq, bcol0 = u.pn * BM + wc * 32 + 8 * fq;
        f32x4 bv[2][2];
#pragma unroll
        for (int bj = 0; bj < 2; ++bj)
#pragma unroll
            for (int n = 0; n < 2; ++n) bv[bj][n] = bias ? *(const f32x4*)(bias + bcol0 + bj * HALF + 4 * n) : (f32x4){0.f, 0.f, 0.f, 0.f};
#pragma unroll
        for (int ai = 0; ai < 2; ++ai)
#pragma unroll
            for (int m = 0; m < 4; ++m) { bf16_t* rowp = base + (size_t)(row0 + ai * HALF + m * 16) * ldc + col0;
#pragma unroll
                for (int bj = 0; bj < 2; ++bj) { f32x4 v0 = acc[ai][bj][m][0] + bv[bj][0], v1 = acc[ai][bj][m][1] + bv[bj][1];
                    if (ACT == 1) { f32x2 a = gelu_pk((f32x2){v0[0], v0[1]}), b = gelu_pk((f32x2){v0[2], v0[3]}), c = gelu_pk((f32x2){v1[0], v1[1]}), d = gelu_pk((f32x2){v1[2], v1[3]});
                        v0 = (f32x4){a.x, a.y, b.x, b.y}; v1 = (f32x4){c.x, c.y, d.x, d.y}; }
                    v0 = v0 * sc; v1 = v1 * sc; u32x4 w; w.x = cvt_pk_bf16(v0[0], v0[1]); w.y = cvt_pk_bf16(v0[2], v0[3]); w.z = cvt_pk_bf16(v1[0], v1[1]); w.w = cvt_pk_bf16(v1[2], v1[3]);
                    *(u32x4*)(rowp + bj * HALF) = w; } }
    }
};

template <class Epi, class Sched, bool ALIGN_EPI = false, bool SP2 = false>
__device__ __forceinline__ void gemm_phase(PG8_LAS unsigned char* lds, const Gemm g, const Sched& S, const Epi& E) {
    int tid = threadIdx.x; asm volatile("" : "+v"(tid));
    const int wid = __builtin_amdgcn_readfirstlane(tid >> 6), lane = tid & 63, wr = wid >> 2, wc = wid & 3, fr = lane & 15, fq = lane >> 4;
    const int K = g.K, nt = K / BK;
    unsigned voffA[2], voffB[2];
#pragma unroll
    for (int i = 0; i < 2; ++i) { int R, C; stage_rc(tid * 16 + i * 8192, R, C); const int Rb = Epi::PERM ? ((R & ~31) + perm32(R & 31)) : R;
        voffA[i] = (unsigned)(R * K + C) * 2u; voffB[i] = (unsigned)(Rb * K + C) * 2u; }
    const size_t kstep = (size_t)(BK * 2);
    const size_t hstep = (size_t)HALF * K * 2;
    const size_t tstep = 2 * hstep;
    const unsigned ldsw = (unsigned)wid * 1024u;
    const int aoff = lds_byte(wr * 64 + fr, fq * 8), boff = lds_byte(wc * 32 + fr, fq * 8);
#define PG8_SA(b, h) (((b) * 2 + (h)) * HTB)
#define PG8_SB(b, h) ((4 + (b) * 2 + (h)) * HTB)
#define PG8_STAGE(bufoff, gbase, voff) do { _Pragma("unroll") for (int _i = 0; _i < 2; ++_i) \
        __builtin_amdgcn_global_load_lds((const unsigned*)((const char*)(gbase) + (voff)[_i]), (PG8_LAS unsigned*)(lds + (bufoff) + ldsw + _i * 8192), 16, 0, 0); } while (0)
#define PG8_LDA(dst, b, h) do { _Pragma("unroll") for (int m = 0; m < 4; ++m) _Pragma("unroll") for (int k = 0; k < 2; ++k) dst[m][k] = *(const PG8_LAS bf16x8*)(lds + PG8_SA(b, h) + aoff + m * 2048 + k * 1024); } while (0)
#define PG8_LDB(dst, b, h) do { _Pragma("unroll") for (int n = 0; n < 2; ++n) _Pragma("unroll") for (int k = 0; k < 2; ++k) dst[n][k] = *(const PG8_LAS bf16x8*)(lds + PG8_SB(b, h) + boff + n * 2048 + k * 1024); } while (0)
#define PG8_MMA(ai, bj, At, Bt) do { __builtin_amdgcn_s_setprio(1); _Pragma("unroll") for (int m = 0; m < 4; ++m) _Pragma("unroll") for (int n = 0; n < 2; ++n) _Pragma("unroll") for (int k = 0; k < 2; ++k) \
        acc[ai][bj][m][n] = __builtin_amdgcn_mfma_f32_16x16x32_bf16(Bt[n][k], At[m][k], acc[ai][bj][m][n], 0, 0, 0); __builtin_amdgcn_s_setprio(0); } while (0)
#define PG8_WAIT_V(n) asm volatile("s_waitcnt vmcnt(" #n ")" ::: "memory")
#define PG8_WAIT_L(n) asm volatile("s_waitcnt lgkmcnt(" #n ")" ::: "memory")
#define PG8_BAR __builtin_amdgcn_s_barrier()
#define PG8_SCHED __builtin_amdgcn_sched_barrier(0)
    Unit cur, nxt; int ui = 0;
    if (!S.next(0, cur)) return;
    f32x4 acc[2][2][4][2];
#pragma unroll
    for (int a = 0; a < 2; ++a)
#pragma unroll
        for (int b = 0; b < 2; ++b)
#pragma unroll
            for (int m = 0; m < 4; ++m)
#pragma unroll
                for (int n = 0; n < 2; ++n) acc[a][b][m][n] = (f32x4){0.f, 0.f, 0.f, 0.f};
    bf16x8 At[4][2], B0[2][2], B1[2][2];
    const char* cA = (const char*)g.A + (size_t)cur.pm * tstep; const char* cB = (const char*)g.Bt + (size_t)cur.pn * tstep;
    S.a_ready(cur);
    if constexpr (SP2) {
        PG8_STAGE(PG8_SB(0, 0), cB, voffB); PG8_STAGE(PG8_SB(0, 1), cB + hstep, voffB); PG8_STAGE(PG8_SA(0, 0), cA, voffA); PG8_STAGE(PG8_SA(0, 1), cA + hstep, voffA);
        if (wr == 1) PG8_BAR;
        PG8_WAIT_V(2); PG8_BAR;
        PG8_STAGE(PG8_SB(1, 0), cB + kstep, voffB); PG8_STAGE(PG8_SA(1, 0), cA + kstep, voffA); PG8_STAGE(PG8_SB(1, 1), cB + hstep + kstep, voffB);
        PG8_WAIT_V(6); PG8_BAR;
    } else {
        PG8_STAGE(PG8_SB(0, 0), cB, voffB); PG8_STAGE(PG8_SA(0, 0), cA, voffA); PG8_STAGE(PG8_SB(0, 1), cB + hstep, voffB); PG8_STAGE(PG8_SA(0, 1), cA + hstep, voffA);
        if (wr == 1) PG8_BAR;
        PG8_WAIT_V(4); PG8_BAR;
        PG8_STAGE(PG8_SB(1, 0), cB + kstep, voffB); PG8_STAGE(PG8_SA(1, 0), cA + kstep, voffA); PG8_STAGE(PG8_SB(1, 1), cB + hstep + kstep, voffB);
        PG8_WAIT_V(6); PG8_BAR;
    }
    for (;;) {
        const bool has_next = S.next(ui + 1, nxt);
        const char* nA = has_next ? (const char*)g.A + (size_t)nxt.pm * tstep : cA; const char* nB = has_next ? (const char*)g.Bt + (size_t)nxt.pn * tstep : cB;
        for (int t = 0; t < nt; t += 2) {
            const bool last = (t == nt - 2);
            const char* a1 = cA + (size_t)(t + 1) * kstep;
            const char* a2 = last ? nA : cA + (size_t)(t + 2) * kstep; const char* b2 = last ? nB : cB + (size_t)(t + 2) * kstep;
            const char* a3 = a2 + kstep; const char* b3 = b2 + kstep;
            if (last && has_next) S.a_ready(nxt);
            if constexpr (SP2) {
            PG8_LDB(B0, 0, 0); PG8_LDB(B1, 0, 1); PG8_SCHED; PG8_LDA(At, 0, 0); PG8_STAGE(PG8_SA(1, 1), a1 + hstep, voffA);
            PG8_WAIT_V(8); PG8_WAIT_L(0); PG8_BAR; PG8_MMA(0, 0, At, B0); PG8_MMA(0, 1, At, B1); PG8_BAR; PG8_SCHED;
            PG8_LDA(At, 0, 1); PG8_STAGE(PG8_SB(0, 0), b2, voffB); PG8_STAGE(PG8_SB(0, 1), b2 + hstep, voffB); PG8_STAGE(PG8_SA(0, 0), a2, voffA);
            PG8_WAIT_V(8); PG8_WAIT_L(0); PG8_BAR; PG8_MMA(1, 0, At, B0); PG8_MMA(1, 1, At, B1); PG8_BAR; PG8_SCHED;
            PG8_LDB(B0, 1, 0); PG8_LDB(B1, 1, 1); PG8_SCHED; PG8_LDA(At, 1, 0); PG8_STAGE(PG8_SA(0, 1), a2 + hstep, voffA);
            PG8_WAIT_V(8); PG8_WAIT_L(0); PG8_BAR; PG8_MMA(0, 0, At, B0); PG8_MMA(0, 1, At, B1); PG8_BAR; PG8_SCHED;
            PG8_LDA(At, 1, 1); PG8_STAGE(PG8_SB(1, 0), b3, voffB); PG8_STAGE(PG8_SB(1, 1), b3 + hstep, voffB); PG8_STAGE(PG8_SA(1, 0), a3, voffA);
            PG8_WAIT_V(8); PG8_WAIT_L(0); PG8_BAR; PG8_MMA(1, 0, At, B0); PG8_MMA(1, 1, At, B1); PG8_BAR; PG8_SCHED;
            } else {
            PG8_LDB(B0, 0, 0); PG8_SCHED; PG8_LDA(At, 0, 0); PG8_STAGE(PG8_SA(1, 1), a1 + hstep, voffA);
            PG8_WAIT_L(8); PG8_BAR; PG8_WAIT_L(0); PG8_MMA(0, 0, At, B0); PG8_BAR; PG8_SCHED;
            PG8_LDB(B1, 0, 1); PG8_STAGE(PG8_SB(0, 0), b2, voffB);
            PG8_BAR; PG8_WAIT_L(0); PG8_MMA(0, 1, At, B1); PG8_BAR;
            PG8_LDA(At, 0, 1); PG8_STAGE(PG8_SA(0, 0), a2, voffA);
            PG8_BAR; PG8_WAIT_L(0); PG8_MMA(1, 0, At, B0); PG8_BAR; PG8_SCHED;
            PG8_STAGE(PG8_SB(0, 1), b2 + hstep, voffB);
            PG8_WAIT_V(6); PG8_BAR; PG8_MMA(1, 1, At, B1); PG8_BAR;
            PG8_LDB(B0, 1, 0); PG8_SCHED; PG8_LDA(At, 1, 0); PG8_STAGE(PG8_SA(0, 1), a2 + hstep, voffA);
            PG8_WAIT_L(8); PG8_BAR; PG8_WAIT_L(0); PG8_MMA(0, 0, At, B0); PG8_BAR; PG8_SCHED;
            PG8_LDB(B1, 1, 1); PG8_STAGE(PG8_SB(1, 0), b3, voffB);
            PG8_BAR; PG8_WAIT_L(0); PG8_MMA(0, 1, At, B1); PG8_BAR;
            PG8_LDA(At, 1, 1); PG8_STAGE(PG8_SA(1, 0), a3, voffA);
            PG8_BAR; PG8_WAIT_L(0); PG8_MMA(1, 0, At, B0); PG8_BAR; PG8_SCHED;
            PG8_STAGE(PG8_SB(1, 1), b3 + hstep, voffB);
            PG8_WAIT_V(6); PG8_BAR; PG8_MMA(1, 1, At, B1); PG8_BAR;
            }
        }
        if constexpr (ALIGN_EPI) { if (wr == 0) PG8_BAR; }
        if constexpr (!Epi::AFTER_DRAIN) { E(acc, cur, wr, wc, fr, fq); S.done(cur); }
        if (!has_next) break;
#pragma unroll
        for (int a = 0; a < 2; ++a)
#pragma unroll
            for (int b = 0; b < 2; ++b)
#pragma unroll
                for (int m = 0; m < 4; ++m)
#pragma unroll
                    for (int n = 0; n < 2; ++n) acc[a][b][m][n] = (f32x4){0.f, 0.f, 0.f, 0.f};
        cur = nxt; cA = nA; cB = nB; ++ui;
        if constexpr (ALIGN_EPI) { if (wr == 1) PG8_BAR; }
    }
    PG8_WAIT_V(0);
    if constexpr (!ALIGN_EPI) { if (wr == 0) PG8_BAR; }
    PG8_BAR;
    if constexpr (Epi::AFTER_DRAIN) { E.fused(acc, cur, wr, wc, fr, fq, lds, wid, lane); S.done(cur); }
#undef PG8_SA
#undef PG8_SB
#undef PG8_STAGE
#undef PG8_LDA
#undef PG8_LDB
#undef PG8_MMA
#undef PG8_WAIT_V
#undef PG8_WAIT_L
#undef PG8_BAR
#undef PG8_SCHED
}
}
#include <hip/hip_cooperative_groups.h>
namespace cg = cooperative_groups;
#define LAS __attribute__((address_space(3)))
typedef unsigned short bf16;
typedef float f32x4 __attribute__((ext_vector_type(4)));
typedef float f32x2 __attribute__((ext_vector_type(2)));
typedef float f32x16 __attribute__((ext_vector_type(16)));
typedef short bf16x8 __attribute__((ext_vector_type(8)));
typedef short s16x4 __attribute__((ext_vector_type(4)));
typedef unsigned u32x4 __attribute__((ext_vector_type(4)));
typedef unsigned u32x2 __attribute__((ext_vector_type(2)));
typedef __bf16 bf16x2_t __attribute__((ext_vector_type(2)));

constexpr int BATCH = 2, T = 16384, D = 1024, M = BATCH * T, DEPTH = 2;
constexpr int NPROJ = 4352, NSRC = 4232;
constexpr int LDA = 1280, LDV = 512, LDB = 2560;
constexpr float LN_EPS = 1e-5f, GN_EPS = 64e-5f;
constexpr float DN_ALPHA = 1.41421356237f;
constexpr float C2 = 0.125f * 1.4426950408889634f;
constexpr float L2E = 1.4426950408889634f;
constexpr size_t MiB = 1u << 20;
constexpr size_t WS_CTL = 0, CTL_ZERO_BYTES = 1 * MiB;
constexpr size_t WS_WIN = 2 * MiB, WS_WOUT = 20 * MiB, WS_CUM = 24 * MiB, WS_SCS = 25 * MiB, WS_SCN = 30 * MiB;
constexpr size_t WS_XN = WS_SCN, WS_YM = WS_SCN;
constexpr size_t WS_LORA = 29 * MiB;
constexpr size_t WS_PA = 190 * MiB, WS_YA = WS_PA, WS_PV = 270 * MiB, WS_PB = 302 * MiB, WS_VS = 462 * MiB, WS_FS = 494 * MiB, WS_END = 498 * MiB;
constexpr int CW_QUEUE = 64;
constexpr int CW_KMAX = 1024;
constexpr int CW_MOD = 16384;
constexpr int LDS_BYTES = 147456;
#ifndef PROBE_REP
#define PROBE_REP 0
#endif

__device__ __forceinline__ unsigned f2bf(float f) { unsigned u = __builtin_bit_cast(unsigned, f); return (u + 0x7fffu + ((u >> 16) & 1u)) >> 16; }
__device__ __forceinline__ unsigned pk2(float lo, float hi) { return f2bf(lo) | (f2bf(hi) << 16); }
__device__ __forceinline__ float bf2f(unsigned short v) { return __uint_as_float(((unsigned)v) << 16); }
__device__ __forceinline__ float bflo(unsigned w) { return __uint_as_float(w << 16); }
__device__ __forceinline__ float bfhi(unsigned w) { return __uint_as_float(w & 0xffff0000u); }
__device__ __forceinline__ unsigned cvtpk(float lo, float hi) { f32x2 v = {lo, hi}; bf16x2_t b = __builtin_convertvector(v, bf16x2_t); return __builtin_bit_cast(unsigned, b); }
__device__ __forceinline__ float wave_sum(float v) {
#pragma unroll
    for (int o = 1; o < 64; o <<= 1) v += __shfl_xor(v, o);
    return v;
}
__device__ __forceinline__ float fast_sigmoid(float x) { return 1.f / (1.f + __expf(-x)); }

struct Args { const float* in[21]; float* out; unsigned char* ws; };

struct EpiProj {
    static constexpr bool PERM = true, AFTER_DRAIN = false;
    bf16 *PA, *PVb, *PB;
    __device__ __forceinline__ void operator()(const pg8::f32x4 (&acc)[2][2][4][2], const pg8::Unit& u, int wr, int wc, int fr, int fq) const {
        const int row0 = u.pm * 256 + wr * 64 + fr; const int pn = u.pn;
        bf16* base; int ldc, colt; float sc = 1.f; bool act = false;
        if (pn < 4) { base = PA; ldc = LDA; colt = pn * 256; }
        else if (pn < 6) { base = PVb; ldc = LDV; colt = (pn - 4) * 256; }
        else if (pn == 6) { base = PA; ldc = LDA; colt = 1024; }
        else { base = PB; ldc = LDB; colt = (pn - 7) * 256; if (pn < 9) sc = C2; if (pn >= 13) act = true; }
        const int col0 = colt + wc * 32 + 8 * fq;
#pragma unroll
        for (int ai = 0; ai < 2; ++ai)
#pragma unroll
            for (int m = 0; m < 4; ++m) { bf16* rowp = base + (size_t)(row0 + ai * 128 + m * 16) * ldc + col0;
#pragma unroll
                for (int bj = 0; bj < 2; ++bj) { pg8::f32x4 v0 = acc[ai][bj][m][0], v1 = acc[ai][bj][m][1];
                    if (act) {
#pragma unroll
                        for (int e = 0; e < 4; ++e) { v0[e] = v0[e] * fast_sigmoid(v0[e]); v1[e] = v1[e] * fast_sigmoid(v1[e]); } }
                    v0 = v0 * sc; v1 = v1 * sc; u32x4 w; w.x = cvtpk(v0[0], v0[1]); w.y = cvtpk(v0[2], v0[3]); w.z = cvtpk(v1[0], v1[1]); w.w = cvtpk(v1[2], v1[3]);
                    *(u32x4*)(rowp + bj * 128) = w; } }
    }
};
struct EpiOut {
    static constexpr bool PERM = false, AFTER_DRAIN = false;
    float* hz; const float* modl;
    __device__ __forceinline__ void operator()(const pg8::f32x4 (&acc)[2][2][4][2], const pg8::Unit& u, int wr, int wc, int fr, int fq) const {
        const int col0 = u.pn * 256 + wc * 32 + 4 * fq; const int b = (u.pm * 256) >= T ? 1 : 0; const float* gate = modl + b * 3072 + 2048;
#pragma unroll
        for (int bj = 0; bj < 2; ++bj)
#pragma unroll
            for (int n = 0; n < 2; ++n) { const int c = col0 + bj * 128 + n * 16; const f32x4 g = *(const f32x4*)(gate + c) + 1.0f;
#pragma unroll
                for (int ai = 0; ai < 2; ++ai)
#pragma unroll
                    for (int m = 0; m < 4; ++m) { const int r = u.pm * 256 + ai * 128 + wr * 64 + m * 16 + fr; float* p = hz + (size_t)r * D + c;
                        const f32x4 hx = *(const f32x4*)p; f32x4 a; a[0] = acc[ai][bj][m][n][0]; a[1] = acc[ai][bj][m][n][1]; a[2] = acc[ai][bj][m][n][2]; a[3] = acc[ai][bj][m][n][3];
                        *(f32x4*)p = hx * DN_ALPHA + g * a; } }
    }
};

__device__ __forceinline__ int win_map(int n) { if (n < 1664) return n; if (n < 1672) return 3200 + n - 1664; if (n < 1792) return -1; if (n < 3328) return n - 128; return n - 120; }
template <bool MAP> __device__ __forceinline__ void transpose_item(const float* W, int Nsrc, int Ndst, bf16* WT, LAS float* scr, int item, int lane) {
    const int nblk = Ndst / 32, kb = item / nblk, nb = item % nblk, k0 = 64 * kb, n0 = 32 * nb;
    const int src = MAP ? win_map(n0 + (lane & 31)) : n0 + (lane & 31);
#pragma unroll 8
    for (int i = 0; i < 32; ++i) { const int kk = 2 * i + (lane >> 5); scr[kk * 33 + (lane & 31)] = src >= 0 ? W[(size_t)(k0 + kk) * Nsrc + src] : 0.f; }
    asm volatile("s_waitcnt lgkmcnt(0)" ::: "memory");
    const int c = lane & 7;
#pragma unroll
    for (int j = 0; j < 4; ++j) { const int n = (lane >> 3) + 8 * j; const LAS float* s = scr + (8 * c) * 33 + n;
        u32x4 o; o.x = pk2(s[0 * 33], s[1 * 33]); o.y = pk2(s[2 * 33], s[3 * 33]); o.z = pk2(s[4 * 33], s[5 * 33]); o.w = pk2(s[6 * 33], s[7 * 33]);
        *(u32x4*)(WT + (size_t)(n0 + n) * 1024 + k0 + 8 * c) = o; }
    asm volatile("s_waitcnt lgkmcnt(0)" ::: "memory");
}
__device__ __forceinline__ void p0a(const Args& a, LAS unsigned char* lds, int tid, int lane, int wave, int G) {
    LAS float* scr = (LAS float*)(lds + wave * 16384);
    const int gw = blockIdx.x * 8 + wave, NGW = G * 8;
    constexpr int I_IN = 16 * (NPROJ / 32), I_OUT = 16 * 32;
    for (int it = gw; it < 2 * (I_IN + I_OUT); it += NGW) {
        int r = it; const int l = r / (I_IN + I_OUT); r -= l * (I_IN + I_OUT);
        if (r < I_IN) transpose_item<true>(a.in[6] + (size_t)l * 1024 * NSRC, NSRC, NPROJ, (bf16*)(a.ws + WS_WIN) + (size_t)l * NPROJ * 1024, scr, r, lane);
        else transpose_item<false>(a.in[18] + (size_t)l * 1024 * 1024, 1024, 1024, (bf16*)(a.ws + WS_WOUT) + (size_t)l * 1024 * 1024, scr, r - I_IN, lane);
    }
    { bf16* LT = (bf16*)(a.ws + WS_LORA);
      for (int w = blockIdx.x * 512 + tid; w < 2 * 2 * 512 * 64; w += G * 512) { const int k = w & 63, n = (w >> 6) & 511, which = (w >> 15) & 1, l = w >> 16;
          const float* src = (which ? a.in[11] : a.in[9]) + (size_t)l * 64 * 512; LT[w] = (bf16)f2bf(src[k * 512 + n]); } }
    float* mod = (float*)(a.ws + WS_CTL) + CW_MOD;
    const float* cvec = a.in[1];
    for (int w = blockIdx.x * 512 + tid; w < 2 * 16 * 3072; w += G * 512) {
        const int j = w % 3072, sl = (w / 3072) % 16, l = w / (3072 * 16);
        const float* wa = a.in[4] + (size_t)l * 1024 * 3072 + (size_t)(sl * 64) * 3072 + j;
        float s0 = 0.f, s1 = 0.f;
#pragma unroll 8
        for (int i = 0; i < 64; ++i) { const float wv = wa[(size_t)i * 3072]; s0 += cvec[sl * 64 + i] * wv; s1 += cvec[1024 + sl * 64 + i] * wv; }
        if (sl == 0) { const float bb = a.in[5][l * 3072 + j]; s0 += bb; s1 += bb; }
        atomicAdd(mod + (l * 2 + 0) * 3072 + j, s0); atomicAdd(mod + (l * 2 + 1) * 3072 + j, s1);
    }
}
__device__ __forceinline__ void ln_rows(const float* src, const float* g, const float* bb, float* dst, bf16* xn, const float* modn, int lane, int wave, int G) {
    const int gw = blockIdx.x * 8 + wave, NGW = G * 8;
    f32x4 gv[4], bv[4];
#pragma unroll
    for (int j = 0; j < 4; ++j) { gv[j] = ((const f32x4*)g)[lane + 64 * j]; bv[j] = ((const f32x4*)bb)[lane + 64 * j]; }
    for (int m = gw; m < M; m += NGW) {
        const f32x4* xr = (const f32x4*)(src + (size_t)m * D) + lane;
        f32x4 v[4]; float s = 0.f;
#pragma unroll
        for (int j = 0; j < 4; ++j) { v[j] = xr[64 * j]; s += (v[j].x + v[j].y) + (v[j].z + v[j].w); }
        const float mean = wave_sum(s) * (1.f / D); float s2 = 0.f;
#pragma unroll
        for (int j = 0; j < 4; ++j) { v[j] = v[j] - mean; s2 += (v[j].x * v[j].x + v[j].y * v[j].y) + (v[j].z * v[j].z + v[j].w * v[j].w); }
        const float rstd = 1.f / sqrtf(wave_sum(s2) * (1.f / D) + LN_EPS);
        f32x4* o = (f32x4*)(dst + (size_t)m * D) + lane;
        const int b = m >= T ? 1 : 0;
#pragma unroll
        for (int j = 0; j < 4; ++j) { const f32x4 hv = v[j] * rstd * gv[j] + bv[j]; o[64 * j] = hv;
            if (modn) { const f32x4 sh = ((const f32x4*)(modn + b * 3072))[lane + 64 * j], sc = ((const f32x4*)(modn + b * 3072 + 1024))[lane + 64 * j];
                const f32x4 y = hv * (sc + 1.0f) + sh; u32x2 w; w.x = pk2(y.x, y.y); w.y = pk2(y.z, y.w);
                *((u32x2*)(xn + (size_t)m * D) + lane + 64 * j) = w; } }
    }
}
__device__ __forceinline__ int crow(int r, int hi) { return (r & 3) + 8 * (r >> 2) + 4 * hi; }
__device__ __forceinline__ float tanh_fast(float x) { const float e = __expf(2.f * x); return 1.f - 2.f / (e + 1.f); }
__device__ __forceinline__ void cum_kmax(const Args& a, LAS unsigned char* lds, int l, int bh, int tid, int lane, int wave) {
    const int b = bh >> 3, h = bh & 7;
    const bf16* PA = (const bf16*)(a.ws + WS_PA); const bf16* PB = (const bf16*)(a.ws + WS_PB);
    float* cum = (float*)(a.ws + WS_CUM) + (size_t)bh * T;
    const float bf = a.in[17][l * 8 + h];
    LAS float* red = (LAS float*)lds;
    const int t0 = tid * 32;
    float s = 0.f, kmx = 0.f;
#pragma unroll 1
    for (int i = 0; i < 32; ++i) { const size_t m = (size_t)b * T + t0 + i;
        const float z = bf2f(PA[m * LDA + 1152 + h]) + bf;
        const float lf = fminf(z, 0.f) - log1pf(__expf(-fabsf(z)));
        s += lf; cum[t0 + i] = s;
        const u32x4* kr = (const u32x4*)(PB + m * LDB + 512 + h * 64); float q = 0.f;
#pragma unroll
        for (int c = 0; c < 8; ++c) { const u32x4 w = kr[c];
            q += bflo(w.x) * bflo(w.x) + bfhi(w.x) * bfhi(w.x) + bflo(w.y) * bflo(w.y) + bfhi(w.y) * bfhi(w.y) + bflo(w.z) * bflo(w.z) + bfhi(w.z) * bfhi(w.z) + bflo(w.w) * bflo(w.w) + bfhi(w.w) * bfhi(w.w); }
        kmx = fmaxf(kmx, q); }
    red[tid] = s;
#pragma unroll
    for (int o = 1; o < 64; o <<= 1) kmx = fmaxf(kmx, __shfl_xor(kmx, o));
    if (lane == 0) red[512 + wave] = kmx;
    __syncthreads();
    if (tid == 0) { float run = 0.f; for (int i = 0; i < 512; ++i) { const float v = red[i]; red[i] = run; run += v; }
        float k = 0.f; for (int i = 0; i < 8; ++i) k = fmaxf(k, red[512 + i]);
        ((float*)(a.ws + WS_CTL))[CW_KMAX + 16 * l + bh] = sqrtf(k); }
    __syncthreads();
    const float off = red[tid];
#pragma unroll 1
    for (int i = 0; i < 32; ++i) cum[t0 + i] += off;
    __syncthreads();
}
__device__ __forceinline__ void prep_phase(const Args& a, LAS unsigned char* lds, int l, int tid, int lane, int wave, int G) {
    const bf16* PA = (const bf16*)(a.ws + WS_PA); const bf16* PV = (const bf16*)(a.ws + WS_PV);
    bf16* SCN = (bf16*)(a.ws + WS_SCN); float* SCS = (float*)(a.ws + WS_SCS); bf16* VS = (bf16*)(a.ws + WS_VS);
    LAS unsigned char* lowL = lds;
    LAS bf16* CL = (LAS bf16*)(lds + 16384);
    const int c = tid, h = wave, r32 = lane & 31, hi = lane >> 5;
    const bf16* LT = (const bf16*)(a.ws + WS_LORA) + (size_t)l * 2 * 512 * 64;
    const float* mix = a.in[7] + l * 1664;
    const float mix_r = mix[c], mix_k = mix[512 + c], mix_v = mix[1024 + c];
    const int ftok = tid >> 3, fi0 = (tid & 7) * 16;
    f32x4 mlow[4];
#pragma unroll
    for (int q = 0; q < 4; ++q) mlow[q] = *(const f32x4*)(mix + 1536 + fi0 + 4 * q);
    const float w0c = a.in[8][l * 512 + c], a0c = a.in[10][l * 512 + c], kkc = a.in[12][l * 512 + c], kac = a.in[13][l * 512 + c], rkc = a.in[14][l * 512 + c];
    unsigned* pq = (unsigned*)(a.ws + WS_CTL) + CW_QUEUE + 1024 + 64 * l;
    volatile LAS unsigned* ptask = (volatile LAS unsigned*)(lds + 140000);
    for (;;) {
        __syncthreads();
        if (tid == 0) ptask[0] = atomicAdd(pq, 1u);
        __syncthreads();
        const unsigned ptk = ptask[0];
        if (ptk >= 16u + (unsigned)(M / 64)) break;
        if (ptk < 16u) { cum_kmax(a, lds + 135168, l, (int)ptk, tid, lane, wave); continue; }
        const int chunk = (int)ptk - 16;
        const int m0 = chunk * 64, b = m0 >= T ? 1 : 0, t0 = m0 - b * T; const int bh = b * 8 + h;
        { const int m = m0 + ftok, t = t0 + ftok;
          const u32x4* cp = (const u32x4*)(PA + (size_t)m * LDA + 1024 + fi0);
          const u32x4 c0 = cp[0], c1 = cp[1]; u32x4 p0 = {0u, 0u, 0u, 0u}, p1 = p0;
          if (t > 0) { const u32x4* pp = (const u32x4*)(PA + (size_t)(m - 1) * LDA + 1024 + fi0); p0 = pp[0]; p1 = pp[1]; }
          float cur[16], prv[16];
          cur[0] = bflo(c0.x); cur[1] = bfhi(c0.x); cur[2] = bflo(c0.y); cur[3] = bfhi(c0.y); cur[4] = bflo(c0.z); cur[5] = bfhi(c0.z); cur[6] = bflo(c0.w); cur[7] = bfhi(c0.w);
          cur[8] = bflo(c1.x); cur[9] = bfhi(c1.x); cur[10] = bflo(c1.y); cur[11] = bfhi(c1.y); cur[12] = bflo(c1.z); cur[13] = bfhi(c1.z); cur[14] = bflo(c1.w); cur[15] = bfhi(c1.w);
          prv[0] = bflo(p0.x); prv[1] = bfhi(p0.x); prv[2] = bflo(p0.y); prv[3] = bfhi(p0.y); prv[4] = bflo(p0.z); prv[5] = bfhi(p0.z); prv[6] = bflo(p0.w); prv[7] = bfhi(p0.w);
          prv[8] = bflo(p1.x); prv[9] = bfhi(p1.x); prv[10] = bflo(p1.y); prv[11] = bfhi(p1.y); prv[12] = bflo(p1.z); prv[13] = bfhi(p1.z); prv[14] = bflo(p1.w); prv[15] = bfhi(p1.w);
#pragma unroll
          for (int q = 0; q < 16; ++q) { float val = cur[q] + (prv[q] - cur[q]) * mlow[q >> 2][q & 3]; if (fi0 < 64) val = tanh_fast(val); cur[q] = val; }
          u32x4 o0 = {cvtpk(cur[0], cur[1]), cvtpk(cur[2], cur[3]), cvtpk(cur[4], cur[5]), cvtpk(cur[6], cur[7])};
          u32x4 o1 = {cvtpk(cur[8], cur[9]), cvtpk(cur[10], cur[11]), cvtpk(cur[12], cur[13]), cvtpk(cur[14], cur[15])};
          const int ch = 2 * (tid & 7);
          *(LAS u32x4*)(lowL + ftok * 256 + ((ch ^ (ftok & 7)) << 4)) = o0; *(LAS u32x4*)(lowL + ftok * 256 + (((ch + 1) ^ (ftok & 7)) << 4)) = o1; }
        __syncthreads();
        float pr = 0.f, pk = 0.f, pv = 0.f;
        if (t0 > 0) { pr = bf2f(PA[(size_t)(m0 - 1) * LDA + c]); pk = bf2f(PA[(size_t)(m0 - 1) * LDA + 512 + c]); pv = bf2f(PV[(size_t)(m0 - 1) * LDV + c]); }
#pragma unroll 1
        for (int tr = 0; tr < 2; ++tr) {
            { f32x16 Cw0 = {}, Cw1 = {}, Ca0 = {}, Ca1 = {};
              const int trow = 32 * tr + r32;
              bf16x8 Bw[2][4], Ba[2][4];
#pragma unroll
              for (int tc = 0; tc < 2; ++tc)
#pragma unroll
                for (int sx = 0; sx < 4; ++sx) { const int n = 64 * h + 32 * tc + r32;
                    Bw[tc][sx] = __builtin_bit_cast(bf16x8, *(const u32x4*)(LT + (size_t)n * 64 + 16 * sx + 8 * hi));
                    Ba[tc][sx] = __builtin_bit_cast(bf16x8, *(const u32x4*)(LT + 512 * 64 + (size_t)n * 64 + 16 * sx + 8 * hi)); }
#pragma unroll
              for (int sx = 0; sx < 4; ++sx) {
                  const bf16x8 Aw = *(const LAS bf16x8*)(lowL + trow * 256 + (((2 * sx + hi) ^ (trow & 7)) << 4));
                  const bf16x8 Aa = *(const LAS bf16x8*)(lowL + trow * 256 + (((8 + 2 * sx + hi) ^ (trow & 7)) << 4));
                  Cw0 = __builtin_amdgcn_mfma_f32_32x32x16_bf16(Aw, Bw[0][sx], Cw0, 0, 0, 0); Cw1 = __builtin_amdgcn_mfma_f32_32x32x16_bf16(Aw, Bw[1][sx], Cw1, 0, 0, 0);
                  Ca0 = __builtin_amdgcn_mfma_f32_32x32x16_bf16(Aa, Ba[0][sx], Ca0, 0, 0, 0); Ca1 = __builtin_amdgcn_mfma_f32_32x32x16_bf16(Aa, Ba[1][sx], Ca1, 0, 0, 0); }
#pragma unroll
              for (int r = 0; r < 16; ++r) { LAS bf16* row = CL + crow(r, hi) * 1024 + 64 * h + r32;
                  row[0] = (bf16)f2bf(Cw0[r]); row[32] = (bf16)f2bf(Cw1[r]); row[512] = (bf16)f2bf(Ca0[r]); row[544] = (bf16)f2bf(Ca1[r]); } }
            __syncthreads();
#pragma unroll 1
            for (int g = 0; g < 4; ++g) {
                const int tl0 = g * 8, mg = m0 + 32 * tr + tl0, tg = t0 + 32 * tr + tl0;
                float cr[8], ck[8], cv[8];
#pragma unroll
                for (int tt = 0; tt < 8; ++tt) { cr[tt] = bf2f(PA[(size_t)(mg + tt) * LDA + c]); ck[tt] = bf2f(PA[(size_t)(mg + tt) * LDA + 512 + c]); cv[tt] = bf2f(PV[(size_t)(mg + tt) * LDV + c]); }
                float rr[8], kkr[8], kp[8], vv[8], av[8], omw[8], red[32];
#pragma unroll
                for (int tt = 0; tt < 8; ++tt) {
                    const float prr = tt ? cr[tt - 1] : pr, prk = tt ? ck[tt - 1] : pk, prv = tt ? cv[tt - 1] : pv;
                    const float r = cr[tt] + (prr - cr[tt]) * mix_r, k = ck[tt] + (prk - ck[tt]) * mix_k; vv[tt] = cv[tt] + (prv - cv[tt]) * mix_v;
                    const float wl = w0c + bf2f(CL[(tl0 + tt) * 1024 + c]), al = a0c + bf2f(CL[(tl0 + tt) * 1024 + 512 + c]);
                    const float z = -wl; const float sp = fmaxf(z, 0.f) + __logf(1.f + __expf(-fabsf(z)));
                    const float e = __expf(-sp - 0.5f); omw[tt] = 1.f - __expf(-e);
                    av[tt] = fast_sigmoid(al);
                    kkr[tt] = k * kkc; kp[tt] = k * (1.f + (av[tt] - 1.f) * kac); rr[tt] = r;
                    red[tt] = kkr[tt] * kkr[tt]; red[8 + tt] = kkr[tt] * av[tt] * r; red[16 + tt] = kp[tt] * r; red[24 + tt] = r * kp[tt] * rkc;
                }
                pr = cr[7]; pk = ck[7]; pv = cv[7];
#pragma unroll
                for (int o = 1; o < 64; o <<= 1) {
#pragma unroll
                    for (int i = 0; i < 32; ++i) red[i] += __shfl_xor(red[i], o); }
#pragma unroll
                for (int tt = 0; tt < 8; ++tt) {
                    const float inv = 1.f / fmaxf(sqrtf(red[tt]), 1e-12f);
                    const float kk = kkr[tt] * inv, bbv = kk * av[tt], wr = (1.f - omw[tt]) * rr[tt];
                    bf16* rec = SCN + ((size_t)bh * T + tg + tt) * 320 + lane;
                    rec[0] = (bf16)f2bf(kk); rec[64] = (bf16)f2bf(wr); rec[128] = (bf16)f2bf(omw[tt]); rec[192] = (bf16)f2bf(bbv); rec[256] = (bf16)f2bf(kp[tt]);
                    VS[(size_t)(mg + tt) * 512 + c] = (bf16)f2bf(vv[tt]);
                    if (lane == 0) { f32x4 sc = {red[8 + tt] * inv, red[16 + tt], red[24 + tt], 0.f}; *(f32x4*)(SCS + ((size_t)bh * T + tg + tt) * 4) = sc; }
                }
            }
            __syncthreads();
        }
    }
    __syncthreads();
}

__device__ __forceinline__ float dppf(float x, const int ctrl_sel) {
    unsigned u = __float_as_uint(x), r;
    if (ctrl_sel == 0) r = __builtin_amdgcn_update_dpp(0, u, 0xB1, 0xF, 0xF, true);
    else if (ctrl_sel == 1) r = __builtin_amdgcn_update_dpp(0, u, 0x4E, 0xF, 0xF, true);
    else r = __builtin_amdgcn_update_dpp(0, u, 0x141, 0xF, 0xF, true);
    return __uint_as_float(r);
}
__device__ __forceinline__ float red8(float x) { x += dppf(x, 0); x += dppf(x, 1); x += dppf(x, 2); return x; }
constexpr int SC_CH = 32, SC_BUF = SC_CH * 320 * 4, SC_VOFF = 2 * SC_BUF, SC_SOFF = SC_VOFF + 2 * SC_CH * 32 * 4, SC_ROWB = SC_SOFF + 2 * SC_CH * 16;
constexpr int NSEG = 8, SEGLEN = T / NSEG;
struct ScanOps { f32x4 kk, wr, w, bb, kp; float v; f32x2 brkr; };
__device__ __forceinline__ void scan_ld(ScanOps& o, const LAS unsigned char* bp, const LAS float* vb, const LAS float* sb, int s) {
    const LAS f32x4* op = (const LAS f32x4*)(bp + s * 1280);
    o.kk = op[0]; o.wr = op[16]; o.w = op[32]; o.bb = op[48]; o.kp = op[64];
    o.v = vb[s * 32]; o.brkr = *(const LAS f32x2*)(sb + s * 4);
}
__device__ __forceinline__ float red16(float x) {
    x += __uint_as_float(__builtin_amdgcn_update_dpp(0, __float_as_uint(x), 0xB1, 0xF, 0xF, true));
    x += __uint_as_float(__builtin_amdgcn_update_dpp(0, __float_as_uint(x), 0x4E, 0xF, 0xF, true));
    x += __uint_as_float(__builtin_amdgcn_update_dpp(0, __float_as_uint(x), 0x141, 0xF, 0xF, true));
    x += __uint_as_float(__builtin_amdgcn_update_dpp(0, __float_as_uint(x), 0x140, 0xF, 0xF, true));
    return x;
}
template <bool PASSC> __device__ __forceinline__ void scan_task(const Args& a, LAS unsigned char* lds, int bh, int seg, int rb, int tid, int lane, int wave) {
    const int b = bh >> 3, h = bh & 7;
    const bool ident = !PASSC && rb >= 2; const int row0 = (rb & 1) * 32;
    const int t0 = seg * SEGLEN;
    const bf16* SCN = (const bf16*)(a.ws + WS_SCN) + ((size_t)bh * T + t0) * 320;
    const float* SCS = (const float*)(a.ws + WS_SCS) + ((size_t)bh * T + t0) * 4;
    const bf16* VS = (const bf16*)(a.ws + WS_VS) + ((size_t)b * T + t0) * 512 + h * 64 + row0;
    float* YA = (float*)(a.ws + WS_YA) + ((size_t)b * T + t0) * 512 + h * 64 + row0;
    float* FSb = (float*)(a.ws + WS_FS) + (size_t)bh * NSEG * 128 * 64;
    constexpr int NCH = SEGLEN / SC_CH;
    const int rowl = tid >> 4, j = lane & 15;
    f32x4 S = {0.f, 0.f, 0.f, 0.f};
    __syncthreads();
    if constexpr (PASSC) {
        LAS float* rowb = (LAS float*)(lds + SC_ROWB);
        for (int k = 0; k < seg; ++k) {
            const float* Pk = FSb + ((size_t)k * 128 + 64) * 64; const float* Uk = FSb + ((size_t)k * 128 + row0 + rowl) * 64;
            *(LAS f32x4*)(rowb + rowl * 64 + 4 * j) = S;
            __syncthreads();
            f32x4 acc = *(const f32x4*)(Uk + 4 * j);
#pragma unroll 8
            for (int jj = 0; jj < 64; ++jj) acc += *(const f32x4*)(Pk + jj * 64 + 4 * j) * rowb[rowl * 64 + jj];
            S = acc;
            __syncthreads();
        }
    } else if (ident) {
#pragma unroll
        for (int e = 0; e < 4; ++e) S[e] = (4 * j + e == row0 + rowl) ? 1.f : 0.f;
    }
    u32x4 mreg[3]; u32x4 vreg = {0u, 0u, 0u, 0u}; f32x4 sreg;
    auto gload = [&](int c) {
        const u32x4* src = (const u32x4*)(SCN + (size_t)c * SC_CH * 320);
#pragma unroll
        for (int i = 0; i < 3; ++i) { const int p = tid + 512 * i; if (p < 1280) mreg[i] = src[p]; }
        if (tid < 128) { if (!ident) vreg = *(const u32x4*)(VS + (size_t)(c * SC_CH + (tid >> 2)) * 512 + (tid & 3) * 8); }
        else if (tid < 160) { sreg = *(const f32x4*)(SCS + (size_t)(c * SC_CH + (tid - 128)) * 4); }
    };
    auto lwrite = [&](int c) {
        LAS unsigned char* bp = lds + (c & 1) * SC_BUF;
#pragma unroll
        for (int i = 0; i < 3; ++i) { const int p = tid + 512 * i; const int arr = (p >> 3) % 5;
            if (p < 1280) { const u32x4 w = mreg[i]; f32x4 lo, hi;
                lo[0] = bflo(w.x); lo[1] = bfhi(w.x); lo[2] = bflo(w.y); lo[3] = bfhi(w.y); hi[0] = bflo(w.z); hi[1] = bfhi(w.z); hi[2] = bflo(w.w); hi[3] = bfhi(w.w);
                if (arr == 2) { lo = 1.0f - lo; hi = 1.0f - hi; }
                LAS f32x4* d = (LAS f32x4*)(bp + (size_t)p * 32); d[0] = lo; d[1] = hi; } }
        if (tid < 128) { const u32x4 w = vreg; f32x4 lo, hi;
            lo[0] = bflo(w.x); lo[1] = bfhi(w.x); lo[2] = bflo(w.y); lo[3] = bfhi(w.y); hi[0] = bflo(w.z); hi[1] = bfhi(w.z); hi[2] = bflo(w.w); hi[3] = bfhi(w.w);
            LAS f32x4* d = (LAS f32x4*)(lds + SC_VOFF + (c & 1) * (SC_CH * 32 * 4) + tid * 32); d[0] = lo; d[1] = hi; }
        else if (tid < 160) { *(LAS f32x4*)(lds + SC_SOFF + (c & 1) * (SC_CH * 16) + (tid - 128) * 16) = sreg; }
    };
    gload(0); lwrite(0); gload(1);
    __syncthreads();
    float ykeep = 0.f;
    for (int c = 0; c < NCH; ++c) {
        if (c + 1 < NCH) lwrite(c + 1);
        if (c + 2 < NCH) gload(c + 2);
        const LAS unsigned char* bp = lds + (c & 1) * SC_BUF + j * 16;
        const LAS float* vb = (const LAS float*)(lds + SC_VOFF + (c & 1) * (SC_CH * 32 * 4)) + rowl;
        const LAS float* sb = (const LAS float*)(lds + SC_SOFF + (c & 1) * (SC_CH * 16));
        ScanOps nx; scan_ld(nx, bp, vb, sb, 0);
#pragma unroll 4
        for (int s = 0; s < SC_CH; ++s) {
            const ScanOps o = nx;
            if (s + 1 < SC_CH) scan_ld(nx, bp, vb, sb, s + 1);
            const f32x4 pa4 = S * o.kk;
            const f32x4 sp = S * o.w + o.kp * o.v;
            const float sa = red16((pa4[0] + pa4[1]) + (pa4[2] + pa4[3]));
            if constexpr (PASSC) {
                const f32x4 py4 = S * o.wr;
                const float ys = red16((py4[0] + py4[1]) + (py4[2] + py4[3]));
                const float y = ys - sa * o.brkr.x + o.v * o.brkr.y;
                ykeep = ((s & 15) == j) ? y : ykeep;
                if ((s & 15) == 15) YA[(size_t)(c * SC_CH + (s - 15) + j) * 512 + rowl] = ykeep;
            }
            S = sp - o.bb * sa;
        }
        __syncthreads();
    }
    if constexpr (!PASSC) *(f32x4*)(FSb + ((size_t)seg * 128 + (ident ? 64 : 0) + row0 + rowl) * 64 + 4 * j) = S;
}

typedef short v4i16_t __attribute__((ext_vector_type(4)));
__device__ __forceinline__ s16x4 vtr(const LAS unsigned char* p) { return __builtin_bit_cast(s16x4, __builtin_amdgcn_ds_read_tr16_b64_v4i16((LAS v4i16_t*)p)); }
constexpr int AT_KS = 0, AT_VS = 9216, AT_BIAS = 18432, AT_WSF = 18688, AT_FLAG = 19712, AT_TASK = 140000;
__device__ __forceinline__ void attn_unit(const Args& a, LAS unsigned char* lds, int l, int bh, int qb, int tid, int lane, int wid) {
    const int b = bh >> 3, h = bh & 7, r32 = lane & 31, hi = lane >> 5;
    const int q0 = qb * 256;
    bf16* PB = (bf16*)(a.ws + WS_PB);
    const float* cumh = (const float*)(a.ws + WS_CUM) + (size_t)bh * T;
    const float kmax = ((const float*)(a.ws + WS_CTL))[CW_KMAX + 16 * l + bh];
    const size_t rowbase = (size_t)b * T;
    const bf16* Qp = PB + (rowbase + q0 + wid * 32 + r32) * LDB + h * 64;
    bf16x8 qr[4]; float qs = 0.f;
#pragma unroll
    for (int d0 = 0; d0 < 4; ++d0) { const u32x4 w = *(const u32x4*)(Qp + d0 * 16 + hi * 8); qr[d0] = __builtin_bit_cast(bf16x8, w);
        qs += bflo(w.x) * bflo(w.x) + bfhi(w.x) * bfhi(w.x) + bflo(w.y) * bflo(w.y) + bfhi(w.y) * bfhi(w.y) + bflo(w.z) * bflo(w.z) + bfhi(w.z) * bfhi(w.z) + bflo(w.w) * bflo(w.w) + bfhi(w.w) * bfhi(w.w); }
    qs += __shfl_xor(qs, 32);
    const float qbound = sqrtf(qs) * kmax * 1.01f + 0.01f;
    const float ref = cumh[q0 + 255];
    const int srow = tid >> 3, sch = tid & 7;
    const bf16* Kg = PB + rowbase * LDB + 512 + h * 64 + sch * 8; const bf16* Vg = Kg + 512;
    LAS unsigned char* Ks = lds + AT_KS; LAS unsigned char* Vs = lds + AT_VS; LAS float* biasL = (LAS float*)(lds + AT_BIAS);
    LAS float* wsf = (LAS float*)(lds + AT_WSF) + wid * 32; volatile LAS unsigned* flag = (volatile LAS unsigned*)(lds + AT_FLAG);
    if (tid < 3) flag[tid] = 0u;
    float m = -INFINITY, lsum = 0.f; f32x16 o0 = {}, o1 = {};
    u32x4 kreg, vreg; float breg = 0.f, bnx = 0.f;
    int j = qb * 4 + 3;
    { kreg = *(const u32x4*)(Kg + (size_t)(64 * j + srow) * LDB); vreg = *(const u32x4*)(Vg + (size_t)(64 * j + srow) * LDB);
      if (tid < 64) breg = (ref - cumh[64 * j + tid]) * L2E; bnx = j > 0 ? (ref - cumh[64 * j - 1]) * L2E : 0.f; }
    const int q4 = (lane & 15) >> 2, p4 = lane & 3, blk = (lane >> 4) & 1;
    const int qrow = q0 + wid * 32 + r32;
    int it = 0;
    __syncthreads();
    for (;;) {
        *(LAS u32x4*)(Ks + srow * 144 + sch * 16) = kreg; *(LAS u32x4*)(Vs + srow * 144 + sch * 16) = vreg; if (tid < 64) biasL[tid] = breg;
        const float bnx_cur = bnx;
        __syncthreads();
        if (j > 0) { const int jn = j - 1;
            kreg = *(const u32x4*)(Kg + (size_t)(64 * jn + srow) * LDB); vreg = *(const u32x4*)(Vg + (size_t)(64 * jn + srow) * LDB);
            if (tid < 64) breg = (ref - cumh[64 * jn + tid]) * L2E; bnx = jn > 0 ? (ref - cumh[64 * jn - 1]) * L2E : 0.f; }
        if (64 * j <= q0 + 32 * wid + 31) {
            f32x16 p0 = {}, p1 = {};
#pragma unroll
            for (int d0 = 0; d0 < 4; ++d0) {
                const bf16x8 k0 = *(const LAS bf16x8*)(Ks + r32 * 144 + d0 * 32 + hi * 16);
                const bf16x8 k1 = *(const LAS bf16x8*)(Ks + (32 + r32) * 144 + d0 * 32 + hi * 16);
                p0 = __builtin_amdgcn_mfma_f32_32x32x16_bf16(k0, qr[d0], p0, 0, 0, 0);
                p1 = __builtin_amdgcn_mfma_f32_32x32x16_bf16(k1, qr[d0], p1, 0, 0, 0); }
#pragma unroll
            for (int g = 0; g < 4; ++g) { const f32x4 b0 = *(const LAS f32x4*)(biasL + 8 * g + 4 * hi), b1 = *(const LAS f32x4*)(biasL + 32 + 8 * g + 4 * hi);
#pragma unroll
                for (int e = 0; e < 4; ++e) { p0[4 * g + e] += b0[e]; p1[4 * g + e] += b1[e]; } }
            if (64 * j + 63 > q0 + 32 * wid) {
#pragma unroll
                for (int r = 0; r < 16; ++r) { const int kv = 64 * j + crow(r, hi); if (kv > qrow) p0[r] = -INFINITY; if (kv + 32 > qrow) p1[r] = -INFINITY; } }
            float mx = fmaxf(p0[0], p1[0]);
#pragma unroll
            for (int r = 1; r < 16; ++r) mx = fmaxf(mx, fmaxf(p0[r], p1[r]));
            mx = fmaxf(mx, __shfl_xor(mx, 32));
            const float mnew = fmaxf(m, mx); const float f = __builtin_amdgcn_exp2f(m - mnew); m = mnew;
            float rs = 0.f;
#pragma unroll
            for (int r = 0; r < 16; ++r) { p0[r] = __builtin_amdgcn_exp2f(p0[r] - mnew); p1[r] = __builtin_amdgcn_exp2f(p1[r] - mnew); rs += p0[r] + p1[r]; }
            lsum = lsum * f + rs;
            if (__any(f != 1.f)) {
                if (hi == 0) wsf[r32] = f;
                asm volatile("s_waitcnt lgkmcnt(0)" ::: "memory");
#pragma unroll
                for (int r = 0; r < 16; ++r) { const float fr = wsf[crow(r, hi)]; o0[r] *= fr; o1[r] *= fr; }
            }
            u32x4 pw[4];
            pw[0] = (u32x4){cvtpk(p0[0], p0[1]), cvtpk(p0[2], p0[3]), cvtpk(p0[4], p0[5]), cvtpk(p0[6], p0[7])};
            pw[1] = (u32x4){cvtpk(p0[8], p0[9]), cvtpk(p0[10], p0[11]), cvtpk(p0[12], p0[13]), cvtpk(p0[14], p0[15])};
            pw[2] = (u32x4){cvtpk(p1[0], p1[1]), cvtpk(p1[2], p1[3]), cvtpk(p1[4], p1[5]), cvtpk(p1[6], p1[7])};
            pw[3] = (u32x4){cvtpk(p1[8], p1[9]), cvtpk(p1[10], p1[11]), cvtpk(p1[12], p1[13]), cvtpk(p1[14], p1[15])};
#pragma unroll
            for (int s = 0; s < 4; ++s) { const int kvb = 16 * (s & 1) + 32 * (s >> 1);
                const LAS unsigned char* va = Vs + (kvb + 4 * hi + q4) * 144 + (16 * blk + 4 * p4) * 2;
                const s16x4 l0 = vtr(va), h0 = vtr(va + 8 * 144), l1 = vtr(va + 64), h1 = vtr(va + 8 * 144 + 64);
                const bf16x8 vf0 = {l0[0], l0[1], l0[2], l0[3], h0[0], h0[1], h0[2], h0[3]}, vf1 = {l1[0], l1[1], l1[2], l1[3], h1[0], h1[1], h1[2], h1[3]};
                const bf16x8 pa = __builtin_bit_cast(bf16x8, pw[s]);
                o0 = __builtin_amdgcn_mfma_f32_32x32x16_bf16(pa, vf0, o0, 0, 0, 0);
                o1 = __builtin_amdgcn_mfma_f32_32x32x16_bf16(pa, vf1, o1, 0, 0, 0); }
        }
        if (j == 0) break;
        const bool need = (qbound + bnx_cur > m - 40.f);
        if (tid == 0) flag[(it + 1) % 3] = 0u;
        if (__any(need) && lane == 0) flag[it % 3] = 1u;
        __syncthreads();
        const unsigned cont = flag[it % 3];
        if (!cont) break;
        --j; ++it;
    }
    lsum += __shfl_xor(lsum, 32);
    if (hi == 0) wsf[r32] = 1.f / lsum;
    asm volatile("s_waitcnt lgkmcnt(0)" ::: "memory");
    bf16* Ow = (bf16*)(a.ws + WS_PV) + (rowbase + q0 + wid * 32) * LDV + h * 64 + r32;
#pragma unroll
    for (int r = 0; r < 16; ++r) { const float inv = wsf[crow(r, hi)]; bf16* op = Ow + (size_t)crow(r, hi) * LDV;
        op[0] = (bf16)f2bf(o0[r] * inv); op[32] = (bf16)f2bf(o1[r] * inv); }
    __syncthreads();
}
__device__ __forceinline__ void p3a_phase(const Args& a, LAS unsigned char* lds, int l, int tid, int lane, int wave) {
    unsigned* ctr = (unsigned*)(a.ws + WS_CTL) + CW_QUEUE + 64 * l;
    volatile LAS unsigned* task = (volatile LAS unsigned*)(lds + AT_TASK);
    for (;;) {
        __syncthreads();
        if (tid == 0) task[0] = atomicAdd(ctr, 1u);
        __syncthreads();
        const unsigned tk = task[0];
        if (tk >= 512u + 1024u) break;
        if (tk < 512u) { const int bh = (int)(tk >> 5), seg = (int)((tk >> 2) & 7), rb = (int)(tk & 3);
            if (seg == NSEG - 1 || (seg == 0 && rb >= 2)) continue;
            scan_task<false>(a, lds, bh, seg, rb, tid, lane, wave); }
        else { const unsigned u = tk - 512u; attn_unit(a, lds, l, (int)(u & 15), 63 - (int)(u >> 4), tid, lane, wave); }
    }
}
__device__ __forceinline__ void p3b_phase(const Args& a, LAS unsigned char* lds, int l, int tid, int lane, int wave) {
    unsigned* ctr = (unsigned*)(a.ws + WS_CTL) + CW_QUEUE + 512 + 64 * l;
    volatile LAS unsigned* task = (volatile LAS unsigned*)(lds + AT_TASK);
    for (;;) {
        __syncthreads();
        if (tid == 0) task[0] = atomicAdd(ctr, 1u);
        __syncthreads();
        const unsigned tk = task[0];
        if (tk >= 256u) break;
        scan_task<true>(a, lds, (int)(tk >> 4), (int)((tk >> 1) & 7), (int)(tk & 1), tid, lane, wave);
    }
}

__device__ __forceinline__ void merge_phase(const Args& a, int l, int tid, int lane, int wave, int G) {
    const float* YA = (const float*)(a.ws + WS_YA); const bf16* VS = (const bf16*)(a.ws + WS_VS); const bf16* PB = (const bf16*)(a.ws + WS_PB);
    const float* SCS = (const float*)(a.ws + WS_SCS); bf16* YM = (bf16*)(a.ws + WS_YM);
    const int c = tid, h = wave;
    const float gg = a.in[15][l * 512 + c], gb = a.in[16][l * 512 + c];
    constexpr int MT = 8;
    for (int m0 = blockIdx.x * MT; m0 < M; m0 += G * MT) {
        float ya[MT], v[MT], g1[MT], g2[MT], yb[MT], rkr[MT], mean[MT], var[MT];
#pragma unroll
        for (int u = 0; u < MT; ++u) { const int m = m0 + u; const int b = m >= T ? 1 : 0, t = m - b * T;
            ya[u] = YA[(size_t)m * 512 + c]; v[u] = bf2f(VS[(size_t)m * 512 + c]);
            g1[u] = bf2f(PB[(size_t)m * LDB + 1536 + c]); g2[u] = bf2f(PB[(size_t)m * LDB + 2048 + c]);
            yb[u] = bf2f(((const bf16*)(a.ws + WS_PV))[(size_t)m * LDV + c]);
            rkr[u] = SCS[((size_t)(b * 8 + h) * T + t) * 4 + 2]; mean[u] = ya[u]; }
#pragma unroll
        for (int o = 1; o < 64; o <<= 1) {
#pragma unroll
            for (int u = 0; u < MT; ++u) mean[u] += __shfl_xor(mean[u], o); }
#pragma unroll
        for (int u = 0; u < MT; ++u) { mean[u] *= (1.f / 64.f); const float d = ya[u] - mean[u]; var[u] = d * d; }
#pragma unroll
        for (int o = 1; o < 64; o <<= 1) {
#pragma unroll
            for (int u = 0; u < MT; ++u) var[u] += __shfl_xor(var[u], o); }
#pragma unroll
        for (int u = 0; u < MT; ++u) { const int m = m0 + u;
            const float yn = (ya[u] - mean[u]) * rsqrtf(var[u] * (1.f / 64.f) + GN_EPS) * gg + gb + rkr[u] * v[u];
            YM[(size_t)m * D + c] = (bf16)f2bf(yn * g1[u]); YM[(size_t)m * D + 512 + c] = (bf16)f2bf(yb[u] * g2[u]); }
    }
}

#ifndef N_LAUNCH_MODE
#define N_LAUNCH_MODE 1
#endif
template <int MASK, bool COOP> __device__ __forceinline__ void run_phases(const Args& a, LAS unsigned char* lds, int l0, int l1) {
    const int G = gridDim.x;
#define LAUNDER() int tid = threadIdx.x; asm volatile("" : "+v"(tid)); const int lane = tid & 63, wave = __builtin_amdgcn_readfirstlane(tid >> 6); (void)lane; (void)wave
    float* hbuf = a.out;
    const float* mod = (const float*)(a.ws + WS_CTL) + CW_MOD;
    bf16* XN = (bf16*)(a.ws + WS_XN);
#define GSYNC() do { if constexpr (COOP) cg::this_grid().sync(); } while (0)
    if constexpr (MASK & 1) { LAUNDER(); p0a(a, lds, tid, lane, wave, G); GSYNC(); }
    if constexpr (MASK & 2) { LAUNDER(); ln_rows(a.in[0], a.in[2], a.in[3], hbuf, XN, mod, lane, wave, G); GSYNC(); }
#pragma unroll 1
    for (int l = l0; l < l1; ++l) {
        for (int rep = 0; rep < ((PROBE_REP & 4) ? 2 : 1); ++rep)
        if constexpr (MASK & 4) { pg8::Gemm g{XN, (const bf16*)(a.ws + WS_WIN) + (size_t)l * NPROJ * 1024, M, NPROJ, 1024}; pg8::StaticOrder S; S.init(M, NPROJ, G, (int)blockIdx.x);
          EpiProj E{(bf16*)(a.ws + WS_PA), (bf16*)(a.ws + WS_PV), (bf16*)(a.ws + WS_PB)};
          pg8::gemm_phase<EpiProj, pg8::StaticOrder, true, true>(lds, g, S, E); GSYNC(); }
        for (int rep = 0; rep < ((PROBE_REP & 8) ? 2 : 1); ++rep)
        if constexpr (MASK & 8) { LAUNDER(); prep_phase(a, lds, l, tid, lane, wave, G); GSYNC(); }
        if constexpr (MASK & 16) { { LAUNDER(); p3a_phase(a, lds, l, tid, lane, wave); } GSYNC(); { LAUNDER(); p3b_phase(a, lds, l, tid, lane, wave); } GSYNC(); }
        for (int rep = 0; rep < ((PROBE_REP & 32) ? 2 : 1); ++rep)
        if constexpr (MASK & 32) { LAUNDER(); merge_phase(a, l, tid, lane, wave, G); GSYNC(); }
        if constexpr (MASK & 64) { pg8::Gemm g{(const bf16*)(a.ws + WS_YM), (const bf16*)(a.ws + WS_WOUT) + (size_t)l * 1024 * 1024, M, D, D}; pg8::StaticOrder S; S.init(M, D, G, (int)blockIdx.x);
          EpiOut E{hbuf, mod + l * 2 * 3072};
          pg8::gemm_phase<EpiOut, pg8::StaticOrder, true, true>(lds, g, S, E); GSYNC(); }
        if constexpr (MASK & 128) { LAUNDER(); ln_rows(hbuf, a.in[19] + l * D, a.in[20] + l * D, hbuf, XN, (l + 1 < DEPTH) ? mod + (l + 1) * 2 * 3072 : nullptr, lane, wave, G);
          if (l + 1 < l1) GSYNC(); }
    }
#undef GSYNC
#undef LAUNDER
}
#ifndef FMASK
#define FMASK 0xFF
#endif
#if N_LAUNCH_MODE == 1
__global__ void __launch_bounds__(512, 2) hymba_fwd(Args a) {
    extern __shared__ __attribute__((aligned(16))) unsigned char lds_raw[];
    run_phases<FMASK, true>(a, (LAS unsigned char*)lds_raw, 0, DEPTH);
}
#else
template <int MASK> __global__ void __launch_bounds__(512, 2) hymba_phase(Args a, int l) {
    extern __shared__ __attribute__((aligned(16))) unsigned char lds_raw[];
    run_phases<MASK, false>(a, (LAS unsigned char*)lds_raw, l, l + 1);
}
template <int MASK> static void launch_phase(const Args& a, int l, hipStream_t stream) {
    static bool attr = false;
    if (!attr) { (void)hipFuncSetAttribute((const void*)hymba_phase<MASK>, hipFuncAttributeMaxDynamicSharedMemorySize, LDS_BYTES); attr = true; }
    hipLaunchKernelGGL(hymba_phase<MASK>, dim3(256), dim3(512), LDS_BYTES, stream, a, l);
}
#endif

extern "C" void kernel_launch(void* const* d_in, const int* in_sizes, int n_in, void* d_out, int out_size, void* d_ws, size_t ws_size, hipStream_t stream) {
    if (n_in != 21 || ws_size < WS_END) { fprintf(stderr, "kernel_launch: unexpected n_in %d / ws %zu\n", n_in, ws_size); return; }
    (void)hipMemsetAsync((char*)d_ws + WS_CTL, 0, CTL_ZERO_BYTES, stream);
    Args a{};
    for (int i = 0; i < 21; ++i) a.in[i] = (const float*)d_in[i];
    a.out = (float*)d_out; a.ws = (unsigned char*)d_ws;
#if N_LAUNCH_MODE == 1
    static int grid = 0;
    if (grid == 0) {
        int dev = 0, cus = 0, per_cu = 0;
        (void)hipGetDevice(&dev); (void)hipDeviceGetAttribute(&cus, hipDeviceAttributeMultiprocessorCount, dev);
        (void)hipFuncSetAttribute((const void*)hymba_fwd, hipFuncAttributeMaxDynamicSharedMemorySize, LDS_BYTES);
        (void)hipOccupancyMaxActiveBlocksPerMultiprocessor(&per_cu, (const void*)hymba_fwd, 512, LDS_BYTES);
        if (per_cu < 1) per_cu = 1;
        (void)hipGetLastError();
        grid = cus * per_cu;
    }
    void* args[] = {&a};
    hipError_t e = hipLaunchCooperativeKernel((const void*)hymba_fwd, dim3(grid), dim3(512), args, LDS_BYTES, stream);
    if (e != hipSuccess) fprintf(stderr, "cooperative launch failed: %s (grid %d)\n", hipGetErrorString(e), grid);
#else
    launch_phase<1>(a, 0, stream); launch_phase<2>(a, 0, stream);
    for (int l = 0; l < DEPTH; ++l) { launch_phase<4>(a, l, stream); launch_phase<8>(a, l, stream); launch_phase<16>(a, l, stream); launch_phase<32>(a, l, stream); launch_phase<64>(a, l, stream); launch_phase<128>(a, l, stream); }
#endif
}
```

```cpp
#include <hip/hip_runtime.h>
#include <cstdio>
#include <cstdint>
namespace pg8 {
#define PG8_LAS __attribute__((address_space(3)))
typedef unsigned short bf16_t;
typedef short bf16x8 __attribute__((ext_vector_type(8)));
typedef float f32x4 __attribute__((ext_vector_type(4)));
typedef unsigned u32x4 __attribute__((ext_vector_type(4)));
constexpr int BM = 256, BK = 64, HALF = 128, HTB = HALF * BK * 2  , STAGE_BYTES = 8 * HTB, NXCD = 8, WGM = 8;

__host__ __device__ __forceinline__ int lds_byte(int r, int c) { const int st = (r >> 4) * 2 + (c >> 5), rr = r & 15, cc = c & 31, ob = rr * 64 + cc * 2; return st * 1024 + (ob ^ (((ob >> 9) & 1) << 5)); }
__host__ __device__ __forceinline__ void stage_rc(int b, int& R, int& C) { const int st = b / 1024, sb = b % 1024, swz = sb ^ (((sb >> 9) & 1) << 5); R = (st >> 1) * 16 + swz / 64; C = (st & 1) * 32 + (swz % 64) / 2; }
__host__ __device__ __forceinline__ int perm32(int rho) { const int n = rho >> 4, i = rho & 15; return 8 * (i >> 2) + 4 * n + (i & 3); }

struct Unit { int pm, pn; };
struct Gemm { const bf16_t* A; const bf16_t* Bt; int M, N, K; };

struct StaticOrder {
    int nM, nN, nwg, G, c;
    __host__ __device__ void init(int M, int N, int G_, int c_) { nM = M / BM; nN = N / BM; nwg = nM * nN; G = G_; c = c_; }
    __host__ __device__ bool next(int i, Unit& u) const {
        const long L = (long)i * G + c; if (L >= nwg) return false;
        int wgid = (int)L; { const int q = nwg / NXCD, r = nwg % NXCD, xcd = wgid % NXCD, off = wgid / NXCD; wgid = (xcd < r ? xcd * (q + 1) : r * (q + 1) + (xcd - r) * q) + off; }
        const int nig = WGM * nN, gid = wgid / nig, fm = gid * WGM, gsz = (nM - fm) < WGM ? (nM - fm) : WGM;
        u.pm = fm + ((wgid % nig) % gsz); u.pn = (wgid % nig) / gsz; return true;
    }
    __device__ __forceinline__ void a_ready(const Unit&) const {}
    __device__ __forceinline__ void done(const Unit&) const {}
};

__device__ __forceinline__ unsigned cvt_pk_bf16(float lo, float hi) { unsigned r; asm volatile("v_cvt_pk_bf16_f32 %0, %1, %2" : "=v"(r) : "v"(lo), "v"(hi)); return r; }
typedef float f32x2 __attribute__((ext_vector_type(2)));
__device__ __forceinline__ f32x2 gelu_pk(f32x2 v) {
    const f32x2 av = __builtin_elementwise_abs(v), d = av * 0.2316418882f + 1.0f;
    f32x2 t; t.x = __builtin_amdgcn_rcpf(d.x); t.y = __builtin_amdgcn_rcpf(d.y);
    f32x2 q = t * 0.5307027145f + (-0.7265760135f); q = q * t + 0.7107068705f; q = q * t + (-0.142248368f); q = q * t + 0.127414796f; q = q * t;
    const f32x2 s = (v * v) * (-0.72134752044f);
    f32x2 e; e.x = __builtin_amdgcn_exp2f(s.x); e.y = __builtin_amdgcn_exp2f(s.y);
    const f32x2 m = v * (q * e), r = v - m;
    f32x2 o; o.x = v.x < 0.f ? m.x : r.x; o.y = v.y < 0.f ? m.y : r.y; return o;
}

template <int ACT  > struct EpiBf16 {
    static constexpr bool PERM = true, AFTER_DRAIN = false; static_assert(ACT == 0 || ACT == 1, "EpiBf16: ACT is 0 (none) or 1 (gelu_pk)");
    bf16_t* O; int ldc; const float* bias; int split_cols; size_t split_stride; float scale0;
    __device__ __forceinline__ void operator()(const f32x4 (&acc)[2][2][4][2], const Unit& u, int wr, int wc, int fr, int fq) const {
        const int row0 = u.pm * BM + wr * 64 + fr; int colt = u.pn * BM; bf16_t* base = O;
        float sc = 1.f; if (split_cols) { const int t = colt / split_cols; base += (size_t)t * split_stride; colt -= t * split_cols; if (t == 0) sc = scale0; }
        const int col0 = colt + wc * 32 + 8 * fq, bcol0 = u.pn * BM + wc * 32 + 8 * fq;
        f32x4 bv[2][2];
#pragma unroll
        for (int bj = 0; bj < 2; ++bj)
#pragma unroll
            for (int n = 0; n < 2; ++n) bv[bj][n] = bias ? *(const f32x4*)(bias + bcol0 + bj * HALF + 4 * n) : (f32x4){0.f, 0.f, 0.f, 0.f};
#pragma unroll
        for (int ai = 0; ai < 2; ++ai)
#pragma unroll
            for (int m = 0; m < 4; ++m) { bf16_t* rowp = base + (size_t)(row0 + ai * HALF + m * 16) * ldc + col0;
#pragma unroll
                for (int bj = 0; bj < 2; ++bj) { f32x4 v0 = acc[ai][bj][m][0] + bv[bj][0], v1 = acc[ai][bj][m][1] + bv[bj][1];
                    if (ACT == 1) { f32x2 a = gelu_pk((f32x2){v0[0], v0[1]}), b = gelu_pk((f32x2){v0[2], v0[3]}), c = gelu_pk((f32x2){v1[0], v1[1]}), d = gelu_pk((f32x2){v1[2], v1[3]});
                        v0 = (f32x4){a.x, a.y, b.x, b.y}; v1 = (f32x4){c.x, c.y, d.x, d.y}; }
                    v0 = v0 * sc; v1 = v1 * sc; u32x4 w; w.x = cvt_pk_bf16(v0[0], v0[1]); w.y = cvt_pk_bf16(v0[2], v0[3]); w.z = cvt_pk_bf16(v1[0], v1[1]); w.w = cvt_pk_bf16(v1[2], v1[3]);
                    *(u32x4*)(rowp + bj * HALF) = w; } }
    }
};

template <class Epi, class Sched, bool ALIGN_EPI = false, bool SP2 = false>
__device__ __forceinline__ void gemm_phase(PG8_LAS unsigned char* lds, const Gemm g, const Sched& S, const Epi& E) {
    int tid = threadIdx.x; asm volatile("" : "+v"(tid));
    const int wid = __builtin_amdgcn_readfirstlane(tid >> 6), lane = tid & 63, wr = wid >> 2, wc = wid & 3, fr = lane & 15, fq = lane >> 4;
    const int K = g.K, nt = K / BK;
    unsigned voffA[2], voffB[2];
#pragma unroll
    for (int i = 0; i < 2; ++i) { int R, C; stage_rc(tid * 16 + i * 8192, R, C); const int Rb = Epi::PERM ? ((R & ~31) + perm32(R & 31)) : R;
        voffA[i] = (unsigned)(R * K + C) * 2u; voffB[i] = (unsigned)(Rb * K + C) * 2u; }
    const size_t kstep = (size_t)(BK * 2);
    const size_t hstep = (size_t)HALF * K * 2;
    const size_t tstep = 2 * hstep;
    const unsigned ldsw = (unsigned)wid * 1024u;
    const int aoff = lds_byte(wr * 64 + fr, fq * 8), boff = lds_byte(wc * 32 + fr, fq * 8);
#define PG8_SA(b, h) (((b) * 2 + (h)) * HTB)
#define PG8_SB(b, h) ((4 + (b) * 2 + (h)) * HTB)
#define PG8_STAGE(bufoff, gbase, voff) do { _Pragma("unroll") for (int _i = 0; _i < 2; ++_i) \
        __builtin_amdgcn_global_load_lds((const unsigned*)((const char*)(gbase) + (voff)[_i]), (PG8_LAS unsigned*)(lds + (bufoff) + ldsw + _i * 8192), 16, 0, 0); } while (0)
#define PG8_LDA(dst, b, h) do { _Pragma("unroll") for (int m = 0; m < 4; ++m) _Pragma("unroll") for (int k = 0; k < 2; ++k) dst[m][k] = *(const PG8_LAS bf16x8*)(lds + PG8_SA(b, h) + aoff + m * 2048 + k * 1024); } while (0)
#define PG8_LDB(dst, b, h) do { _Pragma("unroll") for (int n = 0; n < 2; ++n) _Pragma("unroll") for (int k = 0; k < 2; ++k) dst[n][k] = *(const PG8_LAS bf16x8*)(lds + PG8_SB(b, h) + boff + n * 2048 + k * 1024); } while (0)
#define PG8_MMA(ai, bj, At, Bt) do { __builtin_amdgcn_s_setprio(1); _Pragma("unroll") for (int m = 0; m < 4; ++m) _Pragma("unroll") for (int n = 0; n < 2; ++n) _Pragma("unroll") for (int k = 0; k < 2; ++k) \
        acc[ai][bj][m][n] = __builtin_amdgcn_mfma_f32_16x16x32_bf16(Bt[n][k], At[m][k], acc[ai][bj][m][n], 0, 0, 0); __builtin_amdgcn_s_setprio(0); } while (0)
#define PG8_WAIT_V(n) asm volatile("s_waitcnt vmcnt(" #n ")" ::: "memory")
#define PG8_WAIT_L(n) asm volatile("s_waitcnt lgkmcnt(" #n ")" ::: "memory")
#define PG8_BAR __builtin_amdgcn_s_barrier()
#define PG8_SCHED __builtin_amdgcn_sched_barrier(0)
    Unit cur, nxt; int ui = 0;
    if (!S.next(0, cur)) return;
    f32x4 acc[2][2][4][2];
#pragma unroll
    for (int a = 0; a < 2; ++a)
#pragma unroll
        for (int b = 0; b < 2; ++b)
#pragma unroll
            for (int m = 0; m < 4; ++m)
#pragma unroll
                for (int n = 0; n < 2; ++n) acc[a][b][m][n] = (f32x4){0.f, 0.f, 0.f, 0.f};
    bf16x8 At[4][2], B0[2][2], B1[2][2];
    const char* cA = (const char*)g.A + (size_t)cur.pm * tstep; const char* cB = (const char*)g.Bt + (size_t)cur.pn * tstep;
    S.a_ready(cur);
    if constexpr (SP2) {
        PG8_STAGE(PG8_SB(0, 0), cB, voffB); PG8_STAGE(PG8_SB(0, 1), cB + hstep, voffB); PG8_STAGE(PG8_SA(0, 0), cA, voffA); PG8_STAGE(PG8_SA(0, 1), cA + hstep, voffA);
        if (wr == 1) PG8_BAR;
        PG8_WAIT_V(2); PG8_BAR;
        PG8_STAGE(PG8_SB(1, 0), cB + kstep, voffB); PG8_STAGE(PG8_SA(1, 0), cA + kstep, voffA); PG8_STAGE(PG8_SB(1, 1), cB + hstep + kstep, voffB);
        PG8_WAIT_V(6); PG8_BAR;
    } else {
        PG8_STAGE(PG8_SB(0, 0), cB, voffB); PG8_STAGE(PG8_SA(0, 0), cA, voffA); PG8_STAGE(PG8_SB(0, 1), cB + hstep, voffB); PG8_STAGE(PG8_SA(0, 1), cA + hstep, voffA);
        if (wr == 1) PG8_BAR;
        PG8_WAIT_V(4); PG8_BAR;
        PG8_STAGE(PG8_SB(1, 0), cB + kstep, voffB); PG8_STAGE(PG8_SA(1, 0), cA + kstep, voffA); PG8_STAGE(PG8_SB(1, 1), cB + hstep + kstep, voffB);
        PG8_WAIT_V(6); PG8_BAR;
    }
    for (;;) {
        const bool has_next = S.next(ui + 1, nxt);
        const char* nA = has_next ? (const char*)g.A + (size_t)nxt.pm * tstep : cA; const char* nB = has_next ? (const char*)g.Bt + (size_t)nxt.pn * tstep : cB;
        for (int t = 0; t < nt; t += 2) {
            const bool last = (t == nt - 2);
            const char* a1 = cA + (size_t)(t + 1) * kstep;
            const char* a2 = last ? nA : cA + (size_t)(t + 2) * kstep; const char* b2 = last ? nB : cB + (size_t)(t + 2) * kstep;
            const char* a3 = a2 + kstep; const char* b3 = b2 + kstep;
            if (last && has_next) S.a_ready(nxt);
            if constexpr (SP2) {
            PG8_LDB(B0, 0, 0); PG8_LDB(B1, 0, 1); PG8_SCHED; PG8_LDA(At, 0, 0); PG8_STAGE(PG8_SA(1, 1), a1 + hstep, voffA);
            PG8_WAIT_V(8); PG8_WAIT_L(0); PG8_BAR; PG8_MMA(0, 0, At, B0); PG8_MMA(0, 1, At, B1); PG8_BAR; PG8_SCHED;
            PG8_LDA(At, 0, 1); PG8_STAGE(PG8_SB(0, 0), b2, voffB); PG8_STAGE(PG8_SB(0, 1), b2 + hstep, voffB); PG8_STAGE(PG8_SA(0, 0), a2, voffA);
            PG8_WAIT_V(8); PG8_WAIT_L(0); PG8_BAR; PG8_MMA(1, 0, At, B0); PG8_MMA(1, 1, At, B1); PG8_BAR; PG8_SCHED;
            PG8_LDB(B0, 1, 0); PG8_LDB(B1, 1, 1); PG8_SCHED; PG8_LDA(At, 1, 0); PG8_STAGE(PG8_SA(0, 1), a2 + hstep, voffA);
            PG8_WAIT_V(8); PG8_WAIT_L(0); PG8_BAR; PG8_MMA(0, 0, At, B0); PG8_MMA(0, 1, At, B1); PG8_BAR; PG8_SCHED;
            PG8_LDA(At, 1, 1); PG8_STAGE(PG8_SB(1, 0), b3, voffB); PG8_STAGE(PG8_SB(1, 1), b3 + hstep, voffB); PG8_STAGE(PG8_SA(1, 0), a3, voffA);
            PG8_WAIT_V(8); PG8_WAIT_L(0); PG8_BAR; PG8_MMA(1, 0, At, B0); PG8_MMA(1, 1, At, B1); PG8_BAR; PG8_SCHED;
            } else {
            PG8_LDB(B0, 0, 0); PG8_SCHED; PG8_LDA(At, 0, 0); PG8_STAGE(PG8_SA(1, 1), a1 + hstep, voffA);
            PG8_WAIT_L(8); PG8_BAR; PG8_WAIT_L(0); PG8_MMA(0, 0, At, B0); PG8_BAR; PG8_SCHED;
            PG8_LDB(B1, 0, 1); PG8_STAGE(PG8_SB(0, 0), b2, voffB);
            PG8_BAR; PG8_WAIT_L(0); PG8_MMA(0, 1, At, B1); PG8_BAR;
            PG8_LDA(At, 0, 1); PG8_STAGE(PG8_SA(0, 0), a2, voffA);
            PG8_BAR; PG8_WAIT_L(0); PG8_MMA(1, 0, At, B0); PG8_BAR; PG8_SCHED;
            PG8_STAGE(PG8_SB(0, 1), b2 + hstep, voffB);
            PG8_WAIT_V(6); PG8_BAR; PG8_MMA(1, 1, At, B1); PG8_BAR;
            PG8_LDB(B0, 1, 0); PG8_SCHED; PG8_LDA(At, 1, 0); PG8_STAGE(PG8_SA(0, 1), a2 + hstep, voffA);
            PG8_WAIT_L(8); PG8_BAR; PG8_WAIT_L(0); PG8_MMA(0, 0, At, B0); PG8_BAR; PG8_SCHED;
            PG8_LDB(B1, 1, 1); PG8_STAGE(PG8_SB(1, 0), b3, voffB);
            PG8_BAR; PG8_WAIT_L(0); PG8_MMA(0, 1, At, B1); PG8_BAR;
            PG8_LDA(At, 1, 1); PG8_STAGE(PG8_SA(1, 0), a3, voffA);
            PG8_BAR; PG8_WAIT_L(0); PG8_MMA(1, 0, At, B0); PG8_BAR; PG8_SCHED;
            PG8_STAGE(PG8_SB(1, 1), b3 + hstep, voffB);
            PG8_WAIT_V(6); PG8_BAR; PG8_MMA(1, 1, At, B1); PG8_BAR;
            }
        }
        if constexpr (ALIGN_EPI) { if (wr == 0) PG8_BAR; }
        if constexpr (!Epi::AFTER_DRAIN) { E(acc, cur, wr, wc, fr, fq); S.done(cur); }
        if (!has_next) break;
#pragma unroll
        for (int a = 0; a < 2; ++a)
#pragma unroll
            for (int b = 0; b < 2; ++b)
#pragma unroll
                for (int m = 0; m < 4; ++m)
#pragma unroll
                    for (int n = 0; n < 2; ++n) acc[a][b][m][n] = (f32x4){0.f, 0.f, 0.f, 0.f};
        cur = nxt; cA = nA; cB = nB; ++ui;
        if constexpr (ALIGN_EPI) { if (wr == 1) PG8_BAR; }
    }
    PG8_WAIT_V(0);
    if constexpr (!ALIGN_EPI) { if (wr == 0) PG8_BAR; }
    PG8_BAR;
    if constexpr (Epi::AFTER_DRAIN) { E.fused(acc, cur, wr, wc, fr, fq, lds, wid, lane); S.done(cur); }
#undef PG8_SA
#undef PG8_SB
#undef PG8_STAGE
#undef PG8_LDA
#undef PG8_LDB
#undef PG8_MMA
#undef PG8_WAIT_V
#undef PG8_WAIT_L
#undef PG8_BAR
#undef PG8_SCHED
}
}
#include <hip/hip_cooperative_groups.h>
namespace cg = cooperative_groups;
#define LAS __attribute__((address_space(3)))
typedef unsigned short bf16;
typedef float f32x4 __attribute__((ext_vector_type(4)));
typedef float f32x2 __attribute__((ext_vector_type(2)));
typedef float f32x16 __attribute__((ext_vector_type(16)));
typedef short bf16x8 __attribute__((ext_vector_type(8)));
typedef short s16x4 __attribute__((ext_vector_type(4)));
typedef unsigned u32x4 __attribute__((ext_vector_type(4)));
typedef unsigned u32x2 __attribute__((ext_vector_type(2)));
typedef __bf16 bf16x2_t __attribute__((ext_vector_type(2)));

constexpr int BATCH = 2, T = 16384, D = 1024, M = BATCH * T, DEPTH = 2;
constexpr int NPROJ = 4352, NSRC = 4232;
constexpr int LDA = 1280, LDV = 512, LDB = 2560;
constexpr float LN_EPS = 1e-5f, GN_EPS = 64e-5f;
constexpr float DN_ALPHA = 1.41421356237f;
constexpr float C2 = 0.125f * 1.4426950408889634f;
constexpr float L2E = 1.4426950408889634f;
constexpr size_t MiB = 1u << 20;
constexpr size_t WS_CTL = 0, CTL_ZERO_BYTES = 1 * MiB;
constexpr size_t WS_WIN = 2 * MiB, WS_WOUT = 20 * MiB, WS_CUM = 24 * MiB, WS_SCS = 25 * MiB, WS_SCN = 30 * MiB;
constexpr size_t WS_XN = WS_SCN, WS_YM = WS_SCN;
constexpr size_t WS_LORA = 29 * MiB;
constexpr size_t WS_PA = 190 * MiB, WS_YA = WS_PA, WS_PV = 270 * MiB, WS_PB = 302 * MiB, WS_VS = 462 * MiB, WS_FS = 494 * MiB, WS_END = 502 * MiB;
constexpr int CW_QUEUE = 64;
constexpr int CW_KMAX = 1024;
constexpr int CW_MOD = 16384;
constexpr int LDS_BYTES = 147456;
#ifndef PROBE_REP
#define PROBE_REP 0
#endif

__device__ __forceinline__ unsigned f2bf(float f) { unsigned u = __builtin_bit_cast(unsigned, f); return (u + 0x7fffu + ((u >> 16) & 1u)) >> 16; }
__device__ __forceinline__ unsigned pk2(float lo, float hi) { return f2bf(lo) | (f2bf(hi) << 16); }
__device__ __forceinline__ float bf2f(unsigned short v) { return __uint_as_float(((unsigned)v) << 16); }
__device__ __forceinline__ float bflo(unsigned w) { return __uint_as_float(w << 16); }
__device__ __forceinline__ float bfhi(unsigned w) { return __uint_as_float(w & 0xffff0000u); }
__device__ __forceinline__ unsigned cvtpk(float lo, float hi) { f32x2 v = {lo, hi}; bf16x2_t b = __builtin_convertvector(v, bf16x2_t); return __builtin_bit_cast(unsigned, b); }
__device__ __forceinline__ float wave_sum(float v) {
#pragma unroll
    for (int o = 1; o < 64; o <<= 1) v += __shfl_xor(v, o);
    return v;
}
__device__ __forceinline__ float fast_sigmoid(float x) { return 1.f / (1.f + __expf(-x)); }

struct Args { const float* in[21]; float* out; unsigned char* ws; };

struct EpiProj {
    static constexpr bool PERM = true, AFTER_DRAIN = false;
    bf16 *PA, *PVb, *PB;
    __device__ __forceinline__ void operator()(const pg8::f32x4 (&acc)[2][2][4][2], const pg8::Unit& u, int wr, int wc, int fr, int fq) const {
        const int row0 = u.pm * 256 + wr * 64 + fr; const int pn = u.pn;
        bf16* base; int ldc, colt; float sc = 1.f; bool act = false;
        if (pn < 4) { base = PA; ldc = LDA; colt = pn * 256; }
        else if (pn < 6) { base = PVb; ldc = LDV; colt = (pn - 4) * 256; }
        else if (pn == 6) { base = PA; ldc = LDA; colt = 1024; }
        else { base = PB; ldc = LDB; colt = (pn - 7) * 256; if (pn < 9) sc = C2; if (pn >= 13) act = true; }
        const int col0 = colt + wc * 32 + 8 * fq;
#pragma unroll
        for (int ai = 0; ai < 2; ++ai)
#pragma unroll
            for (int m = 0; m < 4; ++m) { bf16* rowp = base + (size_t)(row0 + ai * 128 + m * 16) * ldc + col0;
#pragma unroll
                for (int bj = 0; bj < 2; ++bj) { pg8::f32x4 v0 = acc[ai][bj][m][0], v1 = acc[ai][bj][m][1];
                    if (act) {
#pragma unroll
                        for (int e = 0; e < 4; ++e) { v0[e] = v0[e] * fast_sigmoid(v0[e]); v1[e] = v1[e] * fast_sigmoid(v1[e]); } }
                    v0 = v0 * sc; v1 = v1 * sc; u32x4 w; w.x = cvtpk(v0[0], v0[1]); w.y = cvtpk(v0[2], v0[3]); w.z = cvtpk(v1[0], v1[1]); w.w = cvtpk(v1[2], v1[3]);
                    *(u32x4*)(rowp + bj * 128) = w; } }
    }
};
struct EpiOut {
    static constexpr bool PERM = false, AFTER_DRAIN = false;
    float* hz; const float* modl;
    __device__ __forceinline__ void operator()(const pg8::f32x4 (&acc)[2][2][4][2], const pg8::Unit& u, int wr, int wc, int fr, int fq) const {
        const int col0 = u.pn * 256 + wc * 32 + 4 * fq; const int b = (u.pm * 256) >= T ? 1 : 0; const float* gate = modl + b * 3072 + 2048;
#pragma unroll
        for (int bj = 0; bj < 2; ++bj)
#pragma unroll
            for (int n = 0; n < 2; ++n) { const int c = col0 + bj * 128 + n * 16; const f32x4 g = *(const f32x4*)(gate + c) + 1.0f;
#pragma unroll
                for (int ai = 0; ai < 2; ++ai)
#pragma unroll
                    for (int m = 0; m < 4; ++m) { const int r = u.pm * 256 + ai * 128 + wr * 64 + m * 16 + fr; float* p = hz + (size_t)r * D + c;
                        const f32x4 hx = *(const f32x4*)p; f32x4 a; a[0] = acc[ai][bj][m][n][0]; a[1] = acc[ai][bj][m][n][1]; a[2] = acc[ai][bj][m][n][2]; a[3] = acc[ai][bj][m][n][3];
                        *(f32x4*)p = hx * DN_ALPHA + g * a; } }
    }
};

__device__ __forceinline__ int win_map(int n) { if (n < 1664) return n; if (n < 1672) return 3200 + n - 1664; if (n < 1792) return -1; if (n < 3328) return n - 128; return n - 120; }
template <bool MAP> __device__ __forceinline__ void transpose_item(const float* W, int Nsrc, int Ndst, bf16* WT, LAS float* scr, int item, int lane) {
    const int nblk = Ndst / 32, kb = item / nblk, nb = item % nblk, k0 = 64 * kb, n0 = 32 * nb;
    const int src = MAP ? win_map(n0 + (lane & 31)) : n0 + (lane & 31);
#pragma unroll 8
    for (int i = 0; i < 32; ++i) { const int kk = 2 * i + (lane >> 5); scr[kk * 33 + (lane & 31)] = src >= 0 ? W[(size_t)(k0 + kk) * Nsrc + src] : 0.f; }
    asm volatile("s_waitcnt lgkmcnt(0)" ::: "memory");
    const int c = lane & 7;
#pragma unroll
    for (int j = 0; j < 4; ++j) { const int n = (lane >> 3) + 8 * j; const LAS float* s = scr + (8 * c) * 33 + n;
        u32x4 o; o.x = pk2(s[0 * 33], s[1 * 33]); o.y = pk2(s[2 * 33], s[3 * 33]); o.z = pk2(s[4 * 33], s[5 * 33]); o.w = pk2(s[6 * 33], s[7 * 33]);
        *(u32x4*)(WT + (size_t)(n0 + n) * 1024 + k0 + 8 * c) = o; }
    asm volatile("s_waitcnt lgkmcnt(0)" ::: "memory");
}
__device__ __forceinline__ void p0a(const Args& a, LAS unsigned char* lds, int tid, int lane, int wave, int G) {
    LAS float* scr = (LAS float*)(lds + wave * 16384);
    const int gw = blockIdx.x * 8 + wave, NGW = G * 8;
    constexpr int I_IN = 16 * (NPROJ / 32), I_OUT = 16 * 32;
    for (int it = gw; it < 2 * (I_IN + I_OUT); it += NGW) {
        int r = it; const int l = r / (I_IN + I_OUT); r -= l * (I_IN + I_OUT);
        if (r < I_IN) transpose_item<true>(a.in[6] + (size_t)l * 1024 * NSRC, NSRC, NPROJ, (bf16*)(a.ws + WS_WIN) + (size_t)l * NPROJ * 1024, scr, r, lane);
        else transpose_item<false>(a.in[18] + (size_t)l * 1024 * 1024, 1024, 1024, (bf16*)(a.ws + WS_WOUT) + (size_t)l * 1024 * 1024, scr, r - I_IN, lane);
    }
    { bf16* LT = (bf16*)(a.ws + WS_LORA);
      for (int w = blockIdx.x * 512 + tid; w < 2 * 2 * 512 * 64; w += G * 512) { const int k = w & 63, n = (w >> 6) & 511, which = (w >> 15) & 1, l = w >> 16;
          const float* src = (which ? a.in[11] : a.in[9]) + (size_t)l * 64 * 512; LT[w] = (bf16)f2bf(src[k * 512 + n]); } }
    float* mod = (float*)(a.ws + WS_CTL) + CW_MOD;
    const float* cvec = a.in[1];
    for (int w = blockIdx.x * 512 + tid; w < 2 * 16 * 3072; w += G * 512) {
        const int j = w % 3072, sl = (w / 3072) % 16, l = w / (3072 * 16);
        const float* wa = a.in[4] + (size_t)l * 1024 * 3072 + (size_t)(sl * 64) * 3072 + j;
        float s0 = 0.f, s1 = 0.f;
#pragma unroll 8
        for (int i = 0; i < 64; ++i) { const float wv = wa[(size_t)i * 3072]; s0 += cvec[sl * 64 + i] * wv; s1 += cvec[1024 + sl * 64 + i] * wv; }
        if (sl == 0) { const float bb = a.in[5][l * 3072 + j]; s0 += bb; s1 += bb; }
        atomicAdd(mod + (l * 2 + 0) * 3072 + j, s0); atomicAdd(mod + (l * 2 + 1) * 3072 + j, s1);
    }
}
__device__ __forceinline__ void ln_rows(const float* src, const float* g, const float* bb, float* dst, bf16* xn, const float* modn, int lane, int wave, int G) {
    const int gw = blockIdx.x * 8 + wave, NGW = G * 8;
    f32x4 gv[4], bv[4];
#pragma unroll
    for (int j = 0; j < 4; ++j) { gv[j] = ((const f32x4*)g)[lane + 64 * j]; bv[j] = ((const f32x4*)bb)[lane + 64 * j]; }
    for (int m = gw; m < M; m += NGW) {
        const f32x4* xr = (const f32x4*)(src + (size_t)m * D) + lane;
        f32x4 v[4]; float s = 0.f;
#pragma unroll
        for (int j = 0; j < 4; ++j) { v[j] = xr[64 * j]; s += (v[j].x + v[j].y) + (v[j].z + v[j].w); }
        const float mean = wave_sum(s) * (1.f / D); float s2 = 0.f;
#pragma unroll
        for (int j = 0; j < 4; ++j) { v[j] = v[j] - mean; s2 += (v[j].x * v[j].x + v[j].y * v[j].y) + (v[j].z * v[j].z + v[j].w * v[j].w); }
        const float rstd = 1.f / sqrtf(wave_sum(s2) * (1.f / D) + LN_EPS);
        f32x4* o = (f32x4*)(dst + (size_t)m * D) + lane;
        const int b = m >= T ? 1 : 0;
#pragma unroll
        for (int j = 0; j < 4; ++j) { const f32x4 hv = v[j] * rstd * gv[j] + bv[j]; o[64 * j] = hv;
            if (modn) { const f32x4 sh = ((const f32x4*)(modn + b * 3072))[lane + 64 * j], sc = ((const f32x4*)(modn + b * 3072 + 1024))[lane + 64 * j];
                const f32x4 y = hv * (sc + 1.0f) + sh; u32x2 w; w.x = pk2(y.x, y.y); w.y = pk2(y.z, y.w);
                *((u32x2*)(xn + (size_t)m * D) + lane + 64 * j) = w; } }
    }
}
__device__ __forceinline__ int crow(int r, int hi) { return (r & 3) + 8 * (r >> 2) + 4 * hi; }
__device__ __forceinline__ float tanh_fast(float x) { const float e = __expf(2.f * x); return 1.f - 2.f / (e + 1.f); }
__device__ __forceinline__ void cum_kmax(const Args& a, LAS unsigned char* lds, int l, int bh, int tid, int lane, int wave) {
    const int b = bh >> 3, h = bh & 7;
    const bf16* PA = (const bf16*)(a.ws + WS_PA); const bf16* PB = (const bf16*)(a.ws + WS_PB);
    float* cum = (float*)(a.ws + WS_CUM) + (size_t)bh * T;
    const float bf = a.in[17][l * 8 + h];
    LAS float* red = (LAS float*)lds;
    const int t0 = tid * 32;
    float s = 0.f, kmx = 0.f;
#pragma unroll 1
    for (int i = 0; i < 32; ++i) { const size_t m = (size_t)b * T + t0 + i;
        const float z = bf2f(PA[m * LDA + 1152 + h]) + bf;
        const float lf = fminf(z, 0.f) - log1pf(__expf(-fabsf(z)));
        s += lf; cum[t0 + i] = s;
        const u32x4* kr = (const u32x4*)(PB + m * LDB + 512 + h * 64); float q = 0.f;
#pragma unroll
        for (int c = 0; c < 8; ++c) { const u32x4 w = kr[c];
            q += bflo(w.x) * bflo(w.x) + bfhi(w.x) * bfhi(w.x) + bflo(w.y) * bflo(w.y) + bfhi(w.y) * bfhi(w.y) + bflo(w.z) * bflo(w.z) + bfhi(w.z) * bfhi(w.z) + bflo(w.w) * bflo(w.w) + bfhi(w.w) * bfhi(w.w); }
        kmx = fmaxf(kmx, q); }
    red[tid] = s;
#pragma unroll
    for (int o = 1; o < 64; o <<= 1) kmx = fmaxf(kmx, __shfl_xor(kmx, o));
    if (lane == 0) red[512 + wave] = kmx;
    __syncthreads();
    if (tid == 0) { float run = 0.f; for (int i = 0; i < 512; ++i) { const float v = red[i]; red[i] = run; run += v; }
        float k = 0.f; for (int i = 0; i < 8; ++i) k = fmaxf(k, red[512 + i]);
        ((float*)(a.ws + WS_CTL))[CW_KMAX + 16 * l + bh] = sqrtf(k); }
    __syncthreads();
    const float off = red[tid];
#pragma unroll 1
    for (int i = 0; i < 32; ++i) cum[t0 + i] += off;
    __syncthreads();
}
__device__ __forceinline__ void prep_phase(const Args& a, LAS unsigned char* lds, int l, int tid, int lane, int wave, int G) {
    const bf16* PA = (const bf16*)(a.ws + WS_PA); const bf16* PV = (const bf16*)(a.ws + WS_PV);
    bf16* SCN = (bf16*)(a.ws + WS_SCN); float* SCS = (float*)(a.ws + WS_SCS); bf16* VS = (bf16*)(a.ws + WS_VS);
    LAS unsigned char* lowL = lds;
    LAS bf16* CL = (LAS bf16*)(lds + 16384);
    const int c = tid, h = wave, r32 = lane & 31, hi = lane >> 5;
    const bf16* LT = (const bf16*)(a.ws + WS_LORA) + (size_t)l * 2 * 512 * 64;
    const float* mix = a.in[7] + l * 1664;
    const float mix_r = mix[c], mix_k = mix[512 + c], mix_v = mix[1024 + c];
    const int ftok = tid >> 3, fi0 = (tid & 7) * 16;
    f32x4 mlow[4];
#pragma unroll
    for (int q = 0; q < 4; ++q) mlow[q] = *(const f32x4*)(mix + 1536 + fi0 + 4 * q);
    const float w0c = a.in[8][l * 512 + c], a0c = a.in[10][l * 512 + c], kkc = a.in[12][l * 512 + c], kac = a.in[13][l * 512 + c], rkc = a.in[14][l * 512 + c];
    unsigned* pq = (unsigned*)(a.ws + WS_CTL) + CW_QUEUE + 1024 + 64 * l;
    volatile LAS unsigned* ptask = (volatile LAS unsigned*)(lds + 140000);
    for (;;) {
        __syncthreads();
        if (tid == 0) ptask[0] = atomicAdd(pq, 1u);
        __syncthreads();
        const unsigned ptk = ptask[0];
        if (ptk >= 16u + (unsigned)(M / 64)) break;
        if (ptk < 16u) { cum_kmax(a, lds + 135168, l, (int)ptk, tid, lane, wave); continue; }
        const int chunk = (int)ptk - 16;
        const int m0 = chunk * 64, b = m0 >= T ? 1 : 0, t0 = m0 - b * T; const int bh = b * 8 + h;
        { const int m = m0 + ftok, t = t0 + ftok;
          const u32x4* cp = (const u32x4*)(PA + (size_t)m * LDA + 1024 + fi0);
          const u32x4 c0 = cp[0], c1 = cp[1]; u32x4 p0 = {0u, 0u, 0u, 0u}, p1 = p0;
          if (t > 0) { const u32x4* pp = (const u32x4*)(PA + (size_t)(m - 1) * LDA + 1024 + fi0); p0 = pp[0]; p1 = pp[1]; }
          float cur[16], prv[16];
          cur[0] = bflo(c0.x); cur[1] = bfhi(c0.x); cur[2] = bflo(c0.y); cur[3] = bfhi(c0.y); cur[4] = bflo(c0.z); cur[5] = bfhi(c0.z); cur[6] = bflo(c0.w); cur[7] = bfhi(c0.w);
          cur[8] = bflo(c1.x); cur[9] = bfhi(c1.x); cur[10] = bflo(c1.y); cur[11] = bfhi(c1.y); cur[12] = bflo(c1.z); cur[13] = bfhi(c1.z); cur[14] = bflo(c1.w); cur[15] = bfhi(c1.w);
          prv[0] = bflo(p0.x); prv[1] = bfhi(p0.x); prv[2] = bflo(p0.y); prv[3] = bfhi(p0.y); prv[4] = bflo(p0.z); prv[5] = bfhi(p0.z); prv[6] = bflo(p0.w); prv[7] = bfhi(p0.w);
          prv[8] = bflo(p1.x); prv[9] = bfhi(p1.x); prv[10] = bflo(p1.y); prv[11] = bfhi(p1.y); prv[12] = bflo(p1.z); prv[13] = bfhi(p1.z); prv[14] = bflo(p1.w); prv[15] = bfhi(p1.w);
#pragma unroll
          for (int q = 0; q < 16; ++q) { float val = cur[q] + (prv[q] - cur[q]) * mlow[q >> 2][q & 3]; if (fi0 < 64) val = tanh_fast(val); cur[q] = val; }
          u32x4 o0 = {cvtpk(cur[0], cur[1]), cvtpk(cur[2], cur[3]), cvtpk(cur[4], cur[5]), cvtpk(cur[6], cur[7])};
          u32x4 o1 = {cvtpk(cur[8], cur[9]), cvtpk(cur[10], cur[11]), cvtpk(cur[12], cur[13]), cvtpk(cur[14], cur[15])};
          const int ch = 2 * (tid & 7);
          *(LAS u32x4*)(lowL + ftok * 256 + ((ch ^ (ftok & 7)) << 4)) = o0; *(LAS u32x4*)(lowL + ftok * 256 + (((ch + 1) ^ (ftok & 7)) << 4)) = o1; }
        __syncthreads();
        float pr = 0.f, pk = 0.f, pv = 0.f;
        if (t0 > 0) { pr = bf2f(PA[(size_t)(m0 - 1) * LDA + c]); pk = bf2f(PA[(size_t)(m0 - 1) * LDA + 512 + c]); pv = bf2f(PV[(size_t)(m0 - 1) * LDV + c]); }
#pragma unroll 1
        for (int tr = 0; tr < 2; ++tr) {
            { f32x16 Cw0 = {}, Cw1 = {}, Ca0 = {}, Ca1 = {};
              const int trow = 32 * tr + r32;
              bf16x8 Bw[2][4], Ba[2][4];
#pragma unroll
              for (int tc = 0; tc < 2; ++tc)
#pragma unroll
                for (int sx = 0; sx < 4; ++sx) { const int n = 64 * h + 32 * tc + r32;
                    Bw[tc][sx] = __builtin_bit_cast(bf16x8, *(const u32x4*)(LT + (size_t)n * 64 + 16 * sx + 8 * hi));
                    Ba[tc][sx] = __builtin_bit_cast(bf16x8, *(const u32x4*)(LT + 512 * 64 + (size_t)n * 64 + 16 * sx + 8 * hi)); }
#pragma unroll
              for (int sx = 0; sx < 4; ++sx) {
                  const bf16x8 Aw = *(const LAS bf16x8*)(lowL + trow * 256 + (((2 * sx + hi) ^ (trow & 7)) << 4));
                  const bf16x8 Aa = *(const LAS bf16x8*)(lowL + trow * 256 + (((8 + 2 * sx + hi) ^ (trow & 7)) << 4));
                  Cw0 = __builtin_amdgcn_mfma_f32_32x32x16_bf16(Aw, Bw[0][sx], Cw0, 0, 0, 0); Cw1 = __builtin_amdgcn_mfma_f32_32x32x16_bf16(Aw, Bw[1][sx], Cw1, 0, 0, 0);
                  Ca0 = __builtin_amdgcn_mfma_f32_32x32x16_bf16(Aa, Ba[0][sx], Ca0, 0, 0, 0); Ca1 = __builtin_amdgcn_mfma_f32_32x32x16_bf16(Aa, Ba[1][sx], Ca1, 0, 0, 0); }
#pragma unroll
              for (int r = 0; r < 16; ++r) { LAS bf16* row = CL + crow(r, hi) * 1024 + 64 * h + r32;
                  row[0] = (bf16)f2bf(Cw0[r]); row[32] = (bf16)f2bf(Cw1[r]); row[512] = (bf16)f2bf(Ca0[r]); row[544] = (bf16)f2bf(Ca1[r]); } }
            __syncthreads();
#pragma unroll 1
            for (int g = 0; g < 4; ++g) {
                const int tl0 = g * 8, mg = m0 + 32 * tr + tl0, tg = t0 + 32 * tr + tl0;
                float cr[8], ck[8], cv[8];
#pragma unroll
                for (int tt = 0; tt < 8; ++tt) { cr[tt] = bf2f(PA[(size_t)(mg + tt) * LDA + c]); ck[tt] = bf2f(PA[(size_t)(mg + tt) * LDA + 512 + c]); cv[tt] = bf2f(PV[(size_t)(mg + tt) * LDV + c]); }
                float rr[8], kkr[8], kp[8], vv[8], av[8], omw[8], red[32];
#pragma unroll
                for (int tt = 0; tt < 8; ++tt) {
                    const float prr = tt ? cr[tt - 1] : pr, prk = tt ? ck[tt - 1] : pk, prv = tt ? cv[tt - 1] : pv;
                    const float r = cr[tt] + (prr - cr[tt]) * mix_r, k = ck[tt] + (prk - ck[tt]) * mix_k; vv[tt] = cv[tt] + (prv - cv[tt]) * mix_v;
                    const float wl = w0c + bf2f(CL[(tl0 + tt) * 1024 + c]), al = a0c + bf2f(CL[(tl0 + tt) * 1024 + 512 + c]);
                    const float z = -wl; const float sp = fmaxf(z, 0.f) + __logf(1.f + __expf(-fabsf(z)));
                    const float e = __expf(-sp - 0.5f); omw[tt] = 1.f - __expf(-e);
                    av[tt] = fast_sigmoid(al);
                    kkr[tt] = k * kkc; kp[tt] = k * (1.f + (av[tt] - 1.f) * kac); rr[tt] = r;
                    red[tt] = kkr[tt] * kkr[tt]; red[8 + tt] = kkr[tt] * av[tt] * r; red[16 + tt] = kp[tt] * r; red[24 + tt] = r * kp[tt] * rkc;
                }
                pr = cr[7]; pk = ck[7]; pv = cv[7];
#pragma unroll
                for (int o = 1; o < 64; o <<= 1) {
#pragma unroll
                    for (int i = 0; i < 32; ++i) red[i] += __shfl_xor(red[i], o); }
#pragma unroll
                for (int tt = 0; tt < 8; ++tt) {
                    const float inv = 1.f / fmaxf(sqrtf(red[tt]), 1e-12f);
                    const float kk = kkr[tt] * inv, bbv = kk * av[tt], wr = (1.f - omw[tt]) * rr[tt];
                    bf16* rec = SCN + ((size_t)bh * T + tg + tt) * 320 + lane;
                    rec[0] = (bf16)f2bf(kk); rec[64] = (bf16)f2bf(wr); rec[128] = (bf16)f2bf(omw[tt]); rec[192] = (bf16)f2bf(bbv); rec[256] = (bf16)f2bf(kp[tt]);
                    VS[(size_t)(mg + tt) * 512 + c] = (bf16)f2bf(vv[tt]);
                    if (lane == 0) { f32x4 sc = {red[8 + tt] * inv, red[16 + tt], red[24 + tt], 0.f}; *(f32x4*)(SCS + ((size_t)bh * T + tg + tt) * 4) = sc; }
                }
            }
            __syncthreads();
        }
    }
    __syncthreads();
}

__device__ __forceinline__ float dppf(float x, const int ctrl_sel) {
    unsigned u = __float_as_uint(x), r;
    if (ctrl_sel == 0) r = __builtin_amdgcn_update_dpp(0, u, 0xB1, 0xF, 0xF, true);
    else if (ctrl_sel == 1) r = __builtin_amdgcn_update_dpp(0, u, 0x4E, 0xF, 0xF, true);
    else r = __builtin_amdgcn_update_dpp(0, u, 0x141, 0xF, 0xF, true);
    return __uint_as_float(r);
}
__device__ __forceinline__ float red8(float x) { x += dppf(x, 0); x += dppf(x, 1); x += dppf(x, 2); return x; }
constexpr int SC_CH = 32, SC_STEP = 1024, SC_BUF = SC_CH * SC_STEP, SC_VOFF = 2 * SC_BUF, SC_SOFF = SC_VOFF + 2 * SC_CH * 64 * 4, SC_ROWB = SC_SOFF + 2 * SC_CH * 16;
constexpr int NSEG = 16, SEGLEN = T / NSEG;
typedef float f32x4m __attribute__((ext_vector_type(4)));
template <bool PASSC> __device__ __forceinline__ void scan_task(const Args& a, LAS unsigned char* lds, int bh, int seg, int tid, int lane, int wave) {
    const int b = bh >> 3, h = bh & 7;
    const int t0 = seg * SEGLEN;
    const bf16* SCN = (const bf16*)(a.ws + WS_SCN) + ((size_t)bh * T + t0) * 320;
    const float* SCS = (const float*)(a.ws + WS_SCS) + ((size_t)bh * T + t0) * 4;
    const bf16* VS = (const bf16*)(a.ws + WS_VS) + ((size_t)b * T + t0) * 512 + h * 64;
    float* YA = (float*)(a.ws + WS_YA) + ((size_t)b * T + t0) * 512 + h * 64;
    float* FSb = (float*)(a.ws + WS_FS) + (size_t)bh * NSEG * 128 * 64;
    constexpr int NCH = SEGLEN / SC_CH;
    const int n16 = lane & 15, g = lane >> 4;
    const bool ident = !PASSC && wave >= 4;
    const bool active = PASSC ? (wave < 4) : true;
    const int row = 16 * (wave & 3) + n16;
    f32x4 Sf[4];
#pragma unroll
    for (int i = 0; i < 4; ++i) Sf[i] = (f32x4){0.f, 0.f, 0.f, 0.f};
    __syncthreads();
    if constexpr (PASSC) {
        LAS float* rowb = (LAS float*)(lds + SC_ROWB);
        const int crow_ = tid >> 3, kq = (tid & 7) * 8;
        f32x4 c0 = {0.f, 0.f, 0.f, 0.f}, c1 = c0;
        LAS float* pbuf = (LAS float*)lds;
        f32x4 pr0, pr1;
        if (seg > 0) { const float* Pk = FSb + ((size_t)0 * 128 + 64 + crow_) * 64 + kq; pr0 = *(const f32x4*)Pk; pr1 = *(const f32x4*)(Pk + 4); }
        for (int k = 0; k < seg; ++k) {
            const float* Uk = FSb + ((size_t)k * 128 + crow_) * 64 + kq;
            f32x4 a0 = *(const f32x4*)Uk, a1 = *(const f32x4*)(Uk + 4);
            *(LAS f32x4*)(rowb + crow_ * 64 + kq) = c0; *(LAS f32x4*)(rowb + crow_ * 64 + kq + 4) = c1;
            *(LAS f32x4*)(pbuf + crow_ * 64 + kq) = pr0; *(LAS f32x4*)(pbuf + crow_ * 64 + kq + 4) = pr1;
            __syncthreads();
            if (k + 1 < seg) { const float* Pn = FSb + ((size_t)(k + 1) * 128 + 64 + crow_) * 64 + kq; pr0 = *(const f32x4*)Pn; pr1 = *(const f32x4*)(Pn + 4); }
#pragma unroll 4
            for (int jj = 0; jj < 64; ++jj) { const float sj = rowb[crow_ * 64 + jj]; a0 += *(const LAS f32x4*)(pbuf + jj * 64 + kq) * sj; a1 += *(const LAS f32x4*)(pbuf + jj * 64 + kq + 4) * sj; }
            c0 = a0; c1 = a1;
            __syncthreads();
        }
        *(LAS f32x4*)(rowb + crow_ * 64 + kq) = c0; *(LAS f32x4*)(rowb + crow_ * 64 + kq + 4) = c1;
        __syncthreads();
        if (active) {
#pragma unroll
            for (int q = 0; q < 2; ++q) { Sf[2 * q] = *(const LAS f32x4*)(rowb + row * 64 + 32 * q + 8 * g); Sf[2 * q + 1] = *(const LAS f32x4*)(rowb + row * 64 + 32 * q + 8 * g + 4); }
        }
    } else if (ident) {
#pragma unroll
        for (int i = 0; i < 4; ++i)
#pragma unroll
            for (int e = 0; e < 4; ++e) Sf[i][e] = (32 * (i >> 1) + 8 * g + 4 * (i & 1) + e == row) ? 1.f : 0.f;
    }
    u32x4 mreg[3]; u32x4 vreg = {0u, 0u, 0u, 0u}; f32x4 sreg;
    auto gload = [&](int c) {
        const u32x4* src = (const u32x4*)(SCN + (size_t)c * SC_CH * 320);
#pragma unroll
        for (int i = 0; i < 3; ++i) { const int p = tid + 512 * i; if (p < 1280) mreg[i] = src[p]; }
        if (tid < 256) vreg = *(const u32x4*)(VS + (size_t)(c * SC_CH + (tid >> 3)) * 512 + (tid & 7) * 8);
        else if (tid < 288) sreg = *(const f32x4*)(SCS + (size_t)(c * SC_CH + (tid - 256)) * 4);
    };
    auto lwrite = [&](int c) {
        LAS unsigned char* bp = lds + (c & 1) * SC_BUF;
#pragma unroll
        for (int i = 0; i < 3; ++i) { const int p = tid + 512 * i;
            if (p < 1280) { const int st = p / 40, q = p - st * 40, arr = q >> 3, e8 = q & 7; const u32x4 w = mreg[i];
                LAS unsigned char* d = bp + st * SC_STEP;
                if (arr < 2) { *(LAS u32x4*)(d + 768 + arr * 128 + e8 * 16) = w; }
                else { f32x4 lo, hi;
                    lo[0] = bflo(w.x); lo[1] = bfhi(w.x); lo[2] = bflo(w.y); lo[3] = bfhi(w.y); hi[0] = bflo(w.z); hi[1] = bfhi(w.z); hi[2] = bflo(w.w); hi[3] = bfhi(w.w);
                    if (arr == 2) { lo = 1.0f - lo; hi = 1.0f - hi; }
                    LAS f32x4* df = (LAS f32x4*)(d + (arr - 2) * 256 + e8 * 32); df[0] = lo; df[1] = hi; } } }
        if (tid < 256) { const u32x4 w = vreg; f32x4 lo, hi;
            lo[0] = bflo(w.x); lo[1] = bfhi(w.x); lo[2] = bflo(w.y); lo[3] = bfhi(w.y); hi[0] = bflo(w.z); hi[1] = bfhi(w.z); hi[2] = bflo(w.w); hi[3] = bfhi(w.w);
            LAS f32x4* d = (LAS f32x4*)(lds + SC_VOFF + (c & 1) * (SC_CH * 64 * 4) + tid * 32); d[0] = lo; d[1] = hi; }
        else if (tid < 288) { *(LAS f32x4*)(lds + SC_SOFF + (c & 1) * (SC_CH * 16) + (tid - 256) * 16) = sreg; }
    };
    gload(0); lwrite(0); gload(1);
    __syncthreads();
    for (int c = 0; c < NCH; ++c) {
        if (c + 1 < NCH) lwrite(c + 1);
        if (c + 2 < NCH) gload(c + 2);
        if (active) {
            const LAS unsigned char* bp = lds + (c & 1) * SC_BUF;
            const LAS float* vb = (const LAS float*)(lds + SC_VOFF + (c & 1) * (SC_CH * 64 * 4)) + row;
            const LAS float* sb = (const LAS float*)(lds + SC_SOFF + (c & 1) * (SC_CH * 16));
#define SC_OFF(i) (((i) >> 1) * 128 + g * 32 + ((i) & 1) * 16)
#define SC_DECL(X) bf16x8 X##a0, X##a1, X##r0, X##r1; float X##v; f32x2 X##s
#define SC_LD(X, sidx) do { const LAS unsigned char* p_ = bp + (sidx) * SC_STEP; \
                X##a0 = *(const LAS bf16x8*)(p_ + 768 + g * 16); X##a1 = *(const LAS bf16x8*)(p_ + 768 + 64 + g * 16); \
                if constexpr (PASSC) { X##r0 = *(const LAS bf16x8*)(p_ + 896 + g * 16); X##r1 = *(const LAS bf16x8*)(p_ + 896 + 64 + g * 16); X##s = *(const LAS f32x2*)(sb + (sidx) * 4); } \
                X##v = ident ? 0.f : vb[(sidx) * 64]; } while (0)
#define SC_STEPM(X, Y, sidx, ldnext) do { const LAS unsigned char* p_ = bp + (sidx) * SC_STEP; \
                const f32x4 w0_ = *(const LAS f32x4*)(p_ + SC_OFF(0)), w1_ = *(const LAS f32x4*)(p_ + SC_OFF(1)), w2_ = *(const LAS f32x4*)(p_ + SC_OFF(2)), w3_ = *(const LAS f32x4*)(p_ + SC_OFF(3)); \
                const f32x4 k0_ = *(const LAS f32x4*)(p_ + 512 + SC_OFF(0)), k1_ = *(const LAS f32x4*)(p_ + 512 + SC_OFF(1)), k2_ = *(const LAS f32x4*)(p_ + 512 + SC_OFF(2)), k3_ = *(const LAS f32x4*)(p_ + 512 + SC_OFF(3)); \
                const f32x4 b0_ = *(const LAS f32x4*)(p_ + 256 + SC_OFF(0)), b1_ = *(const LAS f32x4*)(p_ + 256 + SC_OFF(1)), b2_ = *(const LAS f32x4*)(p_ + 256 + SC_OFF(2)), b3_ = *(const LAS f32x4*)(p_ + 256 + SC_OFF(3)); \
                if (ldnext) SC_LD(Y, (sidx) + 1); \
                u32x4 sb0, sb1; \
                sb0.x = cvtpk(Sf[0][0], Sf[0][1]); sb0.y = cvtpk(Sf[0][2], Sf[0][3]); sb0.z = cvtpk(Sf[1][0], Sf[1][1]); sb0.w = cvtpk(Sf[1][2], Sf[1][3]); \
                sb1.x = cvtpk(Sf[2][0], Sf[2][1]); sb1.y = cvtpk(Sf[2][2], Sf[2][3]); sb1.z = cvtpk(Sf[3][0], Sf[3][1]); sb1.w = cvtpk(Sf[3][2], Sf[3][3]); \
                const bf16x8 B0 = __builtin_bit_cast(bf16x8, sb0), B1 = __builtin_bit_cast(bf16x8, sb1); \
                f32x4m acc = {0.f, 0.f, 0.f, 0.f}; \
                acc = __builtin_amdgcn_mfma_f32_16x16x32_bf16(X##a0, B0, acc, 0, 0, 0); \
                acc = __builtin_amdgcn_mfma_f32_16x16x32_bf16(X##a1, B1, acc, 0, 0, 0); \
                float ys = 0.f; \
                if constexpr (PASSC) { f32x4m accy = {0.f, 0.f, 0.f, 0.f}; \
                    accy = __builtin_amdgcn_mfma_f32_16x16x32_bf16(X##r0, B0, accy, 0, 0, 0); \
                    accy = __builtin_amdgcn_mfma_f32_16x16x32_bf16(X##r1, B1, accy, 0, 0, 0); ys = accy[0]; } \
                const f32x4 sp0 = Sf[0] * w0_ + k0_ * X##v, sp1 = Sf[1] * w1_ + k1_ * X##v, sp2 = Sf[2] * w2_ + k2_ * X##v, sp3 = Sf[3] * w3_ + k3_ * X##v; \
                const float sa = acc[0]; \
                Sf[0] = sp0 - b0_ * sa; Sf[1] = sp1 - b1_ * sa; Sf[2] = sp2 - b2_ * sa; Sf[3] = sp3 - b3_ * sa; \
                if constexpr (PASSC) { const float y = ys - sa * X##s.x + X##v * X##s.y; if (g == 0) YA[(size_t)(c * SC_CH + (sidx)) * 512 + row] = y; } } while (0)
            SC_DECL(oA); SC_DECL(oB);
            SC_LD(oA, 0);
#pragma unroll 1
            for (int s = 0; s < SC_CH; s += 2) {
                SC_STEPM(oA, oB, s, true);
                __builtin_amdgcn_sched_barrier(0);
                SC_STEPM(oB, oA, s + 1, (s + 2 < SC_CH));
                __builtin_amdgcn_sched_barrier(0);
            }
#undef SC_OFF
#undef SC_DECL
#undef SC_LD
#undef SC_STEPM
        }
        __syncthreads();
    }
    if constexpr (!PASSC) { float* fp = FSb + ((size_t)seg * 128 + (ident ? 64 : 0) + row) * 64 + 8 * g;
#pragma unroll
        for (int q = 0; q < 2; ++q) { *(f32x4*)(fp + 32 * q) = Sf[2 * q]; *(f32x4*)(fp + 32 * q + 4) = Sf[2 * q + 1]; } }
}

typedef short v4i16_t __attribute__((ext_vector_type(4)));
__device__ __forceinline__ s16x4 vtr(const LAS unsigned char* p) { return __builtin_bit_cast(s16x4, __builtin_amdgcn_ds_read_tr16_b64_v4i16((LAS v4i16_t*)p)); }
constexpr int AT_KS = 0, AT_VS = 9216, AT_BIAS = 18432, AT_WSF = 18688, AT_FLAG = 19712, AT_TASK = 140000;
__device__ __forceinline__ void attn_unit(const Args& a, LAS unsigned char* lds, int l, int bh, int qb, int tid, int lane, int wid) {
    const int b = bh >> 3, h = bh & 7, r32 = lane & 31, hi = lane >> 5;
    const int q0 = qb * 256;
    bf16* PB = (bf16*)(a.ws + WS_PB);
    const float* cumh = (const float*)(a.ws + WS_CUM) + (size_t)bh * T;
    const float kmax = ((const float*)(a.ws + WS_CTL))[CW_KMAX + 16 * l + bh];
    const size_t rowbase = (size_t)b * T;
    const bf16* Qp = PB + (rowbase + q0 + wid * 32 + r32) * LDB + h * 64;
    bf16x8 qr[4]; float qs = 0.f;
#pragma unroll
    for (int d0 = 0; d0 < 4; ++d0) { const u32x4 w = *(const u32x4*)(Qp + d0 * 16 + hi * 8); qr[d0] = __builtin_bit_cast(bf16x8, w);
        qs += bflo(w.x) * bflo(w.x) + bfhi(w.x) * bfhi(w.x) + bflo(w.y) * bflo(w.y) + bfhi(w.y) * bfhi(w.y) + bflo(w.z) * bflo(w.z) + bfhi(w.z) * bfhi(w.z) + bflo(w.w) * bflo(w.w) + bfhi(w.w) * bfhi(w.w); }
    qs += __shfl_xor(qs, 32);
    const float qbound = sqrtf(qs) * kmax * 1.01f + 0.01f;
    const float ref = cumh[q0 + 255];
    const int srow = tid >> 3, sch = tid & 7;
    const bf16* Kg = PB + rowbase * LDB + 512 + h * 64 + sch * 8; const bf16* Vg = Kg + 512;
    LAS unsigned char* Ks = lds + AT_KS; LAS unsigned char* Vs = lds + AT_VS; LAS float* biasL = (LAS float*)(lds + AT_BIAS);
    LAS float* wsf = (LAS float*)(lds + AT_WSF) + wid * 32; volatile LAS unsigned* flag = (volatile LAS unsigned*)(lds + AT_FLAG);
    if (tid < 3) flag[tid] = 0u;
    float m = -INFINITY, lsum = 0.f; f32x16 o0 = {}, o1 = {};
    u32x4 kreg, vreg; float breg = 0.f, bnx = 0.f;
    int j = qb * 4 + 3;
    { kreg = *(const u32x4*)(Kg + (size_t)(64 * j + srow) * LDB); vreg = *(const u32x4*)(Vg + (size_t)(64 * j + srow) * LDB);
      if (tid < 64) breg = (ref - cumh[64 * j + tid]) * L2E; bnx = j > 0 ? (ref - cumh[64 * j - 1]) * L2E : 0.f; }
    const int q4 = (lane & 15) >> 2, p4 = lane & 3, blk = (lane >> 4) & 1;
    const int qrow = q0 + wid * 32 + r32;
    int it = 0;
    __syncthreads();
    for (;;) {
        *(LAS u32x4*)(Ks + srow * 144 + sch * 16) = kreg; *(LAS u32x4*)(Vs + srow * 144 + sch * 16) = vreg; if (tid < 64) biasL[tid] = breg;
        const float bnx_cur = bnx;
        __syncthreads();
        if (j > 0) { const int jn = j - 1;
            kreg = *(const u32x4*)(Kg + (size_t)(64 * jn + srow) * LDB); vreg = *(const u32x4*)(Vg + (size_t)(64 * jn + srow) * LDB);
            if (tid < 64) breg = (ref - cumh[64 * jn + tid]) * L2E; bnx = jn > 0 ? (ref - cumh[64 * jn - 1]) * L2E : 0.f; }
        if (64 * j <= q0 + 32 * wid + 31) {
            f32x16 p0 = {}, p1 = {};
#pragma unroll
            for (int d0 = 0; d0 < 4; ++d0) {
                const bf16x8 k0 = *(const LAS bf16x8*)(Ks + r32 * 144 + d0 * 32 + hi * 16);
                const bf16x8 k1 = *(const LAS bf16x8*)(Ks + (32 + r32) * 144 + d0 * 32 + hi * 16);
                p0 = __builtin_amdgcn_mfma_f32_32x32x16_bf16(k0, qr[d0], p0, 0, 0, 0);
                p1 = __builtin_amdgcn_mfma_f32_32x32x16_bf16(k1, qr[d0], p1, 0, 0, 0); }
#pragma unroll
            for (int g = 0; g < 4; ++g) { const f32x4 b0 = *(const LAS f32x4*)(biasL + 8 * g + 4 * hi), b1 = *(const LAS f32x4*)(biasL + 32 + 8 * g + 4 * hi);
#pragma unroll
                for (int e = 0; e < 4; ++e) { p0[4 * g + e] += b0[e]; p1[4 * g + e] += b1[e]; } }
            if (64 * j + 63 > q0 + 32 * wid) {
#pragma unroll
                for (int r = 0; r < 16; ++r) { const int kv = 64 * j + crow(r, hi); if (kv > qrow) p0[r] = -INFINITY; if (kv + 32 > qrow) p1[r] = -INFINITY; } }
            float mx = fmaxf(p0[0], p1[0]);
#pragma unroll
            for (int r = 1; r < 16; ++r) mx = fmaxf(mx, fmaxf(p0[r], p1[r]));
            mx = fmaxf(mx, __shfl_xor(mx, 32));
            const float mnew = fmaxf(m, mx); const float f = __builtin_amdgcn_exp2f(m - mnew); m = mnew;
            float rs = 0.f;
#pragma unroll
            for (int r = 0; r < 16; ++r) { p0[r] = __builtin_amdgcn_exp2f(p0[r] - mnew); p1[r] = __builtin_amdgcn_exp2f(p1[r] - mnew); rs += p0[r] + p1[r]; }
            lsum = lsum * f + rs;
            if (__any(f != 1.f)) {
                if (hi == 0) wsf[r32] = f;
                asm volatile("s_waitcnt lgkmcnt(0)" ::: "memory");
#pragma unroll
                for (int r = 0; r < 16; ++r) { const float fr = wsf[crow(r, hi)]; o0[r] *= fr; o1[r] *= fr; }
            }
            u32x4 pw[4];
            pw[0] = (u32x4){cvtpk(p0[0], p0[1]), cvtpk(p0[2], p0[3]), cvtpk(p0[4], p0[5]), cvtpk(p0[6], p0[7])};
            pw[1] = (u32x4){cvtpk(p0[8], p0[9]), cvtpk(p0[10], p0[11]), cvtpk(p0[12], p0[13]), cvtpk(p0[14], p0[15])};
            pw[2] = (u32x4){cvtpk(p1[0], p1[1]), cvtpk(p1[2], p1[3]), cvtpk(p1[4], p1[5]), cvtpk(p1[6], p1[7])};
            pw[3] = (u32x4){cvtpk(p1[8], p1[9]), cvtpk(p1[10], p1[11]), cvtpk(p1[12], p1[13]), cvtpk(p1[14], p1[15])};
#pragma unroll
            for (int s = 0; s < 4; ++s) { const int kvb = 16 * (s & 1) + 32 * (s >> 1);
                const LAS unsigned char* va = Vs + (kvb + 4 * hi + q4) * 144 + (16 * blk + 4 * p4) * 2;
                const s16x4 l0 = vtr(va), h0 = vtr(va + 8 * 144), l1 = vtr(va + 64), h1 = vtr(va + 8 * 144 + 64);
                const bf16x8 vf0 = {l0[0], l0[1], l0[2], l0[3], h0[0], h0[1], h0[2], h0[3]}, vf1 = {l1[0], l1[1], l1[2], l1[3], h1[0], h1[1], h1[2], h1[3]};
                const bf16x8 pa = __builtin_bit_cast(bf16x8, pw[s]);
                o0 = __builtin_amdgcn_mfma_f32_32x32x16_bf16(pa, vf0, o0, 0, 0, 0);
                o1 = __builtin_amdgcn_mfma_f32_32x32x16_bf16(pa, vf1, o1, 0, 0, 0); }
        }
        if (j == 0) break;
        const bool need = (qbound + bnx_cur > m - 40.f);
        if (tid == 0) flag[(it + 1) % 3] = 0u;
        if (__any(need) && lane == 0) flag[it % 3] = 1u;
        __syncthreads();
        const unsigned cont = flag[it % 3];
        if (!cont) break;
        --j; ++it;
    }
    lsum += __shfl_xor(lsum, 32);
    if (hi == 0) wsf[r32] = 1.f / lsum;
    asm volatile("s_waitcnt lgkmcnt(0)" ::: "memory");
    bf16* Ow = (bf16*)(a.ws + WS_PV) + (rowbase + q0 + wid * 32) * LDV + h * 64 + r32;
#pragma unroll
    for (int r = 0; r < 16; ++r) { const float inv = wsf[crow(r, hi)]; bf16* op = Ow + (size_t)crow(r, hi) * LDV;
        op[0] = (bf16)f2bf(o0[r] * inv); op[32] = (bf16)f2bf(o1[r] * inv); }
    __syncthreads();
}
__device__ __forceinline__ void p3a_phase(const Args& a, LAS unsigned char* lds, int l, int tid, int lane, int wave) {
    unsigned* ctr = (unsigned*)(a.ws + WS_CTL) + CW_QUEUE + 64 * l;
    volatile LAS unsigned* task = (volatile LAS unsigned*)(lds + AT_TASK);
    for (;;) {
        __syncthreads();
        if (tid == 0) task[0] = atomicAdd(ctr, 1u);
        __syncthreads();
        const unsigned tk = task[0];
        if (tk >= 240u + 1024u) break;
        int t2 = tid; asm volatile("" : "+v"(t2)); const int lane2 = t2 & 63;
        if (tk < 240u) { scan_task<false>(a, lds, (int)(tk / 15u), (int)(tk % 15u), t2, lane2, wave); }
        else { const unsigned u = tk - 240u; attn_unit(a, lds, l, (int)(u & 15), 63 - (int)(u >> 4), t2, lane2, wave); }
    }
}
__device__ __forceinline__ void p3b_phase(const Args& a, LAS unsigned char* lds, int l, int tid, int lane, int wave) {
    unsigned* ctr = (unsigned*)(a.ws + WS_CTL) + CW_QUEUE + 512 + 64 * l;
    volatile LAS unsigned* task = (volatile LAS unsigned*)(lds + AT_TASK);
    for (;;) {
        __syncthreads();
        if (tid == 0) task[0] = atomicAdd(ctr, 1u);
        __syncthreads();
        const unsigned tk = task[0];
        if (tk >= 256u) break;
        scan_task<true>(a, lds, (int)(tk >> 4), (int)(tk & 15), tid, lane, wave);
    }
}

__device__ __forceinline__ void merge_phase(const Args& a, int l, int tid, int lane, int wave, int G) {
    const float* YA = (const float*)(a.ws + WS_YA); const bf16* VS = (const bf16*)(a.ws + WS_VS); const bf16* PB = (const bf16*)(a.ws + WS_PB);
    const float* SCS = (const float*)(a.ws + WS_SCS); bf16* YM = (bf16*)(a.ws + WS_YM);
    const int c = tid, h = wave;
    const float gg = a.in[15][l * 512 + c], gb = a.in[16][l * 512 + c];
    constexpr int MT = 8;
    for (int m0 = blockIdx.x * MT; m0 < M; m0 += G * MT) {
        float ya[MT], v[MT], g1[MT], g2[MT], yb[MT], rkr[MT], mean[MT], var[MT];
#pragma unroll
        for (int u = 0; u < MT; ++u) { const int m = m0 + u; const int b = m >= T ? 1 : 0, t = m - b * T;
            ya[u] = YA[(size_t)m * 512 + c]; v[u] = bf2f(VS[(size_t)m * 512 + c]);
            g1[u] = bf2f(PB[(size_t)m * LDB + 1536 + c]); g2[u] = bf2f(PB[(size_t)m * LDB + 2048 + c]);
            yb[u] = bf2f(((const bf16*)(a.ws + WS_PV))[(size_t)m * LDV + c]);
            rkr[u] = SCS[((size_t)(b * 8 + h) * T + t) * 4 + 2]; mean[u] = ya[u]; }
#pragma unroll
        for (int o = 1; o < 64; o <<= 1) {
#pragma unroll
            for (int u = 0; u < MT; ++u) mean[u] += __shfl_xor(mean[u], o); }
#pragma unroll
        for (int u = 0; u < MT; ++u) { mean[u] *= (1.f / 64.f); const float d = ya[u] - mean[u]; var[u] = d * d; }
#pragma unroll
        for (int o = 1; o < 64; o <<= 1) {
#pragma unroll
            for (int u = 0; u < MT; ++u) var[u] += __shfl_xor(var[u], o); }
#pragma unroll
        for (int u = 0; u < MT; ++u) { const int m = m0 + u;
            const float yn = (ya[u] - mean[u]) * rsqrtf(var[u] * (1.f / 64.f) + GN_EPS) * gg + gb + rkr[u] * v[u];
            YM[(size_t)m * D + c] = (bf16)f2bf(yn * g1[u]); YM[(size_t)m * D + 512 + c] = (bf16)f2bf(yb[u] * g2[u]); }
    }
}

#ifndef N_LAUNCH_MODE
#define N_LAUNCH_MODE 1
#endif
template <int MASK, bool COOP> __device__ __forceinline__ void run_phases(const Args& a, LAS unsigned char* lds, int l0, int l1) {
    const int G = gridDim.x;
#define LAUNDER() int tid = threadIdx.x; asm volatile("" : "+v"(tid)); const int lane = tid & 63, wave = __builtin_amdgcn_readfirstlane(tid >> 6); (void)lane; (void)wave
    float* hbuf = a.out;
    const float* mod = (const float*)(a.ws + WS_CTL) + CW_MOD;
    bf16* XN = (bf16*)(a.ws + WS_XN);
#define GSYNC() do { if constexpr (COOP) cg::this_grid().sync(); } while (0)
    if constexpr (MASK & 1) { LAUNDER(); p0a(a, lds, tid, lane, wave, G); GSYNC(); }
    if constexpr (MASK & 2) { LAUNDER(); ln_rows(a.in[0], a.in[2], a.in[3], hbuf, XN, mod, lane, wave, G); GSYNC(); }
#pragma unroll 1
    for (int l = l0; l < l1; ++l) {
        for (int rep = 0; rep < ((PROBE_REP & 4) ? 2 : 1); ++rep)
        if constexpr (MASK & 4) { pg8::Gemm g{XN, (const bf16*)(a.ws + WS_WIN) + (size_t)l * NPROJ * 1024, M, NPROJ, 1024}; pg8::StaticOrder S; S.init(M, NPROJ, G, (int)blockIdx.x);
          EpiProj E{(bf16*)(a.ws + WS_PA), (bf16*)(a.ws + WS_PV), (bf16*)(a.ws + WS_PB)};
          pg8::gemm_phase<EpiProj, pg8::StaticOrder, true, true>(lds, g, S, E); GSYNC(); }
        for (int rep = 0; rep < ((PROBE_REP & 8) ? 2 : 1); ++rep)
        if constexpr (MASK & 8) { LAUNDER(); prep_phase(a, lds, l, tid, lane, wave, G); GSYNC(); }
        if constexpr (MASK & 16) { { LAUNDER(); p3a_phase(a, lds, l, tid, lane, wave); } GSYNC(); { LAUNDER(); p3b_phase(a, lds, l, tid, lane, wave); } GSYNC(); }
        for (int rep = 0; rep < ((PROBE_REP & 32) ? 2 : 1); ++rep)
        if constexpr (MASK & 32) { LAUNDER(); merge_phase(a, l, tid, lane, wave, G); GSYNC(); }
        if constexpr (MASK & 64) { pg8::Gemm g{(const bf16*)(a.ws + WS_YM), (const bf16*)(a.ws + WS_WOUT) + (size_t)l * 1024 * 1024, M, D, D}; pg8::StaticOrder S; S.init(M, D, G, (int)blockIdx.x);
          EpiOut E{hbuf, mod + l * 2 * 3072};
          pg8::gemm_phase<EpiOut, pg8::StaticOrder, true, true>(lds, g, S, E); GSYNC(); }
        if constexpr (MASK & 128) { LAUNDER(); ln_rows(hbuf, a.in[19] + l * D, a.in[20] + l * D, hbuf, XN, (l + 1 < DEPTH) ? mod + (l + 1) * 2 * 3072 : nullptr, lane, wave, G);
          if (l + 1 < l1) GSYNC(); }
    }
#undef GSYNC
#undef LAUNDER
}
#ifndef FMASK
#define FMASK 0xFF
#endif
#if N_LAUNCH_MODE == 1
__global__ void __launch_bounds__(512, 2) hymba_fwd(Args a) {
    extern __shared__ __attribute__((aligned(16))) unsigned char lds_raw[];
    run_phases<FMASK, true>(a, (LAS unsigned char*)lds_raw, 0, DEPTH);
}
#else
template <int MASK> __global__ void __launch_bounds__(512, 2) hymba_phase(Args a, int l) {
    extern __shared__ __attribute__((aligned(16))) unsigned char lds_raw[];
    run_phases<MASK, false>(a, (LAS unsigned char*)lds_raw, l, l + 1);
}
template <int MASK> static void launch_phase(const Args& a, int l, hipStream_t stream) {
    static bool attr = false;
    if (!attr) { (void)hipFuncSetAttribute((const void*)hymba_phase<MASK>, hipFuncAttributeMaxDynamicSharedMemorySize, LDS_BYTES); attr = true; }
    hipLaunchKernelGGL(hymba_phase<MASK>, dim3(256), dim3(512), LDS_BYTES, stream, a, l);
}
#endif

extern "C" void kernel_launch(void* const* d_in, const int* in_sizes, int n_in, void* d_out, int out_size, void* d_ws, size_t ws_size, hipStream_t stream) {
    if (n_in != 21 || ws_size < WS_END) { fprintf(stderr, "kernel_launch: unexpected n_in %d / ws %zu\n", n_in, ws_size); return; }
    (void)hipMemsetAsync((char*)d_ws + WS_CTL, 0, CTL_ZERO_BYTES, stream);
    Args a{};
    for (int i = 0; i < 21; ++i) a.in[i] = (const float*)d_in[i];
    a.out = (float*)d_out; a.ws = (unsigned char*)d_ws;
#if N_LAUNCH_MODE == 1
    static int grid = 0;
    if (grid == 0) {
        int dev = 0, cus = 0, per_cu = 0;
        (void)hipGetDevice(&dev); (void)hipDeviceGetAttribute(&cus, hipDeviceAttributeMultiprocessorCount, dev);
        (void)hipFuncSetAttribute((const void*)hymba_fwd, hipFuncAttributeMaxDynamicSharedMemorySize, LDS_BYTES);
        (void)hipOccupancyMaxActiveBlocksPerMultiprocessor(&per_cu, (const void*)hymba_fwd, 512, LDS_BYTES);
        if (per_cu < 1) per_cu = 1;
        (void)hipGetLastError();
        grid = cus * per_cu;
    }
    void* args[] = {&a};
    hipError_t e = hipLaunchCooperativeKernel((const void*)hymba_fwd, dim3(grid), dim3(512), args, LDS_BYTES, stream);
    if (e != hipSuccess) fprintf(stderr, "cooperative launch failed: %s (grid %d)\n", hipGetErrorString(e), grid);
#else
    launch_phase<1>(a, 0, stream); launch_phase<2>(a, 0, stream);
    for (int l = 0; l < DEPTH; ++l) { launch_phase<4>(a, l, stream); launch_phase<8>(a, l, stream); launch_phase<16>(a, l, stream); launch_phase<32>(a, l, stream); launch_phase<64>(a, l, stream); launch_phase<128>(a, l, stream); }
#endif
}
```

```cpp
#include <hip/hip_runtime.h>
#include <cstdio>
#include <cstdint>
namespace pg8 {
#define PG8_LAS __attribute__((address_space(3)))
typedef unsigned short bf16_t;
typedef short bf16x8 __attribute__((ext_vector_type(8)));
typedef float f32x4 __attribute__((ext_vector_type(4)));
typedef unsigned u32x4 __attribute__((ext_vector_type(4)));
constexpr int BM = 256, BK = 64, HALF = 128, HTB = HALF * BK * 2  , STAGE_BYTES = 8 * HTB, NXCD = 8, WGM = 8;

__host__ __device__ __forceinline__ int lds_byte(int r, int c) { const int st = (r >> 4) * 2 + (c >> 5), rr = r & 15, cc = c & 31, ob = rr * 64 + cc * 2; return st * 1024 + (ob ^ (((ob >> 9) & 1) << 5)); }
__host__ __device__ __forceinline__ void stage_rc(int b, int& R, int& C) { const int st = b / 1024, sb = b % 1024, swz = sb ^ (((sb >> 9) & 1) << 5); R = (st >> 1) * 16 + swz / 64; C = (st & 1) * 32 + (swz % 64) / 2; }
__host__ __device__ __forceinline__ int perm32(int rho) { const int n = rho >> 4, i = rho & 15; return 8 * (i >> 2) + 4 * n + (i & 3); }

struct Unit { int pm, pn; };
struct Gemm { const bf16_t* A; const bf16_t* Bt; int M, N, K; };

struct StaticOrder {
    int nM, nN, nwg, G, c;
    __host__ __device__ void init(int M, int N, int G_, int c_) { nM = M / BM; nN = N / BM; nwg = nM * nN; G = G_; c = c_; }
    __host__ __device__ bool next(int i, Unit& u) const {
        const long L = (long)i * G + c; if (L >= nwg) return false;
        int wgid = (int)L; { const int q = nwg / NXCD, r = nwg % NXCD, xcd = wgid % NXCD, off = wgid / NXCD; wgid = (xcd < r ? xcd * (q + 1) : r * (q + 1) + (xcd - r) * q) + off; }
        const int nig = WGM * nN, gid = wgid / nig, fm = gid * WGM, gsz = (nM - fm) < WGM ? (nM - fm) : WGM;
        u.pm = fm + ((wgid % nig) % gsz); u.pn = (wgid % nig) / gsz; return true;
    }
    __device__ __forceinline__ void a_ready(const Unit&) const {}
    __device__ __forceinline__ void done(const Unit&) const {}
};

__device__ __forceinline__ unsigned cvt_pk_bf16(float lo, float hi) { unsigned r; asm volatile("v_cvt_pk_bf16_f32 %0, %1, %2" : "=v"(r) : "v"(lo), "v"(hi)); return r; }
typedef float f32x2 __attribute__((ext_vector_type(2)));
__device__ __forceinline__ f32x2 gelu_pk(f32x2 v) {
    const f32x2 av = __builtin_elementwise_abs(v), d = av * 0.2316418882f + 1.0f;
    f32x2 t; t.x = __builtin_amdgcn_rcpf(d.x); t.y = __builtin_amdgcn_rcpf(d.y);
    f32x2 q = t * 0.5307027145f + (-0.7265760135f); q = q * t + 0.7107068705f; q = q * t + (-0.142248368f); q = q * t + 0.127414796f; q = q * t;
    const f32x2 s = (v * v) * (-0.72134752044f);
    f32x2 e; e.x = __builtin_amdgcn_exp2f(s.x); e.y = __builtin_amdgcn_exp2f(s.y);
    const f32x2 m = v * (q * e), r = v - m;
    f32x2 o; o.x = v.x < 0.f ? m.x : r.x; o.y = v.y < 0.f ? m.y : r.y; return o;
}

template <int ACT  > struct EpiBf16 {
    static constexpr bool PERM = true, AFTER_DRAIN = false; static_assert(ACT == 0 || ACT == 1, "EpiBf16: ACT is 0 (none) or 1 (gelu_pk)");
    bf16_t* O; int ldc; const float* bias; int split_cols; size_t split_stride; float scale0;
    __device__ __forceinline__ void operator()(const f32x4 (&acc)[2][2][4][2], const Unit& u, int wr, int wc, int fr, int fq) const {
        const int row0 = u.pm * BM + wr * 64 + fr; int colt = u.pn * BM; bf16_t* base = O;
        float sc = 1.f; if (split_cols) { const int t = colt / split_cols; base += (size_t)t * split_stride; colt -= t * split_cols; if (t == 0) sc = scale0; }
        const int col0 = colt + wc * 32 + 8 * fq, bcol0 = u.pn * BM + wc * 32 + 8 * fq;
        f32x4 bv[2][2];
#pragma unroll
        for (int bj = 0; bj < 2; ++bj)
#pragma unroll
            for (int n = 0; n < 2; ++n) bv[bj][n] = bias ? *(const f32x4*)(bias + bcol0 + bj * HALF + 4 * n) : (f32x4){0.f, 0.f, 0.f, 0.f};
#pragma unroll
        for (int ai = 0; ai < 2; ++ai)
#pragma unroll
            for (int m = 0; m < 4; ++m) { bf16_t* rowp = base + (size_t)(row0 + ai * HALF + m * 16) * ldc + col0;
#pragma unroll
                for (int bj = 0; bj < 2; ++bj) { f32x4 v0 = acc[ai][bj][m][0] + bv[bj][0], v1 = acc[ai][bj][m][1] + bv[bj][1];
                    if (ACT == 1) { f32x2 a = gelu_pk((f32x2){v0[0], v0[1]}), b = gelu_pk((f32x2){v0[2], v0[3]}), c = gelu_pk((f32x2){v1[0], v1[1]}), d = gelu_pk((f32x2){v1[2], v1[3]});
                        v0 = (f32x4){a.x, a.y, b.x, b.y}; v1 = (f32x4){c.x, c.y, d.x, d.y}; }
                    v0 = v0 * sc; v1 = v1 * sc; u32x4 w; w.x = cvt_pk_bf16(v0[0], v0[1]); w.y = cvt_pk_bf16(v0[2], v0[3]); w.z = cvt_pk_bf16(v1[0], v1[1]); w.w = cvt_pk_bf16(v1[2], v1[3]);
                    *(u32x4*)(rowp + bj * HALF) = w; } }
    }
};

template <class Epi, class Sched, bool ALIGN_EPI = false, bool SP2 = false>
__device__ __forceinline__ void gemm_phase(PG8_LAS unsigned char* lds, const Gemm g, const Sched& S, const Epi& E) {
    int tid = threadIdx.x; asm volatile("" : "+v"(tid));
    const int wid = __builtin_amdgcn_readfirstlane(tid >> 6), lane = tid & 63, wr = wid >> 2, wc = wid & 3, fr = lane & 15, fq = lane >> 4;
    const int K = g.K, nt = K / BK;
    unsigned voffA[2], voffB[2];
#pragma unroll
    for (int i = 0; i < 2; ++i) { int R, C; stage_rc(tid * 16 + i * 8192, R, C); const int Rb = Epi::PERM ? ((R & ~31) + perm32(R & 31)) : R;
        voffA[i] = (unsigned)(R * K + C) * 2u; voffB[i] = (unsigned)(Rb * K + C) * 2u; }
    const size_t kstep = (size_t)(BK * 2);
    const size_t hstep = (size_t)HALF * K * 2;
    const size_t tstep = 2 * hstep;
    const unsigned ldsw = (unsigned)wid * 1024u;
    const int aoff = lds_byte(wr * 64 + fr, fq * 8), boff = lds_byte(wc * 32 + fr, fq * 8);
#define PG8_SA(b, h) (((b) * 2 + (h)) * HTB)
#define PG8_SB(b, h) ((4 + (b) * 2 + (h)) * HTB)
#define PG8_STAGE(bufoff, gbase, voff) do { _Pragma("unroll") for (int _i = 0; _i < 2; ++_i) \
        __builtin_amdgcn_global_load_lds((const unsigned*)((const char*)(gbase) + (voff)[_i]), (PG8_LAS unsigned*)(lds + (bufoff) + ldsw + _i * 8192), 16, 0, 0); } while (0)
#define PG8_LDA(dst, b, h) do { _Pragma("unroll") for (int m = 0; m < 4; ++m) _Pragma("unroll") for (int k = 0; k < 2; ++k) dst[m][k] = *(const PG8_LAS bf16x8*)(lds + PG8_SA(b, h) + aoff + m * 2048 + k * 1024); } while (0)
#define PG8_LDB(dst, b, h) do { _Pragma("unroll") for (int n = 0; n < 2; ++n) _Pragma("unroll") for (int k = 0; k < 2; ++k) dst[n][k] = *(const PG8_LAS bf16x8*)(lds + PG8_SB(b, h) + boff + n * 2048 + k * 1024); } while (0)
#define PG8_MMA(ai, bj, At, Bt) do { __builtin_amdgcn_s_setprio(1); _Pragma("unroll") for (int m = 0; m < 4; ++m) _Pragma("unroll") for (int n = 0; n < 2; ++n) _Pragma("unroll") for (int k = 0; k < 2; ++k) \
        acc[ai][bj][m][n] = __builtin_amdgcn_mfma_f32_16x16x32_bf16(Bt[n][k], At[m][k], acc[ai][bj][m][n], 0, 0, 0); __builtin_amdgcn_s_setprio(0); } while (0)
#define PG8_WAIT_V(n) asm volatile("s_waitcnt vmcnt(" #n ")" ::: "memory")
#define PG8_WAIT_L(n) asm volatile("s_waitcnt lgkmcnt(" #n ")" ::: "memory")
#define PG8_BAR __builtin_amdgcn_s_barrier()
#define PG8_SCHED __builtin_amdgcn_sched_barrier(0)
    Unit cur, nxt; int ui = 0;
    if (!S.next(0, cur)) return;
    f32x4 acc[2][2][4][2];
#pragma unroll
    for (int a = 0; a < 2; ++a)
#pragma unroll
        for (int b = 0; b < 2; ++b)
#pragma unroll
            for (int m = 0; m < 4; ++m)
#pragma unroll
                for (int n = 0; n < 2; ++n) acc[a][b][m][n] = (f32x4){0.f, 0.f, 0.f, 0.f};
    bf16x8 At[4][2], B0[2][2], B1[2][2];
    const char* cA = (const char*)g.A + (size_t)cur.pm * tstep; const char* cB = (const char*)g.Bt + (size_t)cur.pn * tstep;
    S.a_ready(cur);
    if constexpr (SP2) {
        PG8_STAGE(PG8_SB(0, 0), cB, voffB); PG8_STAGE(PG8_SB(0, 1), cB + hstep, voffB); PG8_STAGE(PG8_SA(0, 0), cA, voffA); PG8_STAGE(PG8_SA(0, 1), cA + hstep, voffA);
        if (wr == 1) PG8_BAR;
        PG8_WAIT_V(2); PG8_BAR;
        PG8_STAGE(PG8_SB(1, 0), cB + kstep, voffB); PG8_STAGE(PG8_SA(1, 0), cA + kstep, voffA); PG8_STAGE(PG8_SB(1, 1), cB + hstep + kstep, voffB);
        PG8_WAIT_V(6); PG8_BAR;
    } else {
        PG8_STAGE(PG8_SB(0, 0), cB, voffB); PG8_STAGE(PG8_SA(0, 0), cA, voffA); PG8_STAGE(PG8_SB(0, 1), cB + hstep, voffB); PG8_STAGE(PG8_SA(0, 1), cA + hstep, voffA);
        if (wr == 1) PG8_BAR;
        PG8_WAIT_V(4); PG8_BAR;
        PG8_STAGE(PG8_SB(1, 0), cB + kstep, voffB); PG8_STAGE(PG8_SA(1, 0), cA + kstep, voffA); PG8_STAGE(PG8_SB(1, 1), cB + hstep + kstep, voffB);
        PG8_WAIT_V(6); PG8_BAR;
    }
    for (;;) {
        const bool has_next = S.next(ui + 1, nxt);
        const char* nA = has_next ? (const char*)g.A + (size_t)nxt.pm * tstep : cA; const char* nB = has_next ? (const char*)g.Bt + (size_t)nxt.pn * tstep : cB;
        for (int t = 0; t < nt; t += 2) {
            const bool last = (t == nt - 2);
            const char* a1 = cA + (size_t)(t + 1) * kstep;
            const char* a2 = last ? nA : cA + (size_t)(t + 2) * kstep; const char* b2 = last ? nB : cB + (size_t)(t + 2) * kstep;
            const char* a3 = a2 + kstep; const char* b3 = b2 + kstep;
            if (last && has_next) S.a_ready(nxt);
            if constexpr (SP2) {
            PG8_LDB(B0, 0, 0); PG8_LDB(B1, 0, 1); PG8_SCHED; PG8_LDA(At, 0, 0); PG8_STAGE(PG8_SA(1, 1), a1 + hstep, voffA);
            PG8_WAIT_V(8); PG8_WAIT_L(0); PG8_BAR; PG8_MMA(0, 0, At, B0); PG8_MMA(0, 1, At, B1); PG8_BAR; PG8_SCHED;
            PG8_LDA(At, 0, 1); PG8_STAGE(PG8_SB(0, 0), b2, voffB); PG8_STAGE(PG8_SB(0, 1), b2 + hstep, voffB); PG8_STAGE(PG8_SA(0, 0), a2, voffA);
            PG8_WAIT_V(8); PG8_WAIT_L(0); PG8_BAR; PG8_MMA(1, 0, At, B0); PG8_MMA(1, 1, At, B1); PG8_BAR; PG8_SCHED;
            PG8_LDB(B0, 1, 0); PG8_LDB(B1, 1, 1); PG8_SCHED; PG8_LDA(At, 1, 0); PG8_STAGE(PG8_SA(0, 1), a2 + hstep, voffA);
            PG8_WAIT_V(8); PG8_WAIT_L(0); PG8_BAR; PG8_MMA(0, 0, At, B0); PG8_MMA(0, 1, At, B1); PG8_BAR; PG8_SCHED;
            PG8_LDA(At, 1, 1); PG8_STAGE(PG8_SB(1, 0), b3, voffB); PG8_STAGE(PG8_SB(1, 1), b3 + hstep, voffB); PG8_STAGE(PG8_SA(1, 0), a3, voffA);
            PG8_WAIT_V(8); PG8_WAIT_L(0); PG8_BAR; PG8_MMA(1, 0, At, B0); PG8_MMA(1, 1, At, B1); PG8_BAR; PG8_SCHED;
            } else {
            PG8_LDB(B0, 0, 0); PG8_SCHED; PG8_LDA(At, 0, 0); PG8_STAGE(PG8_SA(1, 1), a1 + hstep, voffA);
            PG8_WAIT_L(8); PG8_BAR; PG8_WAIT_L(0); PG8_MMA(0, 0, At, B0); PG8_BAR; PG8_SCHED;
            PG8_LDB(B1, 0, 1); PG8_STAGE(PG8_SB(0, 0), b2, voffB);
            PG8_BAR; PG8_WAIT_L(0); PG8_MMA(0, 1, At, B1); PG8_BAR;
            PG8_LDA(At, 0, 1); PG8_STAGE(PG8_SA(0, 0), a2, voffA);
            PG8_BAR; PG8_WAIT_L(0); PG8_MMA(1, 0, At, B0); PG8_BAR; PG8_SCHED;
            PG8_STAGE(PG8_SB(0, 1), b2 + hstep, voffB);
            PG8_WAIT_V(6); PG8_BAR; PG8_MMA(1, 1, At, B1); PG8_BAR;
            PG8_LDB(B0, 1, 0); PG8_SCHED; PG8_LDA(At, 1, 0); PG8_STAGE(PG8_SA(0, 1), a2 + hstep, voffA);
            PG8_WAIT_L(8); PG8_BAR; PG8_WAIT_L(0); PG8_MMA(0, 0, At, B0); PG8_BAR; PG8_SCHED;
            PG8_LDB(B1, 1, 1); PG8_STAGE(PG8_SB(1, 0), b3, voffB);
            PG8_BAR; PG8_WAIT_L(0); PG8_MMA(0, 1, At, B1); PG8_BAR;
            PG8_LDA(At, 1, 1); PG8_STAGE(PG8_SA(1, 0), a3, voffA);
            PG8_BAR; PG8_WAIT_L(0); PG8_MMA(1, 0, At, B0); PG8_BAR; PG8_SCHED;
            PG8_STAGE(PG8_SB(1, 1), b3 + hstep, voffB);
            PG8_WAIT_V(6); PG8_BAR; PG8_MMA(1, 1, At, B1); PG8_BAR;
            }
        }
        if constexpr (ALIGN_EPI) { if (wr == 0) PG8_BAR; }
        if constexpr (!Epi::AFTER_DRAIN) { E(acc, cur, wr, wc, fr, fq); S.done(cur); }
        if (!has_next) break;
#pragma unroll
        for (int a = 0; a < 2; ++a)
#pragma unroll
            for (int b = 0; b < 2; ++b)
#pragma unroll
                for (int m = 0; m < 4; ++m)
#pragma unroll
                    for (int n = 0; n < 2; ++n) acc[a][b][m][n] = (f32x4){0.f, 0.f, 0.f, 0.f};
        cur = nxt; cA = nA; cB = nB; ++ui;
        if constexpr (ALIGN_EPI) { if (wr == 1) PG8_BAR; }
    }
    PG8_WAIT_V(0);
    if constexpr (!ALIGN_EPI) { if (wr == 0) PG8_BAR; }
    PG8_BAR;
    if constexpr (Epi::AFTER_DRAIN) { E.fused(acc, cur, wr, wc, fr, fq, lds, wid, lane); S.done(cur); }
#undef PG8_SA
#undef PG8_SB
#undef PG8_STAGE
#undef PG8_LDA
#undef PG8_LDB
#undef PG8_MMA
#undef PG8_WAIT_V
#undef PG8_WAIT_L
#undef PG8_BAR
#undef PG8_SCHED
}
}
#include <hip/hip_cooperative_groups.h>
namespace cg = cooperative_groups;
#define LAS __attribute__((address_space(3)))
typedef unsigned short bf16;
typedef float f32x4 __attribute__((ext_vector_type(4)));
typedef float f32x2 __attribute__((ext_vector_type(2)));
typedef float f32x16 __attribute__((ext_vector_type(16)));
typedef short bf16x8 __attribute__((ext_vector_type(8)));
typedef short s16x4 __attribute__((ext_vector_type(4)));
typedef unsigned u32x4 __attribute__((ext_vector_type(4)));
typedef unsigned u32x2 __attribute__((ext_vector_type(2)));
typedef __bf16 bf16x2_t __attribute__((ext_vector_type(2)));

constexpr int BATCH = 2, T = 16384, D = 1024, M = BATCH * T, DEPTH = 2;
constexpr int NPROJ = 4352, NSRC = 4232;
constexpr int LDA = 1280, LDV = 512, LDB = 2560;
constexpr float LN_EPS = 1e-5f, GN_EPS = 64e-5f;
constexpr float DN_ALPHA = 1.41421356237f;
constexpr float C2 = 0.125f * 1.4426950408889634f;
constexpr float L2E = 1.4426950408889634f;
constexpr size_t MiB = 1u << 20;
constexpr size_t WS_CTL = 0, CTL_ZERO_BYTES = 1 * MiB;
constexpr size_t WS_WIN = 2 * MiB, WS_WOUT = 20 * MiB, WS_CUM = 24 * MiB, WS_SCS = 25 * MiB, WS_SCN = 30 * MiB;
constexpr size_t WS_XN = WS_SCN, WS_YM = WS_SCN;
constexpr size_t WS_LORA = 29 * MiB;
constexpr size_t WS_PA = 190 * MiB, WS_YA = WS_PA, WS_PV = 270 * MiB, WS_PB = 302 * MiB, WS_VS = 462 * MiB, WS_FS = 494 * MiB, WS_END = 502 * MiB;
constexpr int CW_QUEUE = 64;
constexpr int CW_KMAX = 1024;
constexpr int CW_MOD = 16384;
constexpr int LDS_BYTES = 147456;
#ifndef PROBE_REP
#define PROBE_REP 0
#endif

__device__ __forceinline__ unsigned f2bf(float f) { unsigned u = __builtin_bit_cast(unsigned, f); return (u + 0x7fffu + ((u >> 16) & 1u)) >> 16; }
__device__ __forceinline__ unsigned pk2(float lo, float hi) { return f2bf(lo) | (f2bf(hi) << 16); }
__device__ __forceinline__ float bf2f(unsigned short v) { return __uint_as_float(((unsigned)v) << 16); }
__device__ __forceinline__ float bflo(unsigned w) { return __uint_as_float(w << 16); }
__device__ __forceinline__ float bfhi(unsigned w) { return __uint_as_float(w & 0xffff0000u); }
__device__ __forceinline__ unsigned cvtpk(float lo, float hi) { f32x2 v = {lo, hi}; bf16x2_t b = __builtin_convertvector(v, bf16x2_t); return __builtin_bit_cast(unsigned, b); }
__device__ __forceinline__ float wave_sum(float v) {
#pragma unroll
    for (int o = 1; o < 64; o <<= 1) v += __shfl_xor(v, o);
    return v;
}
__device__ __forceinline__ float fast_sigmoid(float x) { return 1.f / (1.f + __expf(-x)); }

struct Args { const float* in[21]; float* out; unsigned char* ws; };

struct EpiProj {
    static constexpr bool PERM = true, AFTER_DRAIN = false;
    bf16 *PA, *PVb, *PB;
    __device__ __forceinline__ void operator()(const pg8::f32x4 (&acc)[2][2][4][2], const pg8::Unit& u, int wr, int wc, int fr, int fq) const {
        const int row0 = u.pm * 256 + wr * 64 + fr; const int pn = u.pn;
        bf16* base; int ldc, colt; float sc = 1.f; bool act = false;
        if (pn < 4) { base = PA; ldc = LDA; colt = pn * 256; }
        else if (pn < 6) { base = PVb; ldc = LDV; colt = (pn - 4) * 256; }
        else if (pn == 6) { base = PA; ldc = LDA; colt = 1024; }
        else { base = PB; ldc = LDB; colt = (pn - 7) * 256; if (pn < 9) sc = C2; if (pn >= 13) act = true; }
        const int col0 = colt + wc * 32 + 8 * fq;
#pragma unroll
        for (int ai = 0; ai < 2; ++ai)
#pragma unroll
            for (int m = 0; m < 4; ++m) { bf16* rowp = base + (size_t)(row0 + ai * 128 + m * 16) * ldc + col0;
#pragma unroll
                for (int bj = 0; bj < 2; ++bj) { pg8::f32x4 v0 = acc[ai][bj][m][0], v1 = acc[ai][bj][m][1];
                    if (act) {
#pragma unroll
                        for (int e = 0; e < 4; ++e) { v0[e] = v0[e] * fast_sigmoid(v0[e]); v1[e] = v1[e] * fast_sigmoid(v1[e]); } }
                    v0 = v0 * sc; v1 = v1 * sc; u32x4 w; w.x = cvtpk(v0[0], v0[1]); w.y = cvtpk(v0[2], v0[3]); w.z = cvtpk(v1[0], v1[1]); w.w = cvtpk(v1[2], v1[3]);
                    *(u32x4*)(rowp + bj * 128) = w; } }
    }
};
struct EpiOut {
    static constexpr bool PERM = false, AFTER_DRAIN = false;
    float* hz; const float* modl;
    __device__ __forceinline__ void operator()(const pg8::f32x4 (&acc)[2][2][4][2], const pg8::Unit& u, int wr, int wc, int fr, int fq) const {
        const int col0 = u.pn * 256 + wc * 32 + 4 * fq; const int b = (u.pm * 256) >= T ? 1 : 0; const float* gate = modl + b * 3072 + 2048;
#pragma unroll
        for (int bj = 0; bj < 2; ++bj)
#pragma unroll
            for (int n = 0; n < 2; ++n) { const int c = col0 + bj * 128 + n * 16; const f32x4 g = *(const f32x4*)(gate + c) + 1.0f;
#pragma unroll
                for (int ai = 0; ai < 2; ++ai)
#pragma unroll
                    for (int m = 0; m < 4; ++m) { const int r = u.pm * 256 + ai * 128 + wr * 64 + m * 16 + fr; float* p = hz + (size_t)r * D + c;
                        const f32x4 hx = *(const f32x4*)p; f32x4 a; a[0] = acc[ai][bj][m][n][0]; a[1] = acc[ai][bj][m][n][1]; a[2] = acc[ai][bj][m][n][2]; a[3] = acc[ai][bj][m][n][3];
                        *(f32x4*)p = hx * DN_ALPHA + g * a; } }
    }
};

__device__ __forceinline__ int win_map(int n) { if (n < 1664) return n; if (n < 1672) return 3200 + n - 1664; if (n < 1792) return -1; if (n < 3328) return n - 128; return n - 120; }
template <bool MAP> __device__ __forceinline__ void transpose_item(const float* W, int Nsrc, int Ndst, bf16* WT, LAS float* scr, int item, int lane) {
    const int nblk = Ndst / 32, kb = item / nblk, nb = item % nblk, k0 = 64 * kb, n0 = 32 * nb;
    const int src = MAP ? win_map(n0 + (lane & 31)) : n0 + (lane & 31);
#pragma unroll 8
    for (int i = 0; i < 32; ++i) { const int kk = 2 * i + (lane >> 5); scr[kk * 33 + (lane & 31)] = src >= 0 ? W[(size_t)(k0 + kk) * Nsrc + src] : 0.f; }
    asm volatile("s_waitcnt lgkmcnt(0)" ::: "memory");
    const int c = lane & 7;
#pragma unroll
    for (int j = 0; j < 4; ++j) { const int n = (lane >> 3) + 8 * j; const LAS float* s = scr + (8 * c) * 33 + n;
        u32x4 o; o.x = pk2(s[0 * 33], s[1 * 33]); o.y = pk2(s[2 * 33], s[3 * 33]); o.z = pk2(s[4 * 33], s[5 * 33]); o.w = pk2(s[6 * 33], s[7 * 33]);
        *(u32x4*)(WT + (size_t)(n0 + n) * 1024 + k0 + 8 * c) = o; }
    asm volatile("s_waitcnt lgkmcnt(0)" ::: "memory");
}
__device__ __forceinline__ void p0a(const Args& a, LAS unsigned char* lds, int tid, int lane, int wave, int G) {
    LAS float* scr = (LAS float*)(lds + wave * 16384);
    const int gw = blockIdx.x * 8 + wave, NGW = G * 8;
    constexpr int I_IN = 16 * (NPROJ / 32), I_OUT = 16 * 32;
    for (int it = gw; it < 2 * (I_IN + I_OUT); it += NGW) {
        int r = it; const int l = r / (I_IN + I_OUT); r -= l * (I_IN + I_OUT);
        if (r < I_IN) transpose_item<true>(a.in[6] + (size_t)l * 1024 * NSRC, NSRC, NPROJ, (bf16*)(a.ws + WS_WIN) + (size_t)l * NPROJ * 1024, scr, r, lane);
        else transpose_item<false>(a.in[18] + (size_t)l * 1024 * 1024, 1024, 1024, (bf16*)(a.ws + WS_WOUT) + (size_t)l * 1024 * 1024, scr, r - I_IN, lane);
    }
    { bf16* LT = (bf16*)(a.ws + WS_LORA);
      for (int w = blockIdx.x * 512 + tid; w < 2 * 2 * 512 * 64; w += G * 512) { const int k = w & 63, n = (w >> 6) & 511, which = (w >> 15) & 1, l = w >> 16;
          const float* src = (which ? a.in[11] : a.in[9]) + (size_t)l * 64 * 512; LT[w] = (bf16)f2bf(src[k * 512 + n]); } }
    float* mod = (float*)(a.ws + WS_CTL) + CW_MOD;
    const float* cvec = a.in[1];
    for (int w = blockIdx.x * 512 + tid; w < 2 * 16 * 3072; w += G * 512) {
        const int j = w % 3072, sl = (w / 3072) % 16, l = w / (3072 * 16);
        const float* wa = a.in[4] + (size_t)l * 1024 * 3072 + (size_t)(sl * 64) * 3072 + j;
        float s0 = 0.f, s1 = 0.f;
#pragma unroll 8
        for (int i = 0; i < 64; ++i) { const float wv = wa[(size_t)i * 3072]; s0 += cvec[sl * 64 + i] * wv; s1 += cvec[1024 + sl * 64 + i] * wv; }
        if (sl == 0) { const float bb = a.in[5][l * 3072 + j]; s0 += bb; s1 += bb; }
        atomicAdd(mod + (l * 2 + 0) * 3072 + j, s0); atomicAdd(mod + (l * 2 + 1) * 3072 + j, s1);
    }
}
__device__ __forceinline__ void ln_rows(const float* src, const float* g, const float* bb, float* dst, bf16* xn, const float* modn, int lane, int wave, int G) {
    const int gw = blockIdx.x * 8 + wave, NGW = G * 8;
    f32x4 gv[4], bv[4];
#pragma unroll
    for (int j = 0; j < 4; ++j) { gv[j] = ((const f32x4*)g)[lane + 64 * j]; bv[j] = ((const f32x4*)bb)[lane + 64 * j]; }
    for (int m = gw; m < M; m += NGW) {
        const f32x4* xr = (const f32x4*)(src + (size_t)m * D) + lane;
        f32x4 v[4]; float s = 0.f;
#pragma unroll
        for (int j = 0; j < 4; ++j) { v[j] = xr[64 * j]; s += (v[j].x + v[j].y) + (v[j].z + v[j].w); }
        const float mean = wave_sum(s) * (1.f / D); float s2 = 0.f;
#pragma unroll
        for (int j = 0; j < 4; ++j) { v[j] = v[j] - mean; s2 += (v[j].x * v[j].x + v[j].y * v[j].y) + (v[j].z * v[j].z + v[j].w * v[j].w); }
        const float rstd = 1.f / sqrtf(wave_sum(s2) * (1.f / D) + LN_EPS);
        f32x4* o = (f32x4*)(dst + (size_t)m * D) + lane;
        const int b = m >= T ? 1 : 0;
#pragma unroll
        for (int j = 0; j < 4; ++j) { const f32x4 hv = v[j] * rstd * gv[j] + bv[j]; o[64 * j] = hv;
            if (modn) { const f32x4 sh = ((const f32x4*)(modn + b * 3072))[lane + 64 * j], sc = ((const f32x4*)(modn + b * 3072 + 1024))[lane + 64 * j];
                const f32x4 y = hv * (sc + 1.0f) + sh; u32x2 w; w.x = pk2(y.x, y.y); w.y = pk2(y.z, y.w);
                *((u32x2*)(xn + (size_t)m * D) + lane + 64 * j) = w; } }
    }
}
__device__ __forceinline__ int crow(int r, int hi) { return (r & 3) + 8 * (r >> 2) + 4 * hi; }
__device__ __forceinline__ float tanh_fast(float x) { const float e = __expf(2.f * x); return 1.f - 2.f / (e + 1.f); }
__device__ __forceinline__ void cum_kmax(const Args& a, LAS unsigned char* lds, int l, int bh, int tid, int lane, int wave) {
    const int b = bh >> 3, h = bh & 7;
    const bf16* PA = (const bf16*)(a.ws + WS_PA); const bf16* PB = (const bf16*)(a.ws + WS_PB);
    float* cum = (float*)(a.ws + WS_CUM) + (size_t)bh * T;
    const float bf = a.in[17][l * 8 + h];
    LAS float* red = (LAS float*)lds;
    const int t0 = tid * 32;
    float s = 0.f, kmx = 0.f;
#pragma unroll 1
    for (int i = 0; i < 32; ++i) { const size_t m = (size_t)b * T + t0 + i;
        const float z = bf2f(PA[m * LDA + 1152 + h]) + bf;
        const float lf = fminf(z, 0.f) - log1pf(__expf(-fabsf(z)));
        s += lf; cum[t0 + i] = s;
        const u32x4* kr = (const u32x4*)(PB + m * LDB + 512 + h * 64); float q = 0.f;
#pragma unroll
        for (int c = 0; c < 8; ++c) { const u32x4 w = kr[c];
            q += bflo(w.x) * bflo(w.x) + bfhi(w.x) * bfhi(w.x) + bflo(w.y) * bflo(w.y) + bfhi(w.y) * bfhi(w.y) + bflo(w.z) * bflo(w.z) + bfhi(w.z) * bfhi(w.z) + bflo(w.w) * bflo(w.w) + bfhi(w.w) * bfhi(w.w); }
        kmx = fmaxf(kmx, q); }
    red[tid] = s;
#pragma unroll
    for (int o = 1; o < 64; o <<= 1) kmx = fmaxf(kmx, __shfl_xor(kmx, o));
    if (lane == 0) red[512 + wave] = kmx;
    __syncthreads();
    if (tid == 0) { float run = 0.f; for (int i = 0; i < 512; ++i) { const float v = red[i]; red[i] = run; run += v; }
        float k = 0.f; for (int i = 0; i < 8; ++i) k = fmaxf(k, red[512 + i]);
        ((float*)(a.ws + WS_CTL))[CW_KMAX + 16 * l + bh] = sqrtf(k); }
    __syncthreads();
    const float off = red[tid];
#pragma unroll 1
    for (int i = 0; i < 32; ++i) cum[t0 + i] += off;
    __syncthreads();
}
__device__ __forceinline__ void prep_phase(const Args& a, LAS unsigned char* lds, int l, int tid, int lane, int wave, int G) {
    const bf16* PA = (const bf16*)(a.ws + WS_PA); const bf16* PV = (const bf16*)(a.ws + WS_PV);
    bf16* SCN = (bf16*)(a.ws + WS_SCN); float* SCS = (float*)(a.ws + WS_SCS); bf16* VS = (bf16*)(a.ws + WS_VS);
    LAS unsigned char* lowL = lds;
    LAS bf16* CL = (LAS bf16*)(lds + 16384);
    const int c = tid, h = wave, r32 = lane & 31, hi = lane >> 5;
    const bf16* LT = (const bf16*)(a.ws + WS_LORA) + (size_t)l * 2 * 512 * 64;
    const float* mix = a.in[7] + l * 1664;
    const float mix_r = mix[c], mix_k = mix[512 + c], mix_v = mix[1024 + c];
    const int ftok = tid >> 3, fi0 = (tid & 7) * 16;
    f32x4 mlow[4];
#pragma unroll
    for (int q = 0; q < 4; ++q) mlow[q] = *(const f32x4*)(mix + 1536 + fi0 + 4 * q);
    const float w0c = a.in[8][l * 512 + c], a0c = a.in[10][l * 512 + c], kkc = a.in[12][l * 512 + c], kac = a.in[13][l * 512 + c], rkc = a.in[14][l * 512 + c];
    unsigned* pq = (unsigned*)(a.ws + WS_CTL) + CW_QUEUE + 1024 + 64 * l;
    volatile LAS unsigned* ptask = (volatile LAS unsigned*)(lds + 140000);
    for (;;) {
        __syncthreads();
        if (tid == 0) ptask[0] = atomicAdd(pq, 1u);
        __syncthreads();
        const unsigned ptk = ptask[0];
        if (ptk >= 16u + (unsigned)(M / 64)) break;
        if (ptk < 16u) { cum_kmax(a, lds + 135168, l, (int)ptk, tid, lane, wave); continue; }
        const int chunk = (int)ptk - 16;
        const int m0 = chunk * 64, b = m0 >= T ? 1 : 0, t0 = m0 - b * T; const int bh = b * 8 + h;
        { const int m = m0 + ftok, t = t0 + ftok;
          const u32x4* cp = (const u32x4*)(PA + (size_t)m * LDA + 1024 + fi0);
          const u32x4 c0 = cp[0], c1 = cp[1]; u32x4 p0 = {0u, 0u, 0u, 0u}, p1 = p0;
          if (t > 0) { const u32x4* pp = (const u32x4*)(PA + (size_t)(m - 1) * LDA + 1024 + fi0); p0 = pp[0]; p1 = pp[1]; }
          float cur[16], prv[16];
          cur[0] = bflo(c0.x); cur[1] = bfhi(c0.x); cur[2] = bflo(c0.y); cur[3] = bfhi(c0.y); cur[4] = bflo(c0.z); cur[5] = bfhi(c0.z); cur[6] = bflo(c0.w); cur[7] = bfhi(c0.w);
          cur[8] = bflo(c1.x); cur[9] = bfhi(c1.x); cur[10] = bflo(c1.y); cur[11] = bfhi(c1.y); cur[12] = bflo(c1.z); cur[13] = bfhi(c1.z); cur[14] = bflo(c1.w); cur[15] = bfhi(c1.w);
          prv[0] = bflo(p0.x); prv[1] = bfhi(p0.x); prv[2] = bflo(p0.y); prv[3] = bfhi(p0.y); prv[4] = bflo(p0.z); prv[5] = bfhi(p0.z); prv[6] = bflo(p0.w); prv[7] = bfhi(p0.w);
          prv[8] = bflo(p1.x); prv[9] = bfhi(p1.x); prv[10] = bflo(p1.y); prv[11] = bfhi(p1.y); prv[12] = bflo(p1.z); prv[13] = bfhi(p1.z); prv[14] = bflo(p1.w); prv[15] = bfhi(p1.w);
#pragma unroll
          for (int q = 0; q < 16; ++q) { float val = cur[q] + (prv[q] - cur[q]) * mlow[q >> 2][q & 3]; if (fi0 < 64) val = tanh_fast(val); cur[q] = val; }
          u32x4 o0 = {cvtpk(cur[0], cur[1]), cvtpk(cur[2], cur[3]), cvtpk(cur[4], cur[5]), cvtpk(cur[6], cur[7])};
          u32x4 o1 = {cvtpk(cur[8], cur[9]), cvtpk(cur[10], cur[11]), cvtpk(cur[12], cur[13]), cvtpk(cur[14], cur[15])};
          const int ch = 2 * (tid & 7);
          *(LAS u32x4*)(lowL + ftok * 256 + ((ch ^ (ftok & 7)) << 4)) = o0; *(LAS u32x4*)(lowL + ftok * 256 + (((ch + 1) ^ (ftok & 7)) << 4)) = o1; }
        __syncthreads();
        float pr = 0.f, pk = 0.f, pv = 0.f;
        if (t0 > 0) { pr = bf2f(PA[(size_t)(m0 - 1) * LDA + c]); pk = bf2f(PA[(size_t)(m0 - 1) * LDA + 512 + c]); pv = bf2f(PV[(size_t)(m0 - 1) * LDV + c]); }
#pragma unroll 1
        for (int tr = 0; tr < 2; ++tr) {
            { f32x16 Cw0 = {}, Cw1 = {}, Ca0 = {}, Ca1 = {};
              const int trow = 32 * tr + r32;
              bf16x8 Bw[2][4], Ba[2][4];
#pragma unroll
              for (int tc = 0; tc < 2; ++tc)
#pragma unroll
                for (int sx = 0; sx < 4; ++sx) { const int n = 64 * h + 32 * tc + r32;
                    Bw[tc][sx] = __builtin_bit_cast(bf16x8, *(const u32x4*)(LT + (size_t)n * 64 + 16 * sx + 8 * hi));
                    Ba[tc][sx] = __builtin_bit_cast(bf16x8, *(const u32x4*)(LT + 512 * 64 + (size_t)n * 64 + 16 * sx + 8 * hi)); }
#pragma unroll
              for (int sx = 0; sx < 4; ++sx) {
                  const bf16x8 Aw = *(const LAS bf16x8*)(lowL + trow * 256 + (((2 * sx + hi) ^ (trow & 7)) << 4));
                  const bf16x8 Aa = *(const LAS bf16x8*)(lowL + trow * 256 + (((8 + 2 * sx + hi) ^ (trow & 7)) << 4));
                  Cw0 = __builtin_amdgcn_mfma_f32_32x32x16_bf16(Aw, Bw[0][sx], Cw0, 0, 0, 0); Cw1 = __builtin_amdgcn_mfma_f32_32x32x16_bf16(Aw, Bw[1][sx], Cw1, 0, 0, 0);
                  Ca0 = __builtin_amdgcn_mfma_f32_32x32x16_bf16(Aa, Ba[0][sx], Ca0, 0, 0, 0); Ca1 = __builtin_amdgcn_mfma_f32_32x32x16_bf16(Aa, Ba[1][sx], Ca1, 0, 0, 0); }
#pragma unroll
              for (int r = 0; r < 16; ++r) { LAS bf16* row = CL + crow(r, hi) * 1024 + 64 * h + r32;
                  row[0] = (bf16)f2bf(Cw0[r]); row[32] = (bf16)f2bf(Cw1[r]); row[512] = (bf16)f2bf(Ca0[r]); row[544] = (bf16)f2bf(Ca1[r]); } }
            __syncthreads();
#pragma unroll 1
            for (int g = 0; g < 4; ++g) {
                const int tl0 = g * 8, mg = m0 + 32 * tr + tl0, tg = t0 + 32 * tr + tl0;
                float cr[8], ck[8], cv[8];
#pragma unroll
                for (int tt = 0; tt < 8; ++tt) { cr[tt] = bf2f(PA[(size_t)(mg + tt) * LDA + c]); ck[tt] = bf2f(PA[(size_t)(mg + tt) * LDA + 512 + c]); cv[tt] = bf2f(PV[(size_t)(mg + tt) * LDV + c]); }
                float rr[8], kkr[8], kp[8], vv[8], av[8], omw[8], red[32];
#pragma unroll
                for (int tt = 0; tt < 8; ++tt) {
                    const float prr = tt ? cr[tt - 1] : pr, prk = tt ? ck[tt - 1] : pk, prv = tt ? cv[tt - 1] : pv;
                    const float r = cr[tt] + (prr - cr[tt]) * mix_r, k = ck[tt] + (prk - ck[tt]) * mix_k; vv[tt] = cv[tt] + (prv - cv[tt]) * mix_v;
                    const float wl = w0c + bf2f(CL[(tl0 + tt) * 1024 + c]), al = a0c + bf2f(CL[(tl0 + tt) * 1024 + 512 + c]);
                    const float z = -wl; const float sp = fmaxf(z, 0.f) + __logf(1.f + __expf(-fabsf(z)));
                    const float e = __expf(-sp - 0.5f); omw[tt] = 1.f - __expf(-e);
                    av[tt] = fast_sigmoid(al);
                    kkr[tt] = k * kkc; kp[tt] = k * (1.f + (av[tt] - 1.f) * kac); rr[tt] = r;
                    red[tt] = kkr[tt] * kkr[tt]; red[8 + tt] = kkr[tt] * av[tt] * r; red[16 + tt] = kp[tt] * r; red[24 + tt] = r * kp[tt] * rkc;
                }
                pr = cr[7]; pk = ck[7]; pv = cv[7];
#pragma unroll
                for (int o = 1; o < 64; o <<= 1) {
#pragma unroll
                    for (int i = 0; i < 32; ++i) red[i] += __shfl_xor(red[i], o); }
#pragma unroll
                for (int tt = 0; tt < 8; ++tt) {
                    const float inv = 1.f / fmaxf(sqrtf(red[tt]), 1e-12f);
                    const float kk = kkr[tt] * inv, bbv = kk * av[tt], wr = (1.f - omw[tt]) * rr[tt];
                    bf16* rec = SCN + ((size_t)bh * T + tg + tt) * 320 + lane;
                    rec[0] = (bf16)f2bf(kk); rec[64] = (bf16)f2bf(wr); rec[128] = (bf16)f2bf(omw[tt]); rec[192] = (bf16)f2bf(bbv); rec[256] = (bf16)f2bf(kp[tt]);
                    VS[(size_t)(mg + tt) * 512 + c] = (bf16)f2bf(vv[tt]);
                    if (lane == 0) { f32x4 sc = {red[8 + tt] * inv, red[16 + tt], red[24 + tt], 0.f}; *(f32x4*)(SCS + ((size_t)bh * T + tg + tt) * 4) = sc; }
                }
            }
            __syncthreads();
        }
    }
    __syncthreads();
}

__device__ __forceinline__ float dppf(float x, const int ctrl_sel) {
    unsigned u = __float_as_uint(x), r;
    if (ctrl_sel == 0) r = __builtin_amdgcn_update_dpp(0, u, 0xB1, 0xF, 0xF, true);
    else if (ctrl_sel == 1) r = __builtin_amdgcn_update_dpp(0, u, 0x4E, 0xF, 0xF, true);
    else r = __builtin_amdgcn_update_dpp(0, u, 0x141, 0xF, 0xF, true);
    return __uint_as_float(r);
}
__device__ __forceinline__ float red8(float x) { x += dppf(x, 0); x += dppf(x, 1); x += dppf(x, 2); return x; }
constexpr int SC_CH = 32, SC_STEP = 1024, SC_BUF = SC_CH * SC_STEP, SC_VOFF = 2 * SC_BUF, SC_SOFF = SC_VOFF + 2 * SC_CH * 64 * 4, SC_ROWB = SC_SOFF + 2 * SC_CH * 16;
constexpr int NSEG = 16, SEGLEN = T / NSEG;
typedef float f32x4m __attribute__((ext_vector_type(4)));
template <bool PASSC> __device__ __forceinline__ void scan_task(const Args& a, LAS unsigned char* lds, int bh, int seg, int tid, int lane, int wave) {
    const int b = bh >> 3, h = bh & 7;
    const int t0 = seg * SEGLEN;
    const bf16* SCN = (const bf16*)(a.ws + WS_SCN) + ((size_t)bh * T + t0) * 320;
    const float* SCS = (const float*)(a.ws + WS_SCS) + ((size_t)bh * T + t0) * 4;
    const bf16* VS = (const bf16*)(a.ws + WS_VS) + ((size_t)b * T + t0) * 512 + h * 64;
    float* YA = (float*)(a.ws + WS_YA) + ((size_t)b * T + t0) * 512 + h * 64;
    float* FSb = (float*)(a.ws + WS_FS) + (size_t)bh * NSEG * 128 * 64;
    constexpr int NCH = SEGLEN / SC_CH;
    const int n16 = lane & 15, g = lane >> 4;
    const bool ident = !PASSC && wave >= 4;
    const bool active = PASSC ? (wave < 4) : true;
    const int row = 16 * (wave & 3) + n16;
    f32x4 Sf[4];
#pragma unroll
    for (int i = 0; i < 4; ++i) Sf[i] = (f32x4){0.f, 0.f, 0.f, 0.f};
    __syncthreads();
    if constexpr (PASSC) {
        LAS float* rowb = (LAS float*)(lds + SC_ROWB);
        const int crow_ = tid >> 3, kq = (tid & 7) * 8;
        f32x4 c0 = {0.f, 0.f, 0.f, 0.f}, c1 = c0;
        LAS float* pbuf = (LAS float*)lds;
        f32x4 pr0, pr1;
        if (seg > 0) { const float* Pk = FSb + ((size_t)0 * 128 + 64 + crow_) * 64 + kq; pr0 = *(const f32x4*)Pk; pr1 = *(const f32x4*)(Pk + 4); }
        for (int k = 0; k < seg; ++k) {
            const float* Uk = FSb + ((size_t)k * 128 + crow_) * 64 + kq;
            f32x4 a0 = *(const f32x4*)Uk, a1 = *(const f32x4*)(Uk + 4);
            *(LAS f32x4*)(rowb + crow_ * 64 + kq) = c0; *(LAS f32x4*)(rowb + crow_ * 64 + kq + 4) = c1;
            *(LAS f32x4*)(pbuf + crow_ * 64 + kq) = pr0; *(LAS f32x4*)(pbuf + crow_ * 64 + kq + 4) = pr1;
            __syncthreads();
            if (k + 1 < seg) { const float* Pn = FSb + ((size_t)(k + 1) * 128 + 64 + crow_) * 64 + kq; pr0 = *(const f32x4*)Pn; pr1 = *(const f32x4*)(Pn + 4); }
#pragma unroll 4
            for (int jj = 0; jj < 64; ++jj) { const float sj = rowb[crow_ * 64 + jj]; a0 += *(const LAS f32x4*)(pbuf + jj * 64 + kq) * sj; a1 += *(const LAS f32x4*)(pbuf + jj * 64 + kq + 4) * sj; }
            c0 = a0; c1 = a1;
            __syncthreads();
        }
        *(LAS f32x4*)(rowb + crow_ * 64 + kq) = c0; *(LAS f32x4*)(rowb + crow_ * 64 + kq + 4) = c1;
        __syncthreads();
        if (active) {
#pragma unroll
            for (int q = 0; q < 2; ++q) { Sf[2 * q] = *(const LAS f32x4*)(rowb + row * 64 + 32 * q + 8 * g); Sf[2 * q + 1] = *(const LAS f32x4*)(rowb + row * 64 + 32 * q + 8 * g + 4); }
        }
    } else if (ident) {
#pragma unroll
        for (int i = 0; i < 4; ++i)
#pragma unroll
            for (int e = 0; e < 4; ++e) Sf[i][e] = (32 * (i >> 1) + 8 * g + 4 * (i & 1) + e == row) ? 1.f : 0.f;
    }
    u32x4 mreg[3]; u32x4 vreg = {0u, 0u, 0u, 0u}; f32x4 sreg;
    auto gload = [&](int c) {
        const u32x4* src = (const u32x4*)(SCN + (size_t)c * SC_CH * 320);
#pragma unroll
        for (int i = 0; i < 3; ++i) { const int p = tid + 512 * i; if (p < 1280) mreg[i] = src[p]; }
        if (tid < 256) vreg = *(const u32x4*)(VS + (size_t)(c * SC_CH + (tid >> 3)) * 512 + (tid & 7) * 8);
        else if (tid < 288) sreg = *(const f32x4*)(SCS + (size_t)(c * SC_CH + (tid - 256)) * 4);
    };
    auto lwrite = [&](int c) {
        LAS unsigned char* bp = lds + (c & 1) * SC_BUF;
#pragma unroll
        for (int i = 0; i < 3; ++i) { const int p = tid + 512 * i;
            if (p < 1280) { const int st = p / 40, q = p - st * 40, arr = q >> 3, e8 = q & 7; const u32x4 w = mreg[i];
                LAS unsigned char* d = bp + st * SC_STEP;
                if (arr < 2) { *(LAS u32x4*)(d + 768 + arr * 128 + e8 * 16) = w; }
                else { f32x4 lo, hi;
                    lo[0] = bflo(w.x); lo[1] = bfhi(w.x); lo[2] = bflo(w.y); lo[3] = bfhi(w.y); hi[0] = bflo(w.z); hi[1] = bfhi(w.z); hi[2] = bflo(w.w); hi[3] = bfhi(w.w);
                    if (arr == 2) { lo = 1.0f - lo; hi = 1.0f - hi; }
                    LAS f32x4* df = (LAS f32x4*)(d + (arr - 2) * 256 + e8 * 32); df[0] = lo; df[1] = hi; } } }
        if (tid < 256) { const u32x4 w = vreg; f32x4 lo, hi;
            lo[0] = bflo(w.x); lo[1] = bfhi(w.x); lo[2] = bflo(w.y); lo[3] = bfhi(w.y); hi[0] = bflo(w.z); hi[1] = bfhi(w.z); hi[2] = bflo(w.w); hi[3] = bfhi(w.w);
            LAS f32x4* d = (LAS f32x4*)(lds + SC_VOFF + (c & 1) * (SC_CH * 64 * 4) + tid * 32); d[0] = lo; d[1] = hi; }
        else if (tid < 288) { *(LAS f32x4*)(lds + SC_SOFF + (c & 1) * (SC_CH * 16) + (tid - 256) * 16) = sreg; }
    };
    gload(0); lwrite(0); gload(1);
    __syncthreads();
    LAS float* ybuf = (LAS float*)(lds + SC_ROWB + 16384);
    auto yflush = [&](int c) { const f32x4 yv = *(const LAS f32x4*)(ybuf + (c & 1) * (SC_CH * 64) + tid * 4);
        *(f32x4*)(YA + (size_t)(c * SC_CH + (tid >> 4)) * 512 + (tid & 15) * 4) = yv; };
    for (int c = 0; c < NCH; ++c) {
        if constexpr (PASSC) { if (c > 0) yflush(c - 1); }
        if (c + 1 < NCH) lwrite(c + 1);
        if (c + 2 < NCH) gload(c + 2);
        if (active) {
            const LAS unsigned char* bp = lds + (c & 1) * SC_BUF;
            const LAS float* vb = (const LAS float*)(lds + SC_VOFF + (c & 1) * (SC_CH * 64 * 4)) + row;
            const LAS float* sb = (const LAS float*)(lds + SC_SOFF + (c & 1) * (SC_CH * 16));
#define SC_OFF(i) (((i) >> 1) * 128 + g * 32 + ((i) & 1) * 16)
#define SC_DECL(X) bf16x8 X##a0, X##a1, X##r0, X##r1; float X##v; f32x2 X##s
#define SC_LD(X, sidx) do { const LAS unsigned char* p_ = bp + (sidx) * SC_STEP; \
                X##a0 = *(const LAS bf16x8*)(p_ + 768 + g * 16); X##a1 = *(const LAS bf16x8*)(p_ + 768 + 64 + g * 16); \
                if constexpr (PASSC) { X##r0 = *(const LAS bf16x8*)(p_ + 896 + g * 16); X##r1 = *(const LAS bf16x8*)(p_ + 896 + 64 + g * 16); X##s = *(const LAS f32x2*)(sb + (sidx) * 4); } \
                X##v = ident ? 0.f : vb[(sidx) * 64]; } while (0)
#define SC_STEPM(X, Y, sidx, ldnext) do { const LAS unsigned char* p_ = bp + (sidx) * SC_STEP; \
                const f32x4 w0_ = *(const LAS f32x4*)(p_ + SC_OFF(0)), w1_ = *(const LAS f32x4*)(p_ + SC_OFF(1)), w2_ = *(const LAS f32x4*)(p_ + SC_OFF(2)), w3_ = *(const LAS f32x4*)(p_ + SC_OFF(3)); \
                const f32x4 k0_ = *(const LAS f32x4*)(p_ + 512 + SC_OFF(0)), k1_ = *(const LAS f32x4*)(p_ + 512 + SC_OFF(1)), k2_ = *(const LAS f32x4*)(p_ + 512 + SC_OFF(2)), k3_ = *(const LAS f32x4*)(p_ + 512 + SC_OFF(3)); \
                const f32x4 b0_ = *(const LAS f32x4*)(p_ + 256 + SC_OFF(0)), b1_ = *(const LAS f32x4*)(p_ + 256 + SC_OFF(1)), b2_ = *(const LAS f32x4*)(p_ + 256 + SC_OFF(2)), b3_ = *(const LAS f32x4*)(p_ + 256 + SC_OFF(3)); \
                if (ldnext) SC_LD(Y, (sidx) + 1); \
                u32x4 sb0, sb1; \
                sb0.x = cvtpk(Sf[0][0], Sf[0][1]); sb0.y = cvtpk(Sf[0][2], Sf[0][3]); sb0.z = cvtpk(Sf[1][0], Sf[1][1]); sb0.w = cvtpk(Sf[1][2], Sf[1][3]); \
                sb1.x = cvtpk(Sf[2][0], Sf[2][1]); sb1.y = cvtpk(Sf[2][2], Sf[2][3]); sb1.z = cvtpk(Sf[3][0], Sf[3][1]); sb1.w = cvtpk(Sf[3][2], Sf[3][3]); \
                const bf16x8 B0 = __builtin_bit_cast(bf16x8, sb0), B1 = __builtin_bit_cast(bf16x8, sb1); \
                f32x4m acc = {0.f, 0.f, 0.f, 0.f}; \
                acc = __builtin_amdgcn_mfma_f32_16x16x32_bf16(X##a0, B0, acc, 0, 0, 0); \
                acc = __builtin_amdgcn_mfma_f32_16x16x32_bf16(X##a1, B1, acc, 0, 0, 0); \
                float ys = 0.f; \
                if constexpr (PASSC) { f32x4m accy = {0.f, 0.f, 0.f, 0.f}; \
                    accy = __builtin_amdgcn_mfma_f32_16x16x32_bf16(X##r0, B0, accy, 0, 0, 0); \
                    accy = __builtin_amdgcn_mfma_f32_16x16x32_bf16(X##r1, B1, accy, 0, 0, 0); ys = accy[0]; } \
                const f32x4 sp0 = Sf[0] * w0_ + k0_ * X##v, sp1 = Sf[1] * w1_ + k1_ * X##v, sp2 = Sf[2] * w2_ + k2_ * X##v, sp3 = Sf[3] * w3_ + k3_ * X##v; \
                const float sa = acc[0]; \
                Sf[0] = sp0 - b0_ * sa; Sf[1] = sp1 - b1_ * sa; Sf[2] = sp2 - b2_ * sa; Sf[3] = sp3 - b3_ * sa; \
                if constexpr (PASSC) { const float y = ys - sa * X##s.x + X##v * X##s.y; ybuf[(c & 1) * (SC_CH * 64) + (sidx) * 64 + row] = y; } } while (0)
            SC_DECL(oA); SC_DECL(oB);
            SC_LD(oA, 0);
#pragma unroll 1
            for (int s = 0; s < SC_CH; s += 2) {
                SC_STEPM(oA, oB, s, true);
                __builtin_amdgcn_sched_barrier(0);
                SC_STEPM(oB, oA, s + 1, (s + 2 < SC_CH));
                __builtin_amdgcn_sched_barrier(0);
            }
#undef SC_OFF
#undef SC_DECL
#undef SC_LD
#undef SC_STEPM
        }
        __syncthreads();
    }
    if constexpr (PASSC) yflush(NCH - 1);
    if constexpr (!PASSC) { float* fp = FSb + ((size_t)seg * 128 + (ident ? 64 : 0) + row) * 64 + 8 * g;
#pragma unroll
        for (int q = 0; q < 2; ++q) { *(f32x4*)(fp + 32 * q) = Sf[2 * q]; *(f32x4*)(fp + 32 * q + 4) = Sf[2 * q + 1]; } }
}

typedef short v4i16_t __attribute__((ext_vector_type(4)));
__device__ __forceinline__ s16x4 vtr(const LAS unsigned char* p) { return __builtin_bit_cast(s16x4, __builtin_amdgcn_ds_read_tr16_b64_v4i16((LAS v4i16_t*)p)); }
constexpr int AT_KS = 0, AT_VS = 9216, AT_BIAS = 18432, AT_WSF = 18688, AT_FLAG = 19712, AT_TASK = 140000;
__device__ __forceinline__ void attn_unit(const Args& a, LAS unsigned char* lds, int l, int bh, int qb, int tid, int lane, int wid) {
    const int b = bh >> 3, h = bh & 7, r32 = lane & 31, hi = lane >> 5;
    const int q0 = qb * 256;
    bf16* PB = (bf16*)(a.ws + WS_PB);
    const float* cumh = (const float*)(a.ws + WS_CUM) + (size_t)bh * T;
    const float kmax = ((const float*)(a.ws + WS_CTL))[CW_KMAX + 16 * l + bh];
    const size_t rowbase = (size_t)b * T;
    const bf16* Qp = PB + (rowbase + q0 + wid * 32 + r32) * LDB + h * 64;
    bf16x8 qr[4]; float qs = 0.f;
#pragma unroll
    for (int d0 = 0; d0 < 4; ++d0) { const u32x4 w = *(const u32x4*)(Qp + d0 * 16 + hi * 8); qr[d0] = __builtin_bit_cast(bf16x8, w);
        qs += bflo(w.x) * bflo(w.x) + bfhi(w.x) * bfhi(w.x) + bflo(w.y) * bflo(w.y) + bfhi(w.y) * bfhi(w.y) + bflo(w.z) * bflo(w.z) + bfhi(w.z) * bfhi(w.z) + bflo(w.w) * bflo(w.w) + bfhi(w.w) * bfhi(w.w); }
    qs += __shfl_xor(qs, 32);
    const float qbound = sqrtf(qs) * kmax * 1.01f + 0.01f;
    const float ref = cumh[q0 + 255];
    const int srow = tid >> 3, sch = tid & 7;
    const bf16* Kg = PB + rowbase * LDB + 512 + h * 64 + sch * 8; const bf16* Vg = Kg + 512;
    LAS unsigned char* Ks = lds + AT_KS; LAS unsigned char* Vs = lds + AT_VS; LAS float* biasL = (LAS float*)(lds + AT_BIAS);
    LAS float* wsf = (LAS float*)(lds + AT_WSF) + wid * 32; volatile LAS unsigned* flag = (volatile LAS unsigned*)(lds + AT_FLAG);
    if (tid < 3) flag[tid] = 0u;
    float m = -INFINITY, lsum = 0.f; f32x16 o0 = {}, o1 = {};
    u32x4 kreg, vreg; float breg = 0.f, bnx = 0.f;
    int j = qb * 4 + 3;
    { kreg = *(const u32x4*)(Kg + (size_t)(64 * j + srow) * LDB); vreg = *(const u32x4*)(Vg + (size_t)(64 * j + srow) * LDB);
      if (tid < 64) breg = (ref - cumh[64 * j + tid]) * L2E; bnx = j > 0 ? (ref - cumh[64 * j - 1]) * L2E : 0.f; }
    const int q4 = (lane & 15) >> 2, p4 = lane & 3, blk = (lane >> 4) & 1;
    const int qrow = q0 + wid * 32 + r32;
    int it = 0;
    __syncthreads();
    for (;;) {
        *(LAS u32x4*)(Ks + srow * 144 + sch * 16) = kreg; *(LAS u32x4*)(Vs + srow * 144 + sch * 16) = vreg; if (tid < 64) biasL[tid] = breg;
        const float bnx_cur = bnx;
        __syncthreads();
        if (j > 0) { const int jn = j - 1;
            kreg = *(const u32x4*)(Kg + (size_t)(64 * jn + srow) * LDB); vreg = *(const u32x4*)(Vg + (size_t)(64 * jn + srow) * LDB);
            if (tid < 64) breg = (ref - cumh[64 * jn + tid]) * L2E; bnx = jn > 0 ? (ref - cumh[64 * jn - 1]) * L2E : 0.f; }
        if (64 * j <= q0 + 32 * wid + 31) {
            f32x16 p0 = {}, p1 = {};
#pragma unroll
            for (int d0 = 0; d0 < 4; ++d0) {
                const bf16x8 k0 = *(const LAS bf16x8*)(Ks + r32 * 144 + d0 * 32 + hi * 16);
                const bf16x8 k1 = *(const LAS bf16x8*)(Ks + (32 + r32) * 144 + d0 * 32 + hi * 16);
                p0 = __builtin_amdgcn_mfma_f32_32x32x16_bf16(k0, qr[d0], p0, 0, 0, 0);
                p1 = __builtin_amdgcn_mfma_f32_32x32x16_bf16(k1, qr[d0], p1, 0, 0, 0); }
#pragma unroll
            for (int g = 0; g < 4; ++g) { const f32x4 b0 = *(const LAS f32x4*)(biasL + 8 * g + 4 * hi), b1 = *(const LAS f32x4*)(biasL + 32 + 8 * g + 4 * hi);
#pragma unroll
                for (int e = 0; e < 4; ++e) { p0[4 * g + e] += b0[e]; p1[4 * g + e] += b1[e]; } }
            if (64 * j + 63 > q0 + 32 * wid) {
#pragma unroll
                for (int r = 0; r < 16; ++r) { const int kv = 64 * j + crow(r, hi); if (kv > qrow) p0[r] = -INFINITY; if (kv + 32 > qrow) p1[r] = -INFINITY; } }
            float mx = fmaxf(p0[0], p1[0]);
#pragma unroll
            for (int r = 1; r < 16; ++r) mx = fmaxf(mx, fmaxf(p0[r], p1[r]));
            mx = fmaxf(mx, __shfl_xor(mx, 32));
            const float mnew = fmaxf(m, mx); const float f = __builtin_amdgcn_exp2f(m - mnew); m = mnew;
            float rs = 0.f;
#pragma unroll
            for (int r = 0; r < 16; ++r) { p0[r] = __builtin_amdgcn_exp2f(p0[r] - mnew); p1[r] = __builtin_amdgcn_exp2f(p1[r] - mnew); rs += p0[r] + p1[r]; }
            lsum = lsum * f + rs;
            if (__any(f != 1.f)) {
                if (hi == 0) wsf[r32] = f;
                asm volatile("s_waitcnt lgkmcnt(0)" ::: "memory");
#pragma unroll
                for (int r = 0; r < 16; ++r) { const float fr = wsf[crow(r, hi)]; o0[r] *= fr; o1[r] *= fr; }
            }
            u32x4 pw[4];
            pw[0] = (u32x4){cvtpk(p0[0], p0[1]), cvtpk(p0[2], p0[3]), cvtpk(p0[4], p0[5]), cvtpk(p0[6], p0[7])};
            pw[1] = (u32x4){cvtpk(p0[8], p0[9]), cvtpk(p0[10], p0[11]), cvtpk(p0[12], p0[13]), cvtpk(p0[14], p0[15])};
            pw[2] = (u32x4){cvtpk(p1[0], p1[1]), cvtpk(p1[2], p1[3]), cvtpk(p1[4], p1[5]), cvtpk(p1[6], p1[7])};
            pw[3] = (u32x4){cvtpk(p1[8], p1[9]), cvtpk(p1[10], p1[11]), cvtpk(p1[12], p1[13]), cvtpk(p1[14], p1[15])};
#pragma unroll
            for (int s = 0; s < 4; ++s) { const int kvb = 16 * (s & 1) + 32 * (s >> 1);
                const LAS unsigned char* va = Vs + (kvb + 4 * hi + q4) * 144 + (16 * blk + 4 * p4) * 2;
                const s16x4 l0 = vtr(va), h0 = vtr(va + 8 * 144), l1 = vtr(va + 64), h1 = vtr(va + 8 * 144 + 64);
                const bf16x8 vf0 = {l0[0], l0[1], l0[2], l0[3], h0[0], h0[1], h0[2], h0[3]}, vf1 = {l1[0], l1[1], l1[2], l1[3], h1[0], h1[1], h1[2], h1[3]};
                const bf16x8 pa = __builtin_bit_cast(bf16x8, pw[s]);
                o0 = __builtin_amdgcn_mfma_f32_32x32x16_bf16(pa, vf0, o0, 0, 0, 0);
                o1 = __builtin_amdgcn_mfma_f32_32x32x16_bf16(pa, vf1, o1, 0, 0, 0); }
        }
        if (j == 0) break;
        const bool need = (qbound + bnx_cur > m - 40.f);
        if (tid == 0) flag[(it + 1) % 3] = 0u;
        if (__any(need) && lane == 0) flag[it % 3] = 1u;
        __syncthreads();
        const unsigned cont = flag[it % 3];
        if (!cont) break;
        --j; ++it;
    }
    lsum += __shfl_xor(lsum, 32);
    if (hi == 0) wsf[r32] = 1.f / lsum;
    asm volatile("s_waitcnt lgkmcnt(0)" ::: "memory");
    bf16* Ow = (bf16*)(a.ws + WS_PV) + (rowbase + q0 + wid * 32) * LDV + h * 64 + r32;
#pragma unroll
    for (int r = 0; r < 16; ++r) { const float inv = wsf[crow(r, hi)]; bf16* op = Ow + (size_t)crow(r, hi) * LDV;
        op[0] = (bf16)f2bf(o0[r] * inv); op[32] = (bf16)f2bf(o1[r] * inv); }
    __syncthreads();
}
__device__ __forceinline__ void p3a_phase(const Args& a, LAS unsigned char* lds, int l, int tid, int lane, int wave) {
    unsigned* ctr = (unsigned*)(a.ws + WS_CTL) + CW_QUEUE + 64 * l;
    volatile LAS unsigned* task = (volatile LAS unsigned*)(lds + AT_TASK);
    for (;;) {
        __syncthreads();
        if (tid == 0) task[0] = atomicAdd(ctr, 1u);
        __syncthreads();
        const unsigned tk = task[0];
        if (tk >= 240u + 1024u) break;
        int t2 = tid; asm volatile("" : "+v"(t2)); const int lane2 = t2 & 63;
        if (tk < 240u) { scan_task<false>(a, lds, (int)(tk / 15u), (int)(tk % 15u), t2, lane2, wave); }
        else { const unsigned u = tk - 240u; attn_unit(a, lds, l, (int)(u & 15), 63 - (int)(u >> 4), t2, lane2, wave); }
    }
}
__device__ __forceinline__ void p3b_phase(const Args& a, LAS unsigned char* lds, int l, int tid, int lane, int wave) {
    unsigned* ctr = (unsigned*)(a.ws + WS_CTL) + CW_QUEUE + 512 + 64 * l;
    volatile LAS unsigned* task = (volatile LAS unsigned*)(lds + AT_TASK);
    for (;;) {
        __syncthreads();
        if (tid == 0) task[0] = atomicAdd(ctr, 1u);
        __syncthreads();
        const unsigned tk = task[0];
        if (tk >= 256u) break;
        scan_task<true>(a, lds, (int)(tk >> 4), (int)(tk & 15), tid, lane, wave);
    }
}

__device__ __forceinline__ float red16m(float x) {
    x += __uint_as_float(__builtin_amdgcn_update_dpp(0, __float_as_uint(x), 0xB1, 0xF, 0xF, true));
    x += __uint_as_float(__builtin_amdgcn_update_dpp(0, __float_as_uint(x), 0x4E, 0xF, 0xF, true));
    x += __uint_as_float(__builtin_amdgcn_update_dpp(0, __float_as_uint(x), 0x141, 0xF, 0xF, true));
    x += __uint_as_float(__builtin_amdgcn_update_dpp(0, __float_as_uint(x), 0x140, 0xF, 0xF, true));
    return x;
}
__device__ __forceinline__ void merge_phase(const Args& a, int l, int tid, int lane, int wave, int G) {
    const float* YA = (const float*)(a.ws + WS_YA); const bf16* VS = (const bf16*)(a.ws + WS_VS); const bf16* PB = (const bf16*)(a.ws + WS_PB);
    const bf16* PVo = (const bf16*)(a.ws + WS_PV);
    const float* SCS = (const float*)(a.ws + WS_SCS); bf16* YM = (bf16*)(a.ws + WS_YM);
    const int hd = 4 * (wave & 1) + (lane >> 4), c0 = hd * 64 + 4 * (lane & 15), tsub = wave >> 1;
    const f32x4 gg = *(const f32x4*)(a.in[15] + l * 512 + c0), gb = *(const f32x4*)(a.in[16] + l * 512 + c0);
    constexpr int MT = 4;
    for (int mb = blockIdx.x * (4 * MT); mb < M; mb += G * (4 * MT)) {
        f32x4 ya[MT]; u32x2 vv[MT], g1[MT], g2[MT], yb[MT]; float rkr[MT], mean[MT], var[MT];
#pragma unroll
        for (int u = 0; u < MT; ++u) { const int m = mb + 4 * u + tsub; const int b = m >= T ? 1 : 0, t = m - b * T;
            ya[u] = *(const f32x4*)(YA + (size_t)m * 512 + c0); vv[u] = *(const u32x2*)(VS + (size_t)m * 512 + c0);
            g1[u] = *(const u32x2*)(PB + (size_t)m * LDB + 1536 + c0); g2[u] = *(const u32x2*)(PB + (size_t)m * LDB + 2048 + c0);
            yb[u] = *(const u32x2*)(PVo + (size_t)m * LDV + c0);
            rkr[u] = SCS[((size_t)(b * 8 + hd) * T + t) * 4 + 2]; }
#pragma unroll
        for (int u = 0; u < MT; ++u) mean[u] = red16m((ya[u][0] + ya[u][1]) + (ya[u][2] + ya[u][3])) * (1.f / 64.f);
#pragma unroll
        for (int u = 0; u < MT; ++u) { const f32x4 d = ya[u] - mean[u]; var[u] = red16m((d[0] * d[0] + d[1] * d[1]) + (d[2] * d[2] + d[3] * d[3])) * (1.f / 64.f); }
#pragma unroll
        for (int u = 0; u < MT; ++u) { const int m = mb + 4 * u + tsub; const float rs = rsqrtf(var[u] + GN_EPS);
            f32x4 v4 = {bflo(vv[u].x), bfhi(vv[u].x), bflo(vv[u].y), bfhi(vv[u].y)};
            f32x4 ga = {bflo(g1[u].x), bfhi(g1[u].x), bflo(g1[u].y), bfhi(g1[u].y)}, gbv = {bflo(g2[u].x), bfhi(g2[u].x), bflo(g2[u].y), bfhi(g2[u].y)};
            f32x4 y2 = {bflo(yb[u].x), bfhi(yb[u].x), bflo(yb[u].y), bfhi(yb[u].y)};
            const f32x4 yn = ((ya[u] - mean[u]) * rs * gg + gb + v4 * rkr[u]) * ga; const f32x4 yo = y2 * gbv;
            u32x2 o1 = {pk2(yn[0], yn[1]), pk2(yn[2], yn[3])}, o2 = {pk2(yo[0], yo[1]), pk2(yo[2], yo[3])};
            *(u32x2*)(YM + (size_t)m * D + c0) = o1; *(u32x2*)(YM + (size_t)m * D + 512 + c0) = o2; }
    }
}

#ifndef N_LAUNCH_MODE
#define N_LAUNCH_MODE 1
#endif
template <int MASK, bool COOP> __device__ __forceinline__ void run_phases(const Args& a, LAS unsigned char* lds, int l0, int l1) {
    const int G = gridDim.x;
#define LAUNDER() int tid = threadIdx.x; asm volatile("" : "+v"(tid)); const int lane = tid & 63, wave = __builtin_amdgcn_readfirstlane(tid >> 6); (void)lane; (void)wave
    float* hbuf = a.out;
    const float* mod = (const float*)(a.ws + WS_CTL) + CW_MOD;
    bf16* XN = (bf16*)(a.ws + WS_XN);
#define GSYNC() do { if constexpr (COOP) cg::this_grid().sync(); } while (0)
    if constexpr (MASK & 1) { LAUNDER(); p0a(a, lds, tid, lane, wave, G); GSYNC(); }
    if constexpr (MASK & 2) { LAUNDER(); ln_rows(a.in[0], a.in[2], a.in[3], hbuf, XN, mod, lane, wave, G); GSYNC(); }
#pragma unroll 1
    for (int l = l0; l < l1; ++l) {
        for (int rep = 0; rep < ((PROBE_REP & 4) ? 2 : 1); ++rep)
        if constexpr (MASK & 4) { pg8::Gemm g{XN, (const bf16*)(a.ws + WS_WIN) + (size_t)l * NPROJ * 1024, M, NPROJ, 1024}; pg8::StaticOrder S; S.init(M, NPROJ, G, (int)blockIdx.x);
          EpiProj E{(bf16*)(a.ws + WS_PA), (bf16*)(a.ws + WS_PV), (bf16*)(a.ws + WS_PB)};
          pg8::gemm_phase<EpiProj, pg8::StaticOrder, true, true>(lds, g, S, E); GSYNC(); }
        for (int rep = 0; rep < ((PROBE_REP & 8) ? 2 : 1); ++rep)
        if constexpr (MASK & 8) { LAUNDER(); prep_phase(a, lds, l, tid, lane, wave, G); GSYNC(); }
        if constexpr (MASK & 16) { { LAUNDER(); p3a_phase(a, lds, l, tid, lane, wave); } GSYNC(); { LAUNDER(); p3b_phase(a, lds, l, tid, lane, wave); } GSYNC(); }
        for (int rep = 0; rep < ((PROBE_REP & 32) ? 2 : 1); ++rep)
        if constexpr (MASK & 32) { LAUNDER(); merge_phase(a, l, tid, lane, wave, G); GSYNC(); }
        if constexpr (MASK & 64) { pg8::Gemm g{(const bf16*)(a.ws + WS_YM), (const bf16*)(a.ws + WS_WOUT) + (size_t)l * 1024 * 1024, M, D, D}; pg8::StaticOrder S; S.init(M, D, G, (int)blockIdx.x);
          EpiOut E{hbuf, mod + l * 2 * 3072};
          pg8::gemm_phase<EpiOut, pg8::StaticOrder, true, true>(lds, g, S, E); GSYNC(); }
        if constexpr (MASK & 128) { LAUNDER(); ln_rows(hbuf, a.in[19] + l * D, a.in[20] + l * D, hbuf, XN, (l + 1 < DEPTH) ? mod + (l + 1) * 2 * 3072 : nullptr, lane, wave, G);
          if (l + 1 < l1) GSYNC(); }
    }
#undef GSYNC
#undef LAUNDER
}
#ifndef FMASK
#define FMASK 0xFF
#endif
#if N_LAUNCH_MODE == 1
__global__ void __launch_bounds__(512, 2) hymba_fwd(Args a) {
    extern __shared__ __attribute__((aligned(16))) unsigned char lds_raw[];
    run_phases<FMASK, true>(a, (LAS unsigned char*)lds_raw, 0, DEPTH);
}
#else
template <int MASK> __global__ void __launch_bounds__(512, 2) hymba_phase(Args a, int l) {
    extern __shared__ __attribute__((aligned(16))) unsigned char lds_raw[];
    run_phases<MASK, false>(a, (LAS unsigned char*)lds_raw, l, l + 1);
}
template <int MASK> static void launch_phase(const Args& a, int l, hipStream_t stream) {
    static bool attr = false;
    if (!attr) { (void)hipFuncSetAttribute((const void*)hymba_phase<MASK>, hipFuncAttributeMaxDynamicSharedMemorySize, LDS_BYTES); attr = true; }
    hipLaunchKernelGGL(hymba_phase<MASK>, dim3(256), dim3(512), LDS_BYTES, stream, a, l);
}
#endif

extern "C" void kernel_launch(void* const* d_in, const int* in_sizes, int n_in, void* d_out, int out_size, void* d_ws, size_t ws_size, hipStream_t stream) {
    if (n_in != 21 || ws_size < WS_END) { fprintf(stderr, "kernel_launch: unexpected n_in %d / ws %zu\n", n_in, ws_size); return; }
    (void)hipMemsetAsync((char*)d_ws + WS_CTL, 0, CTL_ZERO_BYTES, stream);
    Args a{};
    for (int i = 0; i < 21; ++i) a.in[i] = (const float*)d_in[i];
    a.out = (float*)d_out; a.ws = (unsigned char*)d_ws;
#if N_LAUNCH_MODE == 1
    static int grid = 0;
    if (grid == 0) {
        int dev = 0, cus = 0, per_cu = 0;
        (void)hipGetDevice(&dev); (void)hipDeviceGetAttribute(&cus, hipDeviceAttributeMultiprocessorCount, dev);
        (void)hipFuncSetAttribute((const void*)hymba_fwd, hipFuncAttributeMaxDynamicSharedMemorySize, LDS_BYTES);
        (void)hipOccupancyMaxActiveBlocksPerMultiprocessor(&per_cu, (const void*)hymba_fwd, 512, LDS_BYTES);
        if (per_cu < 1) per_cu = 1;
        (void)hipGetLastError();
        grid = cus * per_cu;
    }
    void* args[] = {&a};
    hipError_t e = hipLaunchCooperativeKernel((const void*)hymba_fwd, dim3(grid), dim3(512), args, LDS_BYTES, stream);
    if (e != hipSuccess) fprintf(stderr, "cooperative launch failed: %s (grid %d)\n", hipGetErrorString(e), grid);
#else
    launch_phase<1>(a, 0, stream); launch_phase<2>(a, 0, stream);
    for (int l = 0; l < DEPTH; ++l) { launch_phase<4>(a, l, stream); launch_phase<8>(a, l, stream); launch_phase<16>(a, l, stream); launch_phase<32>(a, l, stream); launch_phase<64>(a, l, stream); launch_phase<128>(a, l, stream); }
#endif
}
```

```cpp
#include <hip/hip_runtime.h>
#include <cstdio>
#include <cstdint>
namespace pg8 {
#define PG8_LAS __attribute__((address_space(3)))
typedef unsigned short bf16_t;
typedef short bf16x8 __attribute__((ext_vector_type(8)));
typedef float f32x4 __attribute__((ext_vector_type(4)));
typedef unsigned u32x4 __attribute__((ext_vector_type(4)));
constexpr int BM = 256, BK = 64, HALF = 128, HTB = HALF * BK * 2  , STAGE_BYTES = 8 * HTB, NXCD = 8, WGM = 8;

__host__ __device__ __forceinline__ int lds_byte(int r, int c) { const int st = (r >> 4) * 2 + (c >> 5), rr = r & 15, cc = c & 31, ob = rr * 64 + cc * 2; return st * 1024 + (ob ^ (((ob >> 9) & 1) << 5)); }
__host__ __device__ __forceinline__ void stage_rc(int b, int& R, int& C) { const int st = b / 1024, sb = b % 1024, swz = sb ^ (((sb >> 9) & 1) << 5); R = (st >> 1) * 16 + swz / 64; C = (st & 1) * 32 + (swz % 64) / 2; }
__host__ __device__ __forceinline__ int perm32(int rho) { const int n = rho >> 4, i = rho & 15; return 8 * (i >> 2) + 4 * n + (i & 3); }

struct Unit { int pm, pn; };
struct Gemm { const bf16_t* A; const bf16_t* Bt; int M, N, K; };

struct StaticOrder {
    int nM, nN, nwg, G, c;
    __host__ __device__ void init(int M, int N, int G_, int c_) { nM = M / BM; nN = N / BM; nwg = nM * nN; G = G_; c = c_; }
    __host__ __device__ bool next(int i, Unit& u) const {
        const long L = (long)i * G + c; if (L >= nwg) return false;
        int wgid = (int)L; { const int q = nwg / NXCD, r = nwg % NXCD, xcd = wgid % NXCD, off = wgid / NXCD; wgid = (xcd < r ? xcd * (q + 1) : r * (q + 1) + (xcd - r) * q) + off; }
        const int nig = WGM * nN, gid = wgid / nig, fm = gid * WGM, gsz = (nM - fm) < WGM ? (nM - fm) : WGM;
        u.pm = fm + ((wgid % nig) % gsz); u.pn = (wgid % nig) / gsz; return true;
    }
    __device__ __forceinline__ void a_ready(const Unit&) const {}
    __device__ __forceinline__ void done(const Unit&) const {}
};

__device__ __forceinline__ unsigned cvt_pk_bf16(float lo, float hi) { unsigned r; asm volatile("v_cvt_pk_bf16_f32 %0, %1, %2" : "=v"(r) : "v"(lo), "v"(hi)); return r; }
typedef float f32x2 __attribute__((ext_vector_type(2)));
__device__ __forceinline__ f32x2 gelu_pk(f32x2 v) {
    const f32x2 av = __builtin_elementwise_abs(v), d = av * 0.2316418882f + 1.0f;
    f32x2 t; t.x = __builtin_amdgcn_rcpf(d.x); t.y = __builtin_amdgcn_rcpf(d.y);
    f32x2 q = t * 0.5307027145f + (-0.7265760135f); q = q * t + 0.7107068705f; q = q * t + (-0.142248368f); q = q * t + 0.127414796f; q = q * t;
    const f32x2 s = (v * v) * (-0.72134752044f);
    f32x2 e; e.x = __builtin_amdgcn_exp2f(s.x); e.y = __builtin_amdgcn_exp2f(s.y);
    const f32x2 m = v * (q * e), r = v - m;
    f32x2 o; o.x = v.x < 0.f ? m.x : r.x; o.y = v.y < 0.f ? m.y : r.y; return o;
}

template <int ACT  > struct EpiBf16 {
    static constexpr bool PERM = true, AFTER_DRAIN = false; static_assert(ACT == 0 || ACT == 1, "EpiBf16: ACT is 0 (none) or 1 (gelu_pk)");
    bf16_t* O; int ldc; const float* bias; int split_cols; size_t split_stride; float scale0;
    __device__ __forceinline__ void operator()(const f32x4 (&acc)[2][2][4][2], const Unit& u, int wr, int wc, int fr, int fq) const {
        const int row0 = u.pm * BM + wr * 64 + fr; int colt = u.pn * BM; bf16_t* base = O;
        float sc = 1.f; if (split_cols) { const int t = colt / split_cols; base += (size_t)t * split_stride; colt -= t * split_cols; if (t == 0) sc = scale0; }
        const int col0 = colt + wc * 32 + 8 * fq, bcol0 = u.pn * BM + wc * 32 + 8 * fq;
        f32x4 bv[2][2];
#pragma unroll
        for (int bj = 0; bj < 2; ++bj)
#pragma unroll
            for (int n = 0; n < 2; ++n) bv[bj][n] = bias ? *(const f32x4*)(bias + bcol0 + bj * HALF + 4 * n) : (f32x4){0.f, 0.f, 0.f, 0.f};
#pragma unroll
        for (int ai = 0; ai < 2; ++ai)
#pragma unroll
            for (int m = 0; m < 4; ++m) { bf16_t* rowp = base + (size_t)(row0 + ai * HALF + m * 16) * ldc + col0;
#pragma unroll
                for (int bj = 0; bj < 2; ++bj) { f32x4 v0 = acc[ai][bj][m][0] + bv[bj][0], v1 = acc[ai][bj][m][1] + bv[bj][1];
                    if (ACT == 1) { f32x2 a = gelu_pk((f32x2){v0[0], v0[1]}), b = gelu_pk((f32x2){v0[2], v0[3]}), c = gelu_pk((f32x2){v1[0], v1[1]}), d = gelu_pk((f32x2){v1[2], v1[3]});
                        v0 = (f32x4){a.x, a.y, b.x, b.y}; v1 = (f32x4){c.x, c.y, d.x, d.y}; }
                    v0 = v0 * sc; v1 = v1 * sc; u32x4 w; w.x = cvt_pk_bf16(v0[0], v0[1]); w.y = cvt_pk_bf16(v0[2], v0[3]); w.z = cvt_pk_bf16(v1[0], v1[1]); w.w = cvt_pk_bf16(v1[2], v1[3]);
                    *(u32x4*)(rowp + bj * HALF) = w; } }
    }
};

template <class Epi, class Sched, bool ALIGN_EPI = false, bool SP2 = false>
__device__ __forceinline__ void gemm_phase(PG8_LAS unsigned char* lds, const Gemm g, const Sched& S, const Epi& E) {
    int tid = threadIdx.x; asm volatile("" : "+v"(tid));
    const int wid = __builtin_amdgcn_readfirstlane(tid >> 6), lane = tid & 63, wr = wid >> 2, wc = wid & 3, fr = lane & 15, fq = lane >> 4;
    const int K = g.K, nt = K / BK;
    unsigned voffA[2], voffB[2];
#pragma unroll
    for (int i = 0; i < 2; ++i) { int R, C; stage_rc(tid * 16 + i * 8192, R, C); const int Rb = Epi::PERM ? ((R & ~31) + perm32(R & 31)) : R;
        voffA[i] = (unsigned)(R * K + C) * 2u; voffB[i] = (unsigned)(Rb * K + C) * 2u; }
    const size_t kstep = (size_t)(BK * 2);
    const size_t hstep = (size_t)HALF * K * 2;
    const size_t tstep = 2 * hstep;
    const unsigned ldsw = (unsigned)wid * 1024u;
    const int aoff = lds_byte(wr * 64 + fr, fq * 8), boff = lds_byte(wc * 32 + fr, fq * 8);
#define PG8_SA(b, h) (((b) * 2 + (h)) * HTB)
#define PG8_SB(b, h) ((4 + (b) * 2 + (h)) * HTB)
#define PG8_STAGE(bufoff, gbase, voff) do { _Pragma("unroll") for (int _i = 0; _i < 2; ++_i) \
        __builtin_amdgcn_global_load_lds((const unsigned*)((const char*)(gbase) + (voff)[_i]), (PG8_LAS unsigned*)(lds + (bufoff) + ldsw + _i * 8192), 16, 0, 0); } while (0)
#define PG8_LDA(dst, b, h) do { _Pragma("unroll") for (int m = 0; m < 4; ++m) _Pragma("unroll") for (int k = 0; k < 2; ++k) dst[m][k] = *(const PG8_LAS bf16x8*)(lds + PG8_SA(b, h) + aoff + m * 2048 + k * 1024); } while (0)
#define PG8_LDB(dst, b, h) do { _Pragma("unroll") for (int n = 0; n < 2; ++n) _Pragma("unroll") for (int k = 0; k < 2; ++k) dst[n][k] = *(const PG8_LAS bf16x8*)(lds + PG8_SB(b, h) + boff + n * 2048 + k * 1024); } while (0)
#define PG8_MMA(ai, bj, At, Bt) do { __builtin_amdgcn_s_setprio(1); _Pragma("unroll") for (int m = 0; m < 4; ++m) _Pragma("unroll") for (int n = 0; n < 2; ++n) _Pragma("unroll") for (int k = 0; k < 2; ++k) \
        acc[ai][bj][m][n] = __builtin_amdgcn_mfma_f32_16x16x32_bf16(Bt[n][k], At[m][k], acc[ai][bj][m][n], 0, 0, 0); __builtin_amdgcn_s_setprio(0); } while (0)
#define PG8_WAIT_V(n) asm volatile("s_waitcnt vmcnt(" #n ")" ::: "memory")
#define PG8_WAIT_L(n) asm volatile("s_waitcnt lgkmcnt(" #n ")" ::: "memory")
#define PG8_BAR __builtin_amdgcn_s_barrier()
#define PG8_SCHED __builtin_amdgcn_sched_barrier(0)
    Unit cur, nxt; int ui = 0;
    if (!S.next(0, cur)) return;
    f32x4 acc[2][2][4][2];
#pragma unroll
    for (int a = 0; a < 2; ++a)
#pragma unroll
        for (int b = 0; b < 2; ++b)
#pragma unroll
            for (int m = 0; m < 4; ++m)
#pragma unroll
                for (int n = 0; n < 2; ++n) acc[a][b][m][n] = (f32x4){0.f, 0.f, 0.f, 0.f};
    bf16x8 At[4][2], B0[2][2], B1[2][2];
    const char* cA = (const char*)g.A + (size_t)cur.pm * tstep; const char* cB = (const char*)g.Bt + (size_t)cur.pn * tstep;
    S.a_ready(cur);
    if constexpr (SP2) {
        PG8_STAGE(PG8_SB(0, 0), cB, voffB); PG8_STAGE(PG8_SB(0, 1), cB + hstep, voffB); PG8_STAGE(PG8_SA(0, 0), cA, voffA); PG8_STAGE(PG8_SA(0, 1), cA + hstep, voffA);
        if (wr == 1) PG8_BAR;
        PG8_WAIT_V(2); PG8_BAR;
        PG8_STAGE(PG8_SB(1, 0), cB + kstep, voffB); PG8_STAGE(PG8_SA(1, 0), cA + kstep, voffA); PG8_STAGE(PG8_SB(1, 1), cB + hstep + kstep, voffB);
        PG8_WAIT_V(6); PG8_BAR;
    } else {
        PG8_STAGE(PG8_SB(0, 0), cB, voffB); PG8_STAGE(PG8_SA(0, 0), cA, voffA); PG8_STAGE(PG8_SB(0, 1), cB + hstep, voffB); PG8_STAGE(PG8_SA(0, 1), cA + hstep, voffA);
        if (wr == 1) PG8_BAR;
        PG8_WAIT_V(4); PG8_BAR;
        PG8_STAGE(PG8_SB(1, 0), cB + kstep, voffB); PG8_STAGE(PG8_SA(1, 0), cA + kstep, voffA); PG8_STAGE(PG8_SB(1, 1), cB + hstep + kstep, voffB);
        PG8_WAIT_V(6); PG8_BAR;
    }
    for (;;) {
        const bool has_next = S.next(ui + 1, nxt);
        const char* nA = has_next ? (const char*)g.A + (size_t)nxt.pm * tstep : cA; const char* nB = has_next ? (const char*)g.Bt + (size_t)nxt.pn * tstep : cB;
        for (int t = 0; t < nt; t += 2) {
            const bool last = (t == nt - 2);
            const char* a1 = cA + (size_t)(t + 1) * kstep;
            const char* a2 = last ? nA : cA + (size_t)(t + 2) * kstep; const char* b2 = last ? nB : cB + (size_t)(t + 2) * kstep;
            const char* a3 = a2 + kstep; const char* b3 = b2 + kstep;
            if (last && has_next) S.a_ready(nxt);
            if constexpr (SP2) {
            PG8_LDB(B0, 0, 0); PG8_LDB(B1, 0, 1); PG8_SCHED; PG8_LDA(At, 0, 0); PG8_STAGE(PG8_SA(1, 1), a1 + hstep, voffA);
            PG8_WAIT_V(8); PG8_WAIT_L(0); PG8_BAR; PG8_MMA(0, 0, At, B0); PG8_MMA(0, 1, At, B1); PG8_BAR; PG8_SCHED;
            PG8_LDA(At, 0, 1); PG8_STAGE(PG8_SB(0, 0), b2, voffB); PG8_STAGE(PG8_SB(0, 1), b2 + hstep, voffB); PG8_STAGE(PG8_SA(0, 0), a2, voffA);
            PG8_WAIT_V(8); PG8_WAIT_L(0); PG8_BAR; PG8_MMA(1, 0, At, B0); PG8_MMA(1, 1, At, B1); PG8_BAR; PG8_SCHED;
            PG8_LDB(B0, 1, 0); PG8_LDB(B1, 1, 1); PG8_SCHED; PG8_LDA(At, 1, 0); PG8_STAGE(PG8_SA(0, 1), a2 + hstep, voffA);
            PG8_WAIT_V(8); PG8_WAIT_L(0); PG8_BAR; PG8_MMA(0, 0, At, B0); PG8_MMA(0, 1, At, B1); PG8_BAR; PG8_SCHED;
            PG8_LDA(At, 1, 1); PG8_STAGE(PG8_SB(1, 0), b3, voffB); PG8_STAGE(PG8_SB(1, 1), b3 + hstep, voffB); PG8_STAGE(PG8_SA(1, 0), a3, voffA);
            PG8_WAIT_V(8); PG8_WAIT_L(0); PG8_BAR; PG8_MMA(1, 0, At, B0); PG8_MMA(1, 1, At, B1); PG8_BAR; PG8_SCHED;
            } else {
            PG8_LDB(B0, 0, 0); PG8_SCHED; PG8_LDA(At, 0, 0); PG8_STAGE(PG8_SA(1, 1), a1 + hstep, voffA);
            PG8_WAIT_L(8); PG8_BAR; PG8_WAIT_L(0); PG8_MMA(0, 0, At, B0); PG8_BAR; PG8_SCHED;
            PG8_LDB(B1, 0, 1); PG8_STAGE(PG8_SB(0, 0), b2, voffB);
            PG8_BAR; PG8_WAIT_L(0); PG8_MMA(0, 1, At, B1); PG8_BAR;
            PG8_LDA(At, 0, 1); PG8_STAGE(PG8_SA(0, 0), a2, voffA);
            PG8_BAR; PG8_WAIT_L(0); PG8_MMA(1, 0, At, B0); PG8_BAR; PG8_SCHED;
            PG8_STAGE(PG8_SB(0, 1), b2 + hstep, voffB);
            PG8_WAIT_V(6); PG8_BAR; PG8_MMA(1, 1, At, B1); PG8_BAR;
            PG8_LDB(B0, 1, 0); PG8_SCHED; PG8_LDA(At, 1, 0); PG8_STAGE(PG8_SA(0, 1), a2 + hstep, voffA);
            PG8_WAIT_L(8); PG8_BAR; PG8_WAIT_L(0); PG8_MMA(0, 0, At, B0); PG8_BAR; PG8_SCHED;
            PG8_LDB(B1, 1, 1); PG8_STAGE(PG8_SB(1, 0), b3, voffB);
            PG8_BAR; PG8_WAIT_L(0); PG8_MMA(0, 1, At, B1); PG8_BAR;
            PG8_LDA(At, 1, 1); PG8_STAGE(PG8_SA(1, 0), a3, voffA);
            PG8_BAR; PG8_WAIT_L(0); PG8_MMA(1, 0, At, B0); PG8_BAR; PG8_SCHED;
            PG8_STAGE(PG8_SB(1, 1), b3 + hstep, voffB);
            PG8_WAIT_V(6); PG8_BAR; PG8_MMA(1, 1, At, B1); PG8_BAR;
            }
        }
        if constexpr (ALIGN_EPI) { if (wr == 0) PG8_BAR; }
        if constexpr (!Epi::AFTER_DRAIN) { E(acc, cur, wr, wc, fr, fq); S.done(cur); }
        if (!has_next) break;
#pragma unroll
        for (int a = 0; a < 2; ++a)
#pragma unroll
            for (int b = 0; b < 2; ++b)
#pragma unroll
                for (int m = 0; m < 4; ++m)
#pragma unroll
                    for (int n = 0; n < 2; ++n) acc[a][b][m][n] = (f32x4){0.f, 0.f, 0.f, 0.f};
        cur = nxt; cA = nA; cB = nB; ++ui;
        if constexpr (ALIGN_EPI) { if (wr == 1) PG8_BAR; }
    }
    PG8_WAIT_V(0);
    if constexpr (!ALIGN_EPI) { if (wr == 0) PG8_BAR; }
    PG8_BAR;
    if constexpr (Epi::AFTER_DRAIN) { E.fused(acc, cur, wr, wc, fr, fq, lds, wid, lane); S.done(cur); }
#undef PG8_SA
#undef PG8_SB
#undef PG8_STAGE
#undef PG8_LDA
#undef PG8_LDB
#undef PG8_MMA
#undef PG8_WAIT_V
#undef PG8_WAIT_L
#undef PG8_BAR
#undef PG8_SCHED
}
}
#include <hip/hip_cooperative_groups.h>
namespace cg = cooperative_groups;
#define LAS __attribute__((address_space(3)))
typedef unsigned short bf16;
typedef float f32x4 __attribute__((ext_vector_type(4)));
typedef float f32x2 __attribute__((ext_vector_type(2)));
typedef float f32x16 __attribute__((ext_vector_type(16)));
typedef short bf16x8 __attribute__((ext_vector_type(8)));
typedef short s16x4 __attribute__((ext_vector_type(4)));
typedef unsigned u32x4 __attribute__((ext_vector_type(4)));
typedef unsigned u32x2 __attribute__((ext_vector_type(2)));
typedef __bf16 bf16x2_t __attribute__((ext_vector_type(2)));

constexpr int BATCH = 2, T = 16384, D = 1024, M = BATCH * T, DEPTH = 2;
constexpr int NPROJ = 4352, NSRC = 4232;
constexpr int LDA = 1280, LDV = 512, LDB = 2560;
constexpr float LN_EPS = 1e-5f, GN_EPS = 64e-5f;
constexpr float DN_ALPHA = 1.41421356237f;
constexpr float C2 = 0.125f * 1.4426950408889634f;
constexpr float L2E = 1.4426950408889634f;
constexpr size_t MiB = 1u << 20;
constexpr size_t WS_CTL = 0, CTL_ZERO_BYTES = 1 * MiB;
constexpr size_t WS_WIN = 2 * MiB, WS_WOUT = 20 * MiB, WS_CUM = 24 * MiB, WS_SCS = 25 * MiB, WS_SCN = 30 * MiB;
constexpr size_t WS_XN = WS_SCN, WS_YM = WS_SCN;
constexpr size_t WS_LORA = 29 * MiB;
constexpr size_t WS_PA = 190 * MiB, WS_YA = WS_PA, WS_PV = 270 * MiB, WS_PB = 302 * MiB, WS_VS = 462 * MiB, WS_FS = 494 * MiB, WS_END = 502 * MiB;
constexpr int CW_QUEUE = 64;
constexpr int CW_KMAX = 1024;
constexpr int CW_MOD = 16384;
constexpr int LDS_BYTES = 147456;
#ifndef PROBE_REP
#define PROBE_REP 0
#endif

__device__ __forceinline__ unsigned f2bf(float f) { unsigned u = __builtin_bit_cast(unsigned, f); return (u + 0x7fffu + ((u >> 16) & 1u)) >> 16; }
__device__ __forceinline__ unsigned pk2(float lo, float hi) { return f2bf(lo) | (f2bf(hi) << 16); }
__device__ __forceinline__ float bf2f(unsigned short v) { return __uint_as_float(((unsigned)v) << 16); }
__device__ __forceinline__ float bflo(unsigned w) { return __uint_as_float(w << 16); }
__device__ __forceinline__ float bfhi(unsigned w) { return __uint_as_float(w & 0xffff0000u); }
__device__ __forceinline__ unsigned cvtpk(float lo, float hi) { f32x2 v = {lo, hi}; bf16x2_t b = __builtin_convertvector(v, bf16x2_t); return __builtin_bit_cast(unsigned, b); }
__device__ __forceinline__ float row16_sum(float x) {
    x += __uint_as_float(__builtin_amdgcn_update_dpp(0, __float_as_uint(x), 0xB1, 0xF, 0xF, true));
    x += __uint_as_float(__builtin_amdgcn_update_dpp(0, __float_as_uint(x), 0x4E, 0xF, 0xF, true));
    x += __uint_as_float(__builtin_amdgcn_update_dpp(0, __float_as_uint(x), 0x141, 0xF, 0xF, true));
    x += __uint_as_float(__builtin_amdgcn_update_dpp(0, __float_as_uint(x), 0x140, 0xF, 0xF, true));
    return x;
}
__device__ __forceinline__ float wave_sum(float v) { v = row16_sum(v); v += __shfl_xor(v, 16); v += __shfl_xor(v, 32); return v; }
__device__ __forceinline__ float fast_sigmoid(float x) { return 1.f / (1.f + __expf(-x)); }

struct Args { const float* in[21]; float* out; unsigned char* ws; };

struct EpiProj {
    static constexpr bool PERM = true, AFTER_DRAIN = false;
    bf16 *PA, *PVb, *PB;
    __device__ __forceinline__ void operator()(const pg8::f32x4 (&acc)[2][2][4][2], const pg8::Unit& u, int wr, int wc, int fr, int fq) const {
        const int row0 = u.pm * 256 + wr * 64 + fr; const int pn = u.pn;
        bf16* base; int ldc, colt; float sc = 1.f; bool act = false;
        if (pn < 4) { base = PA; ldc = LDA; colt = pn * 256; }
        else if (pn < 6) { base = PVb; ldc = LDV; colt = (pn - 4) * 256; }
        else if (pn == 6) { base = PA; ldc = LDA; colt = 1024; }
        else { base = PB; ldc = LDB; colt = (pn - 7) * 256; if (pn < 9) sc = C2; if (pn >= 13) act = true; }
        const int col0 = colt + wc * 32 + 8 * fq;
#pragma unroll
        for (int ai = 0; ai < 2; ++ai)
#pragma unroll
            for (int m = 0; m < 4; ++m) { bf16* rowp = base + (size_t)(row0 + ai * 128 + m * 16) * ldc + col0;
#pragma unroll
                for (int bj = 0; bj < 2; ++bj) { pg8::f32x4 v0 = acc[ai][bj][m][0], v1 = acc[ai][bj][m][1];
                    if (act) {
#pragma unroll
                        for (int e = 0; e < 4; ++e) { v0[e] = v0[e] * fast_sigmoid(v0[e]); v1[e] = v1[e] * fast_sigmoid(v1[e]); } }
                    v0 = v0 * sc; v1 = v1 * sc; u32x4 w; w.x = cvtpk(v0[0], v0[1]); w.y = cvtpk(v0[2], v0[3]); w.z = cvtpk(v1[0], v1[1]); w.w = cvtpk(v1[2], v1[3]);
                    *(u32x4*)(rowp + bj * 128) = w; } }
    }
};
struct EpiOut {
    static constexpr bool PERM = false, AFTER_DRAIN = false;
    float* hz; const float* modl;
    __device__ __forceinline__ void operator()(const pg8::f32x4 (&acc)[2][2][4][2], const pg8::Unit& u, int wr, int wc, int fr, int fq) const {
        const int col0 = u.pn * 256 + wc * 32 + 4 * fq; const int b = (u.pm * 256) >= T ? 1 : 0; const float* gate = modl + b * 3072 + 2048;
#pragma unroll
        for (int bj = 0; bj < 2; ++bj)
#pragma unroll
            for (int n = 0; n < 2; ++n) { const int c = col0 + bj * 128 + n * 16; const f32x4 g = *(const f32x4*)(gate + c) + 1.0f;
#pragma unroll
                for (int ai = 0; ai < 2; ++ai)
#pragma unroll
                    for (int m = 0; m < 4; ++m) { const int r = u.pm * 256 + ai * 128 + wr * 64 + m * 16 + fr; float* p = hz + (size_t)r * D + c;
                        const f32x4 hx = *(const f32x4*)p; f32x4 a; a[0] = acc[ai][bj][m][n][0]; a[1] = acc[ai][bj][m][n][1]; a[2] = acc[ai][bj][m][n][2]; a[3] = acc[ai][bj][m][n][3];
                        *(f32x4*)p = hx * DN_ALPHA + g * a; } }
    }
};

__device__ __forceinline__ int win_map(int n) { if (n < 1664) return n; if (n < 1672) return 3200 + n - 1664; if (n < 1792) return -1; if (n < 3328) return n - 128; return n - 120; }
template <bool MAP> __device__ __forceinline__ void transpose_item(const float* W, int Nsrc, int Ndst, bf16* WT, LAS float* scr, int item, int lane) {
    const int nblk = Ndst / 32, kb = item / nblk, nb = item % nblk, k0 = 64 * kb, n0 = 32 * nb;
    const int src = MAP ? win_map(n0 + (lane & 31)) : n0 + (lane & 31);
#pragma unroll 8
    for (int i = 0; i < 32; ++i) { const int kk = 2 * i + (lane >> 5); scr[kk * 33 + (lane & 31)] = src >= 0 ? W[(size_t)(k0 + kk) * Nsrc + src] : 0.f; }
    asm volatile("s_waitcnt lgkmcnt(0)" ::: "memory");
    const int c = lane & 7;
#pragma unroll
    for (int j = 0; j < 4; ++j) { const int n = (lane >> 3) + 8 * j; const LAS float* s = scr + (8 * c) * 33 + n;
        u32x4 o; o.x = pk2(s[0 * 33], s[1 * 33]); o.y = pk2(s[2 * 33], s[3 * 33]); o.z = pk2(s[4 * 33], s[5 * 33]); o.w = pk2(s[6 * 33], s[7 * 33]);
        *(u32x4*)(WT + (size_t)(n0 + n) * 1024 + k0 + 8 * c) = o; }
    asm volatile("s_waitcnt lgkmcnt(0)" ::: "memory");
}
__device__ __forceinline__ void p0a(const Args& a, LAS unsigned char* lds, int tid, int lane, int wave, int G) {
    LAS float* scr = (LAS float*)(lds + wave * 16384);
    const int gw = blockIdx.x * 8 + wave, NGW = G * 8;
    constexpr int I_IN = 16 * (NPROJ / 32), I_OUT = 16 * 32;
    for (int it = gw; it < 2 * (I_IN + I_OUT); it += NGW) {
        int r = it; const int l = r / (I_IN + I_OUT); r -= l * (I_IN + I_OUT);
        if (r < I_IN) transpose_item<true>(a.in[6] + (size_t)l * 1024 * NSRC, NSRC, NPROJ, (bf16*)(a.ws + WS_WIN) + (size_t)l * NPROJ * 1024, scr, r, lane);
        else transpose_item<false>(a.in[18] + (size_t)l * 1024 * 1024, 1024, 1024, (bf16*)(a.ws + WS_WOUT) + (size_t)l * 1024 * 1024, scr, r - I_IN, lane);
    }
    { bf16* LT = (bf16*)(a.ws + WS_LORA);
      for (int w = blockIdx.x * 512 + tid; w < 2 * 2 * 512 * 64; w += G * 512) { const int k = w & 63, n = (w >> 6) & 511, which = (w >> 15) & 1, l = w >> 16;
          const float* src = (which ? a.in[11] : a.in[9]) + (size_t)l * 64 * 512; LT[w] = (bf16)f2bf(src[k * 512 + n]); } }
    float* mod = (float*)(a.ws + WS_CTL) + CW_MOD;
    const float* cvec = a.in[1];
    for (int w = blockIdx.x * 512 + tid; w < 2 * 16 * 3072; w += G * 512) {
        const int j = w % 3072, sl = (w / 3072) % 16, l = w / (3072 * 16);
        const float* wa = a.in[4] + (size_t)l * 1024 * 3072 + (size_t)(sl * 64) * 3072 + j;
        float s0 = 0.f, s1 = 0.f;
#pragma unroll 8
        for (int i = 0; i < 64; ++i) { const float wv = wa[(size_t)i * 3072]; s0 += cvec[sl * 64 + i] * wv; s1 += cvec[1024 + sl * 64 + i] * wv; }
        if (sl == 0) { const float bb = a.in[5][l * 3072 + j]; s0 += bb; s1 += bb; }
        atomicAdd(mod + (l * 2 + 0) * 3072 + j, s0); atomicAdd(mod + (l * 2 + 1) * 3072 + j, s1);
    }
}
__device__ __forceinline__ void ln_rows(const float* src, const float* g, const float* bb, float* dst, bf16* xn, const float* modn, int lane, int wave, int G) {
    const int gw = blockIdx.x * 8 + wave, NGW = G * 8;
    f32x4 gv[4], bv[4];
#pragma unroll
    for (int j = 0; j < 4; ++j) { gv[j] = ((const f32x4*)g)[lane + 64 * j]; bv[j] = ((const f32x4*)bb)[lane + 64 * j]; }
    for (int m0 = gw * 2; m0 < M; m0 += NGW * 2) {
        f32x4 v[2][4]; float s[2], s2[2];
#pragma unroll
        for (int u = 0; u < 2; ++u) { const f32x4* xr = (const f32x4*)(src + (size_t)(m0 + u) * D) + lane; s[u] = 0.f;
#pragma unroll
            for (int j = 0; j < 4; ++j) { v[u][j] = xr[64 * j]; s[u] += (v[u][j].x + v[u][j].y) + (v[u][j].z + v[u][j].w); } }
#pragma unroll
        for (int u = 0; u < 2; ++u) s[u] = row16_sum(s[u]);
#pragma unroll
        for (int o = 16; o < 64; o <<= 1) {
#pragma unroll
            for (int u = 0; u < 2; ++u) s[u] += __shfl_xor(s[u], o); }
#pragma unroll
        for (int u = 0; u < 2; ++u) { const float mean = s[u] * (1.f / D); s2[u] = 0.f;
#pragma unroll
            for (int j = 0; j < 4; ++j) { v[u][j] = v[u][j] - mean; s2[u] += (v[u][j].x * v[u][j].x + v[u][j].y * v[u][j].y) + (v[u][j].z * v[u][j].z + v[u][j].w * v[u][j].w); } }
#pragma unroll
        for (int u = 0; u < 2; ++u) s2[u] = row16_sum(s2[u]);
#pragma unroll
        for (int o = 16; o < 64; o <<= 1) {
#pragma unroll
            for (int u = 0; u < 2; ++u) s2[u] += __shfl_xor(s2[u], o); }
#pragma unroll
        for (int u = 0; u < 2; ++u) { const int m = m0 + u;
            const float rstd = 1.f / sqrtf(s2[u] * (1.f / D) + LN_EPS);
            f32x4* o = (f32x4*)(dst + (size_t)m * D) + lane;
            const int b = m >= T ? 1 : 0;
#pragma unroll
            for (int j = 0; j < 4; ++j) { const f32x4 hv = v[u][j] * rstd * gv[j] + bv[j]; o[64 * j] = hv;
                if (modn) { const f32x4 sh = ((const f32x4*)(modn + b * 3072))[lane + 64 * j], sc = ((const f32x4*)(modn + b * 3072 + 1024))[lane + 64 * j];
                    const f32x4 y = hv * (sc + 1.0f) + sh; u32x2 w; w.x = pk2(y.x, y.y); w.y = pk2(y.z, y.w);
                    *((u32x2*)(xn + (size_t)m * D) + lane + 64 * j) = w; } } }
    }
}
__device__ __forceinline__ int crow(int r, int hi) { return (r & 3) + 8 * (r >> 2) + 4 * hi; }
__device__ __forceinline__ float tanh_fast(float x) { const float e = __expf(2.f * x); return 1.f - 2.f / (e + 1.f); }
__device__ __forceinline__ void cum_kmax(const Args& a, LAS unsigned char* lds, int l, int bh, int tid, int lane, int wave) {
    const int b = bh >> 3, h = bh & 7;
    const bf16* PA = (const bf16*)(a.ws + WS_PA); const bf16* PB = (const bf16*)(a.ws + WS_PB);
    float* cum = (float*)(a.ws + WS_CUM) + (size_t)bh * T;
    const float bf = a.in[17][l * 8 + h];
    LAS float* red = (LAS float*)lds;
    const int t0 = tid * 32;
    float s = 0.f, kmx = 0.f;
#pragma unroll 1
    for (int i = 0; i < 32; ++i) { const size_t m = (size_t)b * T + t0 + i;
        const float z = bf2f(PA[m * LDA + 1152 + h]) + bf;
        const float lf = fminf(z, 0.f) - log1pf(__expf(-fabsf(z)));
        s += lf; cum[t0 + i] = s;
        const u32x4* kr = (const u32x4*)(PB + m * LDB + 512 + h * 64); float q = 0.f;
#pragma unroll
        for (int c = 0; c < 8; ++c) { const u32x4 w = kr[c];
            q += bflo(w.x) * bflo(w.x) + bfhi(w.x) * bfhi(w.x) + bflo(w.y) * bflo(w.y) + bfhi(w.y) * bfhi(w.y) + bflo(w.z) * bflo(w.z) + bfhi(w.z) * bfhi(w.z) + bflo(w.w) * bflo(w.w) + bfhi(w.w) * bfhi(w.w); }
        kmx = fmaxf(kmx, q); }
    red[tid] = s;
#pragma unroll
    for (int o = 1; o < 64; o <<= 1) kmx = fmaxf(kmx, __shfl_xor(kmx, o));
    if (lane == 0) red[512 + wave] = kmx;
    __syncthreads();
    if (tid == 0) { float run = 0.f; for (int i = 0; i < 512; ++i) { const float v = red[i]; red[i] = run; run += v; }
        float k = 0.f; for (int i = 0; i < 8; ++i) k = fmaxf(k, red[512 + i]);
        ((float*)(a.ws + WS_CTL))[CW_KMAX + 16 * l + bh] = sqrtf(k); }
    __syncthreads();
    const float off = red[tid];
#pragma unroll 1
    for (int i = 0; i < 32; ++i) cum[t0 + i] += off;
    __syncthreads();
}
__device__ __forceinline__ void prep_phase(const Args& a, LAS unsigned char* lds, int l, int tid, int lane, int wave, int G) {
    const bf16* PA = (const bf16*)(a.ws + WS_PA); const bf16* PV = (const bf16*)(a.ws + WS_PV);
    bf16* SCN = (bf16*)(a.ws + WS_SCN); float* SCS = (float*)(a.ws + WS_SCS); bf16* VS = (bf16*)(a.ws + WS_VS);
    LAS unsigned char* lowL = lds;
    LAS bf16* CL = (LAS bf16*)(lds + 16384);
    const int c = tid, h = wave, r32 = lane & 31, hi = lane >> 5;
    const bf16* LT = (const bf16*)(a.ws + WS_LORA) + (size_t)l * 2 * 512 * 64;
    const float* mix = a.in[7] + l * 1664;
    const float mix_r = mix[c], mix_k = mix[512 + c], mix_v = mix[1024 + c];
    const int ftok = tid >> 3, fi0 = (tid & 7) * 16;
    f32x4 mlow[4];
#pragma unroll
    for (int q = 0; q < 4; ++q) mlow[q] = *(const f32x4*)(mix + 1536 + fi0 + 4 * q);
    const float w0c = a.in[8][l * 512 + c], a0c = a.in[10][l * 512 + c], kkc = a.in[12][l * 512 + c], kac = a.in[13][l * 512 + c], rkc = a.in[14][l * 512 + c];
    unsigned* pq = (unsigned*)(a.ws + WS_CTL) + CW_QUEUE + 1024 + 64 * l;
    volatile LAS unsigned* ptask = (volatile LAS unsigned*)(lds + 140000);
    for (;;) {
        __syncthreads();
        if (tid == 0) ptask[0] = atomicAdd(pq, 1u);
        __syncthreads();
        const unsigned ptk = ptask[0];
        if (ptk >= 16u + (unsigned)(M / 64)) break;
        if (ptk < 16u) { cum_kmax(a, lds + 135168, l, (int)ptk, tid, lane, wave); continue; }
        const int chunk = (int)ptk - 16;
        const int m0 = chunk * 64, b = m0 >= T ? 1 : 0, t0 = m0 - b * T; const int bh = b * 8 + h;
        { const int m = m0 + ftok, t = t0 + ftok;
          const u32x4* cp = (const u32x4*)(PA + (size_t)m * LDA + 1024 + fi0);
          const u32x4 c0 = cp[0], c1 = cp[1]; u32x4 p0 = {0u, 0u, 0u, 0u}, p1 = p0;
          if (t > 0) { const u32x4* pp = (const u32x4*)(PA + (size_t)(m - 1) * LDA + 1024 + fi0); p0 = pp[0]; p1 = pp[1]; }
          float cur[16], prv[16];
          cur[0] = bflo(c0.x); cur[1] = bfhi(c0.x); cur[2] = bflo(c0.y); cur[3] = bfhi(c0.y); cur[4] = bflo(c0.z); cur[5] = bfhi(c0.z); cur[6] = bflo(c0.w); cur[7] = bfhi(c0.w);
          cur[8] = bflo(c1.x); cur[9] = bfhi(c1.x); cur[10] = bflo(c1.y); cur[11] = bfhi(c1.y); cur[12] = bflo(c1.z); cur[13] = bfhi(c1.z); cur[14] = bflo(c1.w); cur[15] = bfhi(c1.w);
          prv[0] = bflo(p0.x); prv[1] = bfhi(p0.x); prv[2] = bflo(p0.y); prv[3] = bfhi(p0.y); prv[4] = bflo(p0.z); prv[5] = bfhi(p0.z); prv[6] = bflo(p0.w); prv[7] = bfhi(p0.w);
          prv[8] = bflo(p1.x); prv[9] = bfhi(p1.x); prv[10] = bflo(p1.y); prv[11] = bfhi(p1.y); prv[12] = bflo(p1.z); prv[13] = bfhi(p1.z); prv[14] = bflo(p1.w); prv[15] = bfhi(p1.w);
#pragma unroll
          for (int q = 0; q < 16; ++q) { float val = cur[q] + (prv[q] - cur[q]) * mlow[q >> 2][q & 3]; if (fi0 < 64) val = tanh_fast(val); cur[q] = val; }
          u32x4 o0 = {cvtpk(cur[0], cur[1]), cvtpk(cur[2], cur[3]), cvtpk(cur[4], cur[5]), cvtpk(cur[6], cur[7])};
          u32x4 o1 = {cvtpk(cur[8], cur[9]), cvtpk(cur[10], cur[11]), cvtpk(cur[12], cur[13]), cvtpk(cur[14], cur[15])};
          const int ch = 2 * (tid & 7);
          *(LAS u32x4*)(lowL + ftok * 256 + ((ch ^ (ftok & 7)) << 4)) = o0; *(LAS u32x4*)(lowL + ftok * 256 + (((ch + 1) ^ (ftok & 7)) << 4)) = o1; }
        __syncthreads();
        float pr = 0.f, pk = 0.f, pv = 0.f;
        if (t0 > 0) { pr = bf2f(PA[(size_t)(m0 - 1) * LDA + c]); pk = bf2f(PA[(size_t)(m0 - 1) * LDA + 512 + c]); pv = bf2f(PV[(size_t)(m0 - 1) * LDV + c]); }
#pragma unroll 1
        for (int tr = 0; tr < 2; ++tr) {
            { f32x16 Cw0 = {}, Cw1 = {}, Ca0 = {}, Ca1 = {};
              const int trow = 32 * tr + r32;
              bf16x8 Bw[2][4], Ba[2][4];
#pragma unroll
              for (int tc = 0; tc < 2; ++tc)
#pragma unroll
                for (int sx = 0; sx < 4; ++sx) { const int n = 64 * h + 32 * tc + r32;
                    Bw[tc][sx] = __builtin_bit_cast(bf16x8, *(const u32x4*)(LT + (size_t)n * 64 + 16 * sx + 8 * hi));
                    Ba[tc][sx] = __builtin_bit_cast(bf16x8, *(const u32x4*)(LT + 512 * 64 + (size_t)n * 64 + 16 * sx + 8 * hi)); }
#pragma unroll
              for (int sx = 0; sx < 4; ++sx) {
                  const bf16x8 Aw = *(const LAS bf16x8*)(lowL + trow * 256 + (((2 * sx + hi) ^ (trow & 7)) << 4));
                  const bf16x8 Aa = *(const LAS bf16x8*)(lowL + trow * 256 + (((8 + 2 * sx + hi) ^ (trow & 7)) << 4));
                  Cw0 = __builtin_amdgcn_mfma_f32_32x32x16_bf16(Aw, Bw[0][sx], Cw0, 0, 0, 0); Cw1 = __builtin_amdgcn_mfma_f32_32x32x16_bf16(Aw, Bw[1][sx], Cw1, 0, 0, 0);
                  Ca0 = __builtin_amdgcn_mfma_f32_32x32x16_bf16(Aa, Ba[0][sx], Ca0, 0, 0, 0); Ca1 = __builtin_amdgcn_mfma_f32_32x32x16_bf16(Aa, Ba[1][sx], Ca1, 0, 0, 0); }
#pragma unroll
              for (int r = 0; r < 16; ++r) { LAS bf16* row = CL + crow(r, hi) * 1024 + 64 * h + r32;
                  row[0] = (bf16)f2bf(Cw0[r]); row[32] = (bf16)f2bf(Cw1[r]); row[512] = (bf16)f2bf(Ca0[r]); row[544] = (bf16)f2bf(Ca1[r]); } }
            __syncthreads();
#pragma unroll 1
            for (int g = 0; g < 4; ++g) {
                const int tl0 = g * 8, mg = m0 + 32 * tr + tl0, tg = t0 + 32 * tr + tl0;
                float cr[8], ck[8], cv[8];
#pragma unroll
                for (int tt = 0; tt < 8; ++tt) { cr[tt] = bf2f(PA[(size_t)(mg + tt) * LDA + c]); ck[tt] = bf2f(PA[(size_t)(mg + tt) * LDA + 512 + c]); cv[tt] = bf2f(PV[(size_t)(mg + tt) * LDV + c]); }
                float rr[8], kkr[8], kp[8], vv[8], av[8], omw[8], red[32];
#pragma unroll
                for (int tt = 0; tt < 8; ++tt) {
                    const float prr = tt ? cr[tt - 1] : pr, prk = tt ? ck[tt - 1] : pk, prv = tt ? cv[tt - 1] : pv;
                    const float r = cr[tt] + (prr - cr[tt]) * mix_r, k = ck[tt] + (prk - ck[tt]) * mix_k; vv[tt] = cv[tt] + (prv - cv[tt]) * mix_v;
                    const float wl = w0c + bf2f(CL[(tl0 + tt) * 1024 + c]), al = a0c + bf2f(CL[(tl0 + tt) * 1024 + 512 + c]);
                    const float z = -wl; const float sp = fmaxf(z, 0.f) + __logf(1.f + __expf(-fabsf(z)));
                    const float e = __expf(-sp - 0.5f); omw[tt] = 1.f - __expf(-e);
                    av[tt] = fast_sigmoid(al);
                    kkr[tt] = k * kkc; kp[tt] = k * (1.f + (av[tt] - 1.f) * kac); rr[tt] = r;
                    red[tt] = kkr[tt] * kkr[tt]; red[8 + tt] = kkr[tt] * av[tt] * r; red[16 + tt] = kp[tt] * r; red[24 + tt] = r * kp[tt] * rkc;
                }
                pr = cr[7]; pk = ck[7]; pv = cv[7];
#pragma unroll
                for (int i = 0; i < 32; ++i) red[i] = row16_sum(red[i]);
#pragma unroll
                for (int o = 16; o < 64; o <<= 1) {
#pragma unroll
                    for (int i = 0; i < 32; ++i) red[i] += __shfl_xor(red[i], o); }
#pragma unroll
                for (int tt = 0; tt < 8; ++tt) {
                    const float inv = 1.f / fmaxf(sqrtf(red[tt]), 1e-12f);
                    const float kk = kkr[tt] * inv, bbv = kk * av[tt], wr = (1.f - omw[tt]) * rr[tt];
                    bf16* rec = SCN + ((size_t)bh * T + tg + tt) * 320 + lane;
                    rec[0] = (bf16)f2bf(kk); rec[64] = (bf16)f2bf(wr); rec[128] = (bf16)f2bf(omw[tt]); rec[192] = (bf16)f2bf(bbv); rec[256] = (bf16)f2bf(kp[tt]);
                    VS[(size_t)(mg + tt) * 512 + c] = (bf16)f2bf(vv[tt]);
                    if (lane == 0) { f32x4 sc = {red[8 + tt] * inv, red[16 + tt], red[24 + tt], 0.f}; *(f32x4*)(SCS + ((size_t)bh * T + tg + tt) * 4) = sc; }
                }
            }
            __syncthreads();
        }
    }
    __syncthreads();
}

__device__ __forceinline__ float dppf(float x, const int ctrl_sel) {
    unsigned u = __float_as_uint(x), r;
    if (ctrl_sel == 0) r = __builtin_amdgcn_update_dpp(0, u, 0xB1, 0xF, 0xF, true);
    else if (ctrl_sel == 1) r = __builtin_amdgcn_update_dpp(0, u, 0x4E, 0xF, 0xF, true);
    else r = __builtin_amdgcn_update_dpp(0, u, 0x141, 0xF, 0xF, true);
    return __uint_as_float(r);
}
__device__ __forceinline__ float red8(float x) { x += dppf(x, 0); x += dppf(x, 1); x += dppf(x, 2); return x; }
constexpr int SC_CH = 32, SC_STEP = 1024, SC_BUF = SC_CH * SC_STEP, SC_VOFF = 2 * SC_BUF, SC_SOFF = SC_VOFF + 2 * SC_CH * 64 * 4, SC_ROWB = SC_SOFF + 2 * SC_CH * 16;
constexpr int NSEG = 16, SEGLEN = T / NSEG;
typedef float f32x4m __attribute__((ext_vector_type(4)));
template <bool PASSC> __device__ __forceinline__ void scan_task(const Args& a, LAS unsigned char* lds, int bh, int seg, int tid, int lane, int wave) {
    const int b = bh >> 3, h = bh & 7;
    const int t0 = seg * SEGLEN;
    const bf16* SCN = (const bf16*)(a.ws + WS_SCN) + ((size_t)bh * T + t0) * 320;
    const float* SCS = (const float*)(a.ws + WS_SCS) + ((size_t)bh * T + t0) * 4;
    const bf16* VS = (const bf16*)(a.ws + WS_VS) + ((size_t)b * T + t0) * 512 + h * 64;
    float* YA = (float*)(a.ws + WS_YA) + ((size_t)b * T + t0) * 512 + h * 64;
    float* FSb = (float*)(a.ws + WS_FS) + (size_t)bh * NSEG * 128 * 64;
    constexpr int NCH = SEGLEN / SC_CH;
    const int n16 = lane & 15, g = lane >> 4;
    const bool ident = !PASSC && wave >= 4;
    const bool active = PASSC ? (wave < 4) : true;
    const int row = 16 * (wave & 3) + n16;
    f32x4 Sf[4];
#pragma unroll
    for (int i = 0; i < 4; ++i) Sf[i] = (f32x4){0.f, 0.f, 0.f, 0.f};
    __syncthreads();
    if constexpr (PASSC) {
        LAS float* rowb = (LAS float*)(lds + SC_ROWB);
        const int crow_ = tid >> 3, kq = (tid & 7) * 8;
        f32x4 c0 = {0.f, 0.f, 0.f, 0.f}, c1 = c0;
        LAS float* pbuf = (LAS float*)lds;
        f32x4 pr0, pr1;
        if (seg > 0) { const float* Pk = FSb + ((size_t)0 * 128 + 64 + crow_) * 64 + kq; pr0 = *(const f32x4*)Pk; pr1 = *(const f32x4*)(Pk + 4); }
        for (int k = 0; k < seg; ++k) {
            const float* Uk = FSb + ((size_t)k * 128 + crow_) * 64 + kq;
            f32x4 a0 = *(const f32x4*)Uk, a1 = *(const f32x4*)(Uk + 4);
            *(LAS f32x4*)(rowb + crow_ * 64 + kq) = c0; *(LAS f32x4*)(rowb + crow_ * 64 + kq + 4) = c1;
            *(LAS f32x4*)(pbuf + crow_ * 64 + kq) = pr0; *(LAS f32x4*)(pbuf + crow_ * 64 + kq + 4) = pr1;
            __syncthreads();
            if (k + 1 < seg) { const float* Pn = FSb + ((size_t)(k + 1) * 128 + 64 + crow_) * 64 + kq; pr0 = *(const f32x4*)Pn; pr1 = *(const f32x4*)(Pn + 4); }
#pragma unroll 4
            for (int jj = 0; jj < 64; ++jj) { const float sj = rowb[crow_ * 64 + jj]; a0 += *(const LAS f32x4*)(pbuf + jj * 64 + kq) * sj; a1 += *(const LAS f32x4*)(pbuf + jj * 64 + kq + 4) * sj; }
            c0 = a0; c1 = a1;
            __syncthreads();
        }
        *(LAS f32x4*)(rowb + crow_ * 64 + kq) = c0; *(LAS f32x4*)(rowb + crow_ * 64 + kq + 4) = c1;
        __syncthreads();
        if (active) {
#pragma unroll
            for (int t4 = 0; t4 < 4; ++t4) Sf[t4] = *(const LAS f32x4*)(rowb + row * 64 + 16 * t4 + 4 * g);
        }
    } else if (ident) {
#pragma unroll
        for (int i = 0; i < 4; ++i)
#pragma unroll
            for (int e = 0; e < 4; ++e) Sf[i][e] = (16 * i + 4 * g + e == row) ? 1.f : 0.f;
    }
    u32x4 mreg[2], breg, kreg; u32x4 vreg = {0u, 0u, 0u, 0u}; f32x4 sreg;
    auto gload = [&](int c) {
        const u32x4* src = (const u32x4*)(SCN + (size_t)c * SC_CH * 320);
        { const int st = tid / 24, q = tid - st * 24; mreg[0] = src[st * 40 + q]; }
        if (tid < 256) { const int jj = 512 + tid, st = jj / 24, q = jj - st * 24; mreg[1] = src[st * 40 + q];
            const int s2 = tid >> 3, e8 = tid & 7; breg = src[s2 * 40 + 24 + e8]; kreg = src[s2 * 40 + 32 + e8]; }
        if (tid < 256) vreg = *(const u32x4*)(VS + (size_t)(c * SC_CH + (tid >> 3)) * 512 + (tid & 7) * 8);
        else if (tid < 288) sreg = *(const f32x4*)(SCS + (size_t)(c * SC_CH + (tid - 256)) * 4);
    };
    auto lwrite = [&](int c) {
        LAS unsigned char* bp = lds + (c & 1) * SC_BUF;
#pragma unroll
        for (int i = 0; i < 2; ++i) { const int jj = tid + 512 * i;
            if (jj < 768) { const int st = jj / 24, q = jj - st * 24, arr = q >> 3, e8 = q & 7; const u32x4 w = mreg[i];
                LAS unsigned char* d = bp + st * SC_STEP;
                if (arr < 2) { *(LAS u32x4*)(d + 256 + arr * 128 + e8 * 16) = w; }
                else { f32x4 lo, hi;
                    lo[0] = bflo(w.x); lo[1] = bfhi(w.x); lo[2] = bflo(w.y); lo[3] = bfhi(w.y); hi[0] = bflo(w.z); hi[1] = bfhi(w.z); hi[2] = bflo(w.w); hi[3] = bfhi(w.w);
                    lo = 1.0f - lo; hi = 1.0f - hi;
                    LAS f32x4* df = (LAS f32x4*)(d + e8 * 32); df[0] = lo; df[1] = hi; } } }
        if (tid < 256) { const int s2 = tid >> 3, e8 = tid & 7; LAS u32x4* d = (LAS u32x4*)(bp + s2 * SC_STEP + 512 + e8 * 64);
            const unsigned bw[4] = {breg.x, breg.y, breg.z, breg.w}, kw[4] = {kreg.x, kreg.y, kreg.z, kreg.w};
#pragma unroll
            for (int pq = 0; pq < 4; ++pq) { const unsigned blo = bw[pq] & 0xffffu, bhi = bw[pq] >> 16, klo = kw[pq] & 0xffffu, khi = kw[pq] >> 16;
                u32x4 o; o.x = klo | (blo << 16); o.y = blo; o.z = khi | (bhi << 16); o.w = bhi; d[pq] = o; } }
        if (tid < 256) { const u32x4 w = vreg; f32x4 lo, hi;
            lo[0] = bflo(w.x); lo[1] = bfhi(w.x); lo[2] = bflo(w.y); lo[3] = bfhi(w.y); hi[0] = bflo(w.z); hi[1] = bfhi(w.z); hi[2] = bflo(w.w); hi[3] = bfhi(w.w);
            LAS f32x4* d = (LAS f32x4*)(lds + SC_VOFF + (c & 1) * (SC_CH * 64 * 4) + tid * 32); d[0] = lo; d[1] = hi; }
        else if (tid < 288) { *(LAS f32x4*)(lds + SC_SOFF + (c & 1) * (SC_CH * 16) + (tid - 256) * 16) = sreg; }
    };
    gload(0); lwrite(0); gload(1);
    __syncthreads();
    LAS float* ybuf = (LAS float*)(lds + SC_ROWB + 16384);
    auto yflush = [&](int c) { const f32x4 yv = *(const LAS f32x4*)(ybuf + (c & 1) * (SC_CH * 64) + tid * 4);
        *(f32x4*)(YA + (size_t)(c * SC_CH + (tid >> 4)) * 512 + (tid & 15) * 4) = yv; };
    for (int c = 0; c < NCH; ++c) {
        if constexpr (PASSC) { if (c > 0) yflush(c - 1); }
        if (c + 1 < NCH) lwrite(c + 1);
        if (c + 2 < NCH) gload(c + 2);
        if (active) {
            const LAS unsigned char* bp = lds + (c & 1) * SC_BUF;
            const LAS float* vb = (const LAS float*)(lds + SC_VOFF + (c & 1) * (SC_CH * 64 * 4)) + row;
            const LAS float* sb = (const LAS float*)(lds + SC_SOFF + (c & 1) * (SC_CH * 16));
#define SC_DECL(X) u32x2 X##a0, X##a1, X##a2, X##a3, X##r0, X##r1, X##r2, X##r3; float X##v; f32x2 X##s
#define SC_LD(X, sidx) do { const LAS unsigned char* p_ = bp + (sidx) * SC_STEP + 256 + g * 8; \
                X##a0 = *(const LAS u32x2*)(p_); X##a1 = *(const LAS u32x2*)(p_ + 32); X##a2 = *(const LAS u32x2*)(p_ + 64); X##a3 = *(const LAS u32x2*)(p_ + 96); \
                if constexpr (PASSC) { X##r0 = *(const LAS u32x2*)(p_ + 128); X##r1 = *(const LAS u32x2*)(p_ + 160); X##r2 = *(const LAS u32x2*)(p_ + 192); X##r3 = *(const LAS u32x2*)(p_ + 224); X##s = *(const LAS f32x2*)(sb + (sidx) * 4); } \
                X##v = ident ? 0.f : vb[(sidx) * 64]; } while (0)
#define SC_STEPM(X, Y, sidx, ldnext) do { const LAS unsigned char* p_ = bp + (sidx) * SC_STEP; \
                const f32x4 w0_ = *(const LAS f32x4*)(p_ + g * 16), w1_ = *(const LAS f32x4*)(p_ + 64 + g * 16), w2_ = *(const LAS f32x4*)(p_ + 128 + g * 16), w3_ = *(const LAS f32x4*)(p_ + 192 + g * 16); \
                const s16x4 f0_ = *(const LAS s16x4*)(p_ + 512 + n16 * 8), f1_ = *(const LAS s16x4*)(p_ + 640 + n16 * 8), f2_ = *(const LAS s16x4*)(p_ + 768 + n16 * 8), f3_ = *(const LAS s16x4*)(p_ + 896 + n16 * 8); \
                if (ldnext) SC_LD(Y, (sidx) + 1); \
                u32x4 sb0, sb1; \
                sb0.x = cvtpk(Sf[0][0], Sf[0][1]); sb0.y = cvtpk(Sf[0][2], Sf[0][3]); sb0.z = cvtpk(Sf[1][0], Sf[1][1]); sb0.w = cvtpk(Sf[1][2], Sf[1][3]); \
                sb1.x = cvtpk(Sf[2][0], Sf[2][1]); sb1.y = cvtpk(Sf[2][2], Sf[2][3]); sb1.z = cvtpk(Sf[3][0], Sf[3][1]); sb1.w = cvtpk(Sf[3][2], Sf[3][3]); \
                const bf16x8 B0 = __builtin_bit_cast(bf16x8, sb0), B1 = __builtin_bit_cast(bf16x8, sb1); \
                const bf16x8 A0 = __builtin_bit_cast(bf16x8, (u32x4){X##a0.x, X##a0.y, X##a1.x, X##a1.y}), A1 = __builtin_bit_cast(bf16x8, (u32x4){X##a2.x, X##a2.y, X##a3.x, X##a3.y}); \
                f32x4m acc = {0.f, 0.f, 0.f, 0.f}, accy = {0.f, 0.f, 0.f, 0.f}; \
                acc = __builtin_amdgcn_mfma_f32_16x16x32_bf16(A0, B0, acc, 0, 0, 0); \
                if constexpr (PASSC) { const bf16x8 R0 = __builtin_bit_cast(bf16x8, (u32x4){X##r0.x, X##r0.y, X##r1.x, X##r1.y}); accy = __builtin_amdgcn_mfma_f32_16x16x32_bf16(R0, B0, accy, 0, 0, 0); } \
                acc = __builtin_amdgcn_mfma_f32_16x16x32_bf16(A1, B1, acc, 0, 0, 0); \
                if constexpr (PASSC) { const bf16x8 R1 = __builtin_bit_cast(bf16x8, (u32x4){X##r2.x, X##r2.y, X##r3.x, X##r3.y}); accy = __builtin_amdgcn_mfma_f32_16x16x32_bf16(R1, B1, accy, 0, 0, 0); } \
                const f32x4 c0_ = Sf[0] * w0_, c1_ = Sf[1] * w1_, c2_ = Sf[2] * w2_, c3_ = Sf[3] * w3_; \
                const float sa = acc[0]; \
                const unsigned sahi = f2bf(sa); const float salo = sa - __uint_as_float(sahi << 16); \
                u32x2 bu; bu.x = (__float_as_uint(X##v) >> 16) | ((sahi ^ 0x8000u) << 16); bu.y = f2bf(-salo); \
                if (g != 0) { bu.x = 0u; bu.y = 0u; } \
                const s16x4 Bu = __builtin_bit_cast(s16x4, bu); \
                Sf[0] = __builtin_amdgcn_mfma_f32_16x16x16bf16_1k(f0_, Bu, c0_, 0, 0, 0); Sf[1] = __builtin_amdgcn_mfma_f32_16x16x16bf16_1k(f1_, Bu, c1_, 0, 0, 0); \
                Sf[2] = __builtin_amdgcn_mfma_f32_16x16x16bf16_1k(f2_, Bu, c2_, 0, 0, 0); Sf[3] = __builtin_amdgcn_mfma_f32_16x16x16bf16_1k(f3_, Bu, c3_, 0, 0, 0); \
                if constexpr (PASSC) { const float y = accy[0] - sa * X##s.x + X##v * X##s.y; ybuf[(c & 1) * (SC_CH * 64) + (sidx) * 64 + row] = y; } } while (0)
            SC_DECL(oA); SC_DECL(oB);
            SC_LD(oA, 0);
#pragma unroll 1
            for (int s = 0; s < SC_CH; s += 2) {
                SC_STEPM(oA, oB, s, true);
                __builtin_amdgcn_sched_barrier(0);
                SC_STEPM(oB, oA, s + 1, (s + 2 < SC_CH));
                __builtin_amdgcn_sched_barrier(0);
            }
#undef SC_DECL
#undef SC_LD
#undef SC_STEPM
        }
        __syncthreads();
    }
    if constexpr (PASSC) yflush(NCH - 1);
    if constexpr (!PASSC) { float* fp = FSb + ((size_t)seg * 128 + (ident ? 64 : 0) + row) * 64 + 4 * g;
#pragma unroll
        for (int t4 = 0; t4 < 4; ++t4) *(f32x4*)(fp + 16 * t4) = Sf[t4]; }
}

typedef short v4i16_t __attribute__((ext_vector_type(4)));
__device__ __forceinline__ s16x4 vtr(const LAS unsigned char* p) { return __builtin_bit_cast(s16x4, __builtin_amdgcn_ds_read_tr16_b64_v4i16((LAS v4i16_t*)p)); }
constexpr int AT_KS = 0, AT_VS = 9216, AT_BIAS = 18432, AT_WSF = 18688, AT_FLAG = 19712, AT_TASK = 140000;
__device__ __forceinline__ void attn_unit(const Args& a, LAS unsigned char* lds, int l, int bh, int qb, int tid, int lane, int wid) {
    const int b = bh >> 3, h = bh & 7, r32 = lane & 31, hi = lane >> 5;
    const int q0 = qb * 256;
    bf16* PB = (bf16*)(a.ws + WS_PB);
    const float* cumh = (const float*)(a.ws + WS_CUM) + (size_t)bh * T;
    const float kmax = ((const float*)(a.ws + WS_CTL))[CW_KMAX + 16 * l + bh];
    const size_t rowbase = (size_t)b * T;
    const bf16* Qp = PB + (rowbase + q0 + wid * 32 + r32) * LDB + h * 64;
    bf16x8 qr[4]; float qs = 0.f;
#pragma unroll
    for (int d0 = 0; d0 < 4; ++d0) { const u32x4 w = *(const u32x4*)(Qp + d0 * 16 + hi * 8); qr[d0] = __builtin_bit_cast(bf16x8, w);
        qs += bflo(w.x) * bflo(w.x) + bfhi(w.x) * bfhi(w.x) + bflo(w.y) * bflo(w.y) + bfhi(w.y) * bfhi(w.y) + bflo(w.z) * bflo(w.z) + bfhi(w.z) * bfhi(w.z) + bflo(w.w) * bflo(w.w) + bfhi(w.w) * bfhi(w.w); }
    qs += __shfl_xor(qs, 32);
    const float qbound = sqrtf(qs) * kmax * 1.01f + 0.01f;
    const float ref = cumh[q0 + 255];
    const int srow = tid >> 3, sch = tid & 7;
    const bf16* Kg = PB + rowbase * LDB + 512 + h * 64 + sch * 8; const bf16* Vg = Kg + 512;
    LAS unsigned char* Ks = lds + AT_KS; LAS unsigned char* Vs = lds + AT_VS; LAS float* biasL = (LAS float*)(lds + AT_BIAS);
    LAS float* wsf = (LAS float*)(lds + AT_WSF) + wid * 32; volatile LAS unsigned* flag = (volatile LAS unsigned*)(lds + AT_FLAG);
    if (tid < 3) flag[tid] = 0u;
    float m = -INFINITY, lsum = 0.f; f32x16 o0 = {}, o1 = {};
    u32x4 kreg, vreg; float breg = 0.f, bnx = 0.f;
    int j = qb * 4 + 3;
    { kreg = *(const u32x4*)(Kg + (size_t)(64 * j + srow) * LDB); vreg = *(const u32x4*)(Vg + (size_t)(64 * j + srow) * LDB);
      if (tid < 64) breg = (ref - cumh[64 * j + tid]) * L2E; bnx = j > 0 ? (ref - cumh[64 * j - 1]) * L2E : 0.f; }
    const int q4 = (lane & 15) >> 2, p4 = lane & 3, blk = (lane >> 4) & 1;
    const int qrow = q0 + wid * 32 + r32;
    int it = 0;
    __syncthreads();
    for (;;) {
        *(LAS u32x4*)(Ks + srow * 144 + sch * 16) = kreg; *(LAS u32x4*)(Vs + srow * 144 + sch * 16) = vreg; if (tid < 64) biasL[tid] = breg;
        const float bnx_cur = bnx;
        __syncthreads();
        if (j > 0) { const int jn = j - 1;
            kreg = *(const u32x4*)(Kg + (size_t)(64 * jn + srow) * LDB); vreg = *(const u32x4*)(Vg + (size_t)(64 * jn + srow) * LDB);
            if (tid < 64) breg = (ref - cumh[64 * jn + tid]) * L2E; bnx = jn > 0 ? (ref - cumh[64 * jn - 1]) * L2E : 0.f; }
        if (64 * j <= q0 + 32 * wid + 31) {
            f32x16 p0 = {}, p1 = {};
#pragma unroll
            for (int d0 = 0; d0 < 4; ++d0) {
                const bf16x8 k0 = *(const LAS bf16x8*)(Ks + r32 * 144 + d0 * 32 + hi * 16);
                const bf16x8 k1 = *(const LAS bf16x8*)(Ks + (32 + r32) * 144 + d0 * 32 + hi * 16);
                p0 = __builtin_amdgcn_mfma_f32_32x32x16_bf16(k0, qr[d0], p0, 0, 0, 0);
                p1 = __builtin_amdgcn_mfma_f32_32x32x16_bf16(k1, qr[d0], p1, 0, 0, 0); }
#pragma unroll
            for (int g = 0; g < 4; ++g) { const f32x4 b0 = *(const LAS f32x4*)(biasL + 8 * g + 4 * hi), b1 = *(const LAS f32x4*)(biasL + 32 + 8 * g + 4 * hi);
#pragma unroll
                for (int e = 0; e < 4; ++e) { p0[4 * g + e] += b0[e]; p1[4 * g + e] += b1[e]; } }
            if (64 * j + 63 > q0 + 32 * wid) {
#pragma unroll
                for (int r = 0; r < 16; ++r) { const int kv = 64 * j + crow(r, hi); if (kv > qrow) p0[r] = -INFINITY; if (kv + 32 > qrow) p1[r] = -INFINITY; } }
            float mx = fmaxf(p0[0], p1[0]);
#pragma unroll
            for (int r = 1; r < 16; ++r) mx = fmaxf(mx, fmaxf(p0[r], p1[r]));
            mx = fmaxf(mx, __shfl_xor(mx, 32));
            const float mnew = fmaxf(m, mx); const float f = __builtin_amdgcn_exp2f(m - mnew); m = mnew;
            float rs = 0.f;
#pragma unroll
            for (int r = 0; r < 16; ++r) { p0[r] = __builtin_amdgcn_exp2f(p0[r] - mnew); p1[r] = __builtin_amdgcn_exp2f(p1[r] - mnew); rs += p0[r] + p1[r]; }
            lsum = lsum * f + rs;
            if (__any(f != 1.f)) {
                if (hi == 0) wsf[r32] = f;
                asm volatile("s_waitcnt lgkmcnt(0)" ::: "memory");
#pragma unroll
                for (int r = 0; r < 16; ++r) { const float fr = wsf[crow(r, hi)]; o0[r] *= fr; o1[r] *= fr; }
            }
            u32x4 pw[4];
            pw[0] = (u32x4){cvtpk(p0[0], p0[1]), cvtpk(p0[2], p0[3]), cvtpk(p0[4], p0[5]), cvtpk(p0[6], p0[7])};
            pw[1] = (u32x4){cvtpk(p0[8], p0[9]), cvtpk(p0[10], p0[11]), cvtpk(p0[12], p0[13]), cvtpk(p0[14], p0[15])};
            pw[2] = (u32x4){cvtpk(p1[0], p1[1]), cvtpk(p1[2], p1[3]), cvtpk(p1[4], p1[5]), cvtpk(p1[6], p1[7])};
            pw[3] = (u32x4){cvtpk(p1[8], p1[9]), cvtpk(p1[10], p1[11]), cvtpk(p1[12], p1[13]), cvtpk(p1[14], p1[15])};
#pragma unroll
            for (int s = 0; s < 4; ++s) { const int kvb = 16 * (s & 1) + 32 * (s >> 1);
                const LAS unsigned char* va = Vs + (kvb + 4 * hi + q4) * 144 + (16 * blk + 4 * p4) * 2;
                const s16x4 l0 = vtr(va), h0 = vtr(va + 8 * 144), l1 = vtr(va + 64), h1 = vtr(va + 8 * 144 + 64);
                const bf16x8 vf0 = {l0[0], l0[1], l0[2], l0[3], h0[0], h0[1], h0[2], h0[3]}, vf1 = {l1[0], l1[1], l1[2], l1[3], h1[0], h1[1], h1[2], h1[3]};
                const bf16x8 pa = __builtin_bit_cast(bf16x8, pw[s]);
                o0 = __builtin_amdgcn_mfma_f32_32x32x16_bf16(pa, vf0, o0, 0, 0, 0);
                o1 = __builtin_amdgcn_mfma_f32_32x32x16_bf16(pa, vf1, o1, 0, 0, 0); }
        }
        if (j == 0) break;
        const bool need = (qbound + bnx_cur > m - 40.f);
        if (tid == 0) flag[(it + 1) % 3] = 0u;
        if (__any(need) && lane == 0) flag[it % 3] = 1u;
        __syncthreads();
        const unsigned cont = flag[it % 3];
        if (!cont) break;
        --j; ++it;
    }
    lsum += __shfl_xor(lsum, 32);
    if (hi == 0) wsf[r32] = 1.f / lsum;
    asm volatile("s_waitcnt lgkmcnt(0)" ::: "memory");
    bf16* Ow = (bf16*)(a.ws + WS_PV) + (rowbase + q0 + wid * 32) * LDV + h * 64 + r32;
#pragma unroll
    for (int r = 0; r < 16; ++r) { const float inv = wsf[crow(r, hi)]; bf16* op = Ow + (size_t)crow(r, hi) * LDV;
        op[0] = (bf16)f2bf(o0[r] * inv); op[32] = (bf16)f2bf(o1[r] * inv); }
    __syncthreads();
}
__device__ __forceinline__ void p3a_phase(const Args& a, LAS unsigned char* lds, int l, int tid, int lane, int wave) {
    unsigned* ctr = (unsigned*)(a.ws + WS_CTL) + CW_QUEUE + 64 * l;
    volatile LAS unsigned* task = (volatile LAS unsigned*)(lds + AT_TASK);
    for (;;) {
        __syncthreads();
        if (tid == 0) task[0] = atomicAdd(ctr, 1u);
        __syncthreads();
        const unsigned tk = task[0];
        if (tk >= 240u + 1024u) break;
        int t2 = tid; asm volatile("" : "+v"(t2)); const int lane2 = t2 & 63;
        if (tk < 240u) { scan_task<false>(a, lds, (int)(tk / 15u), (int)(tk % 15u), t2, lane2, wave); }
        else { const unsigned u = tk - 240u; attn_unit(a, lds, l, (int)(u & 15), 63 - (int)(u >> 4), t2, lane2, wave); }
    }
}
__device__ __forceinline__ void p3b_phase(const Args& a, LAS unsigned char* lds, int l, int tid, int lane, int wave) {
    unsigned* ctr = (unsigned*)(a.ws + WS_CTL) + CW_QUEUE + 512 + 64 * l;
    volatile LAS unsigned* task = (volatile LAS unsigned*)(lds + AT_TASK);
    for (;;) {
        __syncthreads();
        if (tid == 0) task[0] = atomicAdd(ctr, 1u);
        __syncthreads();
        const unsigned tk = task[0];
        if (tk >= 256u) break;
        scan_task<true>(a, lds, (int)(tk >> 4), (int)(tk & 15), tid, lane, wave);
    }
}

__device__ __forceinline__ float red16m(float x) {
    x += __uint_as_float(__builtin_amdgcn_update_dpp(0, __float_as_uint(x), 0xB1, 0xF, 0xF, true));
    x += __uint_as_float(__builtin_amdgcn_update_dpp(0, __float_as_uint(x), 0x4E, 0xF, 0xF, true));
    x += __uint_as_float(__builtin_amdgcn_update_dpp(0, __float_as_uint(x), 0x141, 0xF, 0xF, true));
    x += __uint_as_float(__builtin_amdgcn_update_dpp(0, __float_as_uint(x), 0x140, 0xF, 0xF, true));
    return x;
}
__device__ __forceinline__ void merge_phase(const Args& a, int l, int tid, int lane, int wave, int G) {
    const float* YA = (const float*)(a.ws + WS_YA); const bf16* VS = (const bf16*)(a.ws + WS_VS); const bf16* PB = (const bf16*)(a.ws + WS_PB);
    const bf16* PVo = (const bf16*)(a.ws + WS_PV);
    const float* SCS = (const float*)(a.ws + WS_SCS); bf16* YM = (bf16*)(a.ws + WS_YM);
    const int hd = 4 * (wave & 1) + (lane >> 4), c0 = hd * 64 + 4 * (lane & 15), tsub = wave >> 1;
    const f32x4 gg = *(const f32x4*)(a.in[15] + l * 512 + c0), gb = *(const f32x4*)(a.in[16] + l * 512 + c0);
    constexpr int MT = 4;
    for (int mb = blockIdx.x * (4 * MT); mb < M; mb += G * (4 * MT)) {
        f32x4 ya[MT]; u32x2 vv[MT], g1[MT], g2[MT], yb[MT]; float rkr[MT], mean[MT], var[MT];
#pragma unroll
        for (int u = 0; u < MT; ++u) { const int m = mb + 4 * u + tsub; const int b = m >= T ? 1 : 0, t = m - b * T;
            ya[u] = *(const f32x4*)(YA + (size_t)m * 512 + c0); vv[u] = *(const u32x2*)(VS + (size_t)m * 512 + c0);
            g1[u] = *(const u32x2*)(PB + (size_t)m * LDB + 1536 + c0); g2[u] = *(const u32x2*)(PB + (size_t)m * LDB + 2048 + c0);
            yb[u] = *(const u32x2*)(PVo + (size_t)m * LDV + c0);
            rkr[u] = SCS[((size_t)(b * 8 + hd) * T + t) * 4 + 2]; }
#pragma unroll
        for (int u = 0; u < MT; ++u) mean[u] = red16m((ya[u][0] + ya[u][1]) + (ya[u][2] + ya[u][3])) * (1.f / 64.f);
#pragma unroll
        for (int u = 0; u < MT; ++u) { const f32x4 d = ya[u] - mean[u]; var[u] = red16m((d[0] * d[0] + d[1] * d[1]) + (d[2] * d[2] + d[3] * d[3])) * (1.f / 64.f); }
#pragma unroll
        for (int u = 0; u < MT; ++u) { const int m = mb + 4 * u + tsub; const float rs = rsqrtf(var[u] + GN_EPS);
            f32x4 v4 = {bflo(vv[u].x), bfhi(vv[u].x), bflo(vv[u].y), bfhi(vv[u].y)};
            f32x4 ga = {bflo(g1[u].x), bfhi(g1[u].x), bflo(g1[u].y), bfhi(g1[u].y)}, gbv = {bflo(g2[u].x), bfhi(g2[u].x), bflo(g2[u].y), bfhi(g2[u].y)};
            f32x4 y2 = {bflo(yb[u].x), bfhi(yb[u].x), bflo(yb[u].y), bfhi(yb[u].y)};
            const f32x4 yn = ((ya[u] - mean[u]) * rs * gg + gb + v4 * rkr[u]) * ga; const f32x4 yo = y2 * gbv;
            u32x2 o1 = {pk2(yn[0], yn[1]), pk2(yn[2], yn[3])}, o2 = {pk2(yo[0], yo[1]), pk2(yo[2], yo[3])};
            *(u32x2*)(YM + (size_t)m * D + c0) = o1; *(u32x2*)(YM + (size_t)m * D + 512 + c0) = o2; }
    }
}

#ifndef N_LAUNCH_MODE
#define N_LAUNCH_MODE 1
#endif
template <int MASK, bool COOP> __device__ __forceinline__ void run_phases(const Args& a, LAS unsigned char* lds, int l0, int l1) {
    const int G = gridDim.x;
#define LAUNDER() int tid = threadIdx.x; asm volatile("" : "+v"(tid)); const int lane = tid & 63, wave = __builtin_amdgcn_readfirstlane(tid >> 6); (void)lane; (void)wave
    float* hbuf = a.out;
    const float* mod = (const float*)(a.ws + WS_CTL) + CW_MOD;
    bf16* XN = (bf16*)(a.ws + WS_XN);
#define GSYNC() do { if constexpr (COOP) cg::this_grid().sync(); } while (0)
    if constexpr (MASK & 1) { LAUNDER(); p0a(a, lds, tid, lane, wave, G); GSYNC(); }
    if constexpr (MASK & 2) { LAUNDER(); ln_rows(a.in[0], a.in[2], a.in[3], hbuf, XN, mod, lane, wave, G); GSYNC(); }
#pragma unroll 1
    for (int l = l0; l < l1; ++l) {
        for (int rep = 0; rep < ((PROBE_REP & 4) ? 2 : 1); ++rep)
        if constexpr (MASK & 4) { pg8::Gemm g{XN, (const bf16*)(a.ws + WS_WIN) + (size_t)l * NPROJ * 1024, M, NPROJ, 1024}; pg8::StaticOrder S; S.init(M, NPROJ, G, (int)blockIdx.x);
          EpiProj E{(bf16*)(a.ws + WS_PA), (bf16*)(a.ws + WS_PV), (bf16*)(a.ws + WS_PB)};
          pg8::gemm_phase<EpiProj, pg8::StaticOrder, true, true>(lds, g, S, E); GSYNC(); }
        for (int rep = 0; rep < ((PROBE_REP & 8) ? 2 : 1); ++rep)
        if constexpr (MASK & 8) { LAUNDER(); prep_phase(a, lds, l, tid, lane, wave, G); GSYNC(); }
        if constexpr (MASK & 16) { { LAUNDER(); p3a_phase(a, lds, l, tid, lane, wave); } GSYNC(); { LAUNDER(); p3b_phase(a, lds, l, tid, lane, wave); } GSYNC(); }
        for (int rep = 0; rep < ((PROBE_REP & 32) ? 2 : 1); ++rep)
        if constexpr (MASK & 32) { LAUNDER(); merge_phase(a, l, tid, lane, wave, G); GSYNC(); }
        if constexpr (MASK & 64) { pg8::Gemm g{(const bf16*)(a.ws + WS_YM), (const bf16*)(a.ws + WS_WOUT) + (size_t)l * 1024 * 1024, M, D, D}; pg8::StaticOrder S; S.init(M, D, G, (int)blockIdx.x);
          EpiOut E{hbuf, mod + l * 2 * 3072};
          pg8::gemm_phase<EpiOut, pg8::StaticOrder, true, true>(lds, g, S, E); GSYNC(); }
        if constexpr (MASK & 128) { LAUNDER(); ln_rows(hbuf, a.in[19] + l * D, a.in[20] + l * D, hbuf, XN, (l + 1 < DEPTH) ? mod + (l + 1) * 2 * 3072 : nullptr, lane, wave, G);
          if (l + 1 < l1) GSYNC(); }
    }
#undef GSYNC
#undef LAUNDER
}
#ifndef FMASK
#define FMASK 0xFF
#endif
#if N_LAUNCH_MODE == 1
__global__ void __launch_bounds__(512, 2) hymba_fwd(Args a) {
    extern __shared__ __attribute__((aligned(16))) unsigned char lds_raw[];
    run_phases<FMASK, true>(a, (LAS unsigned char*)lds_raw, 0, DEPTH);
}
#else
template <int MASK> __global__ void __launch_bounds__(512, 2) hymba_phase(Args a, int l) {
    extern __shared__ __attribute__((aligned(16))) unsigned char lds_raw[];
    run_phases<MASK, false>(a, (LAS unsigned char*)lds_raw, l, l + 1);
}
template <int MASK> static void launch_phase(const Args& a, int l, hipStream_t stream) {
    static bool attr = false;
    if (!attr) { (void)hipFuncSetAttribute((const void*)hymba_phase<MASK>, hipFuncAttributeMaxDynamicSharedMemorySize, LDS_BYTES); attr = true; }
    hipLaunchKernelGGL(hymba_phase<MASK>, dim3(256), dim3(512), LDS_BYTES, stream, a, l);
}
#endif

extern "C" void kernel_launch(void* const* d_in, const int* in_sizes, int n_in, void* d_out, int out_size, void* d_ws, size_t ws_size, hipStream_t stream) {
    if (n_in != 21 || ws_size < WS_END) { fprintf(stderr, "kernel_launch: unexpected n_in %d / ws %zu\n", n_in, ws_size); return; }
    (void)hipMemsetAsync((char*)d_ws + WS_CTL, 0, CTL_ZERO_BYTES, stream);
    Args a{};
    for (int i = 0; i < 21; ++i) a.in[i] = (const float*)d_in[i];
    a.out = (float*)d_out; a.ws = (unsigned char*)d_ws;
#if N_LAUNCH_MODE == 1
    static int grid = 0;
    if (grid == 0) {
        int dev = 0, cus = 0, per_cu = 0;
        (void)hipGetDevice(&dev); (void)hipDeviceGetAttribute(&cus, hipDeviceAttributeMultiprocessorCount, dev);
        (void)hipFuncSetAttribute((const void*)hymba_fwd, hipFuncAttributeMaxDynamicSharedMemorySize, LDS_BYTES);
        (void)hipOccupancyMaxActiveBlocksPerMultiprocessor(&per_cu, (const void*)hymba_fwd, 512, LDS_BYTES);
        if (per_cu < 1) per_cu = 1;
        (void)hipGetLastError();
        grid = cus * per_cu;
    }
    void* args[] = {&a};
    hipError_t e = hipLaunchCooperativeKernel((const void*)hymba_fwd, dim3(grid), dim3(512), args, LDS_BYTES, stream);
    if (e != hipSuccess) fprintf(stderr, "cooperative launch failed: %s (grid %d)\n", hipGetErrorString(e), grid);
#else
    launch_phase<1>(a, 0, stream); launch_phase<2>(a, 0, stream);
    for (int l = 0; l < DEPTH; ++l) { launch_phase<4>(a, l, stream); launch_phase<8>(a, l, stream); launch_phase<16>(a, l, stream); launch_phase<32>(a, l, stream); launch_phase<64>(a, l, stream); launch_phase<128>(a, l, stream); }
#endif
}
```

```cpp
#include <hip/hip_runtime.h>
#include <cstdio>
#include <cstdint>
namespace pg8 {
#define PG8_LAS __attribute__((address_space(3)))
typedef unsigned short bf16_t;
typedef short bf16x8 __attribute__((ext_vector_type(8)));
typedef float f32x4 __attribute__((ext_vector_type(4)));
typedef unsigned u32x4 __attribute__((ext_vector_type(4)));
constexpr int BM = 256, BK = 64, HALF = 128, HTB = HALF * BK * 2  , STAGE_BYTES = 8 * HTB, NXCD = 8, WGM = 8;

__host__ __device__ __forceinline__ int lds_byte(int r, int c) { const int st = (r >> 4) * 2 + (c >> 5), rr = r & 15, cc = c & 31, ob = rr * 64 + cc * 2; return st * 1024 + (ob ^ (((ob >> 9) & 1) << 5)); }
__host__ __device__ __forceinline__ void stage_rc(int b, int& R, int& C) { const int st = b / 1024, sb = b % 1024, swz = sb ^ (((sb >> 9) & 1) << 5); R = (st >> 1) * 16 + swz / 64; C = (st & 1) * 32 + (swz % 64) / 2; }
__host__ __device__ __forceinline__ int perm32(int rho) { const int n = rho >> 4, i = rho & 15; return 8 * (i >> 2) + 4 * n + (i & 3); }

struct Unit { int pm, pn; };
struct Gemm { const bf16_t* A; const bf16_t* Bt; int M, N, K; };

struct StaticOrder {
    int nM, nN, nwg, G, c;
    __host__ __device__ void init(int M, int N, int G_, int c_) { nM = M / BM; nN = N / BM; nwg = nM * nN; G = G_; c = c_; }
    __host__ __device__ bool next(int i, Unit& u) const {
        const long L = (long)i * G + c; if (L >= nwg) return false;
        int wgid = (int)L; { const int q = nwg / NXCD, r = nwg % NXCD, xcd = wgid % NXCD, off = wgid / NXCD; wgid = (xcd < r ? xcd * (q + 1) : r * (q + 1) + (xcd - r) * q) + off; }
        const int nig = WGM * nN, gid = wgid / nig, fm = gid * WGM, gsz = (nM - fm) < WGM ? (nM - fm) : WGM;
        u.pm = fm + ((wgid % nig) % gsz); u.pn = (wgid % nig) / gsz; return true;
    }
    __device__ __forceinline__ void a_ready(const Unit&) const {}
    __device__ __forceinline__ void done(const Unit&) const {}
};

__device__ __forceinline__ unsigned cvt_pk_bf16(float lo, float hi) { unsigned r; asm volatile("v_cvt_pk_bf16_f32 %0, %1, %2" : "=v"(r) : "v"(lo), "v"(hi)); return r; }
typedef float f32x2 __attribute__((ext_vector_type(2)));
__device__ __forceinline__ f32x2 gelu_pk(f32x2 v) {
    const f32x2 av = __builtin_elementwise_abs(v), d = av * 0.2316418882f + 1.0f;
    f32x2 t; t.x = __builtin_amdgcn_rcpf(d.x); t.y = __builtin_amdgcn_rcpf(d.y);
    f32x2 q = t * 0.5307027145f + (-0.7265760135f); q = q * t + 0.7107068705f; q = q * t + (-0.142248368f); q = q * t + 0.127414796f; q = q * t;
    const f32x2 s = (v * v) * (-0.72134752044f);
    f32x2 e; e.x = __builtin_amdgcn_exp2f(s.x); e.y = __builtin_amdgcn_exp2f(s.y);
    const f32x2 m = v * (q * e), r = v - m;
    f32x2 o; o.x = v.x < 0.f ? m.x : r.x; o.y = v.y < 0.f ? m.y : r.y; return o;
}

template <int ACT  > struct EpiBf16 {
    static constexpr bool PERM = true, AFTER_DRAIN = false; static_assert(ACT == 0 || ACT == 1, "EpiBf16: ACT is 0 (none) or 1 (gelu_pk)");
    bf16_t* O; int ldc; const float* bias; int split_cols; size_t split_stride; float scale0;
    __device__ __forceinline__ void operator()(const f32x4 (&acc)[2][2][4][2], const Unit& u, int wr, int wc, int fr, int fq) const {
        const int row0 = u.pm * BM + wr * 64 + fr; int colt = u.pn * BM; bf16_t* base = O;
        float sc = 1.f; if (split_cols) { const int t = colt / split_cols; base += (size_t)t * split_stride; colt -= t * split_cols; if (t == 0) sc = scale0; }
        const int col0 = colt + wc * 32 + 8 * fq, bcol0 = u.pn * BM + wc * 32 + 8 * fq;
        f32x4 bv[2][2];
#pragma unroll
        for (int bj = 0; bj < 2; ++bj)
#pragma unroll
            for (int n = 0; n < 2; ++n) bv[bj][n] = bias ? *(const f32x4*)(bias + bcol0 + bj * HALF + 4 * n) : (f32x4){0.f, 0.f, 0.f, 0.f};
#pragma unroll
        for (int ai = 0; ai < 2; ++ai)
#pragma unroll
            for (int m = 0; m < 4; ++m) { bf16_t* rowp = base + (size_t)(row0 + ai * HALF + m * 16) * ldc + col0;
#pragma unroll
                for (int bj = 0; bj < 2; ++bj) { f32x4 v0 = acc[ai][bj][m][0] + bv[bj][0], v1 = acc[ai][bj][m][1] + bv[bj][1];
                    if (ACT == 1) { f32x2 a = gelu_pk((f32x2){v0[0], v0[1]}), b = gelu_pk((f32x2){v0[2], v0[3]}), c = gelu_pk((f32x2){v1[0], v1[1]}), d = gelu_pk((f32x2){v1[2], v1[3]});
                        v0 = (f32x4){a.x, a.y, b.x, b.y}; v1 = (f32x4){c.x, c.y, d.x, d.y}; }
                    v0 = v0 * sc; v1 = v1 * sc; u32x4 w; w.x = cvt_pk_bf16(v0[0], v0[1]); w.y = cvt_pk_bf16(v0[2], v0[3]); w.z = cvt_pk_bf16(v1[0], v1[1]); w.w = cvt_pk_bf16(v1[2], v1[3]);
                    *(u32x4*)(rowp + bj * HALF) = w; } }
    }
};

template <class Epi, class Sched, bool ALIGN_EPI = false, bool SP2 = false>
__device__ __forceinline__ void gemm_phase(PG8_LAS unsigned char* lds, const Gemm g, const Sched& S, const Epi& E) {
    int tid = threadIdx.x; asm volatile("" : "+v"(tid));
    const int wid = __builtin_amdgcn_readfirstlane(tid >> 6), lane = tid & 63, wr = wid >> 2, wc = wid & 3, fr = lane & 15, fq = lane >> 4;
    const int K = g.K, nt = K / BK;
    unsigned voffA[2], voffB[2];
#pragma unroll
    for (int i = 0; i < 2; ++i) { int R, C; stage_rc(tid * 16 + i * 8192, R, C); const int Rb = Epi::PERM ? ((R & ~31) + perm32(R & 31)) : R;
        voffA[i] = (unsigned)(R * K + C) * 2u; voffB[i] = (unsigned)(Rb * K + C) * 2u; }
    const size_t kstep = (size_t)(BK * 2);
    const size_t hstep = (size_t)HALF * K * 2;
    const size_t tstep = 2 * hstep;
    const unsigned ldsw = (unsigned)wid * 1024u;
    const int aoff = lds_byte(wr * 64 + fr, fq * 8), boff = lds_byte(wc * 32 + fr, fq * 8);
#define PG8_SA(b, h) (((b) * 2 + (h)) * HTB)
#define PG8_SB(b, h) ((4 + (b) * 2 + (h)) * HTB)
#define PG8_STAGE(bufoff, gbase, voff) do { _Pragma("unroll") for (int _i = 0; _i < 2; ++_i) \
        __builtin_amdgcn_global_load_lds((const unsigned*)((const char*)(gbase) + (voff)[_i]), (PG8_LAS unsigned*)(lds + (bufoff) + ldsw + _i * 8192), 16, 0, 0); } while (0)
#define PG8_LDA(dst, b, h) do { _Pragma("unroll") for (int m = 0; m < 4; ++m) _Pragma("unroll") for (int k = 0; k < 2; ++k) dst[m][k] = *(const PG8_LAS bf16x8*)(lds + PG8_SA(b, h) + aoff + m * 2048 + k * 1024); } while (0)
#define PG8_LDB(dst, b, h) do { _Pragma("unroll") for (int n = 0; n < 2; ++n) _Pragma("unroll") for (int k = 0; k < 2; ++k) dst[n][k] = *(const PG8_LAS bf16x8*)(lds + PG8_SB(b, h) + boff + n * 2048 + k * 1024); } while (0)
#define PG8_MMA(ai, bj, At, Bt) do { __builtin_amdgcn_s_setprio(1); _Pragma("unroll") for (int m = 0; m < 4; ++m) _Pragma("unroll") for (int n = 0; n < 2; ++n) _Pragma("unroll") for (int k = 0; k < 2; ++k) \
        acc[ai][bj][m][n] = __builtin_amdgcn_mfma_f32_16x16x32_bf16(Bt[n][k], At[m][k], acc[ai][bj][m][n], 0, 0, 0); __builtin_amdgcn_s_setprio(0); } while (0)
#define PG8_WAIT_V(n) asm volatile("s_waitcnt vmcnt(" #n ")" ::: "memory")
#define PG8_WAIT_L(n) asm volatile("s_waitcnt lgkmcnt(" #n ")" ::: "memory")
#define PG8_BAR __builtin_amdgcn_s_barrier()
#define PG8_SCHED __builtin_amdgcn_sched_barrier(0)
    Unit cur, nxt; int ui = 0;
    if (!S.next(0, cur)) return;
    f32x4 acc[2][2][4][2];
#pragma unroll
    for (int a = 0; a < 2; ++a)
#pragma unroll
        for (int b = 0; b < 2; ++b)
#pragma unroll
            for (int m = 0; m < 4; ++m)
#pragma unroll
                for (int n = 0; n < 2; ++n) acc[a][b][m][n] = (f32x4){0.f, 0.f, 0.f, 0.f};
    bf16x8 At[4][2], B0[2][2], B1[2][2];
    const char* cA = (const char*)g.A + (size_t)cur.pm * tstep; const char* cB = (const char*)g.Bt + (size_t)cur.pn * tstep;
    S.a_ready(cur);
    if constexpr (SP2) {
        PG8_STAGE(PG8_SB(0, 0), cB, voffB); PG8_STAGE(PG8_SB(0, 1), cB + hstep, voffB); PG8_STAGE(PG8_SA(0, 0), cA, voffA); PG8_STAGE(PG8_SA(0, 1), cA + hstep, voffA);
        if (wr == 1) PG8_BAR;
        PG8_WAIT_V(2); PG8_BAR;
        PG8_STAGE(PG8_SB(1, 0), cB + kstep, voffB); PG8_STAGE(PG8_SA(1, 0), cA + kstep, voffA); PG8_STAGE(PG8_SB(1, 1), cB + hstep + kstep, voffB);
        PG8_WAIT_V(6); PG8_BAR;
    } else {
        PG8_STAGE(PG8_SB(0, 0), cB, voffB); PG8_STAGE(PG8_SA(0, 0), cA, voffA); PG8_STAGE(PG8_SB(0, 1), cB + hstep, voffB); PG8_STAGE(PG8_SA(0, 1), cA + hstep, voffA);
        if (wr == 1) PG8_BAR;
        PG8_WAIT_V(4); PG8_BAR;
        PG8_STAGE(PG8_SB(1, 0), cB + kstep, voffB); PG8_STAGE(PG8_SA(1, 0), cA + kstep, voffA); PG8_STAGE(PG8_SB(1, 1), cB + hstep + kstep, voffB);
        PG8_WAIT_V(6); PG8_BAR;
    }
    for (;;) {
        const bool has_next = S.next(ui + 1, nxt);
        const char* nA = has_next ? (const char*)g.A + (size_t)nxt.pm * tstep : cA; const char* nB = has_next ? (const char*)g.Bt + (size_t)nxt.pn * tstep : cB;
        for (int t = 0; t < nt; t += 2) {
            const bool last = (t == nt - 2);
            const char* a1 = cA + (size_t)(t + 1) * kstep;
            const char* a2 = last ? nA : cA + (size_t)(t + 2) * kstep; const char* b2 = last ? nB : cB + (size_t)(t + 2) * kstep;
            const char* a3 = a2 + kstep; const char* b3 = b2 + kstep;
            if (last && has_next) S.a_ready(nxt);
            if constexpr (SP2) {
            PG8_LDB(B0, 0, 0); PG8_LDB(B1, 0, 1); PG8_SCHED; PG8_LDA(At, 0, 0); PG8_STAGE(PG8_SA(1, 1), a1 + hstep, voffA);
            PG8_WAIT_V(8); PG8_WAIT_L(0); PG8_BAR; PG8_MMA(0, 0, At, B0); PG8_MMA(0, 1, At, B1); PG8_BAR; PG8_SCHED;
            PG8_LDA(At, 0, 1); PG8_STAGE(PG8_SB(0, 0), b2, voffB); PG8_STAGE(PG8_SB(0, 1), b2 + hstep, voffB); PG8_STAGE(PG8_SA(0, 0), a2, voffA);
            PG8_WAIT_V(8); PG8_WAIT_L(0); PG8_BAR; PG8_MMA(1, 0, At, B0); PG8_MMA(1, 1, At, B1); PG8_BAR; PG8_SCHED;
            PG8_LDB(B0, 1, 0); PG8_LDB(B1, 1, 1); PG8_SCHED; PG8_LDA(At, 1, 0); PG8_STAGE(PG8_SA(0, 1), a2 + hstep, voffA);
            PG8_WAIT_V(8); PG8_WAIT_L(0); PG8_BAR; PG8_MMA(0, 0, At, B0); PG8_MMA(0, 1, At, B1); PG8_BAR; PG8_SCHED;
            PG8_LDA(At, 1, 1); PG8_STAGE(PG8_SB(1, 0), b3, voffB); PG8_STAGE(PG8_SB(1, 1), b3 + hstep, voffB); PG8_STAGE(PG8_SA(1, 0), a3, voffA);
            PG8_WAIT_V(8); PG8_WAIT_L(0); PG8_BAR; PG8_MMA(1, 0, At, B0); PG8_MMA(1, 1, At, B1); PG8_BAR; PG8_SCHED;
            } else {
            PG8_LDB(B0, 0, 0); PG8_SCHED; PG8_LDA(At, 0, 0); PG8_STAGE(PG8_SA(1, 1), a1 + hstep, voffA);
            PG8_WAIT_L(8); PG8_BAR; PG8_WAIT_L(0); PG8_MMA(0, 0, At, B0); PG8_BAR; PG8_SCHED;
            PG8_LDB(B1, 0, 1); PG8_STAGE(PG8_SB(0, 0), b2, voffB);
            PG8_BAR; PG8_WAIT_L(0); PG8_MMA(0, 1, At, B1); PG8_BAR;
            PG8_LDA(At, 0, 1); PG8_STAGE(PG8_SA(0, 0), a2, voffA);
            PG8_BAR; PG8_WAIT_L(0); PG8_MMA(1, 0, At, B0); PG8_BAR; PG8_SCHED;
            PG8_STAGE(PG8_SB(0, 1), b2 + hstep, voffB);
            PG8_WAIT_V(6); PG8_BAR; PG8_MMA(1, 1, At, B1); PG8_BAR;
            PG8_LDB(B0, 1, 0); PG8_SCHED; PG8_LDA(At, 1, 0); PG8_STAGE(PG8_SA(0, 1), a2 + hstep, voffA);
            PG8_WAIT_L(8); PG8_BAR; PG8_WAIT_L(0); PG8_MMA(0, 0, At, B0); PG8_BAR; PG8_SCHED;
            PG8_LDB(B1, 1, 1); PG8_STAGE(PG8_SB(1, 0), b3, voffB);
            PG8_BAR; PG8_WAIT_L(0); PG8_MMA(0, 1, At, B1); PG8_BAR;
            PG8_LDA(At, 1, 1); PG8_STAGE(PG8_SA(1, 0), a3, voffA);
            PG8_BAR; PG8_WAIT_L(0); PG8_MMA(1, 0, At, B0); PG8_BAR; PG8_SCHED;
            PG8_STAGE(PG8_SB(1, 1), b3 + hstep, voffB);
            PG8_WAIT_V(6); PG8_BAR; PG8_MMA(1, 1, At, B1); PG8_BAR;
            }
        }
        if constexpr (ALIGN_EPI) { if (wr == 0) PG8_BAR; }
        if constexpr (!Epi::AFTER_DRAIN) { E(acc, cur, wr, wc, fr, fq); S.done(cur); }
        if (!has_next) break;
#pragma unroll
        for (int a = 0; a < 2; ++a)
#pragma unroll
            for (int b = 0; b < 2; ++b)
#pragma unroll
                for (int m = 0; m < 4; ++m)
#pragma unroll
                    for (int n = 0; n < 2; ++n) acc[a][b][m][n] = (f32x4){0.f, 0.f, 0.f, 0.f};
        cur = nxt; cA = nA; cB = nB; ++ui;
        if constexpr (ALIGN_EPI) { if (wr == 1) PG8_BAR; }
    }
    PG8_WAIT_V(0);
    if constexpr (!ALIGN_EPI) { if (wr == 0) PG8_BAR; }
    PG8_BAR;
    if constexpr (Epi::AFTER_DRAIN) { E.fused(acc, cur, wr, wc, fr, fq, lds, wid, lane); S.done(cur); }
#undef PG8_SA
#undef PG8_SB
#undef PG8_STAGE
#undef PG8_LDA
#undef PG8_LDB
#undef PG8_MMA
#undef PG8_WAIT_V
#undef PG8_WAIT_L
#undef PG8_BAR
#undef PG8_SCHED
}
}
#include <hip/hip_cooperative_groups.h>
namespace cg = cooperative_groups;
#define LAS __attribute__((address_space(3)))
typedef unsigned short bf16;
typedef float f32x4 __attribute__((ext_vector_type(4)));
typedef float f32x2 __attribute__((ext_vector_type(2)));
typedef float f32x16 __attribute__((ext_vector_type(16)));
typedef short bf16x8 __attribute__((ext_vector_type(8)));
typedef short s16x4 __attribute__((ext_vector_type(4)));
typedef unsigned u32x4 __attribute__((ext_vector_type(4)));
typedef unsigned u32x2 __attribute__((ext_vector_type(2)));
typedef __bf16 bf16x2_t __attribute__((ext_vector_type(2)));

constexpr int BATCH = 2, T = 16384, D = 1024, M = BATCH * T, DEPTH = 2;
constexpr int NPROJ = 4352, NSRC = 4232;
constexpr int LDA = 1280, LDV = 512, LDB = 2560;
constexpr float LN_EPS = 1e-5f, GN_EPS = 64e-5f;
constexpr float DN_ALPHA = 1.41421356237f;
constexpr float C2 = 0.125f * 1.4426950408889634f;
constexpr float L2E = 1.4426950408889634f;
constexpr size_t MiB = 1u << 20;
constexpr size_t WS_CTL = 0, CTL_ZERO_BYTES = 1 * MiB;
constexpr size_t WS_WIN = 2 * MiB, WS_WOUT = 20 * MiB, WS_CUM = 24 * MiB, WS_SCS = 25 * MiB, WS_SCN = 30 * MiB;
constexpr size_t WS_XN = WS_SCN, WS_YM = WS_SCN;
constexpr size_t WS_LORA = 29 * MiB;
constexpr size_t WS_PA = 190 * MiB, WS_YA = WS_PA, WS_PV = 270 * MiB, WS_PB = 302 * MiB, WS_VS = 462 * MiB, WS_FS = 494 * MiB, WS_SI = 502 * MiB, WS_END = 506 * MiB;
constexpr int CW_QUEUE = 64;
constexpr int CW_KMAX = 1024;
constexpr int CW_MOD = 16384;
constexpr int LDS_BYTES = 147456;
#ifndef PROBE_REP
#define PROBE_REP 0
#endif

__device__ __forceinline__ unsigned f2bf(float f) { unsigned u = __builtin_bit_cast(unsigned, f); return (u + 0x7fffu + ((u >> 16) & 1u)) >> 16; }
__device__ __forceinline__ unsigned pk2(float lo, float hi) { return f2bf(lo) | (f2bf(hi) << 16); }
__device__ __forceinline__ float bf2f(unsigned short v) { return __uint_as_float(((unsigned)v) << 16); }
__device__ __forceinline__ float bflo(unsigned w) { return __uint_as_float(w << 16); }
__device__ __forceinline__ float bfhi(unsigned w) { return __uint_as_float(w & 0xffff0000u); }
__device__ __forceinline__ unsigned cvtpk(float lo, float hi) { f32x2 v = {lo, hi}; bf16x2_t b = __builtin_convertvector(v, bf16x2_t); return __builtin_bit_cast(unsigned, b); }
__device__ __forceinline__ float row16_sum(float x) {
    x += __uint_as_float(__builtin_amdgcn_update_dpp(0, __float_as_uint(x), 0xB1, 0xF, 0xF, true));
    x += __uint_as_float(__builtin_amdgcn_update_dpp(0, __float_as_uint(x), 0x4E, 0xF, 0xF, true));
    x += __uint_as_float(__builtin_amdgcn_update_dpp(0, __float_as_uint(x), 0x141, 0xF, 0xF, true));
    x += __uint_as_float(__builtin_amdgcn_update_dpp(0, __float_as_uint(x), 0x140, 0xF, 0xF, true));
    return x;
}
__device__ __forceinline__ float wave_sum(float v) { v = row16_sum(v); v += __shfl_xor(v, 16); v += __shfl_xor(v, 32); return v; }
__device__ __forceinline__ float fast_sigmoid(float x) { return 1.f / (1.f + __expf(-x)); }

struct Args { const float* in[21]; float* out; unsigned char* ws; };

struct EpiProj {
    static constexpr bool PERM = true, AFTER_DRAIN = false;
    bf16 *PA, *PVb, *PB;
    __device__ __forceinline__ void operator()(const pg8::f32x4 (&acc)[2][2][4][2], const pg8::Unit& u, int wr, int wc, int fr, int fq) const {
        const int row0 = u.pm * 256 + wr * 64 + fr; const int pn = u.pn;
        bf16* base; int ldc, colt; float sc = 1.f; bool act = false;
        if (pn < 4) { base = PA; ldc = LDA; colt = pn * 256; }
        else if (pn < 6) { base = PVb; ldc = LDV; colt = (pn - 4) * 256; }
        else if (pn == 6) { base = PA; ldc = LDA; colt = 1024; }
        else { base = PB; ldc = LDB; colt = (pn - 7) * 256; if (pn < 9) sc = C2; if (pn >= 13) act = true; }
        const int col0 = colt + wc * 32 + 8 * fq;
#pragma unroll
        for (int ai = 0; ai < 2; ++ai)
#pragma unroll
            for (int m = 0; m < 4; ++m) { bf16* rowp = base + (size_t)(row0 + ai * 128 + m * 16) * ldc + col0;
#pragma unroll
                for (int bj = 0; bj < 2; ++bj) { pg8::f32x4 v0 = acc[ai][bj][m][0], v1 = acc[ai][bj][m][1];
                    if (act) {
#pragma unroll
                        for (int e = 0; e < 4; ++e) { v0[e] = v0[e] * fast_sigmoid(v0[e]); v1[e] = v1[e] * fast_sigmoid(v1[e]); } }
                    v0 = v0 * sc; v1 = v1 * sc; u32x4 w; w.x = cvtpk(v0[0], v0[1]); w.y = cvtpk(v0[2], v0[3]); w.z = cvtpk(v1[0], v1[1]); w.w = cvtpk(v1[2], v1[3]);
                    *(u32x4*)(rowp + bj * 128) = w; } }
    }
};
struct EpiOut {
    static constexpr bool PERM = false, AFTER_DRAIN = false;
    float* hz; const float* modl;
    __device__ __forceinline__ void operator()(const pg8::f32x4 (&acc)[2][2][4][2], const pg8::Unit& u, int wr, int wc, int fr, int fq) const {
        const int col0 = u.pn * 256 + wc * 32 + 4 * fq; const int b = (u.pm * 256) >= T ? 1 : 0; const float* gate = modl + b * 3072 + 2048;
#pragma unroll
        for (int bj = 0; bj < 2; ++bj)
#pragma unroll
            for (int n = 0; n < 2; ++n) { const int c = col0 + bj * 128 + n * 16; const f32x4 g = *(const f32x4*)(gate + c) + 1.0f;
#pragma unroll
                for (int ai = 0; ai < 2; ++ai)
#pragma unroll
                    for (int m = 0; m < 4; ++m) { const int r = u.pm * 256 + ai * 128 + wr * 64 + m * 16 + fr; float* p = hz + (size_t)r * D + c;
                        const f32x4 hx = *(const f32x4*)p; f32x4 a; a[0] = acc[ai][bj][m][n][0]; a[1] = acc[ai][bj][m][n][1]; a[2] = acc[ai][bj][m][n][2]; a[3] = acc[ai][bj][m][n][3];
                        *(f32x4*)p = hx * DN_ALPHA + g * a; } }
    }
};

__device__ __forceinline__ int win_map(int n) { if (n < 1664) return n; if (n < 1672) return 3200 + n - 1664; if (n < 1792) return -1; if (n < 3328) return n - 128; return n - 120; }
template <bool MAP> __device__ __forceinline__ void transpose_item(const float* W, int Nsrc, int Ndst, bf16* WT, LAS float* scr, int item, int lane) {
    const int nblk = Ndst / 32, kb = item / nblk, nb = item % nblk, k0 = 64 * kb, n0 = 32 * nb;
    const int src = MAP ? win_map(n0 + (lane & 31)) : n0 + (lane & 31);
#pragma unroll 8
    for (int i = 0; i < 32; ++i) { const int kk = 2 * i + (lane >> 5); scr[kk * 33 + (lane & 31)] = src >= 0 ? W[(size_t)(k0 + kk) * Nsrc + src] : 0.f; }
    asm volatile("s_waitcnt lgkmcnt(0)" ::: "memory");
    const int c = lane & 7;
#pragma unroll
    for (int j = 0; j < 4; ++j) { const int n = (lane >> 3) + 8 * j; const LAS float* s = scr + (8 * c) * 33 + n;
        u32x4 o; o.x = pk2(s[0 * 33], s[1 * 33]); o.y = pk2(s[2 * 33], s[3 * 33]); o.z = pk2(s[4 * 33], s[5 * 33]); o.w = pk2(s[6 * 33], s[7 * 33]);
        *(u32x4*)(WT + (size_t)(n0 + n) * 1024 + k0 + 8 * c) = o; }
    asm volatile("s_waitcnt lgkmcnt(0)" ::: "memory");
}
__device__ __forceinline__ void p0a(const Args& a, LAS unsigned char* lds, int tid, int lane, int wave, int G) {
    LAS float* scr = (LAS float*)(lds + wave * 16384);
    const int gw = blockIdx.x * 8 + wave, NGW = G * 8;
    constexpr int I_IN = 16 * (NPROJ / 32), I_OUT = 16 * 32;
    for (int it = gw; it < 2 * (I_IN + I_OUT); it += NGW) {
        int r = it; const int l = r / (I_IN + I_OUT); r -= l * (I_IN + I_OUT);
        if (r < I_IN) transpose_item<true>(a.in[6] + (size_t)l * 1024 * NSRC, NSRC, NPROJ, (bf16*)(a.ws + WS_WIN) + (size_t)l * NPROJ * 1024, scr, r, lane);
        else transpose_item<false>(a.in[18] + (size_t)l * 1024 * 1024, 1024, 1024, (bf16*)(a.ws + WS_WOUT) + (size_t)l * 1024 * 1024, scr, r - I_IN, lane);
    }
    { bf16* LT = (bf16*)(a.ws + WS_LORA);
      for (int w = blockIdx.x * 512 + tid; w < 2 * 2 * 512 * 64; w += G * 512) { const int k = w & 63, n = (w >> 6) & 511, which = (w >> 15) & 1, l = w >> 16;
          const float* src = (which ? a.in[11] : a.in[9]) + (size_t)l * 64 * 512; LT[w] = (bf16)f2bf(src[k * 512 + n]); } }
    float* mod = (float*)(a.ws + WS_CTL) + CW_MOD;
    const float* cvec = a.in[1];
    for (int w = blockIdx.x * 512 + tid; w < 2 * 16 * 3072; w += G * 512) {
        const int j = w % 3072, sl = (w / 3072) % 16, l = w / (3072 * 16);
        const float* wa = a.in[4] + (size_t)l * 1024 * 3072 + (size_t)(sl * 64) * 3072 + j;
        float s0 = 0.f, s1 = 0.f;
#pragma unroll 8
        for (int i = 0; i < 64; ++i) { const float wv = wa[(size_t)i * 3072]; s0 += cvec[sl * 64 + i] * wv; s1 += cvec[1024 + sl * 64 + i] * wv; }
        if (sl == 0) { const float bb = a.in[5][l * 3072 + j]; s0 += bb; s1 += bb; }
        atomicAdd(mod + (l * 2 + 0) * 3072 + j, s0); atomicAdd(mod + (l * 2 + 1) * 3072 + j, s1);
    }
}
__device__ __forceinline__ void ln_rows(const float* src, const float* g, const float* bb, float* dst, bf16* xn, const float* modn, int lane, int wave, int G) {
    const int gw = blockIdx.x * 8 + wave, NGW = G * 8;
    f32x4 gv[4], bv[4];
#pragma unroll
    for (int j = 0; j < 4; ++j) { gv[j] = ((const f32x4*)g)[lane + 64 * j]; bv[j] = ((const f32x4*)bb)[lane + 64 * j]; }
    for (int m0 = gw * 2; m0 < M; m0 += NGW * 2) {
        f32x4 v[2][4]; float s[2], s2[2];
#pragma unroll
        for (int u = 0; u < 2; ++u) { const f32x4* xr = (const f32x4*)(src + (size_t)(m0 + u) * D) + lane; s[u] = 0.f;
#pragma unroll
            for (int j = 0; j < 4; ++j) { v[u][j] = xr[64 * j]; s[u] += (v[u][j].x + v[u][j].y) + (v[u][j].z + v[u][j].w); } }
#pragma unroll
        for (int u = 0; u < 2; ++u) s[u] = row16_sum(s[u]);
#pragma unroll
        for (int o = 16; o < 64; o <<= 1) {
#pragma unroll
            for (int u = 0; u < 2; ++u) s[u] += __shfl_xor(s[u], o); }
#pragma unroll
        for (int u = 0; u < 2; ++u) { const float mean = s[u] * (1.f / D); s2[u] = 0.f;
#pragma unroll
            for (int j = 0; j < 4; ++j) { v[u][j] = v[u][j] - mean; s2[u] += (v[u][j].x * v[u][j].x + v[u][j].y * v[u][j].y) + (v[u][j].z * v[u][j].z + v[u][j].w * v[u][j].w); } }
#pragma unroll
        for (int u = 0; u < 2; ++u) s2[u] = row16_sum(s2[u]);
#pragma unroll
        for (int o = 16; o < 64; o <<= 1) {
#pragma unroll
            for (int u = 0; u < 2; ++u) s2[u] += __shfl_xor(s2[u], o); }
#pragma unroll
        for (int u = 0; u < 2; ++u) { const int m = m0 + u;
            const float rstd = 1.f / sqrtf(s2[u] * (1.f / D) + LN_EPS);
            f32x4* o = (f32x4*)(dst + (size_t)m * D) + lane;
            const int b = m >= T ? 1 : 0;
#pragma unroll
            for (int j = 0; j < 4; ++j) { const f32x4 hv = v[u][j] * rstd * gv[j] + bv[j]; o[64 * j] = hv;
                if (modn) { const f32x4 sh = ((const f32x4*)(modn + b * 3072))[lane + 64 * j], sc = ((const f32x4*)(modn + b * 3072 + 1024))[lane + 64 * j];
                    const f32x4 y = hv * (sc + 1.0f) + sh; u32x2 w; w.x = pk2(y.x, y.y); w.y = pk2(y.z, y.w);
                    *((u32x2*)(xn + (size_t)m * D) + lane + 64 * j) = w; } } }
    }
}
__device__ __forceinline__ int crow(int r, int hi) { return (r & 3) + 8 * (r >> 2) + 4 * hi; }
__device__ __forceinline__ float tanh_fast(float x) { const float e = __expf(2.f * x); return 1.f - 2.f / (e + 1.f); }
__device__ __forceinline__ void cum_kmax(const Args& a, LAS unsigned char* lds, int l, int bh, int tid, int lane, int wave) {
    const int b = bh >> 3, h = bh & 7;
    const bf16* PA = (const bf16*)(a.ws + WS_PA); const bf16* PB = (const bf16*)(a.ws + WS_PB);
    float* cum = (float*)(a.ws + WS_CUM) + (size_t)bh * T;
    const float bf = a.in[17][l * 8 + h];
    LAS float* red = (LAS float*)lds;
    const int t0 = tid * 32;
    float s = 0.f, kmx = 0.f;
#pragma unroll 1
    for (int i = 0; i < 32; ++i) { const size_t m = (size_t)b * T + t0 + i;
        const float z = bf2f(PA[m * LDA + 1152 + h]) + bf;
        const float lf = fminf(z, 0.f) - log1pf(__expf(-fabsf(z)));
        s += lf; cum[t0 + i] = s;
        const u32x4* kr = (const u32x4*)(PB + m * LDB + 512 + h * 64); float q = 0.f;
#pragma unroll
        for (int c = 0; c < 8; ++c) { const u32x4 w = kr[c];
            q += bflo(w.x) * bflo(w.x) + bfhi(w.x) * bfhi(w.x) + bflo(w.y) * bflo(w.y) + bfhi(w.y) * bfhi(w.y) + bflo(w.z) * bflo(w.z) + bfhi(w.z) * bfhi(w.z) + bflo(w.w) * bflo(w.w) + bfhi(w.w) * bfhi(w.w); }
        kmx = fmaxf(kmx, q); }
    red[tid] = s;
#pragma unroll
    for (int o = 1; o < 64; o <<= 1) kmx = fmaxf(kmx, __shfl_xor(kmx, o));
    if (lane == 0) red[512 + wave] = kmx;
    __syncthreads();
    if (tid == 0) { float run = 0.f; for (int i = 0; i < 512; ++i) { const float v = red[i]; red[i] = run; run += v; }
        float k = 0.f; for (int i = 0; i < 8; ++i) k = fmaxf(k, red[512 + i]);
        ((float*)(a.ws + WS_CTL))[CW_KMAX + 16 * l + bh] = sqrtf(k); }
    __syncthreads();
    const float off = red[tid];
#pragma unroll 1
    for (int i = 0; i < 32; ++i) cum[t0 + i] += off;
    __syncthreads();
}
__device__ __forceinline__ void prep_phase(const Args& a, LAS unsigned char* lds, int l, int tid, int lane, int wave, int G) {
    const bf16* PA = (const bf16*)(a.ws + WS_PA); const bf16* PV = (const bf16*)(a.ws + WS_PV);
    bf16* SCN = (bf16*)(a.ws + WS_SCN); float* SCS = (float*)(a.ws + WS_SCS); bf16* VS = (bf16*)(a.ws + WS_VS);
    LAS unsigned char* lowL = lds;
    LAS bf16* CL = (LAS bf16*)(lds + 16384);
    const int c = tid, h = wave, r32 = lane & 31, hi = lane >> 5;
    const bf16* LT = (const bf16*)(a.ws + WS_LORA) + (size_t)l * 2 * 512 * 64;
    const float* mix = a.in[7] + l * 1664;
    const float mix_r = mix[c], mix_k = mix[512 + c], mix_v = mix[1024 + c];
    const int ftok = tid >> 3, fi0 = (tid & 7) * 16;
    f32x4 mlow[4];
#pragma unroll
    for (int q = 0; q < 4; ++q) mlow[q] = *(const f32x4*)(mix + 1536 + fi0 + 4 * q);
    const float w0c = a.in[8][l * 512 + c], a0c = a.in[10][l * 512 + c], kkc = a.in[12][l * 512 + c], kac = a.in[13][l * 512 + c], rkc = a.in[14][l * 512 + c];
    unsigned* pq = (unsigned*)(a.ws + WS_CTL) + CW_QUEUE + 1024 + 64 * l;
    volatile LAS unsigned* ptask = (volatile LAS unsigned*)(lds + 140000);
    for (;;) {
        __syncthreads();
        if (tid == 0) ptask[0] = atomicAdd(pq, 1u);
        __syncthreads();
        const unsigned ptk = ptask[0];
        if (ptk >= 16u + (unsigned)(M / 64)) break;
        if (ptk < 16u) { cum_kmax(a, lds + 135168, l, (int)ptk, tid, lane, wave); continue; }
        const int chunk = (int)ptk - 16;
        const int m0 = chunk * 64, b = m0 >= T ? 1 : 0, t0 = m0 - b * T; const int bh = b * 8 + h;
        { const int m = m0 + ftok, t = t0 + ftok;
          const u32x4* cp = (const u32x4*)(PA + (size_t)m * LDA + 1024 + fi0);
          const u32x4 c0 = cp[0], c1 = cp[1]; u32x4 p0 = {0u, 0u, 0u, 0u}, p1 = p0;
          if (t > 0) { const u32x4* pp = (const u32x4*)(PA + (size_t)(m - 1) * LDA + 1024 + fi0); p0 = pp[0]; p1 = pp[1]; }
          float cur[16], prv[16];
          cur[0] = bflo(c0.x); cur[1] = bfhi(c0.x); cur[2] = bflo(c0.y); cur[3] = bfhi(c0.y); cur[4] = bflo(c0.z); cur[5] = bfhi(c0.z); cur[6] = bflo(c0.w); cur[7] = bfhi(c0.w);
          cur[8] = bflo(c1.x); cur[9] = bfhi(c1.x); cur[10] = bflo(c1.y); cur[11] = bfhi(c1.y); cur[12] = bflo(c1.z); cur[13] = bfhi(c1.z); cur[14] = bflo(c1.w); cur[15] = bfhi(c1.w);
          prv[0] = bflo(p0.x); prv[1] = bfhi(p0.x); prv[2] = bflo(p0.y); prv[3] = bfhi(p0.y); prv[4] = bflo(p0.z); prv[5] = bfhi(p0.z); prv[6] = bflo(p0.w); prv[7] = bfhi(p0.w);
          prv[8] = bflo(p1.x); prv[9] = bfhi(p1.x); prv[10] = bflo(p1.y); prv[11] = bfhi(p1.y); prv[12] = bflo(p1.z); prv[13] = bfhi(p1.z); prv[14] = bflo(p1.w); prv[15] = bfhi(p1.w);
#pragma unroll
          for (int q = 0; q < 16; ++q) { float val = cur[q] + (prv[q] - cur[q]) * mlow[q >> 2][q & 3]; if (fi0 < 64) val = tanh_fast(val); cur[q] = val; }
          u32x4 o0 = {cvtpk(cur[0], cur[1]), cvtpk(cur[2], cur[3]), cvtpk(cur[4], cur[5]), cvtpk(cur[6], cur[7])};
          u32x4 o1 = {cvtpk(cur[8], cur[9]), cvtpk(cur[10], cur[11]), cvtpk(cur[12], cur[13]), cvtpk(cur[14], cur[15])};
          const int ch = 2 * (tid & 7);
          *(LAS u32x4*)(lowL + ftok * 256 + ((ch ^ (ftok & 7)) << 4)) = o0; *(LAS u32x4*)(lowL + ftok * 256 + (((ch + 1) ^ (ftok & 7)) << 4)) = o1; }
        __syncthreads();
        float pr = 0.f, pk = 0.f, pv = 0.f;
        if (t0 > 0) { pr = bf2f(PA[(size_t)(m0 - 1) * LDA + c]); pk = bf2f(PA[(size_t)(m0 - 1) * LDA + 512 + c]); pv = bf2f(PV[(size_t)(m0 - 1) * LDV + c]); }
#pragma unroll 1
        for (int tr = 0; tr < 2; ++tr) {
            { f32x16 Cw0 = {}, Cw1 = {}, Ca0 = {}, Ca1 = {};
              const int trow = 32 * tr + r32;
              bf16x8 Bw[2][4], Ba[2][4];
#pragma unroll
              for (int tc = 0; tc < 2; ++tc)
#pragma unroll
                for (int sx = 0; sx < 4; ++sx) { const int n = 64 * h + 32 * tc + r32;
                    Bw[tc][sx] = __builtin_bit_cast(bf16x8, *(const u32x4*)(LT + (size_t)n * 64 + 16 * sx + 8 * hi));
                    Ba[tc][sx] = __builtin_bit_cast(bf16x8, *(const u32x4*)(LT + 512 * 64 + (size_t)n * 64 + 16 * sx + 8 * hi)); }
#pragma unroll
              for (int sx = 0; sx < 4; ++sx) {
                  const bf16x8 Aw = *(const LAS bf16x8*)(lowL + trow * 256 + (((2 * sx + hi) ^ (trow & 7)) << 4));
                  const bf16x8 Aa = *(const LAS bf16x8*)(lowL + trow * 256 + (((8 + 2 * sx + hi) ^ (trow & 7)) << 4));
                  Cw0 = __builtin_amdgcn_mfma_f32_32x32x16_bf16(Aw, Bw[0][sx], Cw0, 0, 0, 0); Cw1 = __builtin_amdgcn_mfma_f32_32x32x16_bf16(Aw, Bw[1][sx], Cw1, 0, 0, 0);
                  Ca0 = __builtin_amdgcn_mfma_f32_32x32x16_bf16(Aa, Ba[0][sx], Ca0, 0, 0, 0); Ca1 = __builtin_amdgcn_mfma_f32_32x32x16_bf16(Aa, Ba[1][sx], Ca1, 0, 0, 0); }
#pragma unroll
              for (int r = 0; r < 16; ++r) { LAS bf16* row = CL + crow(r, hi) * 1024 + 64 * h + r32;
                  row[0] = (bf16)f2bf(Cw0[r]); row[32] = (bf16)f2bf(Cw1[r]); row[512] = (bf16)f2bf(Ca0[r]); row[544] = (bf16)f2bf(Ca1[r]); } }
            __syncthreads();
#pragma unroll 1
            for (int g = 0; g < 4; ++g) {
                const int tl0 = g * 8, mg = m0 + 32 * tr + tl0, tg = t0 + 32 * tr + tl0;
                float cr[8], ck[8], cv[8];
#pragma unroll
                for (int tt = 0; tt < 8; ++tt) { cr[tt] = bf2f(PA[(size_t)(mg + tt) * LDA + c]); ck[tt] = bf2f(PA[(size_t)(mg + tt) * LDA + 512 + c]); cv[tt] = bf2f(PV[(size_t)(mg + tt) * LDV + c]); }
                float rr[8], kkr[8], kp[8], vv[8], av[8], omw[8], red[32];
#pragma unroll
                for (int tt = 0; tt < 8; ++tt) {
                    const float prr = tt ? cr[tt - 1] : pr, prk = tt ? ck[tt - 1] : pk, prv = tt ? cv[tt - 1] : pv;
                    const float r = cr[tt] + (prr - cr[tt]) * mix_r, k = ck[tt] + (prk - ck[tt]) * mix_k; vv[tt] = cv[tt] + (prv - cv[tt]) * mix_v;
                    const float wl = w0c + bf2f(CL[(tl0 + tt) * 1024 + c]), al = a0c + bf2f(CL[(tl0 + tt) * 1024 + 512 + c]);
                    const float z = -wl; const float sp = fmaxf(z, 0.f) + __logf(1.f + __expf(-fabsf(z)));
                    const float e = __expf(-sp - 0.5f); omw[tt] = 1.f - __expf(-e);
                    av[tt] = fast_sigmoid(al);
                    kkr[tt] = k * kkc; kp[tt] = k * (1.f + (av[tt] - 1.f) * kac); rr[tt] = r;
                    red[tt] = kkr[tt] * kkr[tt]; red[8 + tt] = kkr[tt] * av[tt] * r; red[16 + tt] = kp[tt] * r; red[24 + tt] = r * kp[tt] * rkc;
                }
                pr = cr[7]; pk = ck[7]; pv = cv[7];
#pragma unroll
                for (int i = 0; i < 32; ++i) red[i] = row16_sum(red[i]);
#pragma unroll
                for (int o = 16; o < 64; o <<= 1) {
#pragma unroll
                    for (int i = 0; i < 32; ++i) red[i] += __shfl_xor(red[i], o); }
#pragma unroll
                for (int tt = 0; tt < 8; ++tt) {
                    const float inv = 1.f / fmaxf(sqrtf(red[tt]), 1e-12f);
                    const float kk = kkr[tt] * inv, bbv = kk * av[tt], wr = (1.f - omw[tt]) * rr[tt];
                    bf16* rec = SCN + ((size_t)bh * T + tg + tt) * 320 + lane;
                    rec[0] = (bf16)f2bf(kk); rec[64] = (bf16)f2bf(wr); rec[128] = (bf16)f2bf(omw[tt]); rec[192] = (bf16)f2bf(bbv); rec[256] = (bf16)f2bf(kp[tt]);
                    VS[(size_t)(mg + tt) * 512 + c] = (bf16)f2bf(vv[tt]);
                    if (lane == 0) { f32x4 sc = {red[8 + tt] * inv, red[16 + tt], red[24 + tt], 0.f}; *(f32x4*)(SCS + ((size_t)bh * T + tg + tt) * 4) = sc; }
                }
            }
            __syncthreads();
        }
    }
    __syncthreads();
}

__device__ __forceinline__ float dppf(float x, const int ctrl_sel) {
    unsigned u = __float_as_uint(x), r;
    if (ctrl_sel == 0) r = __builtin_amdgcn_update_dpp(0, u, 0xB1, 0xF, 0xF, true);
    else if (ctrl_sel == 1) r = __builtin_amdgcn_update_dpp(0, u, 0x4E, 0xF, 0xF, true);
    else r = __builtin_amdgcn_update_dpp(0, u, 0x141, 0xF, 0xF, true);
    return __uint_as_float(r);
}
__device__ __forceinline__ float red8(float x) { x += dppf(x, 0); x += dppf(x, 1); x += dppf(x, 2); return x; }
constexpr int SC_CH = 32, SC_STEP = 1024, SC_BUF = SC_CH * SC_STEP, SC_VOFF = 2 * SC_BUF, SC_SOFF = SC_VOFF + 2 * SC_CH * 64 * 4, SC_ROWB = SC_SOFF + 2 * SC_CH * 16;
constexpr int NSEG = 16, SEGLEN = T / NSEG;
typedef float f32x4m __attribute__((ext_vector_type(4)));
template <bool PASSC> __device__ __forceinline__ void scan_task(const Args& a, LAS unsigned char* lds, int bh, int seg, int tid, int lane, int wave, unsigned* cntp) {
    const int b = bh >> 3, h = bh & 7;
    const int t0 = seg * SEGLEN;
    const bf16* SCN = (const bf16*)(a.ws + WS_SCN) + ((size_t)bh * T + t0) * 320;
    const float* SCS = (const float*)(a.ws + WS_SCS) + ((size_t)bh * T + t0) * 4;
    const bf16* VS = (const bf16*)(a.ws + WS_VS) + ((size_t)b * T + t0) * 512 + h * 64;
    float* YA = (float*)(a.ws + WS_YA) + ((size_t)b * T + t0) * 512 + h * 64;
    float* FSb = (float*)(a.ws + WS_FS) + (size_t)bh * NSEG * 128 * 64;
    constexpr int NCH = SEGLEN / SC_CH;
    const int n16 = lane & 15, g = lane >> 4;
    const bool ident = !PASSC && wave >= 4;
    const bool active = PASSC ? (wave < 4) : true;
    const int row = 16 * (wave & 3) + n16;
    f32x4 Sf[4];
#pragma unroll
    for (int i = 0; i < 4; ++i) Sf[i] = (f32x4){0.f, 0.f, 0.f, 0.f};
    __syncthreads();
    if constexpr (PASSC) {
        if (active && seg > 0) { const float* SIp = (const float*)(a.ws + WS_SI) + ((size_t)(bh * NSEG + seg) * 64 + row) * 64 + 4 * g;
#pragma unroll
            for (int t4 = 0; t4 < 4; ++t4) Sf[t4] = *(const f32x4*)(SIp + 16 * t4); }
    } else if (ident) {
#pragma unroll
        for (int i = 0; i < 4; ++i)
#pragma unroll
            for (int e = 0; e < 4; ++e) Sf[i][e] = (16 * i + 4 * g + e == row) ? 1.f : 0.f;
    }
    u32x4 mreg[2], breg, kreg; u32x4 vreg = {0u, 0u, 0u, 0u}; f32x4 sreg;
    auto gload = [&](int c) {
        const u32x4* src = (const u32x4*)(SCN + (size_t)c * SC_CH * 320);
        { const int st = tid / 24, q = tid - st * 24; mreg[0] = src[st * 40 + q]; }
        if (tid < 256) { const int jj = 512 + tid, st = jj / 24, q = jj - st * 24; mreg[1] = src[st * 40 + q];
            const int s2 = tid >> 3, e8 = tid & 7; breg = src[s2 * 40 + 24 + e8]; kreg = src[s2 * 40 + 32 + e8]; }
        if (tid < 256) vreg = *(const u32x4*)(VS + (size_t)(c * SC_CH + (tid >> 3)) * 512 + (tid & 7) * 8);
        else if (tid < 288) sreg = *(const f32x4*)(SCS + (size_t)(c * SC_CH + (tid - 256)) * 4);
    };
    auto lwrite = [&](int c) {
        LAS unsigned char* bp = lds + (c & 1) * SC_BUF;
#pragma unroll
        for (int i = 0; i < 2; ++i) { const int jj = tid + 512 * i;
            if (jj < 768) { const int st = jj / 24, q = jj - st * 24, arr = q >> 3, e8 = q & 7; const u32x4 w = mreg[i];
                LAS unsigned char* d = bp + st * SC_STEP;
                if (arr < 2) { *(LAS u32x4*)(d + 256 + arr * 128 + e8 * 16) = w; }
                else { f32x4 lo, hi;
                    lo[0] = bflo(w.x); lo[1] = bfhi(w.x); lo[2] = bflo(w.y); lo[3] = bfhi(w.y); hi[0] = bflo(w.z); hi[1] = bfhi(w.z); hi[2] = bflo(w.w); hi[3] = bfhi(w.w);
                    lo = 1.0f - lo; hi = 1.0f - hi;
                    LAS f32x4* df = (LAS f32x4*)(d + e8 * 32); df[0] = lo; df[1] = hi; } } }
        if (tid < 256) { const int s2 = tid >> 3, e8 = tid & 7; LAS u32x4* d = (LAS u32x4*)(bp + s2 * SC_STEP + 512 + e8 * 64);
            const unsigned bw[4] = {breg.x, breg.y, breg.z, breg.w}, kw[4] = {kreg.x, kreg.y, kreg.z, kreg.w};
#pragma unroll
            for (int pq = 0; pq < 4; ++pq) { const unsigned blo = bw[pq] & 0xffffu, bhi = bw[pq] >> 16, klo = kw[pq] & 0xffffu, khi = kw[pq] >> 16;
                u32x4 o; o.x = klo | (blo << 16); o.y = blo; o.z = khi | (bhi << 16); o.w = bhi; d[pq] = o; } }
        if (tid < 256) { const u32x4 w = vreg; f32x4 lo, hi;
            lo[0] = bflo(w.x); lo[1] = bfhi(w.x); lo[2] = bflo(w.y); lo[3] = bfhi(w.y); hi[0] = bflo(w.z); hi[1] = bfhi(w.z); hi[2] = bflo(w.w); hi[3] = bfhi(w.w);
            LAS f32x4* d = (LAS f32x4*)(lds + SC_VOFF + (c & 1) * (SC_CH * 64 * 4) + tid * 32); d[0] = lo; d[1] = hi; }
        else if (tid < 288) { *(LAS f32x4*)(lds + SC_SOFF + (c & 1) * (SC_CH * 16) + (tid - 256) * 16) = sreg; }
    };
    gload(0); lwrite(0); gload(1);
    __syncthreads();
    LAS float* ybuf = (LAS float*)(lds + SC_ROWB + 16384);
    auto yflush = [&](int c) { const f32x4 yv = *(const LAS f32x4*)(ybuf + (c & 1) * (SC_CH * 64) + tid * 4);
        *(f32x4*)(YA + (size_t)(c * SC_CH + (tid >> 4)) * 512 + (tid & 15) * 4) = yv; };
    for (int c = 0; c < NCH; ++c) {
        if constexpr (PASSC) { if (c > 0) yflush(c - 1); }
        if (c + 1 < NCH) lwrite(c + 1);
        if (c + 2 < NCH) gload(c + 2);
        if (active) {
            const LAS unsigned char* bp = lds + (c & 1) * SC_BUF;
            const LAS float* vb = (const LAS float*)(lds + SC_VOFF + (c & 1) * (SC_CH * 64 * 4)) + row;
            const LAS float* sb = (const LAS float*)(lds + SC_SOFF + (c & 1) * (SC_CH * 16));
#define SC_DECL(X) u32x2 X##a0, X##a1, X##a2, X##a3, X##r0, X##r1, X##r2, X##r3; float X##v; f32x2 X##s
#define SC_LD(X, sidx) do { const LAS unsigned char* p_ = bp + (sidx) * SC_STEP + 256 + g * 8; \
                X##a0 = *(const LAS u32x2*)(p_); X##a1 = *(const LAS u32x2*)(p_ + 32); X##a2 = *(const LAS u32x2*)(p_ + 64); X##a3 = *(const LAS u32x2*)(p_ + 96); \
                if constexpr (PASSC) { X##r0 = *(const LAS u32x2*)(p_ + 128); X##r1 = *(const LAS u32x2*)(p_ + 160); X##r2 = *(const LAS u32x2*)(p_ + 192); X##r3 = *(const LAS u32x2*)(p_ + 224); X##s = *(const LAS f32x2*)(sb + (sidx) * 4); } \
                X##v = ident ? 0.f : vb[(sidx) * 64]; } while (0)
#define SC_STEPM(X, Y, sidx, ldnext) do { const LAS unsigned char* p_ = bp + (sidx) * SC_STEP; \
                const f32x4 w0_ = *(const LAS f32x4*)(p_ + g * 16), w1_ = *(const LAS f32x4*)(p_ + 64 + g * 16), w2_ = *(const LAS f32x4*)(p_ + 128 + g * 16), w3_ = *(const LAS f32x4*)(p_ + 192 + g * 16); \
                const s16x4 f0_ = *(const LAS s16x4*)(p_ + 512 + n16 * 8), f1_ = *(const LAS s16x4*)(p_ + 640 + n16 * 8), f2_ = *(const LAS s16x4*)(p_ + 768 + n16 * 8), f3_ = *(const LAS s16x4*)(p_ + 896 + n16 * 8); \
                if (ldnext) SC_LD(Y, (sidx) + 1); \
                u32x4 sb0, sb1; \
                sb0.x = cvtpk(Sf[0][0], Sf[0][1]); sb0.y = cvtpk(Sf[0][2], Sf[0][3]); sb0.z = cvtpk(Sf[1][0], Sf[1][1]); sb0.w = cvtpk(Sf[1][2], Sf[1][3]); \
                sb1.x = cvtpk(Sf[2][0], Sf[2][1]); sb1.y = cvtpk(Sf[2][2], Sf[2][3]); sb1.z = cvtpk(Sf[3][0], Sf[3][1]); sb1.w = cvtpk(Sf[3][2], Sf[3][3]); \
                const bf16x8 B0 = __builtin_bit_cast(bf16x8, sb0), B1 = __builtin_bit_cast(bf16x8, sb1); \
                const bf16x8 A0 = __builtin_bit_cast(bf16x8, (u32x4){X##a0.x, X##a0.y, X##a1.x, X##a1.y}), A1 = __builtin_bit_cast(bf16x8, (u32x4){X##a2.x, X##a2.y, X##a3.x, X##a3.y}); \
                const f32x4m z4 = {0.f, 0.f, 0.f, 0.f}; f32x4m accy0 = z4, accy1 = z4; \
                const f32x4m acc0 = __builtin_amdgcn_mfma_f32_16x16x32_bf16(A0, B0, z4, 0, 0, 0); \
                const f32x4m acc1 = __builtin_amdgcn_mfma_f32_16x16x32_bf16(A1, B1, z4, 0, 0, 0); \
                if constexpr (PASSC) { const bf16x8 R0 = __builtin_bit_cast(bf16x8, (u32x4){X##r0.x, X##r0.y, X##r1.x, X##r1.y}); accy0 = __builtin_amdgcn_mfma_f32_16x16x32_bf16(R0, B0, z4, 0, 0, 0); \
                    const bf16x8 R1 = __builtin_bit_cast(bf16x8, (u32x4){X##r2.x, X##r2.y, X##r3.x, X##r3.y}); accy1 = __builtin_amdgcn_mfma_f32_16x16x32_bf16(R1, B1, z4, 0, 0, 0); } \
                const f32x4 c0_ = Sf[0] * w0_, c1_ = Sf[1] * w1_, c2_ = Sf[2] * w2_, c3_ = Sf[3] * w3_; \
                const float sa = acc0[0] + acc1[0]; \
                u32x2 bu; bu.x = (__float_as_uint(X##v) >> 16) | (cvtpk(0.f, -sa) & 0xffff0000u); bu.y = 0u; \
                if (g != 0) { bu.x = 0u; bu.y = 0u; } \
                const s16x4 Bu = __builtin_bit_cast(s16x4, bu); \
                Sf[0] = __builtin_amdgcn_mfma_f32_16x16x16bf16_1k(f0_, Bu, c0_, 0, 0, 0); Sf[1] = __builtin_amdgcn_mfma_f32_16x16x16bf16_1k(f1_, Bu, c1_, 0, 0, 0); \
                Sf[2] = __builtin_amdgcn_mfma_f32_16x16x16bf16_1k(f2_, Bu, c2_, 0, 0, 0); Sf[3] = __builtin_amdgcn_mfma_f32_16x16x16bf16_1k(f3_, Bu, c3_, 0, 0, 0); \
                if constexpr (PASSC) { const float y = (accy0[0] + accy1[0]) - sa * X##s.x + X##v * X##s.y; ybuf[(c & 1) * (SC_CH * 64) + (sidx) * 64 + row] = y; } } while (0)
            SC_DECL(oA); SC_DECL(oB);
            SC_LD(oA, 0);
#pragma unroll 1
            for (int s = 0; s < SC_CH; s += 2) {
                SC_STEPM(oA, oB, s, true);
                __builtin_amdgcn_sched_barrier(0);
                SC_STEPM(oB, oA, s + 1, (s + 2 < SC_CH));
                __builtin_amdgcn_sched_barrier(0);
            }
#undef SC_DECL
#undef SC_LD
#undef SC_STEPM
        }
        __syncthreads();
    }
    if constexpr (PASSC) yflush(NCH - 1);
    if constexpr (!PASSC) { float* fp = FSb + ((size_t)seg * 128 + (ident ? 64 : 0) + row) * 64 + 4 * g;
#pragma unroll
        for (int t4 = 0; t4 < 4; ++t4) *(f32x4*)(fp + 16 * t4) = Sf[t4];
        volatile LAS unsigned* lastf = (volatile LAS unsigned*)(lds + 140064);
        __threadfence();
        __syncthreads();
        if (tid == 0) lastf[0] = atomicAdd(cntp, 1u);
        __syncthreads();
        if (lastf[0] == (unsigned)(NSEG - 2)) {
            __threadfence();
            LAS float* rowb = (LAS float*)(lds + SC_ROWB);
            LAS float* pbuf = (LAS float*)lds;
            float* SIb = (float*)(a.ws + WS_SI) + (size_t)bh * NSEG * 64 * 64;
            const int crow_ = tid >> 3, kq = (tid & 7) * 8;
            f32x4 c0 = {0.f, 0.f, 0.f, 0.f}, c1 = c0, pr0, pr1;
            { const float* Pk = FSb + ((size_t)0 * 128 + 64 + crow_) * 64 + kq; pr0 = __builtin_nontemporal_load((const f32x4*)Pk); pr1 = __builtin_nontemporal_load((const f32x4*)(Pk + 4)); }
            for (int k = 0; k < NSEG - 1; ++k) {
                const float* Uk = FSb + ((size_t)k * 128 + crow_) * 64 + kq;
                f32x4 a0 = __builtin_nontemporal_load((const f32x4*)Uk), a1 = __builtin_nontemporal_load((const f32x4*)(Uk + 4));
                *(LAS f32x4*)(rowb + crow_ * 64 + kq) = c0; *(LAS f32x4*)(rowb + crow_ * 64 + kq + 4) = c1;
                *(LAS f32x4*)(pbuf + crow_ * 64 + kq) = pr0; *(LAS f32x4*)(pbuf + crow_ * 64 + kq + 4) = pr1;
                __syncthreads();
                if (k + 2 < NSEG) { const float* Pn = FSb + ((size_t)(k + 1) * 128 + 64 + crow_) * 64 + kq; pr0 = __builtin_nontemporal_load((const f32x4*)Pn); pr1 = __builtin_nontemporal_load((const f32x4*)(Pn + 4)); }
                if (k > 0) {
#pragma unroll 4
                    for (int jj = 0; jj < 64; ++jj) { const float sj = rowb[crow_ * 64 + jj]; a0 += *(const LAS f32x4*)(pbuf + jj * 64 + kq) * sj; a1 += *(const LAS f32x4*)(pbuf + jj * 64 + kq + 4) * sj; } }
                c0 = a0; c1 = a1;
                float* sp_ = SIb + ((size_t)(k + 1) * 64 + crow_) * 64 + kq; *(f32x4*)sp_ = c0; *(f32x4*)(sp_ + 4) = c1;
                __syncthreads();
            }
        }
    }
}

typedef short v4i16_t __attribute__((ext_vector_type(4)));
__device__ __forceinline__ s16x4 vtr(const LAS unsigned char* p) { return __builtin_bit_cast(s16x4, __builtin_amdgcn_ds_read_tr16_b64_v4i16((LAS v4i16_t*)p)); }
constexpr int AT_KS = 0, AT_VS = 9216, AT_BIAS = 18432, AT_WSF = 18688, AT_FLAG = 19712, AT_TASK = 140000;
__device__ __forceinline__ void attn_unit(const Args& a, LAS unsigned char* lds, int l, int bh, int qb, int tid, int lane, int wid) {
    const int b = bh >> 3, h = bh & 7, r32 = lane & 31, hi = lane >> 5;
    const int q0 = qb * 256;
    bf16* PB = (bf16*)(a.ws + WS_PB);
    const float* cumh = (const float*)(a.ws + WS_CUM) + (size_t)bh * T;
    const float kmax = ((const float*)(a.ws + WS_CTL))[CW_KMAX + 16 * l + bh];
    const size_t rowbase = (size_t)b * T;
    const bf16* Qp = PB + (rowbase + q0 + wid * 32 + r32) * LDB + h * 64;
    bf16x8 qr[4]; float qs = 0.f;
#pragma unroll
    for (int d0 = 0; d0 < 4; ++d0) { const u32x4 w = *(const u32x4*)(Qp + d0 * 16 + hi * 8); qr[d0] = __builtin_bit_cast(bf16x8, w);
        qs += bflo(w.x) * bflo(w.x) + bfhi(w.x) * bfhi(w.x) + bflo(w.y) * bflo(w.y) + bfhi(w.y) * bfhi(w.y) + bflo(w.z) * bflo(w.z) + bfhi(w.z) * bfhi(w.z) + bflo(w.w) * bflo(w.w) + bfhi(w.w) * bfhi(w.w); }
    qs += __shfl_xor(qs, 32);
    const float qbound = sqrtf(qs) * kmax * 1.01f + 0.01f;
    const float ref = cumh[q0 + 255];
    const int srow = tid >> 3, sch = tid & 7;
    const bf16* Kg = PB + rowbase * LDB + 512 + h * 64 + sch * 8; const bf16* Vg = Kg + 512;
    LAS unsigned char* Ks = lds + AT_KS; LAS unsigned char* Vs = lds + AT_VS; LAS float* biasL = (LAS float*)(lds + AT_BIAS);
    LAS float* wsf = (LAS float*)(lds + AT_WSF) + wid * 32; volatile LAS unsigned* flag = (volatile LAS unsigned*)(lds + AT_FLAG);
    if (tid < 3) flag[tid] = 0u;
    float m = -INFINITY, lsum = 0.f; f32x16 o0 = {}, o1 = {};
    u32x4 kreg, vreg; float breg = 0.f, bnx = 0.f;
    int j = qb * 4 + 3;
    { kreg = *(const u32x4*)(Kg + (size_t)(64 * j + srow) * LDB); vreg = *(const u32x4*)(Vg + (size_t)(64 * j + srow) * LDB);
      if (tid < 64) breg = (ref - cumh[64 * j + tid]) * L2E; bnx = j > 0 ? (ref - cumh[64 * j - 1]) * L2E : 0.f; }
    const int q4 = (lane & 15) >> 2, p4 = lane & 3, blk = (lane >> 4) & 1;
    const int qrow = q0 + wid * 32 + r32;
    int it = 0;
    __syncthreads();
    for (;;) {
        *(LAS u32x4*)(Ks + srow * 144 + sch * 16) = kreg; *(LAS u32x4*)(Vs + srow * 144 + sch * 16) = vreg; if (tid < 64) biasL[tid] = breg;
        const float bnx_cur = bnx;
        __syncthreads();
        if (j > 0) { const int jn = j - 1;
            kreg = *(const u32x4*)(Kg + (size_t)(64 * jn + srow) * LDB); vreg = *(const u32x4*)(Vg + (size_t)(64 * jn + srow) * LDB);
            if (tid < 64) breg = (ref - cumh[64 * jn + tid]) * L2E; bnx = jn > 0 ? (ref - cumh[64 * jn - 1]) * L2E : 0.f; }
        if (64 * j <= q0 + 32 * wid + 31) {
            f32x16 p0 = {}, p1 = {};
#pragma unroll
            for (int d0 = 0; d0 < 4; ++d0) {
                const bf16x8 k0 = *(const LAS bf16x8*)(Ks + r32 * 144 + d0 * 32 + hi * 16);
                const bf16x8 k1 = *(const LAS bf16x8*)(Ks + (32 + r32) * 144 + d0 * 32 + hi * 16);
                p0 = __builtin_amdgcn_mfma_f32_32x32x16_bf16(k0, qr[d0], p0, 0, 0, 0);
                p1 = __builtin_amdgcn_mfma_f32_32x32x16_bf16(k1, qr[d0], p1, 0, 0, 0); }
#pragma unroll
            for (int g = 0; g < 4; ++g) { const f32x4 b0 = *(const LAS f32x4*)(biasL + 8 * g + 4 * hi), b1 = *(const LAS f32x4*)(biasL + 32 + 8 * g + 4 * hi);
#pragma unroll
                for (int e = 0; e < 4; ++e) { p0[4 * g + e] += b0[e]; p1[4 * g + e] += b1[e]; } }
            if (64 * j + 63 > q0 + 32 * wid) {
#pragma unroll
                for (int r = 0; r < 16; ++r) { const int kv = 64 * j + crow(r, hi); if (kv > qrow) p0[r] = -INFINITY; if (kv + 32 > qrow) p1[r] = -INFINITY; } }
            float mx = fmaxf(p0[0], p1[0]);
#pragma unroll
            for (int r = 1; r < 16; ++r) mx = fmaxf(mx, fmaxf(p0[r], p1[r]));
            mx = fmaxf(mx, __shfl_xor(mx, 32));
            const float mnew = fmaxf(m, mx); const float f = __builtin_amdgcn_exp2f(m - mnew); m = mnew;
            float rs = 0.f;
#pragma unroll
            for (int r = 0; r < 16; ++r) { p0[r] = __builtin_amdgcn_exp2f(p0[r] - mnew); p1[r] = __builtin_amdgcn_exp2f(p1[r] - mnew); rs += p0[r] + p1[r]; }
            lsum = lsum * f + rs;
            if (__any(f != 1.f)) {
                if (hi == 0) wsf[r32] = f;
                asm volatile("s_waitcnt lgkmcnt(0)" ::: "memory");
#pragma unroll
                for (int r = 0; r < 16; ++r) { const float fr = wsf[crow(r, hi)]; o0[r] *= fr; o1[r] *= fr; }
            }
            u32x4 pw[4];
            pw[0] = (u32x4){cvtpk(p0[0], p0[1]), cvtpk(p0[2], p0[3]), cvtpk(p0[4], p0[5]), cvtpk(p0[6], p0[7])};
            pw[1] = (u32x4){cvtpk(p0[8], p0[9]), cvtpk(p0[10], p0[11]), cvtpk(p0[12], p0[13]), cvtpk(p0[14], p0[15])};
            pw[2] = (u32x4){cvtpk(p1[0], p1[1]), cvtpk(p1[2], p1[3]), cvtpk(p1[4], p1[5]), cvtpk(p1[6], p1[7])};
            pw[3] = (u32x4){cvtpk(p1[8], p1[9]), cvtpk(p1[10], p1[11]), cvtpk(p1[12], p1[13]), cvtpk(p1[14], p1[15])};
#pragma unroll
            for (int s = 0; s < 4; ++s) { const int kvb = 16 * (s & 1) + 32 * (s >> 1);
                const LAS unsigned char* va = Vs + (kvb + 4 * hi + q4) * 144 + (16 * blk + 4 * p4) * 2;
                const s16x4 l0 = vtr(va), h0 = vtr(va + 8 * 144), l1 = vtr(va + 64), h1 = vtr(va + 8 * 144 + 64);
                const bf16x8 vf0 = {l0[0], l0[1], l0[2], l0[3], h0[0], h0[1], h0[2], h0[3]}, vf1 = {l1[0], l1[1], l1[2], l1[3], h1[0], h1[1], h1[2], h1[3]};
                const bf16x8 pa = __builtin_bit_cast(bf16x8, pw[s]);
                o0 = __builtin_amdgcn_mfma_f32_32x32x16_bf16(pa, vf0, o0, 0, 0, 0);
                o1 = __builtin_amdgcn_mfma_f32_32x32x16_bf16(pa, vf1, o1, 0, 0, 0); }
        }
        if (j == 0) break;
        const bool need = (qbound + bnx_cur > m - 40.f);
        if (tid == 0) flag[(it + 1) % 3] = 0u;
        if (__any(need) && lane == 0) flag[it % 3] = 1u;
        __syncthreads();
        const unsigned cont = flag[it % 3];
        if (!cont) break;
        --j; ++it;
    }
    lsum += __shfl_xor(lsum, 32);
    if (hi == 0) wsf[r32] = 1.f / lsum;
    asm volatile("s_waitcnt lgkmcnt(0)" ::: "memory");
    bf16* Ow = (bf16*)(a.ws + WS_PV) + (rowbase + q0 + wid * 32) * LDV + h * 64 + r32;
#pragma unroll
    for (int r = 0; r < 16; ++r) { const float inv = wsf[crow(r, hi)]; bf16* op = Ow + (size_t)crow(r, hi) * LDV;
        op[0] = (bf16)f2bf(o0[r] * inv); op[32] = (bf16)f2bf(o1[r] * inv); }
    __syncthreads();
}
__device__ __forceinline__ void p3a_phase(const Args& a, LAS unsigned char* lds, int l, int tid, int lane, int wave) {
    unsigned* ctr = (unsigned*)(a.ws + WS_CTL) + CW_QUEUE + 64 * l;
    volatile LAS unsigned* task = (volatile LAS unsigned*)(lds + AT_TASK);
    for (;;) {
        __syncthreads();
        if (tid == 0) task[0] = atomicAdd(ctr, 1u);
        __syncthreads();
        const unsigned tk = task[0];
        if (tk >= 240u + 1024u) break;
        int t2 = tid; asm volatile("" : "+v"(t2)); const int lane2 = t2 & 63;
        if (tk < 240u) { scan_task<false>(a, lds, (int)(tk / 15u), (int)(tk % 15u), t2, lane2, wave, (unsigned*)(a.ws + WS_CTL) + CW_QUEUE + 2048 + 64 * l + (tk / 15u)); }
        else { const unsigned u = tk - 240u; attn_unit(a, lds, l, (int)(u & 15), 63 - (int)(u >> 4), t2, lane2, wave); }
    }
}
__device__ __forceinline__ void p3b_phase(const Args& a, LAS unsigned char* lds, int l, int tid, int lane, int wave) {
    unsigned* ctr = (unsigned*)(a.ws + WS_CTL) + CW_QUEUE + 512 + 64 * l;
    volatile LAS unsigned* task = (volatile LAS unsigned*)(lds + AT_TASK);
    for (;;) {
        __syncthreads();
        if (tid == 0) task[0] = atomicAdd(ctr, 1u);
        __syncthreads();
        const unsigned tk = task[0];
        if (tk >= 256u) break;
        scan_task<true>(a, lds, (int)(tk >> 4), (int)(tk & 15), tid, lane, wave, nullptr);
    }
}

__device__ __forceinline__ float red16m(float x) {
    x += __uint_as_float(__builtin_amdgcn_update_dpp(0, __float_as_uint(x), 0xB1, 0xF, 0xF, true));
    x += __uint_as_float(__builtin_amdgcn_update_dpp(0, __float_as_uint(x), 0x4E, 0xF, 0xF, true));
    x += __uint_as_float(__builtin_amdgcn_update_dpp(0, __float_as_uint(x), 0x141, 0xF, 0xF, true));
    x += __uint_as_float(__builtin_amdgcn_update_dpp(0, __float_as_uint(x), 0x140, 0xF, 0xF, true));
    return x;
}
__device__ __forceinline__ void merge_phase(const Args& a, int l, int tid, int lane, int wave, int G) {
    const float* YA = (const float*)(a.ws + WS_YA); const bf16* VS = (const bf16*)(a.ws + WS_VS); const bf16* PB = (const bf16*)(a.ws + WS_PB);
    const bf16* PVo = (const bf16*)(a.ws + WS_PV);
    const float* SCS = (const float*)(a.ws + WS_SCS); bf16* YM = (bf16*)(a.ws + WS_YM);
    const int hd = 4 * (wave & 1) + (lane >> 4), c0 = hd * 64 + 4 * (lane & 15), tsub = wave >> 1;
    const f32x4 gg = *(const f32x4*)(a.in[15] + l * 512 + c0), gb = *(const f32x4*)(a.in[16] + l * 512 + c0);
    constexpr int MT = 4;
    for (int mb = blockIdx.x * (4 * MT); mb < M; mb += G * (4 * MT)) {
        f32x4 ya[MT]; u32x2 vv[MT], g1[MT], g2[MT], yb[MT]; float rkr[MT], mean[MT], var[MT];
#pragma unroll
        for (int u = 0; u < MT; ++u) { const int m = mb + 4 * u + tsub; const int b = m >= T ? 1 : 0, t = m - b * T;
            ya[u] = *(const f32x4*)(YA + (size_t)m * 512 + c0); vv[u] = *(const u32x2*)(VS + (size_t)m * 512 + c0);
            g1[u] = *(const u32x2*)(PB + (size_t)m * LDB + 1536 + c0); g2[u] = *(const u32x2*)(PB + (size_t)m * LDB + 2048 + c0);
            yb[u] = *(const u32x2*)(PVo + (size_t)m * LDV + c0);
            rkr[u] = SCS[((size_t)(b * 8 + hd) * T + t) * 4 + 2]; }
#pragma unroll
        for (int u = 0; u < MT; ++u) mean[u] = red16m((ya[u][0] + ya[u][1]) + (ya[u][2] + ya[u][3])) * (1.f / 64.f);
#pragma unroll
        for (int u = 0; u < MT; ++u) { const f32x4 d = ya[u] - mean[u]; var[u] = red16m((d[0] * d[0] + d[1] * d[1]) + (d[2] * d[2] + d[3] * d[3])) * (1.f / 64.f); }
#pragma unroll
        for (int u = 0; u < MT; ++u) { const int m = mb + 4 * u + tsub; const float rs = rsqrtf(var[u] + GN_EPS);
            f32x4 v4 = {bflo(vv[u].x), bfhi(vv[u].x), bflo(vv[u].y), bfhi(vv[u].y)};
            f32x4 ga = {bflo(g1[u].x), bfhi(g1[u].x), bflo(g1[u].y), bfhi(g1[u].y)}, gbv = {bflo(g2[u].x), bfhi(g2[u].x), bflo(g2[u].y), bfhi(g2[u].y)};
            f32x4 y2 = {bflo(yb[u].x), bfhi(yb[u].x), bflo(yb[u].y), bfhi(yb[u].y)};
            const f32x4 yn = ((ya[u] - mean[u]) * rs * gg + gb + v4 * rkr[u]) * ga; const f32x4 yo = y2 * gbv;
            u32x2 o1 = {pk2(yn[0], yn[1]), pk2(yn[2], yn[3])}, o2 = {pk2(yo[0], yo[1]), pk2(yo[2], yo[3])};
            *(u32x2*)(YM + (size_t)m * D + c0) = o1; *(u32x2*)(YM + (size_t)m * D + 512 + c0) = o2; }
    }
}

#ifndef N_LAUNCH_MODE
#define N_LAUNCH_MODE 1
#endif
template <int MASK, bool COOP> __device__ __forceinline__ void run_phases(const Args& a, LAS unsigned char* lds, int l0, int l1) {
    const int G = gridDim.x;
#define LAUNDER() int tid = threadIdx.x; asm volatile("" : "+v"(tid)); const int lane = tid & 63, wave = __builtin_amdgcn_readfirstlane(tid >> 6); (void)lane; (void)wave
    float* hbuf = a.out;
    const float* mod = (const float*)(a.ws + WS_CTL) + CW_MOD;
    bf16* XN = (bf16*)(a.ws + WS_XN);
#define GSYNC() do { if constexpr (COOP) cg::this_grid().sync(); } while (0)
    if constexpr (MASK & 1) { LAUNDER(); p0a(a, lds, tid, lane, wave, G); GSYNC(); }
    if constexpr (MASK & 2) { LAUNDER(); ln_rows(a.in[0], a.in[2], a.in[3], hbuf, XN, mod, lane, wave, G); GSYNC(); }
#pragma unroll 1
    for (int l = l0; l < l1; ++l) {
        for (int rep = 0; rep < ((PROBE_REP & 4) ? 2 : 1); ++rep)
        if constexpr (MASK & 4) { pg8::Gemm g{XN, (const bf16*)(a.ws + WS_WIN) + (size_t)l * NPROJ * 1024, M, NPROJ, 1024}; pg8::StaticOrder S; S.init(M, NPROJ, G, (int)blockIdx.x);
          EpiProj E{(bf16*)(a.ws + WS_PA), (bf16*)(a.ws + WS_PV), (bf16*)(a.ws + WS_PB)};
          pg8::gemm_phase<EpiProj, pg8::StaticOrder, true, true>(lds, g, S, E); GSYNC(); }
        for (int rep = 0; rep < ((PROBE_REP & 8) ? 2 : 1); ++rep)
        if constexpr (MASK & 8) { LAUNDER(); prep_phase(a, lds, l, tid, lane, wave, G); GSYNC(); }
        if constexpr (MASK & 16) { { LAUNDER(); p3a_phase(a, lds, l, tid, lane, wave); } GSYNC(); { LAUNDER(); p3b_phase(a, lds, l, tid, lane, wave); } GSYNC(); }
        for (int rep = 0; rep < ((PROBE_REP & 32) ? 2 : 1); ++rep)
        if constexpr (MASK & 32) { LAUNDER(); merge_phase(a, l, tid, lane, wave, G); GSYNC(); }
        if constexpr (MASK & 64) { pg8::Gemm g{(const bf16*)(a.ws + WS_YM), (const bf16*)(a.ws + WS_WOUT) + (size_t)l * 1024 * 1024, M, D, D}; pg8::StaticOrder S; S.init(M, D, G, (int)blockIdx.x);
          EpiOut E{hbuf, mod + l * 2 * 3072};
          pg8::gemm_phase<EpiOut, pg8::StaticOrder, true, true>(lds, g, S, E); GSYNC(); }
        if constexpr (MASK & 128) { LAUNDER(); ln_rows(hbuf, a.in[19] + l * D, a.in[20] + l * D, hbuf, XN, (l + 1 < DEPTH) ? mod + (l + 1) * 2 * 3072 : nullptr, lane, wave, G);
          if (l + 1 < l1) GSYNC(); }
    }
#undef GSYNC
#undef LAUNDER
}
#ifndef FMASK
#define FMASK 0xFF
#endif
#if N_LAUNCH_MODE == 1
__global__ void __launch_bounds__(512, 2) hymba_fwd(Args a) {
    extern __shared__ __attribute__((aligned(16))) unsigned char lds_raw[];
    run_phases<FMASK, true>(a, (LAS unsigned char*)lds_raw, 0, DEPTH);
}
#else
template <int MASK> __global__ void __launch_bounds__(512, 2) hymba_phase(Args a, int l) {
    extern __shared__ __attribute__((aligned(16))) unsigned char lds_raw[];
    run_phases<MASK, false>(a, (LAS unsigned char*)lds_raw, l, l + 1);
}
template <int MASK> static void launch_phase(const Args& a, int l, hipStream_t stream) {
    static bool attr = false;
    if (!attr) { (void)hipFuncSetAttribute((const void*)hymba_phase<MASK>, hipFuncAttributeMaxDynamicSharedMemorySize, LDS_BYTES); attr = true; }
    hipLaunchKernelGGL(hymba_phase<MASK>, dim3(256), dim3(512), LDS_BYTES, stream, a, l);
}
#endif

extern "C" void kernel_launch(void* const* d_in, const int* in_sizes, int n_in, void* d_out, int out_size, void* d_ws, size_t ws_size, hipStream_t stream) {
    if (n_in != 21 || ws_size < WS_END) { fprintf(stderr, "kernel_launch: unexpected n_in %d / ws %zu\n", n_in, ws_size); return; }
    (void)hipMemsetAsync((char*)d_ws + WS_CTL, 0, CTL_ZERO_BYTES, stream);
    Args a{};
    for (int i = 0; i < 21; ++i) a.in[i] = (const float*)d_in[i];
    a.out = (float*)d_out; a.ws = (unsigned char*)d_ws;
#if N_LAUNCH_MODE == 1
    static int grid = 0;
    if (grid == 0) {
        int dev = 0, cus = 0, per_cu = 0;
        (void)hipGetDevice(&dev); (void)hipDeviceGetAttribute(&cus, hipDeviceAttributeMultiprocessorCount, dev);
        (void)hipFuncSetAttribute((const void*)hymba_fwd, hipFuncAttributeMaxDynamicSharedMemorySize, LDS_BYTES);
        (void)hipOccupancyMaxActiveBlocksPerMultiprocessor(&per_cu, (const void*)hymba_fwd, 512, LDS_BYTES);
        if (per_cu < 1) per_cu = 1;
        (void)hipGetLastError();
        grid = cus * per_cu;
    }
    void* args[] = {&a};
    hipError_t e = hipLaunchCooperativeKernel((const void*)hymba_fwd, dim3(grid), dim3(512), args, LDS_BYTES, stream);
    if (e != hipSuccess) fprintf(stderr, "cooperative launch failed: %s (grid %d)\n", hipGetErrorString(e), grid);
#else
    launch_phase<1>(a, 0, stream); launch_phase<2>(a, 0, stream);
    for (int l = 0; l < DEPTH; ++l) { launch_phase<4>(a, l, stream); launch_phase<8>(a, l, stream); launch_phase<16>(a, l, stream); launch_phase<32>(a, l, stream); launch_phase<64>(a, l, stream); launch_phase<128>(a, l, stream); }
#endif
}
```

```cpp
#include <hip/hip_runtime.h>
#include <cstdio>
#include <cstdint>
namespace pg8 {
#define PG8_LAS __attribute__((address_space(3)))
typedef unsigned short bf16_t;
typedef short bf16x8 __attribute__((ext_vector_type(8)));
typedef float f32x4 __attribute__((ext_vector_type(4)));
typedef unsigned u32x4 __attribute__((ext_vector_type(4)));
constexpr int BM = 256, BK = 64, HALF = 128, HTB = HALF * BK * 2  , STAGE_BYTES = 8 * HTB, NXCD = 8, WGM = 8;

__host__ __device__ __forceinline__ int lds_byte(int r, int c) { const int st = (r >> 4) * 2 + (c >> 5), rr = r & 15, cc = c & 31, ob = rr * 64 + cc * 2; return st * 1024 + (ob ^ (((ob >> 9) & 1) << 5)); }
__host__ __device__ __forceinline__ void stage_rc(int b, int& R, int& C) { const int st = b / 1024, sb = b % 1024, swz = sb ^ (((sb >> 9) & 1) << 5); R = (st >> 1) * 16 + swz / 64; C = (st & 1) * 32 + (swz % 64) / 2; }
__host__ __device__ __forceinline__ int perm32(int rho) { const int n = rho >> 4, i = rho & 15; return 8 * (i >> 2) + 4 * n + (i & 3); }

struct Unit { int pm, pn; };
struct Gemm { const bf16_t* A; const bf16_t* Bt; int M, N, K; };

struct StaticOrder {
    int nM, nN, nwg, G, c;
    __host__ __device__ void init(int M, int N, int G_, int c_) { nM = M / BM; nN = N / BM; nwg = nM * nN; G = G_; c = c_; }
    __host__ __device__ bool next(int i, Unit& u) const {
        const long L = (long)i * G + c; if (L >= nwg) return false;
        int wgid = (int)L; { const int q = nwg / NXCD, r = nwg % NXCD, xcd = wgid % NXCD, off = wgid / NXCD; wgid = (xcd < r ? xcd * (q + 1) : r * (q + 1) + (xcd - r) * q) + off; }
        const int nig = WGM * nN, gid = wgid / nig, fm = gid * WGM, gsz = (nM - fm) < WGM ? (nM - fm) : WGM;
        u.pm = fm + ((wgid % nig) % gsz); u.pn = (wgid % nig) / gsz; return true;
    }
    __device__ __forceinline__ void a_ready(const Unit&) const {}
    __device__ __forceinline__ void done(const Unit&) const {}
};

__device__ __forceinline__ unsigned cvt_pk_bf16(float lo, float hi) { unsigned r; asm volatile("v_cvt_pk_bf16_f32 %0, %1, %2" : "=v"(r) : "v"(lo), "v"(hi)); return r; }
typedef float f32x2 __attribute__((ext_vector_type(2)));
__device__ __forceinline__ f32x2 gelu_pk(f32x2 v) {
    const f32x2 av = __builtin_elementwise_abs(v), d = av * 0.2316418882f + 1.0f;
    f32x2 t; t.x = __builtin_amdgcn_rcpf(d.x); t.y = __builtin_amdgcn_rcpf(d.y);
    f32x2 q = t * 0.5307027145f + (-0.7265760135f); q = q * t + 0.7107068705f; q = q * t + (-0.142248368f); q = q * t + 0.127414796f; q = q * t;
    const f32x2 s = (v * v) * (-0.72134752044f);
    f32x2 e; e.x = __builtin_amdgcn_exp2f(s.x); e.y = __builtin_amdgcn_exp2f(s.y);
    const f32x2 m = v * (q * e), r = v - m;
    f32x2 o; o.x = v.x < 0.f ? m.x : r.x; o.y = v.y < 0.f ? m.y : r.y; return o;
}

template <int ACT  > struct EpiBf16 {
    static constexpr bool PERM = true, AFTER_DRAIN = false; static_assert(ACT == 0 || ACT == 1, "EpiBf16: ACT is 0 (none) or 1 (gelu_pk)");
    bf16_t* O; int ldc; const float* bias; int split_cols; size_t split_stride; float scale0;
    __device__ __forceinline__ void operator()(const f32x4 (&acc)[2][2][4][2], const Unit& u, int wr, int wc, int fr, int fq) const {
        const int row0 = u.pm * BM + wr * 64 + fr; int colt = u.pn * BM; bf16_t* base = O;
        float sc = 1.f; if (split_cols) { const int t = colt / split_cols; base += (size_t)t * split_stride; colt -= t * split_cols; if (t == 0) sc = scale0; }
        const int col0 = colt + wc * 32 + 8 * fq, bcol0 = u.pn * BM + wc * 32 + 8 * fq;
        f32x4 bv[2][2];
#pragma unroll
        for (int bj = 0; bj < 2; ++bj)
#pragma unroll
            for (int n = 0; n < 2; ++n) bv[bj][n] = bias ? *(const f32x4*)(bias + bcol0 + bj * HALF + 4 * n) : (f32x4){0.f, 0.f, 0.f, 0.f};
#pragma unroll
        for (int ai = 0; ai < 2; ++ai)
#pragma unroll
            for (int m = 0; m < 4; ++m) { bf16_t* rowp = base + (size_t)(row0 + ai * HALF + m * 16) * ldc + col0;
#pragma unroll
                for (int bj = 0; bj < 2; ++bj) { f32x4 v0 = acc[ai][bj][m][0] + bv[bj][0], v1 = acc[ai][bj][m][1] + bv[bj][1];
                    if (ACT == 1) { f32x2 a = gelu_pk((f32x2){v0[0], v0[1]}), b = gelu_pk((f32x2){v0[2], v0[3]}), c = gelu_pk((f32x2){v1[0], v1[1]}), d = gelu_pk((f32x2){v1[2], v1[3]});
                        v0 = (f32x4){a.x, a.y, b.x, b.y}; v1 = (f32x4){c.x, c.y, d.x, d.y}; }
                    v0 = v0 * sc; v1 = v1 * sc; u32x4 w; w.x = cvt_pk_bf16(v0[0], v0[1]); w.y = cvt_pk_bf16(v0[2], v0[3]); w.z = cvt_pk_bf16(v1[0], v1[1]); w.w = cvt_pk_bf16(v1[2], v1[3]);
                    *(u32x4*)(rowp + bj * HALF) = w; } }
    }
};

template <class Epi, class Sched, bool ALIGN_EPI = false, bool SP2 = false>
__device__ __forceinline__ void gemm_phase(PG8_LAS unsigned char* lds, const Gemm g, const Sched& S, const Epi& E) {
    int tid = threadIdx.x; asm volatile("" : "+v"(tid));
    const int wid = __builtin_amdgcn_readfirstlane(tid >> 6), lane = tid & 63, wr = wid >> 2, wc = wid & 3, fr = lane & 15, fq = lane >> 4;
    const int K = g.K, nt = K / BK;
    unsigned voffA[2], voffB[2];
#pragma unroll
    for (int i = 0; i < 2; ++i) { int R, C; stage_rc(tid * 16 + i * 8192, R, C); const int Rb = Epi::PERM ? ((R & ~31) + perm32(R & 31)) : R;
        voffA[i] = (unsigned)(R * K + C) * 2u; voffB[i] = (unsigned)(Rb * K + C) * 2u; }
    const size_t kstep = (size_t)(BK * 2);
    const size_t hstep = (size_t)HALF * K * 2;
    const size_t tstep = 2 * hstep;
    const unsigned ldsw = (unsigned)wid * 1024u;
    const int aoff = lds_byte(wr * 64 + fr, fq * 8), boff = lds_byte(wc * 32 + fr, fq * 8);
#define PG8_SA(b, h) (((b) * 2 + (h)) * HTB)
#define PG8_SB(b, h) ((4 + (b) * 2 + (h)) * HTB)
#define PG8_STAGE(bufoff, gbase, voff) do { _Pragma("unroll") for (int _i = 0; _i < 2; ++_i) \
        __builtin_amdgcn_global_load_lds((const unsigned*)((const char*)(gbase) + (voff)[_i]), (PG8_LAS unsigned*)(lds + (bufoff) + ldsw + _i * 8192), 16, 0, 0); } while (0)
#define PG8_LDA(dst, b, h) do { _Pragma("unroll") for (int m = 0; m < 4; ++m) _Pragma("unroll") for (int k = 0; k < 2; ++k) dst[m][k] = *(const PG8_LAS bf16x8*)(lds + PG8_SA(b, h) + aoff + m * 2048 + k * 1024); } while (0)
#define PG8_LDB(dst, b, h) do { _Pragma("unroll") for (int n = 0; n < 2; ++n) _Pragma("unroll") for (int k = 0; k < 2; ++k) dst[n][k] = *(const PG8_LAS bf16x8*)(lds + PG8_SB(b, h) + boff + n * 2048 + k * 1024); } while (0)
#define PG8_MMA(ai, bj, At, Bt) do { __builtin_amdgcn_s_setprio(1); _Pragma("unroll") for (int m = 0; m < 4; ++m) _Pragma("unroll") for (int n = 0; n < 2; ++n) _Pragma("unroll") for (int k = 0; k < 2; ++k) \
        acc[ai][bj][m][n] = __builtin_amdgcn_mfma_f32_16x16x32_bf16(Bt[n][k], At[m][k], acc[ai][bj][m][n], 0, 0, 0); __builtin_amdgcn_s_setprio(0); } while (0)
#define PG8_WAIT_V(n) asm volatile("s_waitcnt vmcnt(" #n ")" ::: "memory")
#define PG8_WAIT_L(n) asm volatile("s_waitcnt lgkmcnt(" #n ")" ::: "memory")
#define PG8_BAR __builtin_amdgcn_s_barrier()
#define PG8_SCHED __builtin_amdgcn_sched_barrier(0)
    Unit cur, nxt; int ui = 0;
    if (!S.next(0, cur)) return;
    f32x4 acc[2][2][4][2];
#pragma unroll
    for (int a = 0; a < 2; ++a)
#pragma unroll
        for (int b = 0; b < 2; ++b)
#pragma unroll
            for (int m = 0; m < 4; ++m)
#pragma unroll
                for (int n = 0; n < 2; ++n) acc[a][b][m][n] = (f32x4){0.f, 0.f, 0.f, 0.f};
    bf16x8 At[4][2], B0[2][2], B1[2][2];
    const char* cA = (const char*)g.A + (size_t)cur.pm * tstep; const char* cB = (const char*)g.Bt + (size_t)cur.pn * tstep;
    S.a_ready(cur);
    if constexpr (SP2) {
        PG8_STAGE(PG8_SB(0, 0), cB, voffB); PG8_STAGE(PG8_SB(0, 1), cB + hstep, voffB); PG8_STAGE(PG8_SA(0, 0), cA, voffA); PG8_STAGE(PG8_SA(0, 1), cA + hstep, voffA);
        if (wr == 1) PG8_BAR;
        PG8_WAIT_V(2); PG8_BAR;
        PG8_STAGE(PG8_SB(1, 0), cB + kstep, voffB); PG8_STAGE(PG8_SA(1, 0), cA + kstep, voffA); PG8_STAGE(PG8_SB(1, 1), cB + hstep + kstep, voffB);
        PG8_WAIT_V(6); PG8_BAR;
    } else {
        PG8_STAGE(PG8_SB(0, 0), cB, voffB); PG8_STAGE(PG8_SA(0, 0), cA, voffA); PG8_STAGE(PG8_SB(0, 1), cB + hstep, voffB); PG8_STAGE(PG8_SA(0, 1), cA + hstep, voffA);
        if (wr == 1) PG8_BAR;
        PG8_WAIT_V(4); PG8_BAR;
        PG8_STAGE(PG8_SB(1, 0), cB + kstep, voffB); PG8_STAGE(PG8_SA(1, 0), cA + kstep, voffA); PG8_STAGE(PG8_SB(1, 1), cB + hstep + kstep, voffB);
        PG8_WAIT_V(6); PG8_BAR;
    }
    for (;;) {
        const bool has_next = S.next(ui + 1, nxt);
        const char* nA = has_next ? (const char*)g.A + (size_t)nxt.pm * tstep : cA; const char* nB = has_next ? (const char*)g.Bt + (size_t)nxt.pn * tstep : cB;
        for (int t = 0; t < nt; t += 2) {
            const bool last = (t == nt - 2);
            const char* a1 = cA + (size_t)(t + 1) * kstep;
            const char* a2 = last ? nA : cA + (size_t)(t + 2) * kstep; const char* b2 = last ? nB : cB + (size_t)(t + 2) * kstep;
            const char* a3 = a2 + kstep; const char* b3 = b2 + kstep;
            if (last && has_next) S.a_ready(nxt);
            if constexpr (SP2) {
            PG8_LDB(B0, 0, 0); PG8_LDB(B1, 0, 1); PG8_SCHED; PG8_LDA(At, 0, 0); PG8_STAGE(PG8_SA(1, 1), a1 + hstep, voffA);
            PG8_WAIT_V(8); PG8_WAIT_L(0); PG8_BAR; PG8_MMA(0, 0, At, B0); PG8_MMA(0, 1, At, B1); PG8_BAR; PG8_SCHED;
            PG8_LDA(At, 0, 1); PG8_STAGE(PG8_SB(0, 0), b2, voffB); PG8_STAGE(PG8_SB(0, 1), b2 + hstep, voffB); PG8_STAGE(PG8_SA(0, 0), a2, voffA);
            PG8_WAIT_V(8); PG8_WAIT_L(0); PG8_BAR; PG8_MMA(1, 0, At, B0); PG8_MMA(1, 1, At, B1); PG8_BAR; PG8_SCHED;
            PG8_LDB(B0, 1, 0); PG8_LDB(B1, 1, 1); PG8_SCHED; PG8_LDA(At, 1, 0); PG8_STAGE(PG8_SA(0, 1), a2 + hstep, voffA);
            PG8_WAIT_V(8); PG8_WAIT_L(0); PG8_BAR; PG8_MMA(0, 0, At, B0); PG8_MMA(0, 1, At, B1); PG8_BAR; PG8_SCHED;
            PG8_LDA(At, 1, 1); PG8_STAGE(PG8_SB(1, 0), b3, voffB); PG8_STAGE(PG8_SB(1, 1), b3 + hstep, voffB); PG8_STAGE(PG8_SA(1, 0), a3, voffA);
            PG8_WAIT_V(8); PG8_WAIT_L(0); PG8_BAR; PG8_MMA(1, 0, At, B0); PG8_MMA(1, 1, At, B1); PG8_BAR; PG8_SCHED;
            } else {
            PG8_LDB(B0, 0, 0); PG8_SCHED; PG8_LDA(At, 0, 0); PG8_STAGE(PG8_SA(1, 1), a1 + hstep, voffA);
            PG8_WAIT_L(8); PG8_BAR; PG8_WAIT_L(0); PG8_MMA(0, 0, At, B0); PG8_BAR; PG8_SCHED;
            PG8_LDB(B1, 0, 1); PG8_STAGE(PG8_SB(0, 0), b2, voffB);
            PG8_BAR; PG8_WAIT_L(0); PG8_MMA(0, 1, At, B1); PG8_BAR;
            PG8_LDA(At, 0, 1); PG8_STAGE(PG8_SA(0, 0), a2, voffA);
            PG8_BAR; PG8_WAIT_L(0); PG8_MMA(1, 0, At, B0); PG8_BAR; PG8_SCHED;
            PG8_STAGE(PG8_SB(0, 1), b2 + hstep, voffB);
            PG8_WAIT_V(6); PG8_BAR; PG8_MMA(1, 1, At, B1); PG8_BAR;
            PG8_LDB(B0, 1, 0); PG8_SCHED; PG8_LDA(At, 1, 0); PG8_STAGE(PG8_SA(0, 1), a2 + hstep, voffA);
            PG8_WAIT_L(8); PG8_BAR; PG8_WAIT_L(0); PG8_MMA(0, 0, At, B0); PG8_BAR; PG8_SCHED;
            PG8_LDB(B1, 1, 1); PG8_STAGE(PG8_SB(1, 0), b3, voffB);
            PG8_BAR; PG8_WAIT_L(0); PG8_MMA(0, 1, At, B1); PG8_BAR;
            PG8_LDA(At, 1, 1); PG8_STAGE(PG8_SA(1, 0), a3, voffA);
            PG8_BAR; PG8_WAIT_L(0); PG8_MMA(1, 0, At, B0); PG8_BAR; PG8_SCHED;
            PG8_STAGE(PG8_SB(1, 1), b3 + hstep, voffB);
            PG8_WAIT_V(6); PG8_BAR; PG8_MMA(1, 1, At, B1); PG8_BAR;
            }
        }
        if constexpr (ALIGN_EPI) { if (wr == 0) PG8_BAR; }
        if constexpr (!Epi::AFTER_DRAIN) { E(acc, cur, wr, wc, fr, fq); S.done(cur); }
        if (!has_next) break;
#pragma unroll
        for (int a = 0; a < 2; ++a)
#pragma unroll
            for (int b = 0; b < 2; ++b)
#pragma unroll
                for (int m = 0; m < 4; ++m)
#pragma unroll
                    for (int n = 0; n < 2; ++n) acc[a][b][m][n] = (f32x4){0.f, 0.f, 0.f, 0.f};
        cur = nxt; cA = nA; cB = nB; ++ui;
        if constexpr (ALIGN_EPI) { if (wr == 1) PG8_BAR; }
    }
    PG8_WAIT_V(0);
    if constexpr (!ALIGN_EPI) { if (wr == 0) PG8_BAR; }
    PG8_BAR;
    if constexpr (Epi::AFTER_DRAIN) { E.fused(acc, cur, wr, wc, fr, fq, lds, wid, lane); S.done(cur); }
#undef PG8_SA
#undef PG8_SB
#undef PG8_STAGE
#undef PG8_LDA
#undef PG8_LDB
#undef PG8_MMA
#undef PG8_WAIT_V
#undef PG8_WAIT_L
#undef PG8_BAR
#undef PG8_SCHED
}
}
#include <hip/hip_cooperative_groups.h>
namespace cg = cooperative_groups;
#define LAS __attribute__((address_space(3)))
typedef unsigned short bf16;
typedef float f32x4 __attribute__((ext_vector_type(4)));
typedef float f32x2 __attribute__((ext_vector_type(2)));
typedef float f32x16 __attribute__((ext_vector_type(16)));
typedef short bf16x8 __attribute__((ext_vector_type(8)));
typedef short s16x4 __attribute__((ext_vector_type(4)));
typedef unsigned u32x4 __attribute__((ext_vector_type(4)));
typedef unsigned u32x2 __attribute__((ext_vector_type(2)));
typedef __bf16 bf16x2_t __attribute__((ext_vector_type(2)));

constexpr int BATCH = 2, T = 16384, D = 1024, M = BATCH * T, DEPTH = 2;
constexpr int NPROJ = 4352, NSRC = 4232;
constexpr int LDA = 1280, LDV = 512, LDB = 2560;
constexpr float LN_EPS = 1e-5f, GN_EPS = 64e-5f;
constexpr float DN_ALPHA = 1.41421356237f;
constexpr float C2 = 0.125f * 1.4426950408889634f;
constexpr float L2E = 1.4426950408889634f;
constexpr size_t MiB = 1u << 20;
constexpr size_t WS_CTL = 0, CTL_ZERO_BYTES = 1 * MiB;
constexpr size_t WS_WIN = 2 * MiB, WS_WOUT = 20 * MiB, WS_CUM = 24 * MiB, WS_SCS = 25 * MiB, WS_SCN = 30 * MiB;
constexpr size_t WS_XN = WS_SCN, WS_YM = WS_SCN;
constexpr size_t WS_CSUM = 29 * MiB + 512 * 1024;
constexpr size_t WS_LORA = 29 * MiB;
constexpr size_t WS_PA = 190 * MiB, WS_YA = WS_PA, WS_PV = 270 * MiB, WS_PB = 302 * MiB, WS_VS = 462 * MiB, WS_FS = 494 * MiB, WS_SI = 502 * MiB, WS_END = 506 * MiB;
constexpr int CW_QUEUE = 64;
constexpr int CW_KMAX = 1024;
constexpr int CW_MOD = 16384;
constexpr int LDS_BYTES = 147456;
#ifndef PROBE_REP
#define PROBE_REP 0
#endif

__device__ __forceinline__ unsigned f2bf(float f) { unsigned u = __builtin_bit_cast(unsigned, f); return (u + 0x7fffu + ((u >> 16) & 1u)) >> 16; }
__device__ __forceinline__ unsigned pk2(float lo, float hi) { return f2bf(lo) | (f2bf(hi) << 16); }
__device__ __forceinline__ float bf2f(unsigned short v) { return __uint_as_float(((unsigned)v) << 16); }
__device__ __forceinline__ float bflo(unsigned w) { return __uint_as_float(w << 16); }
__device__ __forceinline__ float bfhi(unsigned w) { return __uint_as_float(w & 0xffff0000u); }
__device__ __forceinline__ unsigned cvtpk(float lo, float hi) { f32x2 v = {lo, hi}; bf16x2_t b = __builtin_convertvector(v, bf16x2_t); return __builtin_bit_cast(unsigned, b); }
__device__ __forceinline__ float row16_sum(float x) {
    x += __uint_as_float(__builtin_amdgcn_update_dpp(0, __float_as_uint(x), 0xB1, 0xF, 0xF, true));
    x += __uint_as_float(__builtin_amdgcn_update_dpp(0, __float_as_uint(x), 0x4E, 0xF, 0xF, true));
    x += __uint_as_float(__builtin_amdgcn_update_dpp(0, __float_as_uint(x), 0x141, 0xF, 0xF, true));
    x += __uint_as_float(__builtin_amdgcn_update_dpp(0, __float_as_uint(x), 0x140, 0xF, 0xF, true));
    return x;
}
__device__ __forceinline__ float wave_sum(float v) { v = row16_sum(v); v += __shfl_xor(v, 16); v += __shfl_xor(v, 32); return v; }
__device__ __forceinline__ float fast_sigmoid(float x) { return 1.f / (1.f + __expf(-x)); }

struct Args { const float* in[21]; float* out; unsigned char* ws; };

struct EpiProj {
    static constexpr bool PERM = true, AFTER_DRAIN = false;
    bf16 *PA, *PVb, *PB;
    __device__ __forceinline__ void operator()(const pg8::f32x4 (&acc)[2][2][4][2], const pg8::Unit& u, int wr, int wc, int fr, int fq) const {
        const int row0 = u.pm * 256 + wr * 64 + fr; const int pn = u.pn;
        bf16* base; int ldc, colt; float sc = 1.f; bool act = false;
        if (pn < 4) { base = PA; ldc = LDA; colt = pn * 256; }
        else if (pn < 6) { base = PVb; ldc = LDV; colt = (pn - 4) * 256; }
        else if (pn == 6) { base = PA; ldc = LDA; colt = 1024; }
        else { base = PB; ldc = LDB; colt = (pn - 7) * 256; if (pn < 9) sc = C2; if (pn >= 13) act = true; }
        const int col0 = colt + wc * 32 + 8 * fq;
#pragma unroll
        for (int ai = 0; ai < 2; ++ai)
#pragma unroll
            for (int m = 0; m < 4; ++m) { bf16* rowp = base + (size_t)(row0 + ai * 128 + m * 16) * ldc + col0;
#pragma unroll
                for (int bj = 0; bj < 2; ++bj) { pg8::f32x4 v0 = acc[ai][bj][m][0], v1 = acc[ai][bj][m][1];
                    if (act) {
#pragma unroll
                        for (int e = 0; e < 4; ++e) { v0[e] = v0[e] * fast_sigmoid(v0[e]); v1[e] = v1[e] * fast_sigmoid(v1[e]); } }
                    v0 = v0 * sc; v1 = v1 * sc; u32x4 w; w.x = cvtpk(v0[0], v0[1]); w.y = cvtpk(v0[2], v0[3]); w.z = cvtpk(v1[0], v1[1]); w.w = cvtpk(v1[2], v1[3]);
                    *(u32x4*)(rowp + bj * 128) = w; } }
    }
};
struct EpiOut {
    static constexpr bool PERM = false, AFTER_DRAIN = false;
    float* hz; const float* modl;
    __device__ __forceinline__ void operator()(const pg8::f32x4 (&acc)[2][2][4][2], const pg8::Unit& u, int wr, int wc, int fr, int fq) const {
        const int col0 = u.pn * 256 + wc * 32 + 4 * fq; const int b = (u.pm * 256) >= T ? 1 : 0; const float* gate = modl + b * 3072 + 2048;
#pragma unroll
        for (int bj = 0; bj < 2; ++bj)
#pragma unroll
            for (int n = 0; n < 2; ++n) { const int c = col0 + bj * 128 + n * 16; const f32x4 g = *(const f32x4*)(gate + c) + 1.0f;
#pragma unroll
                for (int ai = 0; ai < 2; ++ai)
#pragma unroll
                    for (int m = 0; m < 4; ++m) { const int r = u.pm * 256 + ai * 128 + wr * 64 + m * 16 + fr; float* p = hz + (size_t)r * D + c;
                        const f32x4 hx = *(const f32x4*)p; f32x4 a; a[0] = acc[ai][bj][m][n][0]; a[1] = acc[ai][bj][m][n][1]; a[2] = acc[ai][bj][m][n][2]; a[3] = acc[ai][bj][m][n][3];
                        *(f32x4*)p = hx * DN_ALPHA + g * a; } }
    }
};

__device__ __forceinline__ int win_map(int n) { if (n < 1664) return n; if (n < 1672) return 3200 + n - 1664; if (n < 1792) return -1; if (n < 3328) return n - 128; return n - 120; }
template <bool MAP> __device__ __forceinline__ void transpose_item(const float* W, int Nsrc, int Ndst, bf16* WT, LAS float* scr, int item, int lane) {
    const int nblk = Ndst / 32, kb = item / nblk, nb = item % nblk, k0 = 64 * kb, n0 = 32 * nb;
    const int src = MAP ? win_map(n0 + (lane & 31)) : n0 + (lane & 31);
#pragma unroll 8
    for (int i = 0; i < 32; ++i) { const int kk = 2 * i + (lane >> 5); scr[kk * 33 + (lane & 31)] = src >= 0 ? W[(size_t)(k0 + kk) * Nsrc + src] : 0.f; }
    asm volatile("s_waitcnt lgkmcnt(0)" ::: "memory");
    const int c = lane & 7;
#pragma unroll
    for (int j = 0; j < 4; ++j) { const int n = (lane >> 3) + 8 * j; const LAS float* s = scr + (8 * c) * 33 + n;
        u32x4 o; o.x = pk2(s[0 * 33], s[1 * 33]); o.y = pk2(s[2 * 33], s[3 * 33]); o.z = pk2(s[4 * 33], s[5 * 33]); o.w = pk2(s[6 * 33], s[7 * 33]);
        *(u32x4*)(WT + (size_t)(n0 + n) * 1024 + k0 + 8 * c) = o; }
    asm volatile("s_waitcnt lgkmcnt(0)" ::: "memory");
}
__device__ __forceinline__ void p0a(const Args& a, LAS unsigned char* lds, int tid, int lane, int wave, int G) {
    LAS float* scr = (LAS float*)(lds + wave * 16384);
    const int gw = blockIdx.x * 8 + wave, NGW = G * 8;
    constexpr int I_IN = 16 * (NPROJ / 32), I_OUT = 16 * 32;
    for (int it = gw; it < 2 * (I_IN + I_OUT); it += NGW) {
        int r = it; const int l = r / (I_IN + I_OUT); r -= l * (I_IN + I_OUT);
        if (r < I_IN) transpose_item<true>(a.in[6] + (size_t)l * 1024 * NSRC, NSRC, NPROJ, (bf16*)(a.ws + WS_WIN) + (size_t)l * NPROJ * 1024, scr, r, lane);
        else transpose_item<false>(a.in[18] + (size_t)l * 1024 * 1024, 1024, 1024, (bf16*)(a.ws + WS_WOUT) + (size_t)l * 1024 * 1024, scr, r - I_IN, lane);
    }
    { bf16* LT = (bf16*)(a.ws + WS_LORA);
      for (int w = blockIdx.x * 512 + tid; w < 2 * 2 * 512 * 64; w += G * 512) { const int k = w & 63, n = (w >> 6) & 511, which = (w >> 15) & 1, l = w >> 16;
          const float* src = (which ? a.in[11] : a.in[9]) + (size_t)l * 64 * 512; LT[w] = (bf16)f2bf(src[k * 512 + n]); } }
    float* mod = (float*)(a.ws + WS_CTL) + CW_MOD;
    const float* cvec = a.in[1];
    for (int w = blockIdx.x * 512 + tid; w < 2 * 16 * 3072; w += G * 512) {
        const int j = w % 3072, sl = (w / 3072) % 16, l = w / (3072 * 16);
        const float* wa = a.in[4] + (size_t)l * 1024 * 3072 + (size_t)(sl * 64) * 3072 + j;
        float s0 = 0.f, s1 = 0.f;
#pragma unroll 8
        for (int i = 0; i < 64; ++i) { const float wv = wa[(size_t)i * 3072]; s0 += cvec[sl * 64 + i] * wv; s1 += cvec[1024 + sl * 64 + i] * wv; }
        if (sl == 0) { const float bb = a.in[5][l * 3072 + j]; s0 += bb; s1 += bb; }
        atomicAdd(mod + (l * 2 + 0) * 3072 + j, s0); atomicAdd(mod + (l * 2 + 1) * 3072 + j, s1);
    }
}
__device__ __forceinline__ void ln_rows(const float* src, const float* g, const float* bb, float* dst, bf16* xn, const float* modn, int lane, int wave, int G) {
    const int gw = blockIdx.x * 8 + wave, NGW = G * 8;
    f32x4 gv[4], bv[4];
#pragma unroll
    for (int j = 0; j < 4; ++j) { gv[j] = ((const f32x4*)g)[lane + 64 * j]; bv[j] = ((const f32x4*)bb)[lane + 64 * j]; }
    for (int m0 = gw * 2; m0 < M; m0 += NGW * 2) {
        f32x4 v[2][4]; float s[2], s2[2];
#pragma unroll
        for (int u = 0; u < 2; ++u) { const f32x4* xr = (const f32x4*)(src + (size_t)(m0 + u) * D) + lane; s[u] = 0.f;
#pragma unroll
            for (int j = 0; j < 4; ++j) { v[u][j] = xr[64 * j]; s[u] += (v[u][j].x + v[u][j].y) + (v[u][j].z + v[u][j].w); } }
#pragma unroll
        for (int u = 0; u < 2; ++u) s[u] = row16_sum(s[u]);
#pragma unroll
        for (int o = 16; o < 64; o <<= 1) {
#pragma unroll
            for (int u = 0; u < 2; ++u) s[u] += __shfl_xor(s[u], o); }
#pragma unroll
        for (int u = 0; u < 2; ++u) { const float mean = s[u] * (1.f / D); s2[u] = 0.f;
#pragma unroll
            for (int j = 0; j < 4; ++j) { v[u][j] = v[u][j] - mean; s2[u] += (v[u][j].x * v[u][j].x + v[u][j].y * v[u][j].y) + (v[u][j].z * v[u][j].z + v[u][j].w * v[u][j].w); } }
#pragma unroll
        for (int u = 0; u < 2; ++u) s2[u] = row16_sum(s2[u]);
#pragma unroll
        for (int o = 16; o < 64; o <<= 1) {
#pragma unroll
            for (int u = 0; u < 2; ++u) s2[u] += __shfl_xor(s2[u], o); }
#pragma unroll
        for (int u = 0; u < 2; ++u) { const int m = m0 + u;
            const float rstd = 1.f / sqrtf(s2[u] * (1.f / D) + LN_EPS);
            f32x4* o = (f32x4*)(dst + (size_t)m * D) + lane;
            const int b = m >= T ? 1 : 0;
#pragma unroll
            for (int j = 0; j < 4; ++j) { const f32x4 hv = v[u][j] * rstd * gv[j] + bv[j]; o[64 * j] = hv;
                if (modn) { const f32x4 sh = ((const f32x4*)(modn + b * 3072))[lane + 64 * j], sc = ((const f32x4*)(modn + b * 3072 + 1024))[lane + 64 * j];
                    const f32x4 y = hv * (sc + 1.0f) + sh; u32x2 w; w.x = pk2(y.x, y.y); w.y = pk2(y.z, y.w);
                    *((u32x2*)(xn + (size_t)m * D) + lane + 64 * j) = w; } } }
    }
}
__device__ __forceinline__ int crow(int r, int hi) { return (r & 3) + 8 * (r >> 2) + 4 * hi; }
__device__ __forceinline__ float tanh_fast(float x) { const float e = __expf(2.f * x); return 1.f - 2.f / (e + 1.f); }
__device__ __forceinline__ void cum_kmax(const Args& a, LAS unsigned char* lds, int l, int bh, int tid, int lane, int wave) {
    const int b = bh >> 3, h = bh & 7;
    const bf16* PA = (const bf16*)(a.ws + WS_PA); const bf16* PB = (const bf16*)(a.ws + WS_PB);
    float* cum = (float*)(a.ws + WS_CUM) + (size_t)bh * T;
    const float bf = a.in[17][l * 8 + h];
    LAS float* red = (LAS float*)lds;
    const int t0 = tid * 32;
    float s = 0.f, kmx = 0.f;
#pragma unroll 1
    for (int i = 0; i < 32; ++i) { const size_t m = (size_t)b * T + t0 + i;
        const float z = bf2f(PA[m * LDA + 1152 + h]) + bf;
        const float lf = fminf(z, 0.f) - log1pf(__expf(-fabsf(z)));
        s += lf; cum[t0 + i] = s;
        const u32x4* kr = (const u32x4*)(PB + m * LDB + 512 + h * 64); float q = 0.f;
#pragma unroll
        for (int c = 0; c < 8; ++c) { const u32x4 w = kr[c];
            q += bflo(w.x) * bflo(w.x) + bfhi(w.x) * bfhi(w.x) + bflo(w.y) * bflo(w.y) + bfhi(w.y) * bfhi(w.y) + bflo(w.z) * bflo(w.z) + bfhi(w.z) * bfhi(w.z) + bflo(w.w) * bflo(w.w) + bfhi(w.w) * bfhi(w.w); }
        kmx = fmaxf(kmx, q); }
    red[tid] = s;
#pragma unroll
    for (int o = 1; o < 64; o <<= 1) kmx = fmaxf(kmx, __shfl_xor(kmx, o));
    if (lane == 0) red[512 + wave] = kmx;
    __syncthreads();
    if (tid == 0) { float run = 0.f; for (int i = 0; i < 512; ++i) { const float v = red[i]; red[i] = run; run += v; }
        float k = 0.f; for (int i = 0; i < 8; ++i) k = fmaxf(k, red[512 + i]);
        ((float*)(a.ws + WS_CTL))[CW_KMAX + 16 * l + bh] = sqrtf(k); }
    __syncthreads();
    const float off = red[tid];
#pragma unroll 1
    for (int i = 0; i < 32; ++i) cum[t0 + i] += off;
    __syncthreads();
}
__device__ __forceinline__ void prep_phase(const Args& a, LAS unsigned char* lds, int l, int tid, int lane, int wave, int G) {
    const bf16* PA = (const bf16*)(a.ws + WS_PA); const bf16* PV = (const bf16*)(a.ws + WS_PV);
    bf16* SCN = (bf16*)(a.ws + WS_SCN); float* SCS = (float*)(a.ws + WS_SCS); bf16* VS = (bf16*)(a.ws + WS_VS);
    LAS unsigned char* lowL = lds;
    LAS bf16* CL = (LAS bf16*)(lds + 16384);
    const int c = tid, h = wave, r32 = lane & 31, hi = lane >> 5;
    const bf16* LT = (const bf16*)(a.ws + WS_LORA) + (size_t)l * 2 * 512 * 64;
    const float* mix = a.in[7] + l * 1664;
    const int qc = tid & 127, tsel = tid >> 7, c4 = 4 * qc, hq = qc >> 4;
    const f32x4 mix_r = *(const f32x4*)(mix + c4), mix_k = *(const f32x4*)(mix + 512 + c4), mix_v = *(const f32x4*)(mix + 1024 + c4);
    const int ftok = tid >> 3, fi0 = (tid & 7) * 16;
    f32x4 mlow[4];
#pragma unroll
    for (int q = 0; q < 4; ++q) mlow[q] = *(const f32x4*)(mix + 1536 + fi0 + 4 * q);
    const f32x4 w0c = *(const f32x4*)(a.in[8] + l * 512 + c4), a0c = *(const f32x4*)(a.in[10] + l * 512 + c4), kkc = *(const f32x4*)(a.in[12] + l * 512 + c4), kac = *(const f32x4*)(a.in[13] + l * 512 + c4), rkc = *(const f32x4*)(a.in[14] + l * 512 + c4);
    unsigned* pq = (unsigned*)(a.ws + WS_CTL) + CW_QUEUE + 1024 + 64 * l;
    volatile LAS unsigned* ptask = (volatile LAS unsigned*)(lds + 140000);
    for (;;) {
        __syncthreads();
        if (tid == 0) ptask[0] = atomicAdd(pq, 1u);
        __syncthreads();
        const unsigned ptk = ptask[0];
        if (ptk >= (unsigned)(M / 64)) break;
        const int chunk = (int)ptk;
        const int m0 = chunk * 64, b = m0 >= T ? 1 : 0, t0 = m0 - b * T; const int bh = b * 8 + h;
        LAS float* lfL = (LAS float*)(lds + 81920); LAS float* kqL = (LAS float*)(lds + 83968);
        { const int tkn = tid >> 3, hd = tid & 7; const size_t m = (size_t)m0 + tkn;
          const float z = bf2f(PA[m * LDA + 1152 + hd]) + a.in[17][l * 8 + hd];
          lfL[hd * 64 + tkn] = fminf(z, 0.f) - __logf(1.f + __expf(-fabsf(z)));
          const u32x4* kr = (const u32x4*)((const bf16*)(a.ws + WS_PB) + m * LDB + 512 + hd * 64); float q = 0.f;
#pragma unroll
          for (int cc = 0; cc < 8; ++cc) { const u32x4 w = kr[cc];
              q += bflo(w.x) * bflo(w.x) + bfhi(w.x) * bfhi(w.x) + bflo(w.y) * bflo(w.y) + bfhi(w.y) * bfhi(w.y) + bflo(w.z) * bflo(w.z) + bfhi(w.z) * bfhi(w.z) + bflo(w.w) * bflo(w.w) + bfhi(w.w) * bfhi(w.w); }
          kqL[hd * 64 + tkn] = q; }
        { const int m = m0 + ftok, t = t0 + ftok;
          const u32x4* cp = (const u32x4*)(PA + (size_t)m * LDA + 1024 + fi0);
          const u32x4 c0 = cp[0], c1 = cp[1]; u32x4 p0 = {0u, 0u, 0u, 0u}, p1 = p0;
          if (t > 0) { const u32x4* pp = (const u32x4*)(PA + (size_t)(m - 1) * LDA + 1024 + fi0); p0 = pp[0]; p1 = pp[1]; }
          float cur[16], prv[16];
          cur[0] = bflo(c0.x); cur[1] = bfhi(c0.x); cur[2] = bflo(c0.y); cur[3] = bfhi(c0.y); cur[4] = bflo(c0.z); cur[5] = bfhi(c0.z); cur[6] = bflo(c0.w); cur[7] = bfhi(c0.w);
          cur[8] = bflo(c1.x); cur[9] = bfhi(c1.x); cur[10] = bflo(c1.y); cur[11] = bfhi(c1.y); cur[12] = bflo(c1.z); cur[13] = bfhi(c1.z); cur[14] = bflo(c1.w); cur[15] = bfhi(c1.w);
          prv[0] = bflo(p0.x); prv[1] = bfhi(p0.x); prv[2] = bflo(p0.y); prv[3] = bfhi(p0.y); prv[4] = bflo(p0.z); prv[5] = bfhi(p0.z); prv[6] = bflo(p0.w); prv[7] = bfhi(p0.w);
          prv[8] = bflo(p1.x); prv[9] = bfhi(p1.x); prv[10] = bflo(p1.y); prv[11] = bfhi(p1.y); prv[12] = bflo(p1.z); prv[13] = bfhi(p1.z); prv[14] = bflo(p1.w); prv[15] = bfhi(p1.w);
#pragma unroll
          for (int q = 0; q < 16; ++q) { float val = cur[q] + (prv[q] - cur[q]) * mlow[q >> 2][q & 3]; if (fi0 < 64) val = tanh_fast(val); cur[q] = val; }
          u32x4 o0 = {cvtpk(cur[0], cur[1]), cvtpk(cur[2], cur[3]), cvtpk(cur[4], cur[5]), cvtpk(cur[6], cur[7])};
          u32x4 o1 = {cvtpk(cur[8], cur[9]), cvtpk(cur[10], cur[11]), cvtpk(cur[12], cur[13]), cvtpk(cur[14], cur[15])};
          const int ch = 2 * (tid & 7);
          *(LAS u32x4*)(lowL + ftok * 256 + ((ch ^ (ftok & 7)) << 4)) = o0; *(LAS u32x4*)(lowL + ftok * 256 + (((ch + 1) ^ (ftok & 7)) << 4)) = o1; }
        __syncthreads();
        if (tid < 8) { float run = 0.f, kmx = 0.f;
            for (int tt = 0; tt < 64; ++tt) { run += lfL[tid * 64 + tt]; lfL[tid * 64 + tt] = run; kmx = fmaxf(kmx, kqL[tid * 64 + tt]); }
            ((float*)(a.ws + WS_CSUM))[(b * 8 + tid) * 256 + (t0 >> 6)] = run;
            atomicMax((unsigned*)(a.ws + WS_CTL) + CW_KMAX + 16 * l + b * 8 + tid, __float_as_uint(sqrtf(kmx))); }
#pragma unroll 1
        for (int tr = 0; tr < 2; ++tr) {
            { f32x16 Cw0 = {}, Cw1 = {}, Ca0 = {}, Ca1 = {};
              const int trow = 32 * tr + r32;
              bf16x8 Bw[2][4], Ba[2][4];
#pragma unroll
              for (int tc = 0; tc < 2; ++tc)
#pragma unroll
                for (int sx = 0; sx < 4; ++sx) { const int n = 64 * h + 32 * tc + r32;
                    Bw[tc][sx] = __builtin_bit_cast(bf16x8, *(const u32x4*)(LT + (size_t)n * 64 + 16 * sx + 8 * hi));
                    Ba[tc][sx] = __builtin_bit_cast(bf16x8, *(const u32x4*)(LT + 512 * 64 + (size_t)n * 64 + 16 * sx + 8 * hi)); }
#pragma unroll
              for (int sx = 0; sx < 4; ++sx) {
                  const bf16x8 Aw = *(const LAS bf16x8*)(lowL + trow * 256 + (((2 * sx + hi) ^ (trow & 7)) << 4));
                  const bf16x8 Aa = *(const LAS bf16x8*)(lowL + trow * 256 + (((8 + 2 * sx + hi) ^ (trow & 7)) << 4));
                  Cw0 = __builtin_amdgcn_mfma_f32_32x32x16_bf16(Aw, Bw[0][sx], Cw0, 0, 0, 0); Cw1 = __builtin_amdgcn_mfma_f32_32x32x16_bf16(Aw, Bw[1][sx], Cw1, 0, 0, 0);
                  Ca0 = __builtin_amdgcn_mfma_f32_32x32x16_bf16(Aa, Ba[0][sx], Ca0, 0, 0, 0); Ca1 = __builtin_amdgcn_mfma_f32_32x32x16_bf16(Aa, Ba[1][sx], Ca1, 0, 0, 0); }
#pragma unroll
              for (int r = 0; r < 16; ++r) { LAS bf16* row = CL + crow(r, hi) * 1024 + 64 * h + r32;
                  row[0] = (bf16)f2bf(Cw0[r]); row[32] = (bf16)f2bf(Cw1[r]); row[512] = (bf16)f2bf(Ca0[r]); row[544] = (bf16)f2bf(Ca1[r]); } }
            __syncthreads();
#define UNP4(dst, u2) do { dst[0] = bflo(u2.x); dst[1] = bfhi(u2.x); dst[2] = bflo(u2.y); dst[3] = bfhi(u2.y); } while (0)
#pragma unroll 1
            for (int g = 0; g < 4; ++g) {
                const int tl0 = g * 8 + 2 * tsel, mg = m0 + 32 * tr + tl0, tg = t0 + 32 * tr + tl0;
                u32x2 rr_[3], rk_[3], rv_[3];
#pragma unroll
                for (int u = 0; u < 3; ++u) { const int m = mg - 1 + u;
                    if (u > 0 || tg > 0) { rr_[u] = *(const u32x2*)(PA + (size_t)m * LDA + c4); rk_[u] = *(const u32x2*)(PA + (size_t)m * LDA + 512 + c4); rv_[u] = *(const u32x2*)(PV + (size_t)m * LDV + c4); }
                    else { rr_[u] = (u32x2){0u, 0u}; rk_[u] = rr_[u]; rv_[u] = rr_[u]; } }
                f32x4 fr[3], fk[3], fv[3];
#pragma unroll
                for (int u = 0; u < 3; ++u) { UNP4(fr[u], rr_[u]); UNP4(fk[u], rk_[u]); UNP4(fv[u], rv_[u]); }
                f32x4 r4[2], kkr[2], kp[2], vv[2], av[2], omw[2]; float red[8];
#pragma unroll
                for (int u = 0; u < 2; ++u) {
                    r4[u] = fr[u + 1] + (fr[u] - fr[u + 1]) * mix_r; const f32x4 k4 = fk[u + 1] + (fk[u] - fk[u + 1]) * mix_k; vv[u] = fv[u + 1] + (fv[u] - fv[u + 1]) * mix_v;
                    const u32x2 cw = *(const LAS u32x2*)(CL + (tl0 + u) * 1024 + c4), ca = *(const LAS u32x2*)(CL + (tl0 + u) * 1024 + 512 + c4);
                    f32x4 wl, al; UNP4(wl, cw); UNP4(al, ca); wl = wl + w0c; al = al + a0c;
#pragma unroll
                    for (int e = 0; e < 4; ++e) { const float z = -wl[e]; const float sp = fmaxf(z, 0.f) + __logf(1.f + __expf(-fabsf(z)));
                        const float ee = __expf(-sp - 0.5f); omw[u][e] = 1.f - __expf(-ee); av[u][e] = fast_sigmoid(al[e]); }
                    kkr[u] = k4 * kkc; kp[u] = k4 * ((av[u] - 1.0f) * kac + 1.0f);
                    const f32x4 q0 = kkr[u] * kkr[u], q1 = kkr[u] * av[u] * r4[u], q2 = kp[u] * r4[u], q3 = r4[u] * kp[u] * rkc;
                    red[u] = (q0[0] + q0[1]) + (q0[2] + q0[3]); red[2 + u] = (q1[0] + q1[1]) + (q1[2] + q1[3]); red[4 + u] = (q2[0] + q2[1]) + (q2[2] + q2[3]); red[6 + u] = (q3[0] + q3[1]) + (q3[2] + q3[3]);
                }
#pragma unroll
                for (int i = 0; i < 8; ++i) red[i] = row16_sum(red[i]);
#pragma unroll
                for (int u = 0; u < 2; ++u) {
                    const float inv = 1.f / fmaxf(sqrtf(red[u]), 1e-12f);
                    const f32x4 kk = kkr[u] * inv, bbv = kk * av[u], wr = (1.0f - omw[u]) * r4[u];
                    const int bhq = b * 8 + hq;
                    bf16* rec = SCN + ((size_t)bhq * T + tg + u) * 320 + (c4 & 63);
                    *(u32x2*)(rec) = (u32x2){pk2(kk[0], kk[1]), pk2(kk[2], kk[3])}; *(u32x2*)(rec + 64) = (u32x2){pk2(wr[0], wr[1]), pk2(wr[2], wr[3])};
                    *(u32x2*)(rec + 128) = (u32x2){pk2(omw[u][0], omw[u][1]), pk2(omw[u][2], omw[u][3])}; *(u32x2*)(rec + 192) = (u32x2){pk2(bbv[0], bbv[1]), pk2(bbv[2], bbv[3])};
                    *(u32x2*)(rec + 256) = (u32x2){pk2(kp[u][0], kp[u][1]), pk2(kp[u][2], kp[u][3])};
                    *(u32x2*)(VS + (size_t)(mg + u) * 512 + c4) = (u32x2){pk2(vv[u][0], vv[u][1]), pk2(vv[u][2], vv[u][3])};
                    if ((lane & 15) == 0) { f32x4 sc = {red[2 + u] * inv, red[4 + u], red[6 + u], 0.f}; *(f32x4*)(SCS + ((size_t)bhq * T + tg + u) * 4) = sc; }
                }
            }
#undef UNP4
            __syncthreads();
        }
        { const int tkn = tid >> 3, hd = tid & 7; ((float*)(a.ws + WS_CUM))[(size_t)(b * 8 + hd) * T + t0 + tkn] = lfL[hd * 64 + tkn]; }
    }
    __syncthreads();
}

__device__ __forceinline__ float dppf(float x, const int ctrl_sel) {
    unsigned u = __float_as_uint(x), r;
    if (ctrl_sel == 0) r = __builtin_amdgcn_update_dpp(0, u, 0xB1, 0xF, 0xF, true);
    else if (ctrl_sel == 1) r = __builtin_amdgcn_update_dpp(0, u, 0x4E, 0xF, 0xF, true);
    else r = __builtin_amdgcn_update_dpp(0, u, 0x141, 0xF, 0xF, true);
    return __uint_as_float(r);
}
__device__ __forceinline__ float red8(float x) { x += dppf(x, 0); x += dppf(x, 1); x += dppf(x, 2); return x; }
constexpr int SC_CH = 32, SC_STEP = 1024, SC_BUF = SC_CH * SC_STEP, SC_VOFF = 2 * SC_BUF, SC_SOFF = SC_VOFF + 2 * SC_CH * 64 * 4, SC_ROWB = SC_SOFF + 2 * SC_CH * 16;
constexpr int NSEG = 16, SEGLEN = T / NSEG;
typedef float f32x4m __attribute__((ext_vector_type(4)));
template <bool PASSC> __device__ __forceinline__ void scan_task(const Args& a, LAS unsigned char* lds, int bh, int seg, int tid, int lane, int wave, unsigned* cntp) {
    const int b = bh >> 3, h = bh & 7;
    const int t0 = seg * SEGLEN;
    const bf16* SCN = (const bf16*)(a.ws + WS_SCN) + ((size_t)bh * T + t0) * 320;
    const float* SCS = (const float*)(a.ws + WS_SCS) + ((size_t)bh * T + t0) * 4;
    const bf16* VS = (const bf16*)(a.ws + WS_VS) + ((size_t)b * T + t0) * 512 + h * 64;
    float* YA = (float*)(a.ws + WS_YA) + ((size_t)b * T + t0) * 512 + h * 64;
    float* FSb = (float*)(a.ws + WS_FS) + (size_t)bh * NSEG * 128 * 64;
    constexpr int NCH = SEGLEN / SC_CH;
    const int n16 = lane & 15, g = lane >> 4;
    const bool ident = !PASSC && wave >= 4;
    const bool active = PASSC ? (wave < 4) : true;
    const int row = 16 * (wave & 3) + n16;
    f32x4 Sf[4];
#pragma unroll
    for (int i = 0; i < 4; ++i) Sf[i] = (f32x4){0.f, 0.f, 0.f, 0.f};
    __syncthreads();
    if constexpr (PASSC) {
        if (active && seg > 0) { const float* SIp = (const float*)(a.ws + WS_SI) + ((size_t)(bh * NSEG + seg) * 64 + row) * 64 + 4 * g;
#pragma unroll
            for (int t4 = 0; t4 < 4; ++t4) Sf[t4] = *(const f32x4*)(SIp + 16 * t4); }
    } else if (ident) {
#pragma unroll
        for (int i = 0; i < 4; ++i)
#pragma unroll
            for (int e = 0; e < 4; ++e) Sf[i][e] = (16 * i + 4 * g + e == row) ? 1.f : 0.f;
    }
    u32x4 mreg[2], breg, kreg; u32x4 vreg = {0u, 0u, 0u, 0u}; f32x4 sreg;
    auto gload = [&](int c) {
        const u32x4* src = (const u32x4*)(SCN + (size_t)c * SC_CH * 320);
        { const int st = tid / 24, q = tid - st * 24; mreg[0] = src[st * 40 + q]; }
        if (tid < 256) { const int jj = 512 + tid, st = jj / 24, q = jj - st * 24; mreg[1] = src[st * 40 + q];
            const int s2 = tid >> 3, e8 = tid & 7; breg = src[s2 * 40 + 24 + e8]; kreg = src[s2 * 40 + 32 + e8]; }
        if (tid < 256) vreg = *(const u32x4*)(VS + (size_t)(c * SC_CH + (tid >> 3)) * 512 + (tid & 7) * 8);
        else if (tid < 288) sreg = *(const f32x4*)(SCS + (size_t)(c * SC_CH + (tid - 256)) * 4);
    };
    auto lwrite = [&](int c) {
        LAS unsigned char* bp = lds + (c & 1) * SC_BUF;
#pragma unroll
        for (int i = 0; i < 2; ++i) { const int jj = tid + 512 * i;
            if (jj < 768) { const int st = jj / 24, q = jj - st * 24, arr = q >> 3, e8 = q & 7; const u32x4 w = mreg[i];
                LAS unsigned char* d = bp + st * SC_STEP;
                if (arr < 2) { *(LAS u32x4*)(d + 256 + arr * 128 + e8 * 16) = w; }
                else { f32x4 lo, hi;
                    lo[0] = bflo(w.x); lo[1] = bfhi(w.x); lo[2] = bflo(w.y); lo[3] = bfhi(w.y); hi[0] = bflo(w.z); hi[1] = bfhi(w.z); hi[2] = bflo(w.w); hi[3] = bfhi(w.w);
                    lo = 1.0f - lo; hi = 1.0f - hi;
                    LAS f32x4* df = (LAS f32x4*)(d + e8 * 32); df[0] = lo; df[1] = hi; } } }
        if (tid < 256) { const int s2 = tid >> 3, e8 = tid & 7; LAS u32x4* d = (LAS u32x4*)(bp + s2 * SC_STEP + 512 + e8 * 64);
            const unsigned bw[4] = {breg.x, breg.y, breg.z, breg.w}, kw[4] = {kreg.x, kreg.y, kreg.z, kreg.w};
#pragma unroll
            for (int pq = 0; pq < 4; ++pq) { const unsigned blo = bw[pq] & 0xffffu, bhi = bw[pq] >> 16, klo = kw[pq] & 0xffffu, khi = kw[pq] >> 16;
                u32x4 o; o.x = klo | (blo << 16); o.y = blo; o.z = khi | (bhi << 16); o.w = bhi; d[pq] = o; } }
        if (tid < 256) { const u32x4 w = vreg; f32x4 lo, hi;
            lo[0] = bflo(w.x); lo[1] = bfhi(w.x); lo[2] = bflo(w.y); lo[3] = bfhi(w.y); hi[0] = bflo(w.z); hi[1] = bfhi(w.z); hi[2] = bflo(w.w); hi[3] = bfhi(w.w);
            LAS f32x4* d = (LAS f32x4*)(lds + SC_VOFF + (c & 1) * (SC_CH * 64 * 4) + tid * 32); d[0] = lo; d[1] = hi; }
        else if (tid < 288) { *(LAS f32x4*)(lds + SC_SOFF + (c & 1) * (SC_CH * 16) + (tid - 256) * 16) = sreg; }
    };
    gload(0); lwrite(0); gload(1);
    __syncthreads();
    LAS float* ybuf = (LAS float*)(lds + SC_ROWB + 16384);
    auto yflush = [&](int c) { const f32x4 yv = *(const LAS f32x4*)(ybuf + (c & 1) * (SC_CH * 64) + tid * 4);
        *(f32x4*)(YA + (size_t)(c * SC_CH + (tid >> 4)) * 512 + (tid & 15) * 4) = yv; };
    for (int c = 0; c < NCH; ++c) {
        if constexpr (PASSC) { if (c > 0) yflush(c - 1); }
        if (c + 1 < NCH) lwrite(c + 1);
        if (c + 2 < NCH) gload(c + 2);
        if (active) {
            const LAS unsigned char* bp = lds + (c & 1) * SC_BUF;
            const LAS float* vb = (const LAS float*)(lds + SC_VOFF + (c & 1) * (SC_CH * 64 * 4)) + row;
            const LAS float* sb = (const LAS float*)(lds + SC_SOFF + (c & 1) * (SC_CH * 16));
#define SC_DECL(X) u32x2 X##a0, X##a1, X##a2, X##a3, X##r0, X##r1, X##r2, X##r3; float X##v; f32x2 X##s
#define SC_LD(X, sidx) do { const LAS unsigned char* p_ = bp + (sidx) * SC_STEP + 256 + g * 8; \
                X##a0 = *(const LAS u32x2*)(p_); X##a1 = *(const LAS u32x2*)(p_ + 32); X##a2 = *(const LAS u32x2*)(p_ + 64); X##a3 = *(const LAS u32x2*)(p_ + 96); \
                if constexpr (PASSC) { X##r0 = *(const LAS u32x2*)(p_ + 128); X##r1 = *(const LAS u32x2*)(p_ + 160); X##r2 = *(const LAS u32x2*)(p_ + 192); X##r3 = *(const LAS u32x2*)(p_ + 224); X##s = *(const LAS f32x2*)(sb + (sidx) * 4); } \
                X##v = ident ? 0.f : vb[(sidx) * 64]; } while (0)
#define SC_STEPM(X, Y, sidx, ldnext) do { const LAS unsigned char* p_ = bp + (sidx) * SC_STEP; \
                const f32x4 w0_ = *(const LAS f32x4*)(p_ + g * 16), w1_ = *(const LAS f32x4*)(p_ + 64 + g * 16), w2_ = *(const LAS f32x4*)(p_ + 128 + g * 16), w3_ = *(const LAS f32x4*)(p_ + 192 + g * 16); \
                const s16x4 f0_ = *(const LAS s16x4*)(p_ + 512 + n16 * 8), f1_ = *(const LAS s16x4*)(p_ + 640 + n16 * 8), f2_ = *(const LAS s16x4*)(p_ + 768 + n16 * 8), f3_ = *(const LAS s16x4*)(p_ + 896 + n16 * 8); \
                if (ldnext) SC_LD(Y, (sidx) + 1); \
                u32x4 sb0, sb1; \
                sb0.x = cvtpk(Sf[0][0], Sf[0][1]); sb0.y = cvtpk(Sf[0][2], Sf[0][3]); sb0.z = cvtpk(Sf[1][0], Sf[1][1]); sb0.w = cvtpk(Sf[1][2], Sf[1][3]); \
                sb1.x = cvtpk(Sf[2][0], Sf[2][1]); sb1.y = cvtpk(Sf[2][2], Sf[2][3]); sb1.z = cvtpk(Sf[3][0], Sf[3][1]); sb1.w = cvtpk(Sf[3][2], Sf[3][3]); \
                const bf16x8 B0 = __builtin_bit_cast(bf16x8, sb0), B1 = __builtin_bit_cast(bf16x8, sb1); \
                const bf16x8 A0 = __builtin_bit_cast(bf16x8, (u32x4){X##a0.x, X##a0.y, X##a1.x, X##a1.y}), A1 = __builtin_bit_cast(bf16x8, (u32x4){X##a2.x, X##a2.y, X##a3.x, X##a3.y}); \
                const f32x4m z4 = {0.f, 0.f, 0.f, 0.f}; f32x4m accy0 = z4, accy1 = z4; \
                const f32x4m acc0 = __builtin_amdgcn_mfma_f32_16x16x32_bf16(A0, B0, z4, 0, 0, 0); \
                const f32x4m acc1 = __builtin_amdgcn_mfma_f32_16x16x32_bf16(A1, B1, z4, 0, 0, 0); \
                if constexpr (PASSC) { const bf16x8 R0 = __builtin_bit_cast(bf16x8, (u32x4){X##r0.x, X##r0.y, X##r1.x, X##r1.y}); accy0 = __builtin_amdgcn_mfma_f32_16x16x32_bf16(R0, B0, z4, 0, 0, 0); \
                    const bf16x8 R1 = __builtin_bit_cast(bf16x8, (u32x4){X##r2.x, X##r2.y, X##r3.x, X##r3.y}); accy1 = __builtin_amdgcn_mfma_f32_16x16x32_bf16(R1, B1, z4, 0, 0, 0); } \
                const f32x4 c0_ = Sf[0] * w0_, c1_ = Sf[1] * w1_, c2_ = Sf[2] * w2_, c3_ = Sf[3] * w3_; \
                const float sa = acc0[0] + acc1[0]; \
                u32x2 bu; bu.x = (__float_as_uint(X##v) >> 16) | (cvtpk(0.f, -sa) & 0xffff0000u); bu.y = 0u; \
                if (g != 0) { bu.x = 0u; bu.y = 0u; } \
                const s16x4 Bu = __builtin_bit_cast(s16x4, bu); \
                Sf[0] = __builtin_amdgcn_mfma_f32_16x16x16bf16_1k(f0_, Bu, c0_, 0, 0, 0); Sf[1] = __builtin_amdgcn_mfma_f32_16x16x16bf16_1k(f1_, Bu, c1_, 0, 0, 0); \
                Sf[2] = __builtin_amdgcn_mfma_f32_16x16x16bf16_1k(f2_, Bu, c2_, 0, 0, 0); Sf[3] = __builtin_amdgcn_mfma_f32_16x16x16bf16_1k(f3_, Bu, c3_, 0, 0, 0); \
                if constexpr (PASSC) { const float y = (accy0[0] + accy1[0]) - sa * X##s.x + X##v * X##s.y; ybuf[(c & 1) * (SC_CH * 64) + (sidx) * 64 + row] = y; } } while (0)
            SC_DECL(oA); SC_DECL(oB);
            SC_LD(oA, 0);
#pragma unroll 1
            for (int s = 0; s < SC_CH; s += 2) {
                SC_STEPM(oA, oB, s, true);
                __builtin_amdgcn_sched_barrier(0);
                SC_STEPM(oB, oA, s + 1, (s + 2 < SC_CH));
                __builtin_amdgcn_sched_barrier(0);
            }
#undef SC_DECL
#undef SC_LD
#undef SC_STEPM
        }
        __syncthreads();
    }
    if constexpr (PASSC) yflush(NCH - 1);
    if constexpr (!PASSC) { float* fp = FSb + ((size_t)seg * 128 + (ident ? 64 : 0) + row) * 64 + 4 * g;
#pragma unroll
        for (int t4 = 0; t4 < 4; ++t4) *(f32x4*)(fp + 16 * t4) = Sf[t4];
        volatile LAS unsigned* lastf = (volatile LAS unsigned*)(lds + 140064);
        __threadfence();
        __syncthreads();
        if (tid == 0) lastf[0] = atomicAdd(cntp, 1u);
        __syncthreads();
        if (lastf[0] == (unsigned)(NSEG - 2)) {
            __threadfence();
            LAS float* rowb = (LAS float*)(lds + SC_ROWB);
            LAS float* pbuf = (LAS float*)lds;
            float* SIb = (float*)(a.ws + WS_SI) + (size_t)bh * NSEG * 64 * 64;
            const int crow_ = tid >> 3, kq = (tid & 7) * 8;
            f32x4 c0 = {0.f, 0.f, 0.f, 0.f}, c1 = c0, pr0, pr1;
            { const float* Pk = FSb + ((size_t)0 * 128 + 64 + crow_) * 64 + kq; pr0 = __builtin_nontemporal_load((const f32x4*)Pk); pr1 = __builtin_nontemporal_load((const f32x4*)(Pk + 4)); }
            for (int k = 0; k < NSEG - 1; ++k) {
                const float* Uk = FSb + ((size_t)k * 128 + crow_) * 64 + kq;
                f32x4 a0 = __builtin_nontemporal_load((const f32x4*)Uk), a1 = __builtin_nontemporal_load((const f32x4*)(Uk + 4));
                *(LAS f32x4*)(rowb + crow_ * 64 + kq) = c0; *(LAS f32x4*)(rowb + crow_ * 64 + kq + 4) = c1;
                *(LAS f32x4*)(pbuf + crow_ * 64 + kq) = pr0; *(LAS f32x4*)(pbuf + crow_ * 64 + kq + 4) = pr1;
                __syncthreads();
                if (k + 2 < NSEG) { const float* Pn = FSb + ((size_t)(k + 1) * 128 + 64 + crow_) * 64 + kq; pr0 = __builtin_nontemporal_load((const f32x4*)Pn); pr1 = __builtin_nontemporal_load((const f32x4*)(Pn + 4)); }
                if (k > 0) {
#pragma unroll 4
                    for (int jj = 0; jj < 64; ++jj) { const float sj = rowb[crow_ * 64 + jj]; a0 += *(const LAS f32x4*)(pbuf + jj * 64 + kq) * sj; a1 += *(const LAS f32x4*)(pbuf + jj * 64 + kq + 4) * sj; } }
                c0 = a0; c1 = a1;
                float* sp_ = SIb + ((size_t)(k + 1) * 64 + crow_) * 64 + kq; *(f32x4*)sp_ = c0; *(f32x4*)(sp_ + 4) = c1;
                __syncthreads();
            }
        }
    }
}

typedef short v4i16_t __attribute__((ext_vector_type(4)));
__device__ __forceinline__ s16x4 vtr(const LAS unsigned char* p) { return __builtin_bit_cast(s16x4, __builtin_amdgcn_ds_read_tr16_b64_v4i16((LAS v4i16_t*)p)); }
constexpr int AT_KS = 0, AT_VS = 9216, AT_BIAS = 18432, AT_WSF = 18688, AT_FLAG = 19712, AT_TASK = 140000;
__device__ __forceinline__ void attn_unit(const Args& a, LAS unsigned char* lds, int l, int bh, int qb, int tid, int lane, int wid) {
    const int b = bh >> 3, h = bh & 7, r32 = lane & 31, hi = lane >> 5;
    const int q0 = qb * 256;
    bf16* PB = (bf16*)(a.ws + WS_PB);
    const float* cumh = (const float*)(a.ws + WS_CUM) + (size_t)bh * T;
    const float kmax = ((const float*)(a.ws + WS_CTL))[CW_KMAX + 16 * l + bh];
    const size_t rowbase = (size_t)b * T;
    const bf16* Qp = PB + (rowbase + q0 + wid * 32 + r32) * LDB + h * 64;
    bf16x8 qr[4]; float qs = 0.f;
#pragma unroll
    for (int d0 = 0; d0 < 4; ++d0) { const u32x4 w = *(const u32x4*)(Qp + d0 * 16 + hi * 8); qr[d0] = __builtin_bit_cast(bf16x8, w);
        qs += bflo(w.x) * bflo(w.x) + bfhi(w.x) * bfhi(w.x) + bflo(w.y) * bflo(w.y) + bfhi(w.y) * bfhi(w.y) + bflo(w.z) * bflo(w.z) + bfhi(w.z) * bfhi(w.z) + bflo(w.w) * bflo(w.w) + bfhi(w.w) * bfhi(w.w); }
    qs += __shfl_xor(qs, 32);
    const float qbound = sqrtf(qs) * kmax * 1.01f + 0.01f;
    LAS float* offL = (LAS float*)(lds + 20480);
    { __syncthreads();
      if (wid == 0) { const float* cs = (const float*)(a.ws + WS_CSUM) + bh * 256; const int ntile = qb * 4 + 4;
          f32x4 v4 = {0.f, 0.f, 0.f, 0.f};
#pragma unroll
          for (int i = 0; i < 4; ++i) if (4 * lane + i < ntile) v4[i] = cs[4 * lane + i];
          const float tot = (v4[0] + v4[1]) + (v4[2] + v4[3]); float inc = tot;
#pragma unroll
          for (int o = 1; o < 64; o <<= 1) { const float up = __shfl_up(inc, o); if (lane >= o) inc += up; }
          float ex = inc - tot;
          offL[4 * lane] = ex; ex += v4[0]; offL[4 * lane + 1] = ex; ex += v4[1]; offL[4 * lane + 2] = ex; ex += v4[2]; offL[4 * lane + 3] = ex; }
      __syncthreads(); }
    const float ref = cumh[q0 + 255] + offL[(q0 + 255) >> 6];
    const int srow = tid >> 3, sch = tid & 7;
    const bf16* Kg = PB + rowbase * LDB + 512 + h * 64 + sch * 8; const bf16* Vg = Kg + 512;
    LAS unsigned char* Ks = lds + AT_KS; LAS unsigned char* Vs = lds + AT_VS; LAS float* biasL = (LAS float*)(lds + AT_BIAS);
    LAS float* wsf = (LAS float*)(lds + AT_WSF) + wid * 32; volatile LAS unsigned* flag = (volatile LAS unsigned*)(lds + AT_FLAG);
    if (tid < 3) flag[tid] = 0u;
    float m = -INFINITY, lsum = 0.f; f32x16 o0 = {}, o1 = {};
    u32x4 kreg, vreg; float breg = 0.f, bnx = 0.f;
    int j = qb * 4 + 3;
    { kreg = *(const u32x4*)(Kg + (size_t)(64 * j + srow) * LDB); vreg = *(const u32x4*)(Vg + (size_t)(64 * j + srow) * LDB);
      if (tid < 64) breg = (ref - (cumh[64 * j + tid] + offL[j])) * L2E; bnx = j > 0 ? (ref - (cumh[64 * j - 1] + offL[j - 1])) * L2E : 0.f; }
    const int q4 = (lane & 15) >> 2, p4 = lane & 3, blk = (lane >> 4) & 1;
    const int qrow = q0 + wid * 32 + r32;
    int it = 0;
    __syncthreads();
    for (;;) {
        *(LAS u32x4*)(Ks + srow * 144 + sch * 16) = kreg; *(LAS u32x4*)(Vs + srow * 144 + sch * 16) = vreg; if (tid < 64) biasL[tid] = breg;
        const float bnx_cur = bnx;
        __syncthreads();
        if (j > 0) { const int jn = j - 1;
            kreg = *(const u32x4*)(Kg + (size_t)(64 * jn + srow) * LDB); vreg = *(const u32x4*)(Vg + (size_t)(64 * jn + srow) * LDB);
            if (tid < 64) breg = (ref - (cumh[64 * jn + tid] + offL[jn])) * L2E; bnx = jn > 0 ? (ref - (cumh[64 * jn - 1] + offL[jn - 1])) * L2E : 0.f; }
        if (64 * j <= q0 + 32 * wid + 31) {
            f32x16 p0 = {}, p1 = {};
#pragma unroll
            for (int d0 = 0; d0 < 4; ++d0) {
                const bf16x8 k0 = *(const LAS bf16x8*)(Ks + r32 * 144 + d0 * 32 + hi * 16);
                const bf16x8 k1 = *(const LAS bf16x8*)(Ks + (32 + r32) * 144 + d0 * 32 + hi * 16);
                p0 = __builtin_amdgcn_mfma_f32_32x32x16_bf16(k0, qr[d0], p0, 0, 0, 0);
                p1 = __builtin_amdgcn_mfma_f32_32x32x16_bf16(k1, qr[d0], p1, 0, 0, 0); }
#pragma unroll
            for (int g = 0; g < 4; ++g) { const f32x4 b0 = *(const LAS f32x4*)(biasL + 8 * g + 4 * hi), b1 = *(const LAS f32x4*)(biasL + 32 + 8 * g + 4 * hi);
#pragma unroll
                for (int e = 0; e < 4; ++e) { p0[4 * g + e] += b0[e]; p1[4 * g + e] += b1[e]; } }
            if (64 * j + 63 > q0 + 32 * wid) {
#pragma unroll
                for (int r = 0; r < 16; ++r) { const int kv = 64 * j + crow(r, hi); if (kv > qrow) p0[r] = -INFINITY; if (kv + 32 > qrow) p1[r] = -INFINITY; } }
            float mx = fmaxf(p0[0], p1[0]);
#pragma unroll
            for (int r = 1; r < 16; ++r) mx = fmaxf(mx, fmaxf(p0[r], p1[r]));
            mx = fmaxf(mx, __shfl_xor(mx, 32));
            const float mnew = fmaxf(m, mx); const float f = __builtin_amdgcn_exp2f(m - mnew); m = mnew;
            float rs = 0.f;
#pragma unroll
            for (int r = 0; r < 16; ++r) { p0[r] = __builtin_amdgcn_exp2f(p0[r] - mnew); p1[r] = __builtin_amdgcn_exp2f(p1[r] - mnew); rs += p0[r] + p1[r]; }
            lsum = lsum * f + rs;
            if (__any(f != 1.f)) {
                if (hi == 0) wsf[r32] = f;
                asm volatile("s_waitcnt lgkmcnt(0)" ::: "memory");
#pragma unroll
                for (int r = 0; r < 16; ++r) { const float fr = wsf[crow(r, hi)]; o0[r] *= fr; o1[r] *= fr; }
            }
            u32x4 pw[4];
            pw[0] = (u32x4){cvtpk(p0[0], p0[1]), cvtpk(p0[2], p0[3]), cvtpk(p0[4], p0[5]), cvtpk(p0[6], p0[7])};
            pw[1] = (u32x4){cvtpk(p0[8], p0[9]), cvtpk(p0[10], p0[11]), cvtpk(p0[12], p0[13]), cvtpk(p0[14], p0[15])};
            pw[2] = (u32x4){cvtpk(p1[0], p1[1]), cvtpk(p1[2], p1[3]), cvtpk(p1[4], p1[5]), cvtpk(p1[6], p1[7])};
            pw[3] = (u32x4){cvtpk(p1[8], p1[9]), cvtpk(p1[10], p1[11]), cvtpk(p1[12], p1[13]), cvtpk(p1[14], p1[15])};
#pragma unroll
            for (int s = 0; s < 4; ++s) { const int kvb = 16 * (s & 1) + 32 * (s >> 1);
                const LAS unsigned char* va = Vs + (kvb + 4 * hi + q4) * 144 + (16 * blk + 4 * p4) * 2;
                const s16x4 l0 = vtr(va), h0 = vtr(va + 8 * 144), l1 = vtr(va + 64), h1 = vtr(va + 8 * 144 + 64);
                const bf16x8 vf0 = {l0[0], l0[1], l0[2], l0[3], h0[0], h0[1], h0[2], h0[3]}, vf1 = {l1[0], l1[1], l1[2], l1[3], h1[0], h1[1], h1[2], h1[3]};
                const bf16x8 pa = __builtin_bit_cast(bf16x8, pw[s]);
                o0 = __builtin_amdgcn_mfma_f32_32x32x16_bf16(pa, vf0, o0, 0, 0, 0);
                o1 = __builtin_amdgcn_mfma_f32_32x32x16_bf16(pa, vf1, o1, 0, 0, 0); }
        }
        if (j == 0) break;
        const bool need = (qbound + bnx_cur > m - 40.f);
        if (tid == 0) flag[(it + 1) % 3] = 0u;
        if (__any(need) && lane == 0) flag[it % 3] = 1u;
        __syncthreads();
        const unsigned cont = flag[it % 3];
        if (!cont) break;
        --j; ++it;
    }
    lsum += __shfl_xor(lsum, 32);
    if (hi == 0) wsf[r32] = 1.f / lsum;
    asm volatile("s_waitcnt lgkmcnt(0)" ::: "memory");
    bf16* Ow = (bf16*)(a.ws + WS_PV) + (rowbase + q0 + wid * 32) * LDV + h * 64 + r32;
#pragma unroll
    for (int r = 0; r < 16; ++r) { const float inv = wsf[crow(r, hi)]; bf16* op = Ow + (size_t)crow(r, hi) * LDV;
        op[0] = (bf16)f2bf(o0[r] * inv); op[32] = (bf16)f2bf(o1[r] * inv); }
    __syncthreads();
}
__device__ __forceinline__ void p3a_phase(const Args& a, LAS unsigned char* lds, int l, int tid, int lane, int wave) {
    unsigned* ctr = (unsigned*)(a.ws + WS_CTL) + CW_QUEUE + 64 * l;
    volatile LAS unsigned* task = (volatile LAS unsigned*)(lds + AT_TASK);
    for (;;) {
        __syncthreads();
        if (tid == 0) task[0] = atomicAdd(ctr, 1u);
        __syncthreads();
        const unsigned tk = task[0];
        if (tk >= 240u + 1024u) break;
        int t2 = tid; asm volatile("" : "+v"(t2)); const int lane2 = t2 & 63;
        if (tk < 240u) { scan_task<false>(a, lds, (int)(tk / 15u), (int)(tk % 15u), t2, lane2, wave, (unsigned*)(a.ws + WS_CTL) + CW_QUEUE + 2048 + 64 * l + (tk / 15u)); }
        else { const unsigned u = tk - 240u; attn_unit(a, lds, l, (int)(u & 15), 63 - (int)(u >> 4), t2, lane2, wave); }
    }
}
__device__ __forceinline__ void p3b_phase(const Args& a, LAS unsigned char* lds, int l, int tid, int lane, int wave) {
    unsigned* ctr = (unsigned*)(a.ws + WS_CTL) + CW_QUEUE + 512 + 64 * l;
    volatile LAS unsigned* task = (volatile LAS unsigned*)(lds + AT_TASK);
    for (;;) {
        __syncthreads();
        if (tid == 0) task[0] = atomicAdd(ctr, 1u);
        __syncthreads();
        const unsigned tk = task[0];
        if (tk >= 256u) break;
        scan_task<true>(a, lds, (int)(tk >> 4), (int)(tk & 15), tid, lane, wave, nullptr);
    }
}

__device__ __forceinline__ float red16m(float x) {
    x += __uint_as_float(__builtin_amdgcn_update_dpp(0, __float_as_uint(x), 0xB1, 0xF, 0xF, true));
    x += __uint_as_float(__builtin_amdgcn_update_dpp(0, __float_as_uint(x), 0x4E, 0xF, 0xF, true));
    x += __uint_as_float(__builtin_amdgcn_update_dpp(0, __float_as_uint(x), 0x141, 0xF, 0xF, true));
    x += __uint_as_float(__builtin_amdgcn_update_dpp(0, __float_as_uint(x), 0x140, 0xF, 0xF, true));
    return x;
}
__device__ __forceinline__ void merge_phase(const Args& a, int l, int tid, int lane, int wave, int G) {
    const float* YA = (const float*)(a.ws + WS_YA); const bf16* VS = (const bf16*)(a.ws + WS_VS); const bf16* PB = (const bf16*)(a.ws + WS_PB);
    const bf16* PVo = (const bf16*)(a.ws + WS_PV);
    const float* SCS = (const float*)(a.ws + WS_SCS); bf16* YM = (bf16*)(a.ws + WS_YM);
    const int hd = 4 * (wave & 1) + (lane >> 4), c0 = hd * 64 + 4 * (lane & 15), tsub = wave >> 1;
    const f32x4 gg = *(const f32x4*)(a.in[15] + l * 512 + c0), gb = *(const f32x4*)(a.in[16] + l * 512 + c0);
    constexpr int MT = 4;
    for (int mb = blockIdx.x * (4 * MT); mb < M; mb += G * (4 * MT)) {
        f32x4 ya[MT]; u32x2 vv[MT], g1[MT], g2[MT], yb[MT]; float rkr[MT], mean[MT], var[MT];
#pragma unroll
        for (int u = 0; u < MT; ++u) { const int m = mb + 4 * u + tsub; const int b = m >= T ? 1 : 0, t = m - b * T;
            ya[u] = *(const f32x4*)(YA + (size_t)m * 512 + c0); vv[u] = *(const u32x2*)(VS + (size_t)m * 512 + c0);
            g1[u] = *(const u32x2*)(PB + (size_t)m * LDB + 1536 + c0); g2[u] = *(const u32x2*)(PB + (size_t)m * LDB + 2048 + c0);
            yb[u] = *(const u32x2*)(PVo + (size_t)m * LDV + c0);
            rkr[u] = SCS[((size_t)(b * 8 + hd) * T + t) * 4 + 2]; }
#pragma unroll
        for (int u = 0; u < MT; ++u) mean[u] = red16m((ya[u][0] + ya[u][1]) + (ya[u][2] + ya[u][3])) * (1.f / 64.f);
#pragma unroll
        for (int u = 0; u < MT; ++u) { const f32x4 d = ya[u] - mean[u]; var[u] = red16m((d[0] * d[0] + d[1] * d[1]) + (d[2] * d[2] + d[3] * d[3])) * (1.f / 64.f); }
#pragma unroll
        for (int u = 0; u < MT; ++u) { const int m = mb + 4 * u + tsub; const float rs = rsqrtf(var[u] + GN_EPS);
            f32x4 v4 = {bflo(vv[u].x), bfhi(vv[u].x), bflo(vv[u].y), bfhi(vv[u].y)};
            f32x4 ga = {bflo(g1[u].x), bfhi(g1[u].x), bflo(g1[u].y), bfhi(g1[u].y)}, gbv = {bflo(g2[u].x), bfhi(g2[u].x), bflo(g2[u].y), bfhi(g2[u].y)};
            f32x4 y2 = {bflo(yb[u].x), bfhi(yb[u].x), bflo(yb[u].y), bfhi(yb[u].y)};
            const f32x4 yn = ((ya[u] - mean[u]) * rs * gg + gb + v4 * rkr[u]) * ga; const f32x4 yo = y2 * gbv;
            u32x2 o1 = {pk2(yn[0], yn[1]), pk2(yn[2], yn[3])}, o2 = {pk2(yo[0], yo[1]), pk2(yo[2], yo[3])};
            *(u32x2*)(YM + (size_t)m * D + c0) = o1; *(u32x2*)(YM + (size_t)m * D + 512 + c0) = o2; }
    }
}

#ifndef N_LAUNCH_MODE
#define N_LAUNCH_MODE 1
#endif
template <int MASK, bool COOP> __device__ __forceinline__ void run_phases(const Args& a, LAS unsigned char* lds, int l0, int l1) {
    const int G = gridDim.x;
#define LAUNDER() int tid = threadIdx.x; asm volatile("" : "+v"(tid)); const int lane = tid & 63, wave = __builtin_amdgcn_readfirstlane(tid >> 6); (void)lane; (void)wave
    float* hbuf = a.out;
    const float* mod = (const float*)(a.ws + WS_CTL) + CW_MOD;
    bf16* XN = (bf16*)(a.ws + WS_XN);
#define GSYNC() do { if constexpr (COOP) cg::this_grid().sync(); } while (0)
    if constexpr (MASK & 1) { LAUNDER(); p0a(a, lds, tid, lane, wave, G); GSYNC(); }
    if constexpr (MASK & 2) { LAUNDER(); ln_rows(a.in[0], a.in[2], a.in[3], hbuf, XN, mod, lane, wave, G); GSYNC(); }
#pragma unroll 1
    for (int l = l0; l < l1; ++l) {
        for (int rep = 0; rep < ((PROBE_REP & 4) ? 2 : 1); ++rep)
        if constexpr (MASK & 4) { pg8::Gemm g{XN, (const bf16*)(a.ws + WS_WIN) + (size_t)l * NPROJ * 1024, M, NPROJ, 1024}; pg8::StaticOrder S; S.init(M, NPROJ, G, (int)blockIdx.x);
          EpiProj E{(bf16*)(a.ws + WS_PA), (bf16*)(a.ws + WS_PV), (bf16*)(a.ws + WS_PB)};
          pg8::gemm_phase<EpiProj, pg8::StaticOrder, true, true>(lds, g, S, E); GSYNC(); }
        for (int rep = 0; rep < ((PROBE_REP & 8) ? 2 : 1); ++rep)
        if constexpr (MASK & 8) { LAUNDER(); prep_phase(a, lds, l, tid, lane, wave, G); GSYNC(); }
        if constexpr (MASK & 16) { { LAUNDER(); p3a_phase(a, lds, l, tid, lane, wave); } GSYNC(); { LAUNDER(); p3b_phase(a, lds, l, tid, lane, wave); } GSYNC(); }
        for (int rep = 0; rep < ((PROBE_REP & 32) ? 2 : 1); ++rep)
        if constexpr (MASK & 32) { LAUNDER(); merge_phase(a, l, tid, lane, wave, G); GSYNC(); }
        if constexpr (MASK & 64) { pg8::Gemm g{(const bf16*)(a.ws + WS_YM), (const bf16*)(a.ws + WS_WOUT) + (size_t)l * 1024 * 1024, M, D, D}; pg8::StaticOrder S; S.init(M, D, G, (int)blockIdx.x);
          EpiOut E{hbuf, mod + l * 2 * 3072};
          pg8::gemm_phase<EpiOut, pg8::StaticOrder, true, true>(lds, g, S, E); GSYNC(); }
        if constexpr (MASK & 128) { LAUNDER(); ln_rows(hbuf, a.in[19] + l * D, a.in[20] + l * D, hbuf, XN, (l + 1 < DEPTH) ? mod + (l + 1) * 2 * 3072 : nullptr, lane, wave, G);
          if (l + 1 < l1) GSYNC(); }
    }
#undef GSYNC
#undef LAUNDER
}
#ifndef FMASK
#define FMASK 0xFF
#endif
#if N_LAUNCH_MODE == 1
__global__ void __launch_bounds__(512, 2) hymba_fwd(Args a) {
    extern __shared__ __attribute__((aligned(16))) unsigned char lds_raw[];
    run_phases<FMASK, true>(a, (LAS unsigned char*)lds_raw, 0, DEPTH);
}
#else
template <int MASK> __global__ void __launch_bounds__(512, 2) hymba_phase(Args a, int l) {
    extern __shared__ __attribute__((aligned(16))) unsigned char lds_raw[];
    run_phases<MASK, false>(a, (LAS unsigned char*)lds_raw, l, l + 1);
}
template <int MASK> static void launch_phase(const Args& a, int l, hipStream_t stream) {
    static bool attr = false;
    if (!attr) { (void)hipFuncSetAttribute((const void*)hymba_phase<MASK>, hipFuncAttributeMaxDynamicSharedMemorySize, LDS_BYTES); attr = true; }
    hipLaunchKernelGGL(hymba_phase<MASK>, dim3(256), dim3(512), LDS_BYTES, stream, a, l);
}
#endif

extern "C" void kernel_launch(void* const* d_in, const int* in_sizes, int n_in, void* d_out, int out_size, void* d_ws, size_t ws_size, hipStream_t stream) {
    if (n_in != 21 || ws_size < WS_END) { fprintf(stderr, "kernel_launch: unexpected n_in %d / ws %zu\n", n_in, ws_size); return; }
    (void)hipMemsetAsync((char*)d_ws + WS_CTL, 0, CTL_ZERO_BYTES, stream);
    Args a{};
    for (int i = 0; i < 21; ++i) a.in[i] = (const float*)d_in[i];
    a.out = (float*)d_out; a.ws = (unsigned char*)d_ws;
#if N_LAUNCH_MODE == 1
    static int grid = 0;
    if (grid == 0) {
        int dev = 0, cus = 0, per_cu = 0;
        (void)hipGetDevice(&dev); (void)hipDeviceGetAttribute(&cus, hipDeviceAttributeMultiprocessorCount, dev);
        (void)hipFuncSetAttribute((const void*)hymba_fwd, hipFuncAttributeMaxDynamicSharedMemorySize, LDS_BYTES);
        (void)hipOccupancyMaxActiveBlocksPerMultiprocessor(&per_cu, (const void*)hymba_fwd, 512, LDS_BYTES);
        if (per_cu < 1) per_cu = 1;
        (void)hipGetLastError();
        grid = cus * per_cu;
    }
    void* args[] = {&a};
    hipError_t e = hipLaunchCooperativeKernel((const void*)hymba_fwd, dim3(grid), dim3(512), args, LDS_BYTES, stream);
    if (e != hipSuccess) fprintf(stderr, "cooperative launch failed: %s (grid %d)\n", hipGetErrorString(e), grid);
#else
    launch_phase<1>(a, 0, stream); launch_phase<2>(a, 0, stream);
    for (int l = 0; l < DEPTH; ++l) { launch_phase<4>(a, l, stream); launch_phase<8>(a, l, stream); launch_phase<16>(a, l, stream); launch_phase<32>(a, l, stream); launch_phase<64>(a, l, stream); launch_phase<128>(a, l, stream); }
#endif
}
```

```cpp
#include <hip/hip_runtime.h>
#include <cstdio>
#include <cstdint>
namespace pg8 {
#define PG8_LAS __attribute__((address_space(3)))
typedef unsigned short bf16_t;
typedef short bf16x8 __attribute__((ext_vector_type(8)));
typedef float f32x4 __attribute__((ext_vector_type(4)));
typedef unsigned u32x4 __attribute__((ext_vector_type(4)));
constexpr int BM = 256, BK = 64, HALF = 128, HTB = HALF * BK * 2  , STAGE_BYTES = 8 * HTB, NXCD = 8, WGM = 8;

__host__ __device__ __forceinline__ int lds_byte(int r, int c) { const int st = (r >> 4) * 2 + (c >> 5), rr = r & 15, cc = c & 31, ob = rr * 64 + cc * 2; return st * 1024 + (ob ^ (((ob >> 9) & 1) << 5)); }
__host__ __device__ __forceinline__ void stage_rc(int b, int& R, int& C) { const int st = b / 1024, sb = b % 1024, swz = sb ^ (((sb >> 9) & 1) << 5); R = (st >> 1) * 16 + swz / 64; C = (st & 1) * 32 + (swz % 64) / 2; }
__host__ __device__ __forceinline__ int perm32(int rho) { const int n = rho >> 4, i = rho & 15; return 8 * (i >> 2) + 4 * n + (i & 3); }

struct Unit { int pm, pn; };
struct Gemm { const bf16_t* A; const bf16_t* Bt; int M, N, K; };

struct StaticOrder {
    int nM, nN, nwg, G, c;
    __host__ __device__ void init(int M, int N, int G_, int c_) { nM = M / BM; nN = N / BM; nwg = nM * nN; G = G_; c = c_; }
    __host__ __device__ bool next(int i, Unit& u) const {
        const long L = (long)i * G + c; if (L >= nwg) return false;
        int wgid = (int)L; { const int q = nwg / NXCD, r = nwg % NXCD, xcd = wgid % NXCD, off = wgid / NXCD; wgid = (xcd < r ? xcd * (q + 1) : r * (q + 1) + (xcd - r) * q) + off; }
        const int nig = WGM * nN, gid = wgid / nig, fm = gid * WGM, gsz = (nM - fm) < WGM ? (nM - fm) : WGM;
        u.pm = fm + ((wgid % nig) % gsz); u.pn = (wgid % nig) / gsz; return true;
    }
    __device__ __forceinline__ void a_ready(const Unit&) const {}
    __device__ __forceinline__ void done(const Unit&) const {}
};

__device__ __forceinline__ unsigned cvt_pk_bf16(float lo, float hi) { unsigned r; asm volatile("v_cvt_pk_bf16_f32 %0, %1, %2" : "=v"(r) : "v"(lo), "v"(hi)); return r; }
typedef float f32x2 __attribute__((ext_vector_type(2)));
__device__ __forceinline__ f32x2 gelu_pk(f32x2 v) {
    const f32x2 av = __builtin_elementwise_abs(v), d = av * 0.2316418882f + 1.0f;
    f32x2 t; t.x = __builtin_amdgcn_rcpf(d.x); t.y = __builtin_amdgcn_rcpf(d.y);
    f32x2 q = t * 0.5307027145f + (-0.7265760135f); q = q * t + 0.7107068705f; q = q * t + (-0.142248368f); q = q * t + 0.127414796f; q = q * t;
    const f32x2 s = (v * v) * (-0.72134752044f);
    f32x2 e; e.x = __builtin_amdgcn_exp2f(s.x); e.y = __builtin_amdgcn_exp2f(s.y);
    const f32x2 m = v * (q * e), r = v - m;
    f32x2 o; o.x = v.x < 0.f ? m.x : r.x; o.y = v.y < 0.f ? m.y : r.y; return o;
}

template <int ACT  > struct EpiBf16 {
    static constexpr bool PERM = true, AFTER_DRAIN = false; static_assert(ACT == 0 || ACT == 1, "EpiBf16: ACT is 0 (none) or 1 (gelu_pk)");
    bf16_t* O; int ldc; const float* bias; int split_cols; size_t split_stride; float scale0;
    __device__ __forceinline__ void operator()(const f32x4 (&acc)[2][2][4][2], const Unit& u, int wr, int wc, int fr, int fq) const {
        const int row0 = u.pm * BM + wr * 64 + fr; int colt = u.pn * BM; bf16_t* base = O;
        float sc = 1.f; if (split_cols) { const int t = colt / split_cols; base += (size_t)t * split_stride; colt -= t * split_cols; if (t == 0) sc = scale0; }
        const int col0 = colt + wc * 32 + 8 * fq, bcol0 = u.pn * BM + wc * 32 + 8 * fq;
        f32x4 bv[2][2];
#pragma unroll
        for (int bj = 0; bj < 2; ++bj)
#pragma unroll
            for (int n = 0; n < 2; ++n) bv[bj][n] = bias ? *(const f32x4*)(bias + bcol0 + bj * HALF + 4 * n) : (f32x4){0.f, 0.f, 0.f, 0.f};
#pragma unroll
        for (int ai = 0; ai < 2; ++ai)
#pragma unroll
            for (int m = 0; m < 4; ++m) { bf16_t* rowp = base + (size_t)(row0 + ai * HALF + m * 16) * ldc + col0;
#pragma unroll
                for (int bj = 0; bj < 2; ++bj) { f32x4 v0 = acc[ai][bj][m][0] + bv[bj][0], v1 = acc[ai][bj][m][1] + bv[bj][1];
                    if (ACT == 1) { f32x2 a = gelu_pk((f32x2){v0[0], v0[1]}), b = gelu_pk((f32x2){v0[2], v0[3]}), c = gelu_pk((f32x2){v1[0], v1[1]}), d = gelu_pk((f32x2){v1[2], v1[3]});
                        v0 = (f32x4){a.x, a.y, b.x, b.y}; v1 = (f32x4){c.x, c.y, d.x, d.y}; }
                    v0 = v0 * sc; v1 = v1 * sc; u32x4 w; w.x = cvt_pk_bf16(v0[0], v0[1]); w.y = cvt_pk_bf16(v0[2], v0[3]); w.z = cvt_pk_bf16(v1[0], v1[1]); w.w = cvt_pk_bf16(v1[2], v1[3]);
                    *(u32x4*)(rowp + bj * HALF) = w; } }
    }
};

template <class Epi, class Sched, bool ALIGN_EPI = false, bool SP2 = false>
__device__ __forceinline__ void gemm_phase(PG8_LAS unsigned char* lds, const Gemm g, const Sched& S, const Epi& E) {
    int tid = threadIdx.x; asm volatile("" : "+v"(tid));
    const int wid = __builtin_amdgcn_readfirstlane(tid >> 6), lane = tid & 63, wr = wid >> 2, wc = wid & 3, fr = lane & 15, fq = lane >> 4;
    const int K = g.K, nt = K / BK;
    unsigned voffA[2], voffB[2];
#pragma unroll
    for (int i = 0; i < 2; ++i) { int R, C; stage_rc(tid * 16 + i * 8192, R, C); const int Rb = Epi::PERM ? ((R & ~31) + perm32(R & 31)) : R;
        voffA[i] = (unsigned)(R * K + C) * 2u; voffB[i] = (unsigned)(Rb * K + C) * 2u; }
    const size_t kstep = (size_t)(BK * 2);
    const size_t hstep = (size_t)HALF * K * 2;
    const size_t tstep = 2 * hstep;
    const unsigned ldsw = (unsigned)wid * 1024u;
    const int aoff = lds_byte(wr * 64 + fr, fq * 8), boff = lds_byte(wc * 32 + fr, fq * 8);
#define PG8_SA(b, h) (((b) * 2 + (h)) * HTB)
#define PG8_SB(b, h) ((4 + (b) * 2 + (h)) * HTB)
#define PG8_STAGE(bufoff, gbase, voff) do { _Pragma("unroll") for (int _i = 0; _i < 2; ++_i) \
        __builtin_amdgcn_global_load_lds((const unsigned*)((const char*)(gbase) + (voff)[_i]), (PG8_LAS unsigned*)(lds + (bufoff) + ldsw + _i * 8192), 16, 0, 0); } while (0)
#define PG8_LDA(dst, b, h) do { _Pragma("unroll") for (int m = 0; m < 4; ++m) _Pragma("unroll") for (int k = 0; k < 2; ++k) dst[m][k] = *(const PG8_LAS bf16x8*)(lds + PG8_SA(b, h) + aoff + m * 2048 + k * 1024); } while (0)
#define PG8_LDB(dst, b, h) do { _Pragma("unroll") for (int n = 0; n < 2; ++n) _Pragma("unroll") for (int k = 0; k < 2; ++k) dst[n][k] = *(const PG8_LAS bf16x8*)(lds + PG8_SB(b, h) + boff + n * 2048 + k * 1024); } while (0)
#define PG8_MMA(ai, bj, At, Bt) do { __builtin_amdgcn_s_setprio(1); _Pragma("unroll") for (int m = 0; m < 4; ++m) _Pragma("unroll") for (int n = 0; n < 2; ++n) _Pragma("unroll") for (int k = 0; k < 2; ++k) \
        acc[ai][bj][m][n] = __builtin_amdgcn_mfma_f32_16x16x32_bf16(Bt[n][k], At[m][k], acc[ai][bj][m][n], 0, 0, 0); __builtin_amdgcn_s_setprio(0); } while (0)
#define PG8_WAIT_V(n) asm volatile("s_waitcnt vmcnt(" #n ")" ::: "memory")
#define PG8_WAIT_L(n) asm volatile("s_waitcnt lgkmcnt(" #n ")" ::: "memory")
#define PG8_BAR __builtin_amdgcn_s_barrier()
#define PG8_SCHED __builtin_amdgcn_sched_barrier(0)
    Unit cur, nxt; int ui = 0;
    if (!S.next(0, cur)) return;
    f32x4 acc[2][2][4][2];
#pragma unroll
    for (int a = 0; a < 2; ++a)
#pragma unroll
        for (int b = 0; b < 2; ++b)
#pragma unroll
            for (int m = 0; m < 4; ++m)
#pragma unroll
                for (int n = 0; n < 2; ++n) acc[a][b][m][n] = (f32x4){0.f, 0.f, 0.f, 0.f};
    bf16x8 At[4][2], B0[2][2], B1[2][2];
    const char* cA = (const char*)g.A + (size_t)cur.pm * tstep; const char* cB = (const char*)g.Bt + (size_t)cur.pn * tstep;
    S.a_ready(cur);
    if constexpr (SP2) {
        PG8_STAGE(PG8_SB(0, 0), cB, voffB); PG8_STAGE(PG8_SB(0, 1), cB + hstep, voffB); PG8_STAGE(PG8_SA(0, 0), cA, voffA); PG8_STAGE(PG8_SA(0, 1), cA + hstep, voffA);
        if (wr == 1) PG8_BAR;
        PG8_WAIT_V(2); PG8_BAR;
        PG8_STAGE(PG8_SB(1, 0), cB + kstep, voffB); PG8_STAGE(PG8_SA(1, 0), cA + kstep, voffA); PG8_STAGE(PG8_SB(1, 1), cB + hstep + kstep, voffB);
        PG8_WAIT_V(6); PG8_BAR;
    } else {
        PG8_STAGE(PG8_SB(0, 0), cB, voffB); PG8_STAGE(PG8_SA(0, 0), cA, voffA); PG8_STAGE(PG8_SB(0, 1), cB + hstep, voffB); PG8_STAGE(PG8_SA(0, 1), cA + hstep, voffA);
        if (wr == 1) PG8_BAR;
        PG8_WAIT_V(4); PG8_BAR;
        PG8_STAGE(PG8_SB(1, 0), cB + kstep, voffB); PG8_STAGE(PG8_SA(1, 0), cA + kstep, voffA); PG8_STAGE(PG8_SB(1, 1), cB + hstep + kstep, voffB);
        PG8_WAIT_V(6); PG8_BAR;
    }
    for (;;) {
        const bool has_next = S.next(ui + 1, nxt);
        const char* nA = has_next ? (const char*)g.A + (size_t)nxt.pm * tstep : cA; const char* nB = has_next ? (const char*)g.Bt + (size_t)nxt.pn * tstep : cB;
        for (int t = 0; t < nt; t += 2) {
            const bool last = (t == nt - 2);
            const char* a1 = cA + (size_t)(t + 1) * kstep;
            const char* a2 = last ? nA : cA + (size_t)(t + 2) * kstep; const char* b2 = last ? nB : cB + (size_t)(t + 2) * kstep;
            const char* a3 = a2 + kstep; const char* b3 = b2 + kstep;
            if (last && has_next) S.a_ready(nxt);
            if constexpr (SP2) {
            PG8_LDB(B0, 0, 0); PG8_LDB(B1, 0, 1); PG8_SCHED; PG8_LDA(At, 0, 0); PG8_STAGE(PG8_SA(1, 1), a1 + hstep, voffA);
            PG8_WAIT_V(8); PG8_WAIT_L(0); PG8_BAR; PG8_MMA(0, 0, At, B0); PG8_MMA(0, 1, At, B1); PG8_BAR; PG8_SCHED;
            PG8_LDA(At, 0, 1); PG8_STAGE(PG8_SB(0, 0), b2, voffB); PG8_STAGE(PG8_SB(0, 1), b2 + hstep, voffB); PG8_STAGE(PG8_SA(0, 0), a2, voffA);
            PG8_WAIT_V(8); PG8_WAIT_L(0); PG8_BAR; PG8_MMA(1, 0, At, B0); PG8_MMA(1, 1, At, B1); PG8_BAR; PG8_SCHED;
            PG8_LDB(B0, 1, 0); PG8_LDB(B1, 1, 1); PG8_SCHED; PG8_LDA(At, 1, 0); PG8_STAGE(PG8_SA(0, 1), a2 + hstep, voffA);
            PG8_WAIT_V(8); PG8_WAIT_L(0); PG8_BAR; PG8_MMA(0, 0, At, B0); PG8_MMA(0, 1, At, B1); PG8_BAR; PG8_SCHED;
            PG8_LDA(At, 1, 1); PG8_STAGE(PG8_SB(1, 0), b3, voffB); PG8_STAGE(PG8_SB(1, 1), b3 + hstep, voffB); PG8_STAGE(PG8_SA(1, 0), a3, voffA);
            PG8_WAIT_V(8); PG8_WAIT_L(0); PG8_BAR; PG8_MMA(1, 0, At, B0); PG8_MMA(1, 1, At, B1); PG8_BAR; PG8_SCHED;
            } else {
            PG8_LDB(B0, 0, 0); PG8_SCHED; PG8_LDA(At, 0, 0); PG8_STAGE(PG8_SA(1, 1), a1 + hstep, voffA);
            PG8_WAIT_L(8); PG8_BAR; PG8_WAIT_L(0); PG8_MMA(0, 0, At, B0); PG8_BAR; PG8_SCHED;
            PG8_LDB(B1, 0, 1); PG8_STAGE(PG8_SB(0, 0), b2, voffB);
            PG8_BAR; PG8_WAIT_L(0); PG8_MMA(0, 1, At, B1); PG8_BAR;
            PG8_LDA(At, 0, 1); PG8_STAGE(PG8_SA(0, 0), a2, voffA);
            PG8_BAR; PG8_WAIT_L(0); PG8_MMA(1, 0, At, B0); PG8_BAR; PG8_SCHED;
            PG8_STAGE(PG8_SB(0, 1), b2 + hstep, voffB);
            PG8_WAIT_V(6); PG8_BAR; PG8_MMA(1, 1, At, B1); PG8_BAR;
            PG8_LDB(B0, 1, 0); PG8_SCHED; PG8_LDA(At, 1, 0); PG8_STAGE(PG8_SA(0, 1), a2 + hstep, voffA);
            PG8_WAIT_L(8); PG8_BAR; PG8_WAIT_L(0); PG8_MMA(0, 0, At, B0); PG8_BAR; PG8_SCHED;
            PG8_LDB(B1, 1, 1); PG8_STAGE(PG8_SB(1, 0), b3, voffB);
            PG8_BAR; PG8_WAIT_L(0); PG8_MMA(0, 1, At, B1); PG8_BAR;
            PG8_LDA(At, 1, 1); PG8_STAGE(PG8_SA(1, 0), a3, voffA);
            PG8_BAR; PG8_WAIT_L(0); PG8_MMA(1, 0, At, B0); PG8_BAR; PG8_SCHED;
            PG8_STAGE(PG8_SB(1, 1), b3 + hstep, voffB);
            PG8_WAIT_V(6); PG8_BAR; PG8_MMA(1, 1, At, B1); PG8_BAR;
            }
        }
        if constexpr (ALIGN_EPI) { if (wr == 0) PG8_BAR; }
        if constexpr (!Epi::AFTER_DRAIN) { E(acc, cur, wr, wc, fr, fq); S.done(cur); }
        if (!has_next) break;
#pragma unroll
        for (int a = 0; a < 2; ++a)
#pragma unroll
            for (int b = 0; b < 2; ++b)
#pragma unroll
                for (int m = 0; m < 4; ++m)
#pragma unroll
                    for (int n = 0; n < 2; ++n) acc[a][b][m][n] = (f32x4){0.f, 0.f, 0.f, 0.f};
        cur = nxt; cA = nA; cB = nB; ++ui;
        if constexpr (ALIGN_EPI) { if (wr == 1) PG8_BAR; }
    }
    PG8_WAIT_V(0);
    if constexpr (!ALIGN_EPI) { if (wr == 0) PG8_BAR; }
    PG8_BAR;
    if constexpr (Epi::AFTER_DRAIN) { E.fused(acc, cur, wr, wc, fr, fq, lds, wid, lane); S.done(cur); }
#undef PG8_SA
#undef PG8_SB
#undef PG8_STAGE
#undef PG8_LDA
#undef PG8_LDB
#undef PG8_MMA
#undef PG8_WAIT_V
#undef PG8_WAIT_L
#undef PG8_BAR
#undef PG8_SCHED
}
}
#include <hip/hip_cooperative_groups.h>
namespace cg = cooperative_groups;
#define LAS __attribute__((address_space(3)))
typedef unsigned short bf16;
typedef float f32x4 __attribute__((ext_vector_type(4)));
typedef float f32x2 __attribute__((ext_vector_type(2)));
typedef float f32x16 __attribute__((ext_vector_type(16)));
typedef short bf16x8 __attribute__((ext_vector_type(8)));
typedef short s16x4 __attribute__((ext_vector_type(4)));
typedef unsigned u32x4 __attribute__((ext_vector_type(4)));
typedef unsigned u32x2 __attribute__((ext_vector_type(2)));
typedef __bf16 bf16x2_t __attribute__((ext_vector_type(2)));

constexpr int BATCH = 2, T = 16384, D = 1024, M = BATCH * T, DEPTH = 2;
constexpr int NPROJ = 4352, NSRC = 4232;
constexpr int LDA = 1280, LDV = 512, LDB = 2560;
constexpr float LN_EPS = 1e-5f, GN_EPS = 64e-5f;
constexpr float DN_ALPHA = 1.41421356237f;
constexpr float C2 = 0.125f * 1.4426950408889634f;
constexpr float L2E = 1.4426950408889634f;
constexpr size_t MiB = 1u << 20;
constexpr size_t WS_CTL = 0, CTL_ZERO_BYTES = 1 * MiB;
constexpr size_t WS_WIN = 2 * MiB, WS_WOUT = 20 * MiB, WS_CUM = 24 * MiB, WS_SCS = 25 * MiB, WS_SCN = 30 * MiB;
constexpr size_t WS_XN = WS_SCN;
constexpr size_t WS_CSUM = 29 * MiB + 512 * 1024;
constexpr size_t WS_LORA = 29 * MiB;
constexpr size_t WS_PA = 190 * MiB, WS_YA = WS_PA, WS_YM = WS_PA  , WS_PV = 270 * MiB, WS_PB = 302 * MiB, WS_VS = 462 * MiB, WS_FS = 494 * MiB, WS_SI = 502 * MiB, WS_END = 506 * MiB;
constexpr int CW_QUEUE = 64;
constexpr int CW_KMAX = 1024;
constexpr int CW_MOD = 16384;
constexpr int LDS_BYTES = 147456;
#ifndef PROBE_REP
#define PROBE_REP 0
#endif

__device__ __forceinline__ unsigned f2bf(float f) { unsigned u = __builtin_bit_cast(unsigned, f); return (u + 0x7fffu + ((u >> 16) & 1u)) >> 16; }
__device__ __forceinline__ unsigned pk2(float lo, float hi) { return f2bf(lo) | (f2bf(hi) << 16); }
__device__ __forceinline__ float bf2f(unsigned short v) { return __uint_as_float(((unsigned)v) << 16); }
__device__ __forceinline__ float bflo(unsigned w) { return __uint_as_float(w << 16); }
__device__ __forceinline__ float bfhi(unsigned w) { return __uint_as_float(w & 0xffff0000u); }
__device__ __forceinline__ unsigned cvtpk(float lo, float hi) { f32x2 v = {lo, hi}; bf16x2_t b = __builtin_convertvector(v, bf16x2_t); return __builtin_bit_cast(unsigned, b); }
__device__ __forceinline__ float row16_sum(float x) {
    x += __uint_as_float(__builtin_amdgcn_update_dpp(0, __float_as_uint(x), 0xB1, 0xF, 0xF, true));
    x += __uint_as_float(__builtin_amdgcn_update_dpp(0, __float_as_uint(x), 0x4E, 0xF, 0xF, true));
    x += __uint_as_float(__builtin_amdgcn_update_dpp(0, __float_as_uint(x), 0x141, 0xF, 0xF, true));
    x += __uint_as_float(__builtin_amdgcn_update_dpp(0, __float_as_uint(x), 0x140, 0xF, 0xF, true));
    return x;
}
__device__ __forceinline__ float wave_sum(float v) { v = row16_sum(v); v += __shfl_xor(v, 16); v += __shfl_xor(v, 32); return v; }
__device__ __forceinline__ float fast_sigmoid(float x) { return 1.f / (1.f + __expf(-x)); }

struct Args { const float* in[21]; float* out; unsigned char* ws; };

struct EpiProj {
    static constexpr bool PERM = true, AFTER_DRAIN = false;
    bf16 *PA, *PVb, *PB;
    __device__ __forceinline__ void operator()(const pg8::f32x4 (&acc)[2][2][4][2], const pg8::Unit& u, int wr, int wc, int fr, int fq) const {
        const int row0 = u.pm * 256 + wr * 64 + fr; const int pn = u.pn;
        bf16* base; int ldc, colt; float sc = 1.f; bool act = false;
        if (pn < 4) { base = PA; ldc = LDA; colt = pn * 256; }
        else if (pn < 6) { base = PVb; ldc = LDV; colt = (pn - 4) * 256; }
        else if (pn == 6) { base = PA; ldc = LDA; colt = 1024; }
        else { base = PB; ldc = LDB; colt = (pn - 7) * 256; if (pn < 9) sc = C2; if (pn >= 13) act = true; }
        const int col0 = colt + wc * 32 + 8 * fq;
#pragma unroll
        for (int ai = 0; ai < 2; ++ai)
#pragma unroll
            for (int m = 0; m < 4; ++m) { bf16* rowp = base + (size_t)(row0 + ai * 128 + m * 16) * ldc + col0;
#pragma unroll
                for (int bj = 0; bj < 2; ++bj) { pg8::f32x4 v0 = acc[ai][bj][m][0], v1 = acc[ai][bj][m][1];
                    if (act) {
#pragma unroll
                        for (int e = 0; e < 4; ++e) { v0[e] = v0[e] * fast_sigmoid(v0[e]); v1[e] = v1[e] * fast_sigmoid(v1[e]); } }
                    v0 = v0 * sc; v1 = v1 * sc; u32x4 w; w.x = cvtpk(v0[0], v0[1]); w.y = cvtpk(v0[2], v0[3]); w.z = cvtpk(v1[0], v1[1]); w.w = cvtpk(v1[2], v1[3]);
                    *(u32x4*)(rowp + bj * 128) = w; } }
    }
};
struct EpiOut {
    static constexpr bool PERM = false, AFTER_DRAIN = false;
    float* hz; const float* modl;
    __device__ __forceinline__ void operator()(const pg8::f32x4 (&acc)[2][2][4][2], const pg8::Unit& u, int wr, int wc, int fr, int fq) const {
        const int col0 = u.pn * 256 + wc * 32 + 4 * fq; const int b = (u.pm * 256) >= T ? 1 : 0; const float* gate = modl + b * 3072 + 2048;
#pragma unroll
        for (int bj = 0; bj < 2; ++bj)
#pragma unroll
            for (int n = 0; n < 2; ++n) { const int c = col0 + bj * 128 + n * 16; const f32x4 g = *(const f32x4*)(gate + c) + 1.0f;
#pragma unroll
                for (int ai = 0; ai < 2; ++ai)
#pragma unroll
                    for (int m = 0; m < 4; ++m) { const int r = u.pm * 256 + ai * 128 + wr * 64 + m * 16 + fr; float* p = hz + (size_t)r * D + c;
                        const f32x4 hx = *(const f32x4*)p; f32x4 a; a[0] = acc[ai][bj][m][n][0]; a[1] = acc[ai][bj][m][n][1]; a[2] = acc[ai][bj][m][n][2]; a[3] = acc[ai][bj][m][n][3];
                        *(f32x4*)p = hx * DN_ALPHA + g * a; } }
    }
};

__device__ __forceinline__ int win_map(int n) { if (n < 1664) return n; if (n < 1672) return 3200 + n - 1664; if (n < 1792) return -1; if (n < 3328) return n - 128; return n - 120; }
template <bool MAP> __device__ __forceinline__ void transpose_item(const float* W, int Nsrc, int Ndst, bf16* WT, LAS float* scr, int item, int lane) {
    const int nblk = Ndst / 32, kb = item / nblk, nb = item % nblk, k0 = 64 * kb, n0 = 32 * nb;
    const int src = MAP ? win_map(n0 + (lane & 31)) : n0 + (lane & 31);
#pragma unroll 8
    for (int i = 0; i < 32; ++i) { const int kk = 2 * i + (lane >> 5); scr[kk * 33 + (lane & 31)] = src >= 0 ? W[(size_t)(k0 + kk) * Nsrc + src] : 0.f; }
    asm volatile("s_waitcnt lgkmcnt(0)" ::: "memory");
    const int c = lane & 7;
#pragma unroll
    for (int j = 0; j < 4; ++j) { const int n = (lane >> 3) + 8 * j; const LAS float* s = scr + (8 * c) * 33 + n;
        u32x4 o; o.x = pk2(s[0 * 33], s[1 * 33]); o.y = pk2(s[2 * 33], s[3 * 33]); o.z = pk2(s[4 * 33], s[5 * 33]); o.w = pk2(s[6 * 33], s[7 * 33]);
        *(u32x4*)(WT + (size_t)(n0 + n) * 1024 + k0 + 8 * c) = o; }
    asm volatile("s_waitcnt lgkmcnt(0)" ::: "memory");
}
__device__ __forceinline__ void p0a(const Args& a, LAS unsigned char* lds, int tid, int lane, int wave, int G) {
    LAS float* scr = (LAS float*)(lds + wave * 16384);
    const int gw = blockIdx.x * 8 + wave, NGW = G * 8;
    constexpr int I_IN = 16 * (NPROJ / 32), I_OUT = 16 * 32;
    for (int it = gw; it < 2 * (I_IN + I_OUT); it += NGW) {
        int r = it; const int l = r / (I_IN + I_OUT); r -= l * (I_IN + I_OUT);
        if (r < I_IN) transpose_item<true>(a.in[6] + (size_t)l * 1024 * NSRC, NSRC, NPROJ, (bf16*)(a.ws + WS_WIN) + (size_t)l * NPROJ * 1024, scr, r, lane);
        else transpose_item<false>(a.in[18] + (size_t)l * 1024 * 1024, 1024, 1024, (bf16*)(a.ws + WS_WOUT) + (size_t)l * 1024 * 1024, scr, r - I_IN, lane);
    }
    { bf16* LT = (bf16*)(a.ws + WS_LORA);
      for (int w = blockIdx.x * 512 + tid; w < 2 * 2 * 512 * 64; w += G * 512) { const int k = w & 63, n = (w >> 6) & 511, which = (w >> 15) & 1, l = w >> 16;
          const float* src = (which ? a.in[11] : a.in[9]) + (size_t)l * 64 * 512; LT[w] = (bf16)f2bf(src[k * 512 + n]); } }
    float* mod = (float*)(a.ws + WS_CTL) + CW_MOD;
    const float* cvec = a.in[1];
    for (int w = blockIdx.x * 512 + tid; w < 2 * 16 * 3072; w += G * 512) {
        const int j = w % 3072, sl = (w / 3072) % 16, l = w / (3072 * 16);
        const float* wa = a.in[4] + (size_t)l * 1024 * 3072 + (size_t)(sl * 64) * 3072 + j;
        float s0 = 0.f, s1 = 0.f;
#pragma unroll 8
        for (int i = 0; i < 64; ++i) { const float wv = wa[(size_t)i * 3072]; s0 += cvec[sl * 64 + i] * wv; s1 += cvec[1024 + sl * 64 + i] * wv; }
        if (sl == 0) { const float bb = a.in[5][l * 3072 + j]; s0 += bb; s1 += bb; }
        atomicAdd(mod + (l * 2 + 0) * 3072 + j, s0); atomicAdd(mod + (l * 2 + 1) * 3072 + j, s1);
    }
}
__device__ __forceinline__ void ln_rows(const float* src, const float* g, const float* bb, float* dst, bf16* xn, const float* modn, int lane, int wave, int G) {
    const int gw = blockIdx.x * 8 + wave, NGW = G * 8;
    f32x4 gv[4], bv[4];
#pragma unroll
    for (int j = 0; j < 4; ++j) { gv[j] = ((const f32x4*)g)[lane + 64 * j]; bv[j] = ((const f32x4*)bb)[lane + 64 * j]; }
    for (int m0 = gw * 2; m0 < M; m0 += NGW * 2) {
        f32x4 v[2][4]; float s[2], s2[2];
#pragma unroll
        for (int u = 0; u < 2; ++u) { const f32x4* xr = (const f32x4*)(src + (size_t)(m0 + u) * D) + lane; s[u] = 0.f;
#pragma unroll
            for (int j = 0; j < 4; ++j) { v[u][j] = xr[64 * j]; s[u] += (v[u][j].x + v[u][j].y) + (v[u][j].z + v[u][j].w); } }
#pragma unroll
        for (int u = 0; u < 2; ++u) s[u] = row16_sum(s[u]);
#pragma unroll
        for (int o = 16; o < 64; o <<= 1) {
#pragma unroll
            for (int u = 0; u < 2; ++u) s[u] += __shfl_xor(s[u], o); }
#pragma unroll
        for (int u = 0; u < 2; ++u) { const float mean = s[u] * (1.f / D); s2[u] = 0.f;
#pragma unroll
            for (int j = 0; j < 4; ++j) { v[u][j] = v[u][j] - mean; s2[u] += (v[u][j].x * v[u][j].x + v[u][j].y * v[u][j].y) + (v[u][j].z * v[u][j].z + v[u][j].w * v[u][j].w); } }
#pragma unroll
        for (int u = 0; u < 2; ++u) s2[u] = row16_sum(s2[u]);
#pragma unroll
        for (int o = 16; o < 64; o <<= 1) {
#pragma unroll
            for (int u = 0; u < 2; ++u) s2[u] += __shfl_xor(s2[u], o); }
#pragma unroll
        for (int u = 0; u < 2; ++u) { const int m = m0 + u;
            const float rstd = 1.f / sqrtf(s2[u] * (1.f / D) + LN_EPS);
            f32x4* o = (f32x4*)(dst + (size_t)m * D) + lane;
            const int b = m >= T ? 1 : 0;
#pragma unroll
            for (int j = 0; j < 4; ++j) { const f32x4 hv = v[u][j] * rstd * gv[j] + bv[j]; o[64 * j] = hv;
                if (modn) { const f32x4 sh = ((const f32x4*)(modn + b * 3072))[lane + 64 * j], sc = ((const f32x4*)(modn + b * 3072 + 1024))[lane + 64 * j];
                    const f32x4 y = hv * (sc + 1.0f) + sh; u32x2 w; w.x = pk2(y.x, y.y); w.y = pk2(y.z, y.w);
                    *((u32x2*)(xn + (size_t)m * D) + lane + 64 * j) = w; } } }
    }
}
__device__ __forceinline__ int crow(int r, int hi) { return (r & 3) + 8 * (r >> 2) + 4 * hi; }
__device__ __forceinline__ float tanh_fast(float x) { const float e = __expf(2.f * x); return 1.f - 2.f / (e + 1.f); }
__device__ __forceinline__ void cum_kmax(const Args& a, LAS unsigned char* lds, int l, int bh, int tid, int lane, int wave) {
    const int b = bh >> 3, h = bh & 7;
    const bf16* PA = (const bf16*)(a.ws + WS_PA); const bf16* PB = (const bf16*)(a.ws + WS_PB);
    float* cum = (float*)(a.ws + WS_CUM) + (size_t)bh * T;
    const float bf = a.in[17][l * 8 + h];
    LAS float* red = (LAS float*)lds;
    const int t0 = tid * 32;
    float s = 0.f, kmx = 0.f;
#pragma unroll 1
    for (int i = 0; i < 32; ++i) { const size_t m = (size_t)b * T + t0 + i;
        const float z = bf2f(PA[m * LDA + 1152 + h]) + bf;
        const float lf = fminf(z, 0.f) - log1pf(__expf(-fabsf(z)));
        s += lf; cum[t0 + i] = s;
        const u32x4* kr = (const u32x4*)(PB + m * LDB + 512 + h * 64); float q = 0.f;
#pragma unroll
        for (int c = 0; c < 8; ++c) { const u32x4 w = kr[c];
            q += bflo(w.x) * bflo(w.x) + bfhi(w.x) * bfhi(w.x) + bflo(w.y) * bflo(w.y) + bfhi(w.y) * bfhi(w.y) + bflo(w.z) * bflo(w.z) + bfhi(w.z) * bfhi(w.z) + bflo(w.w) * bflo(w.w) + bfhi(w.w) * bfhi(w.w); }
        kmx = fmaxf(kmx, q); }
    red[tid] = s;
#pragma unroll
    for (int o = 1; o < 64; o <<= 1) kmx = fmaxf(kmx, __shfl_xor(kmx, o));
    if (lane == 0) red[512 + wave] = kmx;
    __syncthreads();
    if (tid == 0) { float run = 0.f; for (int i = 0; i < 512; ++i) { const float v = red[i]; red[i] = run; run += v; }
        float k = 0.f; for (int i = 0; i < 8; ++i) k = fmaxf(k, red[512 + i]);
        ((float*)(a.ws + WS_CTL))[CW_KMAX + 16 * l + bh] = sqrtf(k); }
    __syncthreads();
    const float off = red[tid];
#pragma unroll 1
    for (int i = 0; i < 32; ++i) cum[t0 + i] += off;
    __syncthreads();
}
__device__ __forceinline__ void prep_phase(const Args& a, LAS unsigned char* lds, int l, int tid, int lane, int wave, int G) {
    const bf16* PA = (const bf16*)(a.ws + WS_PA); const bf16* PV = (const bf16*)(a.ws + WS_PV);
    bf16* SCN = (bf16*)(a.ws + WS_SCN); float* SCS = (float*)(a.ws + WS_SCS); bf16* VS = (bf16*)(a.ws + WS_VS);
    LAS unsigned char* lowL = lds;
    LAS bf16* CL = (LAS bf16*)(lds + 16384);
    const int c = tid, h = wave, r32 = lane & 31, hi = lane >> 5;
    const bf16* LT = (const bf16*)(a.ws + WS_LORA) + (size_t)l * 2 * 512 * 64;
    const float* mix = a.in[7] + l * 1664;
    const int qc = tid & 127, tsel = tid >> 7, c4 = 4 * qc, hq = qc >> 4;
    const f32x4 mix_r = *(const f32x4*)(mix + c4), mix_k = *(const f32x4*)(mix + 512 + c4), mix_v = *(const f32x4*)(mix + 1024 + c4);
    const int ftok = tid >> 3, fi0 = (tid & 7) * 16;
    f32x4 mlow[4];
#pragma unroll
    for (int q = 0; q < 4; ++q) mlow[q] = *(const f32x4*)(mix + 1536 + fi0 + 4 * q);
    const f32x4 w0c = *(const f32x4*)(a.in[8] + l * 512 + c4), a0c = *(const f32x4*)(a.in[10] + l * 512 + c4), kkc = *(const f32x4*)(a.in[12] + l * 512 + c4), kac = *(const f32x4*)(a.in[13] + l * 512 + c4), rkc = *(const f32x4*)(a.in[14] + l * 512 + c4);
    unsigned* pq = (unsigned*)(a.ws + WS_CTL) + CW_QUEUE + 1024 + 64 * l;
    volatile LAS unsigned* ptask = (volatile LAS unsigned*)(lds + 140000);
    for (;;) {
        __syncthreads();
        if (tid == 0) ptask[0] = atomicAdd(pq, 1u);
        __syncthreads();
        const unsigned ptk = ptask[0];
        if (ptk >= (unsigned)(M / 64)) break;
        const int chunk = (int)ptk;
        const int m0 = chunk * 64, b = m0 >= T ? 1 : 0, t0 = m0 - b * T; const int bh = b * 8 + h;
        LAS float* lfL = (LAS float*)(lds + 81920); LAS float* kqL = (LAS float*)(lds + 83968);
        { const int tkn = tid >> 3, hd = tid & 7; const size_t m = (size_t)m0 + tkn;
          const float z = bf2f(PA[m * LDA + 1152 + hd]) + a.in[17][l * 8 + hd];
          lfL[hd * 64 + tkn] = fminf(z, 0.f) - __logf(1.f + __expf(-fabsf(z)));
          const u32x4* kr = (const u32x4*)((const bf16*)(a.ws + WS_PB) + m * LDB + 512 + hd * 64); float q = 0.f;
#pragma unroll
          for (int cc = 0; cc < 8; ++cc) { const u32x4 w = kr[cc];
              q += bflo(w.x) * bflo(w.x) + bfhi(w.x) * bfhi(w.x) + bflo(w.y) * bflo(w.y) + bfhi(w.y) * bfhi(w.y) + bflo(w.z) * bflo(w.z) + bfhi(w.z) * bfhi(w.z) + bflo(w.w) * bflo(w.w) + bfhi(w.w) * bfhi(w.w); }
          kqL[hd * 64 + tkn] = q; }
        { const int m = m0 + ftok, t = t0 + ftok;
          const u32x4* cp = (const u32x4*)(PA + (size_t)m * LDA + 1024 + fi0);
          const u32x4 c0 = cp[0], c1 = cp[1]; u32x4 p0 = {0u, 0u, 0u, 0u}, p1 = p0;
          if (t > 0) { const u32x4* pp = (const u32x4*)(PA + (size_t)(m - 1) * LDA + 1024 + fi0); p0 = pp[0]; p1 = pp[1]; }
          float cur[16], prv[16];
          cur[0] = bflo(c0.x); cur[1] = bfhi(c0.x); cur[2] = bflo(c0.y); cur[3] = bfhi(c0.y); cur[4] = bflo(c0.z); cur[5] = bfhi(c0.z); cur[6] = bflo(c0.w); cur[7] = bfhi(c0.w);
          cur[8] = bflo(c1.x); cur[9] = bfhi(c1.x); cur[10] = bflo(c1.y); cur[11] = bfhi(c1.y); cur[12] = bflo(c1.z); cur[13] = bfhi(c1.z); cur[14] = bflo(c1.w); cur[15] = bfhi(c1.w);
          prv[0] = bflo(p0.x); prv[1] = bfhi(p0.x); prv[2] = bflo(p0.y); prv[3] = bfhi(p0.y); prv[4] = bflo(p0.z); prv[5] = bfhi(p0.z); prv[6] = bflo(p0.w); prv[7] = bfhi(p0.w);
          prv[8] = bflo(p1.x); prv[9] = bfhi(p1.x); prv[10] = bflo(p1.y); prv[11] = bfhi(p1.y); prv[12] = bflo(p1.z); prv[13] = bfhi(p1.z); prv[14] = bflo(p1.w); prv[15] = bfhi(p1.w);
#pragma unroll
          for (int q = 0; q < 16; ++q) { float val = cur[q] + (prv[q] - cur[q]) * mlow[q >> 2][q & 3]; if (fi0 < 64) val = tanh_fast(val); cur[q] = val; }
          u32x4 o0 = {cvtpk(cur[0], cur[1]), cvtpk(cur[2], cur[3]), cvtpk(cur[4], cur[5]), cvtpk(cur[6], cur[7])};
          u32x4 o1 = {cvtpk(cur[8], cur[9]), cvtpk(cur[10], cur[11]), cvtpk(cur[12], cur[13]), cvtpk(cur[14], cur[15])};
          const int ch = 2 * (tid & 7);
          *(LAS u32x4*)(lowL + ftok * 256 + ((ch ^ (ftok & 7)) << 4)) = o0; *(LAS u32x4*)(lowL + ftok * 256 + (((ch + 1) ^ (ftok & 7)) << 4)) = o1; }
        __syncthreads();
        if (tid < 8) { float run = 0.f, kmx = 0.f;
            for (int tt = 0; tt < 64; ++tt) { run += lfL[tid * 64 + tt]; lfL[tid * 64 + tt] = run; kmx = fmaxf(kmx, kqL[tid * 64 + tt]); }
            ((float*)(a.ws + WS_CSUM))[(b * 8 + tid) * 256 + (t0 >> 6)] = run;
            atomicMax((unsigned*)(a.ws + WS_CTL) + CW_KMAX + 16 * l + b * 8 + tid, __float_as_uint(sqrtf(kmx))); }
#pragma unroll 1
        for (int tr = 0; tr < 2; ++tr) {
            { f32x16 Cw0 = {}, Cw1 = {}, Ca0 = {}, Ca1 = {};
              const int trow = 32 * tr + r32;
              bf16x8 Bw[2][4], Ba[2][4];
#pragma unroll
              for (int tc = 0; tc < 2; ++tc)
#pragma unroll
                for (int sx = 0; sx < 4; ++sx) { const int n = 64 * h + 32 * tc + r32;
                    Bw[tc][sx] = __builtin_bit_cast(bf16x8, *(const u32x4*)(LT + (size_t)n * 64 + 16 * sx + 8 * hi));
                    Ba[tc][sx] = __builtin_bit_cast(bf16x8, *(const u32x4*)(LT + 512 * 64 + (size_t)n * 64 + 16 * sx + 8 * hi)); }
#pragma unroll
              for (int sx = 0; sx < 4; ++sx) {
                  const bf16x8 Aw = *(const LAS bf16x8*)(lowL + trow * 256 + (((2 * sx + hi) ^ (trow & 7)) << 4));
                  const bf16x8 Aa = *(const LAS bf16x8*)(lowL + trow * 256 + (((8 + 2 * sx + hi) ^ (trow & 7)) << 4));
                  Cw0 = __builtin_amdgcn_mfma_f32_32x32x16_bf16(Aw, Bw[0][sx], Cw0, 0, 0, 0); Cw1 = __builtin_amdgcn_mfma_f32_32x32x16_bf16(Aw, Bw[1][sx], Cw1, 0, 0, 0);
                  Ca0 = __builtin_amdgcn_mfma_f32_32x32x16_bf16(Aa, Ba[0][sx], Ca0, 0, 0, 0); Ca1 = __builtin_amdgcn_mfma_f32_32x32x16_bf16(Aa, Ba[1][sx], Ca1, 0, 0, 0); }
#pragma unroll
              for (int r = 0; r < 16; ++r) { LAS bf16* row = CL + crow(r, hi) * 1024 + 64 * h + r32;
                  row[0] = (bf16)f2bf(Cw0[r]); row[32] = (bf16)f2bf(Cw1[r]); row[512] = (bf16)f2bf(Ca0[r]); row[544] = (bf16)f2bf(Ca1[r]); } }
            __syncthreads();
#define UNP4(dst, u2) do { dst[0] = bflo(u2.x); dst[1] = bfhi(u2.x); dst[2] = bflo(u2.y); dst[3] = bfhi(u2.y); } while (0)
#pragma unroll 1
            for (int g = 0; g < 4; ++g) {
                const int tl0 = g * 8 + 2 * tsel, mg = m0 + 32 * tr + tl0, tg = t0 + 32 * tr + tl0;
                u32x2 rr_[3], rk_[3], rv_[3];
#pragma unroll
                for (int u = 0; u < 3; ++u) { const int m = mg - 1 + u;
                    if (u > 0 || tg > 0) { rr_[u] = *(const u32x2*)(PA + (size_t)m * LDA + c4); rk_[u] = *(const u32x2*)(PA + (size_t)m * LDA + 512 + c4); rv_[u] = *(const u32x2*)(PV + (size_t)m * LDV + c4); }
                    else { rr_[u] = (u32x2){0u, 0u}; rk_[u] = rr_[u]; rv_[u] = rr_[u]; } }
                f32x4 fr[3], fk[3], fv[3];
#pragma unroll
                for (int u = 0; u < 3; ++u) { UNP4(fr[u], rr_[u]); UNP4(fk[u], rk_[u]); UNP4(fv[u], rv_[u]); }
                f32x4 r4[2], kkr[2], kp[2], vv[2], av[2], omw[2]; float red[8];
#pragma unroll
                for (int u = 0; u < 2; ++u) {
                    r4[u] = fr[u + 1] + (fr[u] - fr[u + 1]) * mix_r; const f32x4 k4 = fk[u + 1] + (fk[u] - fk[u + 1]) * mix_k; vv[u] = fv[u + 1] + (fv[u] - fv[u + 1]) * mix_v;
                    const u32x2 cw = *(const LAS u32x2*)(CL + (tl0 + u) * 1024 + c4), ca = *(const LAS u32x2*)(CL + (tl0 + u) * 1024 + 512 + c4);
                    f32x4 wl, al; UNP4(wl, cw); UNP4(al, ca); wl = wl + w0c; al = al + a0c;
#pragma unroll
                    for (int e = 0; e < 4; ++e) { const float z = -wl[e]; const float sp = fmaxf(z, 0.f) + __logf(1.f + __expf(-fabsf(z)));
                        const float ee = __expf(-sp - 0.5f); omw[u][e] = 1.f - __expf(-ee); av[u][e] = fast_sigmoid(al[e]); }
                    kkr[u] = k4 * kkc; kp[u] = k4 * ((av[u] - 1.0f) * kac + 1.0f);
                    const f32x4 q0 = kkr[u] * kkr[u], q1 = kkr[u] * av[u] * r4[u], q2 = kp[u] * r4[u], q3 = r4[u] * kp[u] * rkc;
                    red[u] = (q0[0] + q0[1]) + (q0[2] + q0[3]); red[2 + u] = (q1[0] + q1[1]) + (q1[2] + q1[3]); red[4 + u] = (q2[0] + q2[1]) + (q2[2] + q2[3]); red[6 + u] = (q3[0] + q3[1]) + (q3[2] + q3[3]);
                }
#pragma unroll
                for (int i = 0; i < 8; ++i) red[i] = row16_sum(red[i]);
#pragma unroll
                for (int u = 0; u < 2; ++u) {
                    const float inv = 1.f / fmaxf(sqrtf(red[u]), 1e-12f);
                    const f32x4 kk = kkr[u] * inv, bbv = kk * av[u], wr = (1.0f - omw[u]) * r4[u];
                    const int bhq = b * 8 + hq;
                    bf16* rec = SCN + ((size_t)bhq * T + tg + u) * 320 + (c4 & 63);
                    *(u32x2*)(rec) = (u32x2){pk2(kk[0], kk[1]), pk2(kk[2], kk[3])}; *(u32x2*)(rec + 64) = (u32x2){pk2(wr[0], wr[1]), pk2(wr[2], wr[3])};
                    *(u32x2*)(rec + 128) = (u32x2){pk2(omw[u][0], omw[u][1]), pk2(omw[u][2], omw[u][3])}; *(u32x2*)(rec + 192) = (u32x2){pk2(bbv[0], bbv[1]), pk2(bbv[2], bbv[3])};
                    *(u32x2*)(rec + 256) = (u32x2){pk2(kp[u][0], kp[u][1]), pk2(kp[u][2], kp[u][3])};
                    *(u32x2*)(VS + (size_t)(mg + u) * 512 + c4) = (u32x2){pk2(vv[u][0], vv[u][1]), pk2(vv[u][2], vv[u][3])};
                    if ((lane & 15) == 0) { f32x4 sc = {red[2 + u] * inv, red[4 + u], red[6 + u], 0.f}; *(f32x4*)(SCS + ((size_t)bhq * T + tg + u) * 4) = sc; }
                }
            }
#undef UNP4
            __syncthreads();
        }
        { const int tkn = tid >> 3, hd = tid & 7; ((float*)(a.ws + WS_CUM))[(size_t)(b * 8 + hd) * T + t0 + tkn] = lfL[hd * 64 + tkn]; }
    }
    __syncthreads();
}

__device__ __forceinline__ float dppf(float x, const int ctrl_sel) {
    unsigned u = __float_as_uint(x), r;
    if (ctrl_sel == 0) r = __builtin_amdgcn_update_dpp(0, u, 0xB1, 0xF, 0xF, true);
    else if (ctrl_sel == 1) r = __builtin_amdgcn_update_dpp(0, u, 0x4E, 0xF, 0xF, true);
    else r = __builtin_amdgcn_update_dpp(0, u, 0x141, 0xF, 0xF, true);
    return __uint_as_float(r);
}
__device__ __forceinline__ float red8(float x) { x += dppf(x, 0); x += dppf(x, 1); x += dppf(x, 2); return x; }
constexpr int SC_CH = 32, SC_STEP = 1024, SC_BUF = SC_CH * SC_STEP, SC_VOFF = 2 * SC_BUF, SC_SOFF = SC_VOFF + 2 * SC_CH * 64 * 4, SC_ROWB = SC_SOFF + 2 * SC_CH * 16;
constexpr int NSEG = 16, SEGLEN = T / NSEG;
typedef float f32x4m __attribute__((ext_vector_type(4)));
template <bool PASSC> __device__ __forceinline__ void scan_task(const Args& a, LAS unsigned char* lds, int bh, int seg, int tid, int lane, int wave, unsigned* cntp, int lq_l) {
    const int b = bh >> 3, h = bh & 7;
    const int t0 = seg * SEGLEN;
    const bf16* SCN = (const bf16*)(a.ws + WS_SCN) + ((size_t)bh * T + t0) * 320;
    const float* SCS = (const float*)(a.ws + WS_SCS) + ((size_t)bh * T + t0) * 4;
    const bf16* VS = (const bf16*)(a.ws + WS_VS) + ((size_t)b * T + t0) * 512 + h * 64;
    float* YA = (float*)(a.ws + WS_YA) + ((size_t)b * T + t0) * 512 + h * 64;
    float* FSb = (float*)(a.ws + WS_FS) + (size_t)bh * NSEG * 128 * 64;
    constexpr int NCH = SEGLEN / SC_CH;
    const int n16 = lane & 15, g = lane >> 4;
    const bool ident = !PASSC && wave >= 4;
    const bool active = PASSC ? (wave < 4) : true;
    const int row = 16 * (wave & 3) + n16;
    f32x4 Sf[4];
#pragma unroll
    for (int i = 0; i < 4; ++i) Sf[i] = (f32x4){0.f, 0.f, 0.f, 0.f};
    __syncthreads();
    if constexpr (PASSC) {
        if (active && seg > 0) { const float* SIp = (const float*)(a.ws + WS_SI) + ((size_t)(bh * NSEG + seg) * 64 + row) * 64 + 4 * g;
#pragma unroll
            for (int t4 = 0; t4 < 4; ++t4) Sf[t4] = *(const f32x4*)(SIp + 16 * t4); }
    } else if (ident) {
#pragma unroll
        for (int i = 0; i < 4; ++i)
#pragma unroll
            for (int e = 0; e < 4; ++e) Sf[i][e] = (16 * i + 4 * g + e == row) ? 1.f : 0.f;
    }
    u32x4 mreg[2], breg, kreg; u32x4 vreg = {0u, 0u, 0u, 0u}; f32x4 sreg;
    auto gload = [&](int c) {
        const u32x4* src = (const u32x4*)(SCN + (size_t)c * SC_CH * 320);
        { const int st = tid / 24, q = tid - st * 24; mreg[0] = src[st * 40 + q]; }
        if (tid < 256) { const int jj = 512 + tid, st = jj / 24, q = jj - st * 24; mreg[1] = src[st * 40 + q];
            const int s2 = tid >> 3, e8 = tid & 7; breg = src[s2 * 40 + 24 + e8]; kreg = src[s2 * 40 + 32 + e8]; }
        if (tid < 256) vreg = *(const u32x4*)(VS + (size_t)(c * SC_CH + (tid >> 3)) * 512 + (tid & 7) * 8);
        else if (tid < 288) sreg = *(const f32x4*)(SCS + (size_t)(c * SC_CH + (tid - 256)) * 4);
    };
    auto lwrite = [&](int c) {
        LAS unsigned char* bp = lds + (c & 1) * SC_BUF;
#pragma unroll
        for (int i = 0; i < 2; ++i) { const int jj = tid + 512 * i;
            if (jj < 768) { const int st = jj / 24, q = jj - st * 24, arr = q >> 3, e8 = q & 7; const u32x4 w = mreg[i];
                LAS unsigned char* d = bp + st * SC_STEP;
                if (arr < 2) { *(LAS u32x4*)(d + 256 + arr * 128 + e8 * 16) = w; }
                else { f32x4 lo, hi;
                    lo[0] = bflo(w.x); lo[1] = bfhi(w.x); lo[2] = bflo(w.y); lo[3] = bfhi(w.y); hi[0] = bflo(w.z); hi[1] = bfhi(w.z); hi[2] = bflo(w.w); hi[3] = bfhi(w.w);
                    lo = 1.0f - lo; hi = 1.0f - hi;
                    LAS f32x4* df = (LAS f32x4*)(d + e8 * 32); df[0] = lo; df[1] = hi; } } }
        if (tid < 256) { const int s2 = tid >> 3, e8 = tid & 7; LAS u32x4* d = (LAS u32x4*)(bp + s2 * SC_STEP + 512 + e8 * 64);
            const unsigned bw[4] = {breg.x, breg.y, breg.z, breg.w}, kw[4] = {kreg.x, kreg.y, kreg.z, kreg.w};
#pragma unroll
            for (int pq = 0; pq < 4; ++pq) { const unsigned blo = bw[pq] & 0xffffu, bhi = bw[pq] >> 16, klo = kw[pq] & 0xffffu, khi = kw[pq] >> 16;
                u32x4 o; o.x = klo | (blo << 16); o.y = blo; o.z = khi | (bhi << 16); o.w = bhi; d[pq] = o; } }
        if (tid < 256) { const u32x4 w = vreg; f32x4 lo, hi;
            lo[0] = bflo(w.x); lo[1] = bfhi(w.x); lo[2] = bflo(w.y); lo[3] = bfhi(w.y); hi[0] = bflo(w.z); hi[1] = bfhi(w.z); hi[2] = bflo(w.w); hi[3] = bfhi(w.w);
            LAS f32x4* d = (LAS f32x4*)(lds + SC_VOFF + (c & 1) * (SC_CH * 64 * 4) + tid * 32); d[0] = lo; d[1] = hi; }
        else if (tid < 288) { *(LAS f32x4*)(lds + SC_SOFF + (c & 1) * (SC_CH * 16) + (tid - 256) * 16) = sreg; }
    };
    gload(0); lwrite(0); gload(1);
    __syncthreads();
    LAS float* ybuf = (LAS float*)(lds + SC_ROWB + 16384);
    const int lt_ = tid - 256, ms = (lt_ >> 3) & 31, mr8 = (lt_ & 7) * 8;
    f32x4 gng0 = {}, gng1 = {}, gnb0 = {}, gnb1 = {};
    if constexpr (PASSC) { if (wave >= 4) { const float* gp = a.in[15] + lq_l * 512 + h * 64 + mr8; const float* bp2 = a.in[16] + lq_l * 512 + h * 64 + mr8;
        gng0 = *(const f32x4*)gp; gng1 = *(const f32x4*)(gp + 4); gnb0 = *(const f32x4*)bp2; gnb1 = *(const f32x4*)(bp2 + 4); } }
    auto ymerge = [&](int cc) {
        const LAS float* yp = ybuf + (cc & 1) * (SC_CH * 64) + ms * 64 + mr8;
        const f32x4 y0 = *(const LAS f32x4*)yp, y1 = *(const LAS f32x4*)(yp + 4);
        const size_t m = (size_t)b * T + t0 + cc * SC_CH + ms;
        const u32x4 vv = *(const u32x4*)((const bf16*)(a.ws + WS_VS) + m * 512 + h * 64 + mr8);
        const u32x4 gg = *(const u32x4*)((const bf16*)(a.ws + WS_PB) + m * LDB + 1536 + h * 64 + mr8);
        const float rkr = SCS[(size_t)(cc * SC_CH + ms) * 4 + 2];
        float sm = (y0[0] + y0[1]) + (y0[2] + y0[3]) + (y1[0] + y1[1]) + (y1[2] + y1[3]);
        sm += __uint_as_float(__builtin_amdgcn_update_dpp(0, __float_as_uint(sm), 0xB1, 0xF, 0xF, true));
        sm += __uint_as_float(__builtin_amdgcn_update_dpp(0, __float_as_uint(sm), 0x4E, 0xF, 0xF, true));
        sm += __uint_as_float(__builtin_amdgcn_update_dpp(0, __float_as_uint(sm), 0x141, 0xF, 0xF, true));
        const float mean = sm * (1.f / 64.f);
        const f32x4 d0 = y0 - mean, d1 = y1 - mean;
        float sv = (d0[0] * d0[0] + d0[1] * d0[1]) + (d0[2] * d0[2] + d0[3] * d0[3]) + (d1[0] * d1[0] + d1[1] * d1[1]) + (d1[2] * d1[2] + d1[3] * d1[3]);
        sv += __uint_as_float(__builtin_amdgcn_update_dpp(0, __float_as_uint(sv), 0xB1, 0xF, 0xF, true));
        sv += __uint_as_float(__builtin_amdgcn_update_dpp(0, __float_as_uint(sv), 0x4E, 0xF, 0xF, true));
        sv += __uint_as_float(__builtin_amdgcn_update_dpp(0, __float_as_uint(sv), 0x141, 0xF, 0xF, true));
        const float rs = rsqrtf(sv * (1.f / 64.f) + GN_EPS);
        const f32x4 v0 = {bflo(vv.x), bfhi(vv.x), bflo(vv.y), bfhi(vv.y)}, v1 = {bflo(vv.z), bfhi(vv.z), bflo(vv.w), bfhi(vv.w)};
        const f32x4 g0 = {bflo(gg.x), bfhi(gg.x), bflo(gg.y), bfhi(gg.y)}, g1 = {bflo(gg.z), bfhi(gg.z), bflo(gg.w), bfhi(gg.w)};
        const f32x4 o0 = (d0 * rs * gng0 + gnb0 + v0 * rkr) * g0, o1 = (d1 * rs * gng1 + gnb1 + v1 * rkr) * g1;
        u32x4 ow; ow.x = pk2(o0[0], o0[1]); ow.y = pk2(o0[2], o0[3]); ow.z = pk2(o1[0], o1[1]); ow.w = pk2(o1[2], o1[3]);
        *(u32x4*)((bf16*)(a.ws + WS_YM) + m * D + h * 64 + mr8) = ow;
    };
    for (int c = 0; c < NCH; ++c) {
        if (c + 1 < NCH) lwrite(c + 1);
        if (c + 2 < NCH) gload(c + 2);
        if constexpr (PASSC) { if (c > 0 && wave >= 4) ymerge(c - 1); }
        if (active) {
            const LAS unsigned char* bp = lds + (c & 1) * SC_BUF;
            const LAS float* vb = (const LAS float*)(lds + SC_VOFF + (c & 1) * (SC_CH * 64 * 4)) + row;
            const LAS float* sb = (const LAS float*)(lds + SC_SOFF + (c & 1) * (SC_CH * 16));
#define SC_DECL(X) u32x2 X##a0, X##a1, X##a2, X##a3, X##r0, X##r1, X##r2, X##r3; float X##v; f32x2 X##s
#define SC_LD(X, sidx) do { const LAS unsigned char* p_ = bp + (sidx) * SC_STEP + 256 + g * 8; \
                X##a0 = *(const LAS u32x2*)(p_); X##a1 = *(const LAS u32x2*)(p_ + 32); X##a2 = *(const LAS u32x2*)(p_ + 64); X##a3 = *(const LAS u32x2*)(p_ + 96); \
                if constexpr (PASSC) { X##r0 = *(const LAS u32x2*)(p_ + 128); X##r1 = *(const LAS u32x2*)(p_ + 160); X##r2 = *(const LAS u32x2*)(p_ + 192); X##r3 = *(const LAS u32x2*)(p_ + 224); X##s = *(const LAS f32x2*)(sb + (sidx) * 4); } \
                X##v = ident ? 0.f : vb[(sidx) * 64]; } while (0)
#define SC_STEPM(X, Y, sidx, ldnext) do { const LAS unsigned char* p_ = bp + (sidx) * SC_STEP; \
                const f32x4 w0_ = *(const LAS f32x4*)(p_ + g * 16), w1_ = *(const LAS f32x4*)(p_ + 64 + g * 16), w2_ = *(const LAS f32x4*)(p_ + 128 + g * 16), w3_ = *(const LAS f32x4*)(p_ + 192 + g * 16); \
                const s16x4 f0_ = *(const LAS s16x4*)(p_ + 512 + n16 * 8), f1_ = *(const LAS s16x4*)(p_ + 640 + n16 * 8), f2_ = *(const LAS s16x4*)(p_ + 768 + n16 * 8), f3_ = *(const LAS s16x4*)(p_ + 896 + n16 * 8); \
                if (ldnext) SC_LD(Y, (sidx) + 1); \
                u32x4 sb0, sb1; \
                sb0.x = cvtpk(Sf[0][0], Sf[0][1]); sb0.y = cvtpk(Sf[0][2], Sf[0][3]); sb0.z = cvtpk(Sf[1][0], Sf[1][1]); sb0.w = cvtpk(Sf[1][2], Sf[1][3]); \
                sb1.x = cvtpk(Sf[2][0], Sf[2][1]); sb1.y = cvtpk(Sf[2][2], Sf[2][3]); sb1.z = cvtpk(Sf[3][0], Sf[3][1]); sb1.w = cvtpk(Sf[3][2], Sf[3][3]); \
                const bf16x8 B0 = __builtin_bit_cast(bf16x8, sb0), B1 = __builtin_bit_cast(bf16x8, sb1); \
                const bf16x8 A0 = __builtin_bit_cast(bf16x8, (u32x4){X##a0.x, X##a0.y, X##a1.x, X##a1.y}), A1 = __builtin_bit_cast(bf16x8, (u32x4){X##a2.x, X##a2.y, X##a3.x, X##a3.y}); \
                const f32x4m z4 = {0.f, 0.f, 0.f, 0.f}; f32x4m accy0 = z4, accy1 = z4; \
                const f32x4m acc0 = __builtin_amdgcn_mfma_f32_16x16x32_bf16(A0, B0, z4, 0, 0, 0); \
                const f32x4m acc1 = __builtin_amdgcn_mfma_f32_16x16x32_bf16(A1, B1, z4, 0, 0, 0); \
                if constexpr (PASSC) { const bf16x8 R0 = __builtin_bit_cast(bf16x8, (u32x4){X##r0.x, X##r0.y, X##r1.x, X##r1.y}); accy0 = __builtin_amdgcn_mfma_f32_16x16x32_bf16(R0, B0, z4, 0, 0, 0); \
                    const bf16x8 R1 = __builtin_bit_cast(bf16x8, (u32x4){X##r2.x, X##r2.y, X##r3.x, X##r3.y}); accy1 = __builtin_amdgcn_mfma_f32_16x16x32_bf16(R1, B1, z4, 0, 0, 0); } \
                const f32x4 c0_ = Sf[0] * w0_, c1_ = Sf[1] * w1_, c2_ = Sf[2] * w2_, c3_ = Sf[3] * w3_; \
                const float sa = acc0[0] + acc1[0]; \
                u32x2 bu; bu.x = (__float_as_uint(X##v) >> 16) | (cvtpk(0.f, -sa) & 0xffff0000u); bu.y = 0u; \
                if (g != 0) { bu.x = 0u; bu.y = 0u; } \
                const s16x4 Bu = __builtin_bit_cast(s16x4, bu); \
                Sf[0] = __builtin_amdgcn_mfma_f32_16x16x16bf16_1k(f0_, Bu, c0_, 0, 0, 0); Sf[1] = __builtin_amdgcn_mfma_f32_16x16x16bf16_1k(f1_, Bu, c1_, 0, 0, 0); \
                Sf[2] = __builtin_amdgcn_mfma_f32_16x16x16bf16_1k(f2_, Bu, c2_, 0, 0, 0); Sf[3] = __builtin_amdgcn_mfma_f32_16x16x16bf16_1k(f3_, Bu, c3_, 0, 0, 0); \
                if constexpr (PASSC) { const float y = (accy0[0] + accy1[0]) - sa * X##s.x + X##v * X##s.y; ybuf[(c & 1) * (SC_CH * 64) + (sidx) * 64 + row] = y; } } while (0)
            SC_DECL(oA); SC_DECL(oB);
            SC_LD(oA, 0);
#pragma unroll 1
            for (int s = 0; s < SC_CH; s += 2) {
                SC_STEPM(oA, oB, s, true);
                __builtin_amdgcn_sched_barrier(0);
                SC_STEPM(oB, oA, s + 1, (s + 2 < SC_CH));
                __builtin_amdgcn_sched_barrier(0);
            }
#undef SC_DECL
#undef SC_LD
#undef SC_STEPM
        }
        __syncthreads();
    }
    if constexpr (PASSC) { if (wave >= 4) ymerge(NCH - 1); }
    if constexpr (!PASSC) { float* fp = FSb + ((size_t)seg * 128 + (ident ? 64 : 0) + row) * 64 + 4 * g;
#pragma unroll
        for (int t4 = 0; t4 < 4; ++t4) *(f32x4*)(fp + 16 * t4) = Sf[t4];
        volatile LAS unsigned* lastf = (volatile LAS unsigned*)(lds + 140064);
        __threadfence();
        __syncthreads();
        if (tid == 0) lastf[0] = atomicAdd(cntp, 1u);
        __syncthreads();
        if (lastf[0] == (unsigned)(NSEG - 2)) {
            __threadfence();
            LAS float* rowb = (LAS float*)(lds + SC_ROWB);
            LAS float* pbuf = (LAS float*)lds;
            float* SIb = (float*)(a.ws + WS_SI) + (size_t)bh * NSEG * 64 * 64;
            const int crow_ = tid >> 3, kq = (tid & 7) * 8;
            f32x4 c0 = {0.f, 0.f, 0.f, 0.f}, c1 = c0, pr0, pr1;
            { const float* Pk = FSb + ((size_t)0 * 128 + 64 + crow_) * 64 + kq; pr0 = __builtin_nontemporal_load((const f32x4*)Pk); pr1 = __builtin_nontemporal_load((const f32x4*)(Pk + 4)); }
            for (int k = 0; k < NSEG - 1; ++k) {
                const float* Uk = FSb + ((size_t)k * 128 + crow_) * 64 + kq;
                f32x4 a0 = __builtin_nontemporal_load((const f32x4*)Uk), a1 = __builtin_nontemporal_load((const f32x4*)(Uk + 4));
                *(LAS f32x4*)(rowb + crow_ * 64 + kq) = c0; *(LAS f32x4*)(rowb + crow_ * 64 + kq + 4) = c1;
                *(LAS f32x4*)(pbuf + crow_ * 64 + kq) = pr0; *(LAS f32x4*)(pbuf + crow_ * 64 + kq + 4) = pr1;
                __syncthreads();
                if (k + 2 < NSEG) { const float* Pn = FSb + ((size_t)(k + 1) * 128 + 64 + crow_) * 64 + kq; pr0 = __builtin_nontemporal_load((const f32x4*)Pn); pr1 = __builtin_nontemporal_load((const f32x4*)(Pn + 4)); }
                if (k > 0) {
#pragma unroll 4
                    for (int jj = 0; jj < 64; ++jj) { const float sj = rowb[crow_ * 64 + jj]; a0 += *(const LAS f32x4*)(pbuf + jj * 64 + kq) * sj; a1 += *(const LAS f32x4*)(pbuf + jj * 64 + kq + 4) * sj; } }
                c0 = a0; c1 = a1;
                float* sp_ = SIb + ((size_t)(k + 1) * 64 + crow_) * 64 + kq; *(f32x4*)sp_ = c0; *(f32x4*)(sp_ + 4) = c1;
                __syncthreads();
            }
        }
    }
}

typedef short v4i16_t __attribute__((ext_vector_type(4)));
__device__ __forceinline__ s16x4 vtr(const LAS unsigned char* p) { return __builtin_bit_cast(s16x4, __builtin_amdgcn_ds_read_tr16_b64_v4i16((LAS v4i16_t*)p)); }
constexpr int AT_KS = 0, AT_VS = 9216, AT_BIAS = 18432, AT_WSF = 18688, AT_FLAG = 19712, AT_TASK = 140000;
__device__ __forceinline__ void attn_unit(const Args& a, LAS unsigned char* lds, int l, int bh, int qb, int tid, int lane, int wid) {
    const int b = bh >> 3, h = bh & 7, r32 = lane & 31, hi = lane >> 5;
    const int q0 = qb * 256;
    bf16* PB = (bf16*)(a.ws + WS_PB);
    const float* cumh = (const float*)(a.ws + WS_CUM) + (size_t)bh * T;
    const float kmax = ((const float*)(a.ws + WS_CTL))[CW_KMAX + 16 * l + bh];
    const size_t rowbase = (size_t)b * T;
    const bf16* Qp = PB + (rowbase + q0 + wid * 32 + r32) * LDB + h * 64;
    bf16x8 qr[4]; float qs = 0.f;
#pragma unroll
    for (int d0 = 0; d0 < 4; ++d0) { const u32x4 w = *(const u32x4*)(Qp + d0 * 16 + hi * 8); qr[d0] = __builtin_bit_cast(bf16x8, w);
        qs += bflo(w.x) * bflo(w.x) + bfhi(w.x) * bfhi(w.x) + bflo(w.y) * bflo(w.y) + bfhi(w.y) * bfhi(w.y) + bflo(w.z) * bflo(w.z) + bfhi(w.z) * bfhi(w.z) + bflo(w.w) * bflo(w.w) + bfhi(w.w) * bfhi(w.w); }
    qs += __shfl_xor(qs, 32);
    const float qbound = sqrtf(qs) * kmax * 1.01f + 0.01f;
    LAS float* offL = (LAS float*)(lds + 20480);
    { __syncthreads();
      if (wid == 0) { const float* cs = (const float*)(a.ws + WS_CSUM) + bh * 256; const int ntile = qb * 4 + 4;
          f32x4 v4 = {0.f, 0.f, 0.f, 0.f};
#pragma unroll
          for (int i = 0; i < 4; ++i) if (4 * lane + i < ntile) v4[i] = cs[4 * lane + i];
          const float tot = (v4[0] + v4[1]) + (v4[2] + v4[3]); float inc = tot;
#pragma unroll
          for (int o = 1; o < 64; o <<= 1) { const float up = __shfl_up(inc, o); if (lane >= o) inc += up; }
          float ex = inc - tot;
          offL[4 * lane] = ex; ex += v4[0]; offL[4 * lane + 1] = ex; ex += v4[1]; offL[4 * lane + 2] = ex; ex += v4[2]; offL[4 * lane + 3] = ex; }
      __syncthreads(); }
    const float ref = cumh[q0 + 255] + offL[(q0 + 255) >> 6];
    const int srow = tid >> 3, sch = tid & 7;
    const bf16* Kg = PB + rowbase * LDB + 512 + h * 64 + sch * 8; const bf16* Vg = Kg + 512;
    LAS unsigned char* Ks = lds + AT_KS; LAS unsigned char* Vs = lds + AT_VS; LAS float* biasL = (LAS float*)(lds + AT_BIAS);
    LAS float* wsf = (LAS float*)(lds + AT_WSF) + wid * 32; volatile LAS unsigned* flag = (volatile LAS unsigned*)(lds + AT_FLAG);
    if (tid < 3) flag[tid] = 0u;
    float m = -INFINITY, lsum = 0.f; f32x16 o0 = {}, o1 = {};
    u32x4 kreg, vreg; float breg = 0.f, bnx = 0.f;
    int j = qb * 4 + 3;
    { kreg = *(const u32x4*)(Kg + (size_t)(64 * j + srow) * LDB); vreg = *(const u32x4*)(Vg + (size_t)(64 * j + srow) * LDB);
      if (tid < 64) breg = (ref - (cumh[64 * j + tid] + offL[j])) * L2E; bnx = j > 0 ? (ref - (cumh[64 * j - 1] + offL[j - 1])) * L2E : 0.f; }
    const int q4 = (lane & 15) >> 2, p4 = lane & 3, blk = (lane >> 4) & 1;
    const int qrow = q0 + wid * 32 + r32;
    int it = 0;
    __syncthreads();
    for (;;) {
        *(LAS u32x4*)(Ks + srow * 144 + sch * 16) = kreg; *(LAS u32x4*)(Vs + srow * 144 + sch * 16) = vreg; if (tid < 64) biasL[tid] = breg;
        const float bnx_cur = bnx;
        __syncthreads();
        if (j > 0) { const int jn = j - 1;
            kreg = *(const u32x4*)(Kg + (size_t)(64 * jn + srow) * LDB); vreg = *(const u32x4*)(Vg + (size_t)(64 * jn + srow) * LDB);
            if (tid < 64) breg = (ref - (cumh[64 * jn + tid] + offL[jn])) * L2E; bnx = jn > 0 ? (ref - (cumh[64 * jn - 1] + offL[jn - 1])) * L2E : 0.f; }
        if (64 * j <= q0 + 32 * wid + 31) {
            f32x16 p0 = {}, p1 = {};
#pragma unroll
            for (int d0 = 0; d0 < 4; ++d0) {
                const bf16x8 k0 = *(const LAS bf16x8*)(Ks + r32 * 144 + d0 * 32 + hi * 16);
                const bf16x8 k1 = *(const LAS bf16x8*)(Ks + (32 + r32) * 144 + d0 * 32 + hi * 16);
                p0 = __builtin_amdgcn_mfma_f32_32x32x16_bf16(k0, qr[d0], p0, 0, 0, 0);
                p1 = __builtin_amdgcn_mfma_f32_32x32x16_bf16(k1, qr[d0], p1, 0, 0, 0); }
#pragma unroll
            for (int g = 0; g < 4; ++g) { const f32x4 b0 = *(const LAS f32x4*)(biasL + 8 * g + 4 * hi), b1 = *(const LAS f32x4*)(biasL + 32 + 8 * g + 4 * hi);
#pragma unroll
                for (int e = 0; e < 4; ++e) { p0[4 * g + e] += b0[e]; p1[4 * g + e] += b1[e]; } }
            if (64 * j + 63 > q0 + 32 * wid) {
#pragma unroll
                for (int r = 0; r < 16; ++r) { const int kv = 64 * j + crow(r, hi); if (kv > qrow) p0[r] = -INFINITY; if (kv + 32 > qrow) p1[r] = -INFINITY; } }
            float mx = fmaxf(p0[0], p1[0]);
#pragma unroll
            for (int r = 1; r < 16; ++r) mx = fmaxf(mx, fmaxf(p0[r], p1[r]));
            mx = fmaxf(mx, __shfl_xor(mx, 32));
            const float mnew = fmaxf(m, mx); const float f = __builtin_amdgcn_exp2f(m - mnew); m = mnew;
            float rs = 0.f;
#pragma unroll
            for (int r = 0; r < 16; ++r) { p0[r] = __builtin_amdgcn_exp2f(p0[r] - mnew); p1[r] = __builtin_amdgcn_exp2f(p1[r] - mnew); rs += p0[r] + p1[r]; }
            lsum = lsum * f + rs;
            if (__any(f != 1.f)) {
                if (hi == 0) wsf[r32] = f;
                asm volatile("s_waitcnt lgkmcnt(0)" ::: "memory");
#pragma unroll
                for (int r = 0; r < 16; ++r) { const float fr = wsf[crow(r, hi)]; o0[r] *= fr; o1[r] *= fr; }
            }
            u32x4 pw[4];
            pw[0] = (u32x4){cvtpk(p0[0], p0[1]), cvtpk(p0[2], p0[3]), cvtpk(p0[4], p0[5]), cvtpk(p0[6], p0[7])};
            pw[1] = (u32x4){cvtpk(p0[8], p0[9]), cvtpk(p0[10], p0[11]), cvtpk(p0[12], p0[13]), cvtpk(p0[14], p0[15])};
            pw[2] = (u32x4){cvtpk(p1[0], p1[1]), cvtpk(p1[2], p1[3]), cvtpk(p1[4], p1[5]), cvtpk(p1[6], p1[7])};
            pw[3] = (u32x4){cvtpk(p1[8], p1[9]), cvtpk(p1[10], p1[11]), cvtpk(p1[12], p1[13]), cvtpk(p1[14], p1[15])};
#pragma unroll
            for (int s = 0; s < 4; ++s) { const int kvb = 16 * (s & 1) + 32 * (s >> 1);
                const LAS unsigned char* va = Vs + (kvb + 4 * hi + q4) * 144 + (16 * blk + 4 * p4) * 2;
                const s16x4 l0 = vtr(va), h0 = vtr(va + 8 * 144), l1 = vtr(va + 64), h1 = vtr(va + 8 * 144 + 64);
                const bf16x8 vf0 = {l0[0], l0[1], l0[2], l0[3], h0[0], h0[1], h0[2], h0[3]}, vf1 = {l1[0], l1[1], l1[2], l1[3], h1[0], h1[1], h1[2], h1[3]};
                const bf16x8 pa = __builtin_bit_cast(bf16x8, pw[s]);
                o0 = __builtin_amdgcn_mfma_f32_32x32x16_bf16(pa, vf0, o0, 0, 0, 0);
                o1 = __builtin_amdgcn_mfma_f32_32x32x16_bf16(pa, vf1, o1, 0, 0, 0); }
        }
        if (j == 0) break;
        const bool need = (qbound + bnx_cur > m - 40.f);
        if (tid == 0) flag[(it + 1) % 3] = 0u;
        if (__any(need) && lane == 0) flag[it % 3] = 1u;
        __syncthreads();
        const unsigned cont = flag[it % 3];
        if (!cont) break;
        --j; ++it;
    }
    lsum += __shfl_xor(lsum, 32);
    if (hi == 0) wsf[r32] = 1.f / lsum;
    asm volatile("s_waitcnt lgkmcnt(0)" ::: "memory");
    bf16* Ow = (bf16*)(a.ws + WS_YM) + (rowbase + q0 + wid * 32) * D + 512 + h * 64 + r32;
    const bf16* Gw = PB + (rowbase + q0 + wid * 32) * LDB + 2048 + h * 64 + r32;
#pragma unroll
    for (int r = 0; r < 16; ++r) { const float inv = wsf[crow(r, hi)]; bf16* op = Ow + (size_t)crow(r, hi) * D; const bf16* gp = Gw + (size_t)crow(r, hi) * LDB;
        op[0] = (bf16)f2bf(o0[r] * inv * bf2f(gp[0])); op[32] = (bf16)f2bf(o1[r] * inv * bf2f(gp[32])); }
    __syncthreads();
}
__device__ __forceinline__ void p3a_phase(const Args& a, LAS unsigned char* lds, int l, int tid, int lane, int wave) {
    unsigned* ctr = (unsigned*)(a.ws + WS_CTL) + CW_QUEUE + 64 * l;
    volatile LAS unsigned* task = (volatile LAS unsigned*)(lds + AT_TASK);
    for (;;) {
        __syncthreads();
        if (tid == 0) task[0] = atomicAdd(ctr, 1u);
        __syncthreads();
        const unsigned tk = task[0];
        if (tk >= 240u + 1024u) break;
        int t2 = tid; asm volatile("" : "+v"(t2)); const int lane2 = t2 & 63;
        if (tk < 240u) { scan_task<false>(a, lds, (int)(tk / 15u), (int)(tk % 15u), t2, lane2, wave, (unsigned*)(a.ws + WS_CTL) + CW_QUEUE + 2048 + 64 * l + (tk / 15u), l); }
        else { const unsigned u = tk - 240u; attn_unit(a, lds, l, (int)(u & 15), 63 - (int)(u >> 4), t2, lane2, wave); }
    }
}
__device__ __forceinline__ void p3b_phase(const Args& a, LAS unsigned char* lds, int l, int tid, int lane, int wave) {
    unsigned* ctr = (unsigned*)(a.ws + WS_CTL) + CW_QUEUE + 512 + 64 * l;
    volatile LAS unsigned* task = (volatile LAS unsigned*)(lds + AT_TASK);
    for (;;) {
        __syncthreads();
        if (tid == 0) task[0] = atomicAdd(ctr, 1u);
        __syncthreads();
        const unsigned tk = task[0];
        if (tk >= 256u) break;
        scan_task<true>(a, lds, (int)(tk >> 4), (int)(tk & 15), tid, lane, wave, nullptr, l);
    }
}

__device__ __forceinline__ float red16m(float x) {
    x += __uint_as_float(__builtin_amdgcn_update_dpp(0, __float_as_uint(x), 0xB1, 0xF, 0xF, true));
    x += __uint_as_float(__builtin_amdgcn_update_dpp(0, __float_as_uint(x), 0x4E, 0xF, 0xF, true));
    x += __uint_as_float(__builtin_amdgcn_update_dpp(0, __float_as_uint(x), 0x141, 0xF, 0xF, true));
    x += __uint_as_float(__builtin_amdgcn_update_dpp(0, __float_as_uint(x), 0x140, 0xF, 0xF, true));
    return x;
}
__device__ __forceinline__ void merge_phase(const Args& a, int l, int tid, int lane, int wave, int G) {
    const float* YA = (const float*)(a.ws + WS_YA); const bf16* VS = (const bf16*)(a.ws + WS_VS); const bf16* PB = (const bf16*)(a.ws + WS_PB);
    const bf16* PVo = (const bf16*)(a.ws + WS_PV);
    const float* SCS = (const float*)(a.ws + WS_SCS); bf16* YM = (bf16*)(a.ws + WS_YM);
    const int hd = 4 * (wave & 1) + (lane >> 4), c0 = hd * 64 + 4 * (lane & 15), tsub = wave >> 1;
    const f32x4 gg = *(const f32x4*)(a.in[15] + l * 512 + c0), gb = *(const f32x4*)(a.in[16] + l * 512 + c0);
    constexpr int MT = 4;
    for (int mb = blockIdx.x * (4 * MT); mb < M; mb += G * (4 * MT)) {
        f32x4 ya[MT]; u32x2 vv[MT], g1[MT], g2[MT], yb[MT]; float rkr[MT], mean[MT], var[MT];
#pragma unroll
        for (int u = 0; u < MT; ++u) { const int m = mb + 4 * u + tsub; const int b = m >= T ? 1 : 0, t = m - b * T;
            ya[u] = *(const f32x4*)(YA + (size_t)m * 512 + c0); vv[u] = *(const u32x2*)(VS + (size_t)m * 512 + c0);
            g1[u] = *(const u32x2*)(PB + (size_t)m * LDB + 1536 + c0); g2[u] = *(const u32x2*)(PB + (size_t)m * LDB + 2048 + c0);
            yb[u] = *(const u32x2*)(PVo + (size_t)m * LDV + c0);
            rkr[u] = SCS[((size_t)(b * 8 + hd) * T + t) * 4 + 2]; }
#pragma unroll
        for (int u = 0; u < MT; ++u) mean[u] = red16m((ya[u][0] + ya[u][1]) + (ya[u][2] + ya[u][3])) * (1.f / 64.f);
#pragma unroll
        for (int u = 0; u < MT; ++u) { const f32x4 d = ya[u] - mean[u]; var[u] = red16m((d[0] * d[0] + d[1] * d[1]) + (d[2] * d[2] + d[3] * d[3])) * (1.f / 64.f); }
#pragma unroll
        for (int u = 0; u < MT; ++u) { const int m = mb + 4 * u + tsub; const float rs = rsqrtf(var[u] + GN_EPS);
            f32x4 v4 = {bflo(vv[u].x), bfhi(vv[u].x), bflo(vv[u].y), bfhi(vv[u].y)};
            f32x4 ga = {bflo(g1[u].x), bfhi(g1[u].x), bflo(g1[u].y), bfhi(g1[u].y)}, gbv = {bflo(g2[u].x), bfhi(g2[u].x), bflo(g2[u].y), bfhi(g2[u].y)};
            f32x4 y2 = {bflo(yb[u].x), bfhi(yb[u].x), bflo(yb[u].y), bfhi(yb[u].y)};
            const f32x4 yn = ((ya[u] - mean[u]) * rs * gg + gb + v4 * rkr[u]) * ga; const f32x4 yo = y2 * gbv;
            u32x2 o1 = {pk2(yn[0], yn[1]), pk2(yn[2], yn[3])}, o2 = {pk2(yo[0], yo[1]), pk2(yo[2], yo[3])};
            *(u32x2*)(YM + (size_t)m * D + c0) = o1; *(u32x2*)(YM + (size_t)m * D + 512 + c0) = o2; }
    }
}

#ifndef N_LAUNCH_MODE
#define N_LAUNCH_MODE 1
#endif
template <int MASK, bool COOP> __device__ __forceinline__ void run_phases(const Args& a, LAS unsigned char* lds, int l0, int l1) {
    const int G = gridDim.x;
#define LAUNDER() int tid = threadIdx.x; asm volatile("" : "+v"(tid)); const int lane = tid & 63, wave = __builtin_amdgcn_readfirstlane(tid >> 6); (void)lane; (void)wave
    float* hbuf = a.out;
    const float* mod = (const float*)(a.ws + WS_CTL) + CW_MOD;
    bf16* XN = (bf16*)(a.ws + WS_XN);
#define GSYNC() do { if constexpr (COOP) cg::this_grid().sync(); } while (0)
    if constexpr (MASK & 1) { LAUNDER(); p0a(a, lds, tid, lane, wave, G); GSYNC(); }
    if constexpr (MASK & 2) { LAUNDER(); ln_rows(a.in[0], a.in[2], a.in[3], hbuf, XN, mod, lane, wave, G); GSYNC(); }
#pragma unroll 1
    for (int l = l0; l < l1; ++l) {
        for (int rep = 0; rep < ((PROBE_REP & 4) ? 2 : 1); ++rep)
        if constexpr (MASK & 4) { pg8::Gemm g{XN, (const bf16*)(a.ws + WS_WIN) + (size_t)l * NPROJ * 1024, M, NPROJ, 1024}; pg8::StaticOrder S; S.init(M, NPROJ, G, (int)blockIdx.x);
          EpiProj E{(bf16*)(a.ws + WS_PA), (bf16*)(a.ws + WS_PV), (bf16*)(a.ws + WS_PB)};
          pg8::gemm_phase<EpiProj, pg8::StaticOrder, true, true>(lds, g, S, E); GSYNC(); }
        for (int rep = 0; rep < ((PROBE_REP & 8) ? 2 : 1); ++rep)
        if constexpr (MASK & 8) { LAUNDER(); prep_phase(a, lds, l, tid, lane, wave, G); GSYNC(); }
        if constexpr (MASK & 16) { { LAUNDER(); p3a_phase(a, lds, l, tid, lane, wave); } GSYNC(); { LAUNDER(); p3b_phase(a, lds, l, tid, lane, wave); } GSYNC(); }
        if constexpr (MASK & 64) { pg8::Gemm g{(const bf16*)(a.ws + WS_YM), (const bf16*)(a.ws + WS_WOUT) + (size_t)l * 1024 * 1024, M, D, D}; pg8::StaticOrder S; S.init(M, D, G, (int)blockIdx.x);
          EpiOut E{hbuf, mod + l * 2 * 3072};
          pg8::gemm_phase<EpiOut, pg8::StaticOrder, true, true>(lds, g, S, E); GSYNC(); }
        if constexpr (MASK & 128) { LAUNDER(); ln_rows(hbuf, a.in[19] + l * D, a.in[20] + l * D, hbuf, XN, (l + 1 < DEPTH) ? mod + (l + 1) * 2 * 3072 : nullptr, lane, wave, G);
          if (l + 1 < l1) GSYNC(); }
    }
#undef GSYNC
#undef LAUNDER
}
#ifndef FMASK
#define FMASK 0xFF
#endif
#if N_LAUNCH_MODE == 1
__global__ void __launch_bounds__(512, 2) hymba_fwd(Args a) {
    extern __shared__ __attribute__((aligned(16))) unsigned char lds_raw[];
    run_phases<FMASK, true>(a, (LAS unsigned char*)lds_raw, 0, DEPTH);
}
#else
template <int MASK> __global__ void __launch_bounds__(512, 2) hymba_phase(Args a, int l) {
    extern __shared__ __attribute__((aligned(16))) unsigned char lds_raw[];
    run_phases<MASK, false>(a, (LAS unsigned char*)lds_raw, l, l + 1);
}
template <int MASK> static void launch_phase(const Args& a, int l, hipStream_t stream) {
    static bool attr = false;
    if (!attr) { (void)hipFuncSetAttribute((const void*)hymba_phase<MASK>, hipFuncAttributeMaxDynamicSharedMemorySize, LDS_BYTES); attr = true; }
    hipLaunchKernelGGL(hymba_phase<MASK>, dim3(256), dim3(512), LDS_BYTES, stream, a, l);
}
#endif

extern "C" void kernel_launch(void* const* d_in, const int* in_sizes, int n_in, void* d_out, int out_size, void* d_ws, size_t ws_size, hipStream_t stream) {
    if (n_in != 21 || ws_size < WS_END) { fprintf(stderr, "kernel_launch: unexpected n_in %d / ws %zu\n", n_in, ws_size); return; }
    (void)hipMemsetAsync((char*)d_ws + WS_CTL, 0, CTL_ZERO_BYTES, stream);
    Args a{};
    for (int i = 0; i < 21; ++i) a.in[i] = (const float*)d_in[i];
    a.out = (float*)d_out; a.ws = (unsigned char*)d_ws;
#if N_LAUNCH_MODE == 1
    static int grid = 0;
    if (grid == 0) {
        int dev = 0, cus = 0, per_cu = 0;
        (void)hipGetDevice(&dev); (void)hipDeviceGetAttribute(&cus, hipDeviceAttributeMultiprocessorCount, dev);
        (void)hipFuncSetAttribute((const void*)hymba_fwd, hipFuncAttributeMaxDynamicSharedMemorySize, LDS_BYTES);
        (void)hipOccupancyMaxActiveBlocksPerMultiprocessor(&per_cu, (const void*)hymba_fwd, 512, LDS_BYTES);
        if (per_cu < 1) per_cu = 1;
        (void)hipGetLastError();
        grid = cus * per_cu;
    }
    void* args[] = {&a};
    hipError_t e = hipLaunchCooperativeKernel((const void*)hymba_fwd, dim3(grid), dim3(512), args, LDS_BYTES, stream);
    if (e != hipSuccess) fprintf(stderr, "cooperative launch failed: %s (grid %d)\n", hipGetErrorString(e), grid);
#else
    launch_phase<1>(a, 0, stream); launch_phase<2>(a, 0, stream);
    for (int l = 0; l < DEPTH; ++l) { launch_phase<4>(a, l, stream); launch_phase<8>(a, l, stream); launch_phase<16>(a, l, stream); launch_phase<32>(a, l, stream); launch_phase<64>(a, l, stream); launch_phase<128>(a, l, stream); }
#endif
}
```

```cpp
#include <hip/hip_runtime.h>
#include <cstdio>
#include <cstdint>
namespace pg8 {
#define PG8_LAS __attribute__((address_space(3)))
typedef unsigned short bf16_t;
typedef short bf16x8 __attribute__((ext_vector_type(8)));
typedef float f32x4 __attribute__((ext_vector_type(4)));
typedef unsigned u32x4 __attribute__((ext_vector_type(4)));
constexpr int BM = 256, BK = 64, HALF = 128, HTB = HALF * BK * 2  , STAGE_BYTES = 8 * HTB, NXCD = 8, WGM = 8;

__host__ __device__ __forceinline__ int lds_byte(int r, int c) { const int st = (r >> 4) * 2 + (c >> 5), rr = r & 15, cc = c & 31, ob = rr * 64 + cc * 2; return st * 1024 + (ob ^ (((ob >> 9) & 1) << 5)); }
__host__ __device__ __forceinline__ void stage_rc(int b, int& R, int& C) { const int st = b / 1024, sb = b % 1024, swz = sb ^ (((sb >> 9) & 1) << 5); R = (st >> 1) * 16 + swz / 64; C = (st & 1) * 32 + (swz % 64) / 2; }
__host__ __device__ __forceinline__ int perm32(int rho) { const int n = rho >> 4, i = rho & 15; return 8 * (i >> 2) + 4 * n + (i & 3); }

struct Unit { int pm, pn; };
struct Gemm { const bf16_t* A; const bf16_t* Bt; int M, N, K; };

struct StaticOrder {
    int nM, nN, nwg, G, c;
    __host__ __device__ void init(int M, int N, int G_, int c_) { nM = M / BM; nN = N / BM; nwg = nM * nN; G = G_; c = c_; }
    __host__ __device__ bool next(int i, Unit& u) const {
        const long L = (long)i * G + c; if (L >= nwg) return false;
        int wgid = (int)L; { const int q = nwg / NXCD, r = nwg % NXCD, xcd = wgid % NXCD, off = wgid / NXCD; wgid = (xcd < r ? xcd * (q + 1) : r * (q + 1) + (xcd - r) * q) + off; }
        const int nig = WGM * nN, gid = wgid / nig, fm = gid * WGM, gsz = (nM - fm) < WGM ? (nM - fm) : WGM;
        u.pm = fm + ((wgid % nig) % gsz); u.pn = (wgid % nig) / gsz; return true;
    }
    __device__ __forceinline__ void a_ready(const Unit&) const {}
    __device__ __forceinline__ void done(const Unit&) const {}
};

__device__ __forceinline__ unsigned cvt_pk_bf16(float lo, float hi) { unsigned r; asm volatile("v_cvt_pk_bf16_f32 %0, %1, %2" : "=v"(r) : "v"(lo), "v"(hi)); return r; }
typedef float f32x2 __attribute__((ext_vector_type(2)));
__device__ __forceinline__ f32x2 gelu_pk(f32x2 v) {
    const f32x2 av = __builtin_elementwise_abs(v), d = av * 0.2316418882f + 1.0f;
    f32x2 t; t.x = __builtin_amdgcn_rcpf(d.x); t.y = __builtin_amdgcn_rcpf(d.y);
    f32x2 q = t * 0.5307027145f + (-0.7265760135f); q = q * t + 0.7107068705f; q = q * t + (-0.142248368f); q = q * t + 0.127414796f; q = q * t;
    const f32x2 s = (v * v) * (-0.72134752044f);
    f32x2 e; e.x = __builtin_amdgcn_exp2f(s.x); e.y = __builtin_amdgcn_exp2f(s.y);
    const f32x2 m = v * (q * e), r = v - m;
    f32x2 o; o.x = v.x < 0.f ? m.x : r.x; o.y = v.y < 0.f ? m.y : r.y; return o;
}

template <int ACT  > struct EpiBf16 {
    static constexpr bool PERM = true, AFTER_DRAIN = false; static_assert(ACT == 0 || ACT == 1, "EpiBf16: ACT is 0 (none) or 1 (gelu_pk)");
    bf16_t* O; int ldc; const float* bias; int split_cols; size_t split_stride; float scale0;
    __device__ __forceinline__ void operator()(const f32x4 (&acc)[2][2][4][2], const Unit& u, int wr, int wc, int fr, int fq) const {
        const int row0 = u.pm * BM + wr * 64 + fr; int colt = u.pn * BM; bf16_t* base = O;
        float sc = 1.f; if (split_cols) { const int t = colt / split_cols; base += (size_t)t * split_stride; colt -= t * split_cols; if (t == 0) sc = scale0; }
        const int col0 = colt + wc * 32 + 8 * fq, bcol0 = u.pn * BM + wc * 32 + 8 * fq;
        f32x4 bv[2][2];
#pragma unroll
        for (int bj = 0; bj < 2; ++bj)
#pragma unroll
            for (int n = 0; n < 2; ++n) bv[bj][n] = bias ? *(const f32x4*)(bias + bcol0 + bj * HALF + 4 * n) : (f32x4){0.f, 0.f, 0.f, 0.f};
#pragma unroll
        for (int ai = 0; ai < 2; ++ai)
#pragma unroll
            for (int m = 0; m < 4; ++m) { bf16_t* rowp = base + (size_t)(row0 + ai * HALF + m * 16) * ldc + col0;
#pragma unroll
                for (int bj = 0; bj < 2; ++bj) { f32x4 v0 = acc[ai][bj][m][0] + bv[bj][0], v1 = acc[ai][bj][m][1] + bv[bj][1];
                    if (ACT == 1) { f32x2 a = gelu_pk((f32x2){v0[0], v0[1]}), b = gelu_pk((f32x2){v0[2], v0[3]}), c = gelu_pk((f32x2){v1[0], v1[1]}), d = gelu_pk((f32x2){v1[2], v1[3]});
                        v0 = (f32x4){a.x, a.y, b.x, b.y}; v1 = (f32x4){c.x, c.y, d.x, d.y}; }
                    v0 = v0 * sc; v1 = v1 * sc; u32x4 w; w.x = cvt_pk_bf16(v0[0], v0[1]); w.y = cvt_pk_bf16(v0[2], v0[3]); w.z = cvt_pk_bf16(v1[0], v1[1]); w.w = cvt_pk_bf16(v1[2], v1[3]);
                    *(u32x4*)(rowp + bj * HALF) = w; } }
    }
};

template <class Epi, class Sched, bool ALIGN_EPI = false, bool SP2 = false>
__device__ __forceinline__ void gemm_phase(PG8_LAS unsigned char* lds, const Gemm g, const Sched& S, const Epi& E) {
    int tid = threadIdx.x; asm volatile("" : "+v"(tid));
    const int wid = __builtin_amdgcn_readfirstlane(tid >> 6), lane = tid & 63, wr = wid >> 2, wc = wid & 3, fr = lane & 15, fq = lane >> 4;
    const int K = g.K, nt = K / BK;
    unsigned voffA[2], voffB[2];
#pragma unroll
    for (int i = 0; i < 2; ++i) { int R, C; stage_rc(tid * 16 + i * 8192, R, C); const int Rb = Epi::PERM ? ((R & ~31) + perm32(R & 31)) : R;
        voffA[i] = (unsigned)(R * K + C) * 2u; voffB[i] = (unsigned)(Rb * K + C) * 2u; }
    const size_t kstep = (size_t)(BK * 2);
    const size_t hstep = (size_t)HALF * K * 2;
    const size_t tstep = 2 * hstep;
    const unsigned ldsw = (unsigned)wid * 1024u;
    const int aoff = lds_byte(wr * 64 + fr, fq * 8), boff = lds_byte(wc * 32 + fr, fq * 8);
#define PG8_SA(b, h) (((b) * 2 + (h)) * HTB)
#define PG8_SB(b, h) ((4 + (b) * 2 + (h)) * HTB)
#define PG8_STAGE(bufoff, gbase, voff) do { _Pragma("unroll") for (int _i = 0; _i < 2; ++_i) \
        __builtin_amdgcn_global_load_lds((const unsigned*)((const char*)(gbase) + (voff)[_i]), (PG8_LAS unsigned*)(lds + (bufoff) + ldsw + _i * 8192), 16, 0, 0); } while (0)
#define PG8_LDA(dst, b, h) do { _Pragma("unroll") for (int m = 0; m < 4; ++m) _Pragma("unroll") for (int k = 0; k < 2; ++k) dst[m][k] = *(const PG8_LAS bf16x8*)(lds + PG8_SA(b, h) + aoff + m * 2048 + k * 1024); } while (0)
#define PG8_LDB(dst, b, h) do { _Pragma("unroll") for (int n = 0; n < 2; ++n) _Pragma("unroll") for (int k = 0; k < 2; ++k) dst[n][k] = *(const PG8_LAS bf16x8*)(lds + PG8_SB(b, h) + boff + n * 2048 + k * 1024); } while (0)
#define PG8_MMA(ai, bj, At, Bt) do { __builtin_amdgcn_s_setprio(1); _Pragma("unroll") for (int m = 0; m < 4; ++m) _Pragma("unroll") for (int n = 0; n < 2; ++n) _Pragma("unroll") for (int k = 0; k < 2; ++k) \
        acc[ai][bj][m][n] = __builtin_amdgcn_mfma_f32_16x16x32_bf16(Bt[n][k], At[m][k], acc[ai][bj][m][n], 0, 0, 0); __builtin_amdgcn_s_setprio(0); } while (0)
#define PG8_WAIT_V(n) asm volatile("s_waitcnt vmcnt(" #n ")" ::: "memory")
#define PG8_WAIT_L(n) asm volatile("s_waitcnt lgkmcnt(" #n ")" ::: "memory")
#define PG8_BAR __builtin_amdgcn_s_barrier()
#define PG8_SCHED __builtin_amdgcn_sched_barrier(0)
    Unit cur, nxt; int ui = 0;
    if (!S.next(0, cur)) return;
    f32x4 acc[2][2][4][2];
#pragma unroll
    for (int a = 0; a < 2; ++a)
#pragma unroll
        for (int b = 0; b < 2; ++b)
#pragma unroll
            for (int m = 0; m < 4; ++m)
#pragma unroll
                for (int n = 0; n < 2; ++n) acc[a][b][m][n] = (f32x4){0.f, 0.f, 0.f, 0.f};
    bf16x8 At[4][2], B0[2][2], B1[2][2];
    const char* cA = (const char*)g.A + (size_t)cur.pm * tstep; const char* cB = (const char*)g.Bt + (size_t)cur.pn * tstep;
    S.a_ready(cur);
    if constexpr (SP2) {
        PG8_STAGE(PG8_SB(0, 0), cB, voffB); PG8_STAGE(PG8_SB(0, 1), cB + hstep, voffB); PG8_STAGE(PG8_SA(0, 0), cA, voffA); PG8_STAGE(PG8_SA(0, 1), cA + hstep, voffA);
        if (wr == 1) PG8_BAR;
        PG8_WAIT_V(2); PG8_BAR;
        PG8_STAGE(PG8_SB(1, 0), cB + kstep, voffB); PG8_STAGE(PG8_SA(1, 0), cA + kstep, voffA); PG8_STAGE(PG8_SB(1, 1), cB + hstep + kstep, voffB);
        PG8_WAIT_V(6); PG8_BAR;
    } else {
        PG8_STAGE(PG8_SB(0, 0), cB, voffB); PG8_STAGE(PG8_SA(0, 0), cA, voffA); PG8_STAGE(PG8_SB(0, 1), cB + hstep, voffB); PG8_STAGE(PG8_SA(0, 1), cA + hstep, voffA);
        if (wr == 1) PG8_BAR;
        PG8_WAIT_V(4); PG8_BAR;
        PG8_STAGE(PG8_SB(1, 0), cB + kstep, voffB); PG8_STAGE(PG8_SA(1, 0), cA + kstep, voffA); PG8_STAGE(PG8_SB(1, 1), cB + hstep + kstep, voffB);
        PG8_WAIT_V(6); PG8_BAR;
    }
    for (;;) {
        const bool has_next = S.next(ui + 1, nxt);
        const char* nA = has_next ? (const char*)g.A + (size_t)nxt.pm * tstep : cA; const char* nB = has_next ? (const char*)g.Bt + (size_t)nxt.pn * tstep : cB;
        for (int t = 0; t < nt; t += 2) {
            const bool last = (t == nt - 2);
            const char* a1 = cA + (size_t)(t + 1) * kstep;
            const char* a2 = last ? nA : cA + (size_t)(t + 2) * kstep; const char* b2 = last ? nB : cB + (size_t)(t + 2) * kstep;
            const char* a3 = a2 + kstep; const char* b3 = b2 + kstep;
            if (last && has_next) S.a_ready(nxt);
            if constexpr (SP2) {
            PG8_LDB(B0, 0, 0); PG8_LDB(B1, 0, 1); PG8_SCHED; PG8_LDA(At, 0, 0); PG8_STAGE(PG8_SA(1, 1), a1 + hstep, voffA);
            PG8_WAIT_V(8); PG8_WAIT_L(0); PG8_BAR; PG8_MMA(0, 0, At, B0); PG8_MMA(0, 1, At, B1); PG8_BAR; PG8_SCHED;
            PG8_LDA(At, 0, 1); PG8_STAGE(PG8_SB(0, 0), b2, voffB); PG8_STAGE(PG8_SB(0, 1), b2 + hstep, voffB); PG8_STAGE(PG8_SA(0, 0), a2, voffA);
            PG8_WAIT_V(8); PG8_WAIT_L(0); PG8_BAR; PG8_MMA(1, 0, At, B0); PG8_MMA(1, 1, At, B1); PG8_BAR; PG8_SCHED;
            PG8_LDB(B0, 1, 0); PG8_LDB(B1, 1, 1); PG8_SCHED; PG8_LDA(At, 1, 0); PG8_STAGE(PG8_SA(0, 1), a2 + hstep, voffA);
            PG8_WAIT_V(8); PG8_WAIT_L(0); PG8_BAR; PG8_MMA(0, 0, At, B0); PG8_MMA(0, 1, At, B1); PG8_BAR; PG8_SCHED;
            PG8_LDA(At, 1, 1); PG8_STAGE(PG8_SB(1, 0), b3, voffB); PG8_STAGE(PG8_SB(1, 1), b3 + hstep, voffB); PG8_STAGE(PG8_SA(1, 0), a3, voffA);
            PG8_WAIT_V(8); PG8_WAIT_L(0); PG8_BAR; PG8_MMA(1, 0, At, B0); PG8_MMA(1, 1, At, B1); PG8_BAR; PG8_SCHED;
            } else {
            PG8_LDB(B0, 0, 0); PG8_SCHED; PG8_LDA(At, 0, 0); PG8_STAGE(PG8_SA(1, 1), a1 + hstep, voffA);
            PG8_WAIT_L(8); PG8_BAR; PG8_WAIT_L(0); PG8_MMA(0, 0, At, B0); PG8_BAR; PG8_SCHED;
            PG8_LDB(B1, 0, 1); PG8_STAGE(PG8_SB(0, 0), b2, voffB);
            PG8_BAR; PG8_WAIT_L(0); PG8_MMA(0, 1, At, B1); PG8_BAR;
            PG8_LDA(At, 0, 1); PG8_STAGE(PG8_SA(0, 0), a2, voffA);
            PG8_BAR; PG8_WAIT_L(0); PG8_MMA(1, 0, At, B0); PG8_BAR; PG8_SCHED;
            PG8_STAGE(PG8_SB(0, 1), b2 + hstep, voffB);
            PG8_WAIT_V(6); PG8_BAR; PG8_MMA(1, 1, At, B1); PG8_BAR;
            PG8_LDB(B0, 1, 0); PG8_SCHED; PG8_LDA(At, 1, 0); PG8_STAGE(PG8_SA(0, 1), a2 + hstep, voffA);
            PG8_WAIT_L(8); PG8_BAR; PG8_WAIT_L(0); PG8_MMA(0, 0, At, B0); PG8_BAR; PG8_SCHED;
            PG8_LDB(B1, 1, 1); PG8_STAGE(PG8_SB(1, 0), b3, voffB);
            PG8_BAR; PG8_WAIT_L(0); PG8_MMA(0, 1, At, B1); PG8_BAR;
            PG8_LDA(At, 1, 1); PG8_STAGE(PG8_SA(1, 0), a3, voffA);
            PG8_BAR; PG8_WAIT_L(0); PG8_MMA(1, 0, At, B0); PG8_BAR; PG8_SCHED;
            PG8_STAGE(PG8_SB(1, 1), b3 + hstep, voffB);
            PG8_WAIT_V(6); PG8_BAR; PG8_MMA(1, 1, At, B1); PG8_BAR;
            }
        }
        if constexpr (ALIGN_EPI) { if (wr == 0) PG8_BAR; }
        if constexpr (!Epi::AFTER_DRAIN) { E(acc, cur, wr, wc, fr, fq); S.done(cur); }
        if (!has_next) break;
#pragma unroll
        for (int a = 0; a < 2; ++a)
#pragma unroll
            for (int b = 0; b < 2; ++b)
#pragma unroll
                for (int m = 0; m < 4; ++m)
#pragma unroll
                    for (int n = 0; n < 2; ++n) acc[a][b][m][n] = (f32x4){0.f, 0.f, 0.f, 0.f};
        cur = nxt; cA = nA; cB = nB; ++ui;
        if constexpr (ALIGN_EPI) { if (wr == 1) PG8_BAR; }
    }
    PG8_WAIT_V(0);
    if constexpr (!ALIGN_EPI) { if (wr == 0) PG8_BAR; }
    PG8_BAR;
    if constexpr (Epi::AFTER_DRAIN) { E.fused(acc, cur, wr, wc, fr, fq, lds, wid, lane); S.done(cur); }
#undef PG8_SA
#undef PG8_SB
#undef PG8_STAGE
#undef PG8_LDA
#undef PG8_LDB
#undef PG8_MMA
#undef PG8_WAIT_V
#undef PG8_WAIT_L
#undef PG8_BAR
#undef PG8_SCHED
}
}
#include <hip/hip_cooperative_groups.h>
namespace cg = cooperative_groups;
#define LAS __attribute__((address_space(3)))
typedef unsigned short bf16;
typedef float f32x4 __attribute__((ext_vector_type(4)));
typedef float f32x2 __attribute__((ext_vector_type(2)));
typedef float f32x16 __attribute__((ext_vector_type(16)));
typedef short bf16x8 __attribute__((ext_vector_type(8)));
typedef short s16x4 __attribute__((ext_vector_type(4)));
typedef unsigned u32x4 __attribute__((ext_vector_type(4)));
typedef unsigned u32x2 __attribute__((ext_vector_type(2)));
typedef __bf16 bf16x2_t __attribute__((ext_vector_type(2)));

constexpr int BATCH = 2, T = 16384, D = 1024, M = BATCH * T, DEPTH = 2;
constexpr int NPROJ = 4352, NSRC = 4232;
constexpr int LDA = 1280, LDV = 512, LDB = 2560;
constexpr float LN_EPS = 1e-5f, GN_EPS = 64e-5f;
constexpr float DN_ALPHA = 1.41421356237f;
constexpr float C2 = 0.125f * 1.4426950408889634f;
constexpr float L2E = 1.4426950408889634f;
constexpr size_t MiB = 1u << 20;
constexpr size_t WS_CTL = 0, CTL_ZERO_BYTES = 1 * MiB;
constexpr size_t WS_WIN = 2 * MiB, WS_WOUT = 20 * MiB, WS_CUM = 24 * MiB, WS_SCS = 25 * MiB, WS_SCN = 30 * MiB;
constexpr size_t WS_XN = WS_SCN;
constexpr size_t WS_CSUM = 29 * MiB + 512 * 1024;
constexpr size_t WS_LORA = 29 * MiB;
constexpr size_t WS_PA = 190 * MiB, WS_YA = WS_PA, WS_YM = WS_PA  , WS_PV = 270 * MiB, WS_PB = 302 * MiB, WS_VS = 462 * MiB, WS_FS = 494 * MiB, WS_SI = 502 * MiB, WS_END = 506 * MiB;
constexpr int CW_QUEUE = 64;
constexpr int CW_KMAX = 1024;
constexpr int CW_BAR = 4096;
constexpr int CW_MOD = 16384;
constexpr int LDS_BYTES = 147456;
#ifndef PROBE_REP
#define PROBE_REP 0
#endif

__device__ __forceinline__ unsigned f2bf(float f) { unsigned u = __builtin_bit_cast(unsigned, f); return (u + 0x7fffu + ((u >> 16) & 1u)) >> 16; }
__device__ __forceinline__ unsigned pk2(float lo, float hi) { return f2bf(lo) | (f2bf(hi) << 16); }
__device__ __forceinline__ float bf2f(unsigned short v) { return __uint_as_float(((unsigned)v) << 16); }
__device__ __forceinline__ float bflo(unsigned w) { return __uint_as_float(w << 16); }
__device__ __forceinline__ float bfhi(unsigned w) { return __uint_as_float(w & 0xffff0000u); }
__device__ __forceinline__ unsigned cvtpk(float lo, float hi) { f32x2 v = {lo, hi}; bf16x2_t b = __builtin_convertvector(v, bf16x2_t); return __builtin_bit_cast(unsigned, b); }
__device__ __forceinline__ float row16_sum(float x) {
    x += __uint_as_float(__builtin_amdgcn_update_dpp(0, __float_as_uint(x), 0xB1, 0xF, 0xF, true));
    x += __uint_as_float(__builtin_amdgcn_update_dpp(0, __float_as_uint(x), 0x4E, 0xF, 0xF, true));
    x += __uint_as_float(__builtin_amdgcn_update_dpp(0, __float_as_uint(x), 0x141, 0xF, 0xF, true));
    x += __uint_as_float(__builtin_amdgcn_update_dpp(0, __float_as_uint(x), 0x140, 0xF, 0xF, true));
    return x;
}
__device__ __forceinline__ float wave_sum(float v) { v = row16_sum(v); v += __shfl_xor(v, 16); v += __shfl_xor(v, 32); return v; }
__device__ __forceinline__ float fast_sigmoid(float x) { return 1.f / (1.f + __expf(-x)); }

struct Args { const float* in[21]; float* out; unsigned char* ws; };

struct EpiProj {
    static constexpr bool PERM = true, AFTER_DRAIN = false;
    bf16 *PA, *PVb, *PB;
    __device__ __forceinline__ void operator()(const pg8::f32x4 (&acc)[2][2][4][2], const pg8::Unit& u, int wr, int wc, int fr, int fq) const {
        const int row0 = u.pm * 256 + wr * 64 + fr; const int pn = u.pn;
        bf16* base; int ldc, colt; float sc = 1.f; bool act = false;
        if (pn < 4) { base = PA; ldc = LDA; colt = pn * 256; }
        else if (pn < 6) { base = PVb; ldc = LDV; colt = (pn - 4) * 256; }
        else if (pn == 6) { base = PA; ldc = LDA; colt = 1024; }
        else { base = PB; ldc = LDB; colt = (pn - 7) * 256; if (pn < 9) sc = C2; if (pn >= 13) act = true; }
        const int col0 = colt + wc * 32 + 8 * fq;
#pragma unroll
        for (int ai = 0; ai < 2; ++ai)
#pragma unroll
            for (int m = 0; m < 4; ++m) { bf16* rowp = base + (size_t)(row0 + ai * 128 + m * 16) * ldc + col0;
#pragma unroll
                for (int bj = 0; bj < 2; ++bj) { pg8::f32x4 v0 = acc[ai][bj][m][0], v1 = acc[ai][bj][m][1];
                    if (act) {
#pragma unroll
                        for (int e = 0; e < 4; ++e) { v0[e] = v0[e] * fast_sigmoid(v0[e]); v1[e] = v1[e] * fast_sigmoid(v1[e]); } }
                    v0 = v0 * sc; v1 = v1 * sc; u32x4 w; w.x = cvtpk(v0[0], v0[1]); w.y = cvtpk(v0[2], v0[3]); w.z = cvtpk(v1[0], v1[1]); w.w = cvtpk(v1[2], v1[3]);
                    *(u32x4*)(rowp + bj * 128) = w; } }
    }
};
struct EpiOut {
    static constexpr bool PERM = false, AFTER_DRAIN = false;
    float* hz; const float* modl;
    __device__ __forceinline__ void operator()(const pg8::f32x4 (&acc)[2][2][4][2], const pg8::Unit& u, int wr, int wc, int fr, int fq) const {
        const int col0 = u.pn * 256 + wc * 32 + 4 * fq; const int b = (u.pm * 256) >= T ? 1 : 0; const float* gate = modl + b * 3072 + 2048;
#pragma unroll
        for (int bj = 0; bj < 2; ++bj)
#pragma unroll
            for (int n = 0; n < 2; ++n) { const int c = col0 + bj * 128 + n * 16; const f32x4 g = *(const f32x4*)(gate + c) + 1.0f;
#pragma unroll
                for (int ai = 0; ai < 2; ++ai)
#pragma unroll
                    for (int m = 0; m < 4; ++m) { const int r = u.pm * 256 + ai * 128 + wr * 64 + m * 16 + fr; float* p = hz + (size_t)r * D + c;
                        const f32x4 hx = *(const f32x4*)p; f32x4 a; a[0] = acc[ai][bj][m][n][0]; a[1] = acc[ai][bj][m][n][1]; a[2] = acc[ai][bj][m][n][2]; a[3] = acc[ai][bj][m][n][3];
                        *(f32x4*)p = hx * DN_ALPHA + g * a; } }
    }
};

__device__ __forceinline__ int win_map(int n) { if (n < 1664) return n; if (n < 1672) return 3200 + n - 1664; if (n < 1792) return -1; if (n < 3328) return n - 128; return n - 120; }
template <bool MAP> __device__ __forceinline__ void transpose_item(const float* W, int Nsrc, int Ndst, bf16* WT, LAS float* scr, int item, int lane) {
    const int nblk = Ndst / 32, kb = item / nblk, nb = item % nblk, k0 = 64 * kb, n0 = 32 * nb;
    const int src = MAP ? win_map(n0 + (lane & 31)) : n0 + (lane & 31);
#pragma unroll 8
    for (int i = 0; i < 32; ++i) { const int kk = 2 * i + (lane >> 5); scr[kk * 33 + (lane & 31)] = src >= 0 ? W[(size_t)(k0 + kk) * Nsrc + src] : 0.f; }
    asm volatile("s_waitcnt lgkmcnt(0)" ::: "memory");
    const int c = lane & 7;
#pragma unroll
    for (int j = 0; j < 4; ++j) { const int n = (lane >> 3) + 8 * j; const LAS float* s = scr + (8 * c) * 33 + n;
        u32x4 o; o.x = pk2(s[0 * 33], s[1 * 33]); o.y = pk2(s[2 * 33], s[3 * 33]); o.z = pk2(s[4 * 33], s[5 * 33]); o.w = pk2(s[6 * 33], s[7 * 33]);
        *(u32x4*)(WT + (size_t)(n0 + n) * 1024 + k0 + 8 * c) = o; }
    asm volatile("s_waitcnt lgkmcnt(0)" ::: "memory");
}
__device__ __forceinline__ void p0a(const Args& a, LAS unsigned char* lds, int tid, int lane, int wave, int G) {
    LAS float* scr = (LAS float*)(lds + wave * 16384);
    const int gw = blockIdx.x * 8 + wave, NGW = G * 8;
    constexpr int I_IN = 16 * (NPROJ / 32), I_OUT = 16 * 32;
    for (int it = gw; it < 2 * (I_IN + I_OUT); it += NGW) {
        int r = it; const int l = r / (I_IN + I_OUT); r -= l * (I_IN + I_OUT);
        if (r < I_IN) transpose_item<true>(a.in[6] + (size_t)l * 1024 * NSRC, NSRC, NPROJ, (bf16*)(a.ws + WS_WIN) + (size_t)l * NPROJ * 1024, scr, r, lane);
        else transpose_item<false>(a.in[18] + (size_t)l * 1024 * 1024, 1024, 1024, (bf16*)(a.ws + WS_WOUT) + (size_t)l * 1024 * 1024, scr, r - I_IN, lane);
    }
    { bf16* LT = (bf16*)(a.ws + WS_LORA);
      for (int w = blockIdx.x * 512 + tid; w < 2 * 2 * 512 * 64; w += G * 512) { const int k = w & 63, n = (w >> 6) & 511, which = (w >> 15) & 1, l = w >> 16;
          const float* src = (which ? a.in[11] : a.in[9]) + (size_t)l * 64 * 512; LT[w] = (bf16)f2bf(src[k * 512 + n]); } }
    float* mod = (float*)(a.ws + WS_CTL) + CW_MOD;
    const float* cvec = a.in[1];
    for (int w = blockIdx.x * 512 + tid; w < 2 * 16 * 3072; w += G * 512) {
        const int j = w % 3072, sl = (w / 3072) % 16, l = w / (3072 * 16);
        const float* wa = a.in[4] + (size_t)l * 1024 * 3072 + (size_t)(sl * 64) * 3072 + j;
        float s0 = 0.f, s1 = 0.f;
#pragma unroll 8
        for (int i = 0; i < 64; ++i) { const float wv = wa[(size_t)i * 3072]; s0 += cvec[sl * 64 + i] * wv; s1 += cvec[1024 + sl * 64 + i] * wv; }
        if (sl == 0) { const float bb = a.in[5][l * 3072 + j]; s0 += bb; s1 += bb; }
        atomicAdd(mod + (l * 2 + 0) * 3072 + j, s0); atomicAdd(mod + (l * 2 + 1) * 3072 + j, s1);
    }
}
__device__ __forceinline__ void ln_rows(const float* src, const float* g, const float* bb, float* dst, bf16* xn, const float* modn, int lane, int wave, int G) {
    const int gw = blockIdx.x * 8 + wave, NGW = G * 8;
    f32x4 gv[4], bv[4];
#pragma unroll
    for (int j = 0; j < 4; ++j) { gv[j] = ((const f32x4*)g)[lane + 64 * j]; bv[j] = ((const f32x4*)bb)[lane + 64 * j]; }
    for (int m0 = gw * 2; m0 < M; m0 += NGW * 2) {
        f32x4 v[2][4]; float s[2], s2[2];
#pragma unroll
        for (int u = 0; u < 2; ++u) { const f32x4* xr = (const f32x4*)(src + (size_t)(m0 + u) * D) + lane; s[u] = 0.f;
#pragma unroll
            for (int j = 0; j < 4; ++j) { v[u][j] = xr[64 * j]; s[u] += (v[u][j].x + v[u][j].y) + (v[u][j].z + v[u][j].w); } }
#pragma unroll
        for (int u = 0; u < 2; ++u) s[u] = row16_sum(s[u]);
#pragma unroll
        for (int o = 16; o < 64; o <<= 1) {
#pragma unroll
            for (int u = 0; u < 2; ++u) s[u] += __shfl_xor(s[u], o); }
#pragma unroll
        for (int u = 0; u < 2; ++u) { const float mean = s[u] * (1.f / D); s2[u] = 0.f;
#pragma unroll
            for (int j = 0; j < 4; ++j) { v[u][j] = v[u][j] - mean; s2[u] += (v[u][j].x * v[u][j].x + v[u][j].y * v[u][j].y) + (v[u][j].z * v[u][j].z + v[u][j].w * v[u][j].w); } }
#pragma unroll
        for (int u = 0; u < 2; ++u) s2[u] = row16_sum(s2[u]);
#pragma unroll
        for (int o = 16; o < 64; o <<= 1) {
#pragma unroll
            for (int u = 0; u < 2; ++u) s2[u] += __shfl_xor(s2[u], o); }
#pragma unroll
        for (int u = 0; u < 2; ++u) { const int m = m0 + u;
            const float rstd = 1.f / sqrtf(s2[u] * (1.f / D) + LN_EPS);
            f32x4* o = (f32x4*)(dst + (size_t)m * D) + lane;
            const int b = m >= T ? 1 : 0;
#pragma unroll
            for (int j = 0; j < 4; ++j) { const f32x4 hv = v[u][j] * rstd * gv[j] + bv[j]; o[64 * j] = hv;
                if (modn) { const f32x4 sh = ((const f32x4*)(modn + b * 3072))[lane + 64 * j], sc = ((const f32x4*)(modn + b * 3072 + 1024))[lane + 64 * j];
                    const f32x4 y = hv * (sc + 1.0f) + sh; u32x2 w; w.x = pk2(y.x, y.y); w.y = pk2(y.z, y.w);
                    *((u32x2*)(xn + (size_t)m * D) + lane + 64 * j) = w; } } }
    }
}
__device__ __forceinline__ int crow(int r, int hi) { return (r & 3) + 8 * (r >> 2) + 4 * hi; }
__device__ __forceinline__ float tanh_fast(float x) { const float e = __expf(2.f * x); return 1.f - 2.f / (e + 1.f); }
__device__ __forceinline__ void cum_kmax(const Args& a, LAS unsigned char* lds, int l, int bh, int tid, int lane, int wave) {
    const int b = bh >> 3, h = bh & 7;
    const bf16* PA = (const bf16*)(a.ws + WS_PA); const bf16* PB = (const bf16*)(a.ws + WS_PB);
    float* cum = (float*)(a.ws + WS_CUM) + (size_t)bh * T;
    const float bf = a.in[17][l * 8 + h];
    LAS float* red = (LAS float*)lds;
    const int t0 = tid * 32;
    float s = 0.f, kmx = 0.f;
#pragma unroll 1
    for (int i = 0; i < 32; ++i) { const size_t m = (size_t)b * T + t0 + i;
        const float z = bf2f(PA[m * LDA + 1152 + h]) + bf;
        const float lf = fminf(z, 0.f) - log1pf(__expf(-fabsf(z)));
        s += lf; cum[t0 + i] = s;
        const u32x4* kr = (const u32x4*)(PB + m * LDB + 512 + h * 64); float q = 0.f;
#pragma unroll
        for (int c = 0; c < 8; ++c) { const u32x4 w = kr[c];
            q += bflo(w.x) * bflo(w.x) + bfhi(w.x) * bfhi(w.x) + bflo(w.y) * bflo(w.y) + bfhi(w.y) * bfhi(w.y) + bflo(w.z) * bflo(w.z) + bfhi(w.z) * bfhi(w.z) + bflo(w.w) * bflo(w.w) + bfhi(w.w) * bfhi(w.w); }
        kmx = fmaxf(kmx, q); }
    red[tid] = s;
#pragma unroll
    for (int o = 1; o < 64; o <<= 1) kmx = fmaxf(kmx, __shfl_xor(kmx, o));
    if (lane == 0) red[512 + wave] = kmx;
    __syncthreads();
    if (tid == 0) { float run = 0.f; for (int i = 0; i < 512; ++i) { const float v = red[i]; red[i] = run; run += v; }
        float k = 0.f; for (int i = 0; i < 8; ++i) k = fmaxf(k, red[512 + i]);
        ((float*)(a.ws + WS_CTL))[CW_KMAX + 16 * l + bh] = sqrtf(k); }
    __syncthreads();
    const float off = red[tid];
#pragma unroll 1
    for (int i = 0; i < 32; ++i) cum[t0 + i] += off;
    __syncthreads();
}
__device__ __forceinline__ void prep_phase(const Args& a, LAS unsigned char* lds, int l, int tid, int lane, int wave, int G) {
    const bf16* PA = (const bf16*)(a.ws + WS_PA); const bf16* PV = (const bf16*)(a.ws + WS_PV);
    bf16* SCN = (bf16*)(a.ws + WS_SCN); float* SCS = (float*)(a.ws + WS_SCS); bf16* VS = (bf16*)(a.ws + WS_VS);
    LAS unsigned char* lowL = lds;
    LAS bf16* CL = (LAS bf16*)(lds + 16384);
    const int c = tid, h = wave, r32 = lane & 31, hi = lane >> 5;
    const bf16* LT = (const bf16*)(a.ws + WS_LORA) + (size_t)l * 2 * 512 * 64;
    const float* mix = a.in[7] + l * 1664;
    const int qc = tid & 127, tsel = tid >> 7, c4 = 4 * qc, hq = qc >> 4;
    const f32x4 mix_r = *(const f32x4*)(mix + c4), mix_k = *(const f32x4*)(mix + 512 + c4), mix_v = *(const f32x4*)(mix + 1024 + c4);
    const int ftok = tid >> 3, fi0 = (tid & 7) * 16;
    f32x4 mlow[4];
#pragma unroll
    for (int q = 0; q < 4; ++q) mlow[q] = *(const f32x4*)(mix + 1536 + fi0 + 4 * q);
    const f32x4 w0c = *(const f32x4*)(a.in[8] + l * 512 + c4), a0c = *(const f32x4*)(a.in[10] + l * 512 + c4), kkc = *(const f32x4*)(a.in[12] + l * 512 + c4), kac = *(const f32x4*)(a.in[13] + l * 512 + c4), rkc = *(const f32x4*)(a.in[14] + l * 512 + c4);
    unsigned* pq = (unsigned*)(a.ws + WS_CTL) + CW_QUEUE + 1024 + 64 * l;
    volatile LAS unsigned* ptask = (volatile LAS unsigned*)(lds + 140000);
    for (;;) {
        __syncthreads();
        if (tid == 0) ptask[0] = atomicAdd(pq, 1u);
        __syncthreads();
        const unsigned ptk = ptask[0];
        if (ptk >= (unsigned)(M / 64)) break;
        const int chunk = (int)ptk;
        const int m0 = chunk * 64, b = m0 >= T ? 1 : 0, t0 = m0 - b * T; const int bh = b * 8 + h;
        LAS float* lfL = (LAS float*)(lds + 81920); LAS float* kqL = (LAS float*)(lds + 83968);
        { const int tkn = tid >> 3, hd = tid & 7; const size_t m = (size_t)m0 + tkn;
          const float z = bf2f(PA[m * LDA + 1152 + hd]) + a.in[17][l * 8 + hd];
          lfL[hd * 64 + tkn] = fminf(z, 0.f) - __logf(1.f + __expf(-fabsf(z)));
          const u32x4* kr = (const u32x4*)((const bf16*)(a.ws + WS_PB) + m * LDB + 512 + hd * 64); float q = 0.f;
#pragma unroll
          for (int cc = 0; cc < 8; ++cc) { const u32x4 w = kr[cc];
              q += bflo(w.x) * bflo(w.x) + bfhi(w.x) * bfhi(w.x) + bflo(w.y) * bflo(w.y) + bfhi(w.y) * bfhi(w.y) + bflo(w.z) * bflo(w.z) + bfhi(w.z) * bfhi(w.z) + bflo(w.w) * bflo(w.w) + bfhi(w.w) * bfhi(w.w); }
          kqL[hd * 64 + tkn] = q; }
        { const int m = m0 + ftok, t = t0 + ftok;
          const u32x4* cp = (const u32x4*)(PA + (size_t)m * LDA + 1024 + fi0);
          const u32x4 c0 = cp[0], c1 = cp[1]; u32x4 p0 = {0u, 0u, 0u, 0u}, p1 = p0;
          if (t > 0) { const u32x4* pp = (const u32x4*)(PA + (size_t)(m - 1) * LDA + 1024 + fi0); p0 = pp[0]; p1 = pp[1]; }
          float cur[16], prv[16];
          cur[0] = bflo(c0.x); cur[1] = bfhi(c0.x); cur[2] = bflo(c0.y); cur[3] = bfhi(c0.y); cur[4] = bflo(c0.z); cur[5] = bfhi(c0.z); cur[6] = bflo(c0.w); cur[7] = bfhi(c0.w);
          cur[8] = bflo(c1.x); cur[9] = bfhi(c1.x); cur[10] = bflo(c1.y); cur[11] = bfhi(c1.y); cur[12] = bflo(c1.z); cur[13] = bfhi(c1.z); cur[14] = bflo(c1.w); cur[15] = bfhi(c1.w);
          prv[0] = bflo(p0.x); prv[1] = bfhi(p0.x); prv[2] = bflo(p0.y); prv[3] = bfhi(p0.y); prv[4] = bflo(p0.z); prv[5] = bfhi(p0.z); prv[6] = bflo(p0.w); prv[7] = bfhi(p0.w);
          prv[8] = bflo(p1.x); prv[9] = bfhi(p1.x); prv[10] = bflo(p1.y); prv[11] = bfhi(p1.y); prv[12] = bflo(p1.z); prv[13] = bfhi(p1.z); prv[14] = bflo(p1.w); prv[15] = bfhi(p1.w);
#pragma unroll
          for (int q = 0; q < 16; ++q) { float val = cur[q] + (prv[q] - cur[q]) * mlow[q >> 2][q & 3]; if (fi0 < 64) val = tanh_fast(val); cur[q] = val; }
          u32x4 o0 = {cvtpk(cur[0], cur[1]), cvtpk(cur[2], cur[3]), cvtpk(cur[4], cur[5]), cvtpk(cur[6], cur[7])};
          u32x4 o1 = {cvtpk(cur[8], cur[9]), cvtpk(cur[10], cur[11]), cvtpk(cur[12], cur[13]), cvtpk(cur[14], cur[15])};
          const int ch = 2 * (tid & 7);
          *(LAS u32x4*)(lowL + ftok * 256 + ((ch ^ (ftok & 7)) << 4)) = o0; *(LAS u32x4*)(lowL + ftok * 256 + (((ch + 1) ^ (ftok & 7)) << 4)) = o1; }
        __syncthreads();
        if (tid < 8) { float run = 0.f, kmx = 0.f;
            for (int tt = 0; tt < 64; ++tt) { run += lfL[tid * 64 + tt]; lfL[tid * 64 + tt] = run; kmx = fmaxf(kmx, kqL[tid * 64 + tt]); }
            ((float*)(a.ws + WS_CSUM))[(b * 8 + tid) * 256 + (t0 >> 6)] = run;
            atomicMax((unsigned*)(a.ws + WS_CTL) + CW_KMAX + 16 * l + b * 8 + tid, __float_as_uint(sqrtf(kmx))); }
#pragma unroll 1
        for (int tr = 0; tr < 2; ++tr) {
            { f32x16 Cw0 = {}, Cw1 = {}, Ca0 = {}, Ca1 = {};
              const int trow = 32 * tr + r32;
              bf16x8 Bw[2][4], Ba[2][4];
#pragma unroll
              for (int tc = 0; tc < 2; ++tc)
#pragma unroll
                for (int sx = 0; sx < 4; ++sx) { const int n = 64 * h + 32 * tc + r32;
                    Bw[tc][sx] = __builtin_bit_cast(bf16x8, *(const u32x4*)(LT + (size_t)n * 64 + 16 * sx + 8 * hi));
                    Ba[tc][sx] = __builtin_bit_cast(bf16x8, *(const u32x4*)(LT + 512 * 64 + (size_t)n * 64 + 16 * sx + 8 * hi)); }
#pragma unroll
              for (int sx = 0; sx < 4; ++sx) {
                  const bf16x8 Aw = *(const LAS bf16x8*)(lowL + trow * 256 + (((2 * sx + hi) ^ (trow & 7)) << 4));
                  const bf16x8 Aa = *(const LAS bf16x8*)(lowL + trow * 256 + (((8 + 2 * sx + hi) ^ (trow & 7)) << 4));
                  Cw0 = __builtin_amdgcn_mfma_f32_32x32x16_bf16(Aw, Bw[0][sx], Cw0, 0, 0, 0); Cw1 = __builtin_amdgcn_mfma_f32_32x32x16_bf16(Aw, Bw[1][sx], Cw1, 0, 0, 0);
                  Ca0 = __builtin_amdgcn_mfma_f32_32x32x16_bf16(Aa, Ba[0][sx], Ca0, 0, 0, 0); Ca1 = __builtin_amdgcn_mfma_f32_32x32x16_bf16(Aa, Ba[1][sx], Ca1, 0, 0, 0); }
#pragma unroll
              for (int r = 0; r < 16; ++r) { LAS bf16* row = CL + crow(r, hi) * 1024 + 64 * h + r32;
                  row[0] = (bf16)f2bf(Cw0[r]); row[32] = (bf16)f2bf(Cw1[r]); row[512] = (bf16)f2bf(Ca0[r]); row[544] = (bf16)f2bf(Ca1[r]); } }
            __syncthreads();
#define UNP4(dst, u2) do { dst[0] = bflo(u2.x); dst[1] = bfhi(u2.x); dst[2] = bflo(u2.y); dst[3] = bfhi(u2.y); } while (0)
#pragma unroll 1
            for (int g = 0; g < 4; ++g) {
                const int tl0 = g * 8 + 2 * tsel, mg = m0 + 32 * tr + tl0, tg = t0 + 32 * tr + tl0;
                u32x2 rr_[3], rk_[3], rv_[3];
#pragma unroll
                for (int u = 0; u < 3; ++u) { const int m = mg - 1 + u;
                    if (u > 0 || tg > 0) { rr_[u] = *(const u32x2*)(PA + (size_t)m * LDA + c4); rk_[u] = *(const u32x2*)(PA + (size_t)m * LDA + 512 + c4); rv_[u] = *(const u32x2*)(PV + (size_t)m * LDV + c4); }
                    else { rr_[u] = (u32x2){0u, 0u}; rk_[u] = rr_[u]; rv_[u] = rr_[u]; } }
                f32x4 fr[3], fk[3], fv[3];
#pragma unroll
                for (int u = 0; u < 3; ++u) { UNP4(fr[u], rr_[u]); UNP4(fk[u], rk_[u]); UNP4(fv[u], rv_[u]); }
                f32x4 r4[2], kkr[2], kp[2], vv[2], av[2], omw[2]; float red[8];
#pragma unroll
                for (int u = 0; u < 2; ++u) {
                    r4[u] = fr[u + 1] + (fr[u] - fr[u + 1]) * mix_r; const f32x4 k4 = fk[u + 1] + (fk[u] - fk[u + 1]) * mix_k; vv[u] = fv[u + 1] + (fv[u] - fv[u + 1]) * mix_v;
                    const u32x2 cw = *(const LAS u32x2*)(CL + (tl0 + u) * 1024 + c4), ca = *(const LAS u32x2*)(CL + (tl0 + u) * 1024 + 512 + c4);
                    f32x4 wl, al; UNP4(wl, cw); UNP4(al, ca); wl = wl + w0c; al = al + a0c;
#pragma unroll
                    for (int e = 0; e < 4; ++e) { const float z = -wl[e]; const float sp = fmaxf(z, 0.f) + __logf(1.f + __expf(-fabsf(z)));
                        const float ee = __expf(-sp - 0.5f); omw[u][e] = 1.f - __expf(-ee); av[u][e] = fast_sigmoid(al[e]); }
                    kkr[u] = k4 * kkc; kp[u] = k4 * ((av[u] - 1.0f) * kac + 1.0f);
                    const f32x4 q0 = kkr[u] * kkr[u], q1 = kkr[u] * av[u] * r4[u], q2 = kp[u] * r4[u], q3 = r4[u] * kp[u] * rkc;
                    red[u] = (q0[0] + q0[1]) + (q0[2] + q0[3]); red[2 + u] = (q1[0] + q1[1]) + (q1[2] + q1[3]); red[4 + u] = (q2[0] + q2[1]) + (q2[2] + q2[3]); red[6 + u] = (q3[0] + q3[1]) + (q3[2] + q3[3]);
                }
#pragma unroll
                for (int i = 0; i < 8; ++i) red[i] = row16_sum(red[i]);
#pragma unroll
                for (int u = 0; u < 2; ++u) {
                    const float inv = 1.f / fmaxf(sqrtf(red[u]), 1e-12f);
                    const f32x4 kk = kkr[u] * inv, bbv = kk * av[u], wr = (1.0f - omw[u]) * r4[u];
                    const int bhq = b * 8 + hq;
                    bf16* rec = SCN + ((size_t)bhq * T + tg + u) * 320 + (c4 & 63);
                    *(u32x2*)(rec) = (u32x2){pk2(kk[0], kk[1]), pk2(kk[2], kk[3])}; *(u32x2*)(rec + 64) = (u32x2){pk2(wr[0], wr[1]), pk2(wr[2], wr[3])};
                    *(u32x2*)(rec + 128) = (u32x2){pk2(omw[u][0], omw[u][1]), pk2(omw[u][2], omw[u][3])}; *(u32x2*)(rec + 192) = (u32x2){pk2(bbv[0], bbv[1]), pk2(bbv[2], bbv[3])};
                    *(u32x2*)(rec + 256) = (u32x2){pk2(kp[u][0], kp[u][1]), pk2(kp[u][2], kp[u][3])};
                    *(u32x2*)(VS + (size_t)(mg + u) * 512 + c4) = (u32x2){pk2(vv[u][0], vv[u][1]), pk2(vv[u][2], vv[u][3])};
                    if ((lane & 15) == 0) { f32x4 sc = {red[2 + u] * inv, red[4 + u], red[6 + u], 0.f}; *(f32x4*)(SCS + ((size_t)bhq * T + tg + u) * 4) = sc; }
                }
            }
#undef UNP4
            __syncthreads();
        }
        { const int tkn = tid >> 3, hd = tid & 7; ((float*)(a.ws + WS_CUM))[(size_t)(b * 8 + hd) * T + t0 + tkn] = lfL[hd * 64 + tkn]; }
    }
    __syncthreads();
}

__device__ __forceinline__ float dppf(float x, const int ctrl_sel) {
    unsigned u = __float_as_uint(x), r;
    if (ctrl_sel == 0) r = __builtin_amdgcn_update_dpp(0, u, 0xB1, 0xF, 0xF, true);
    else if (ctrl_sel == 1) r = __builtin_amdgcn_update_dpp(0, u, 0x4E, 0xF, 0xF, true);
    else r = __builtin_amdgcn_update_dpp(0, u, 0x141, 0xF, 0xF, true);
    return __uint_as_float(r);
}
__device__ __forceinline__ float red8(float x) { x += dppf(x, 0); x += dppf(x, 1); x += dppf(x, 2); return x; }
constexpr int SC_CH = 32, SC_STEP = 1024, SC_BUF = SC_CH * SC_STEP, SC_VOFF = 2 * SC_BUF, SC_SOFF = SC_VOFF + 2 * SC_CH * 64 * 4, SC_ROWB = SC_SOFF + 2 * SC_CH * 16;
constexpr int NSEG = 16, SEGLEN = T / NSEG;
typedef float f32x4m __attribute__((ext_vector_type(4)));
template <bool PASSC> __device__ __forceinline__ void scan_task(const Args& a, LAS unsigned char* lds, int bh, int seg, int tid, int lane, int wave, unsigned* cntp, int lq_l) {
    const int b = bh >> 3, h = bh & 7;
    const int t0 = seg * SEGLEN;
    const bf16* SCN = (const bf16*)(a.ws + WS_SCN) + ((size_t)bh * T + t0) * 320;
    const float* SCS = (const float*)(a.ws + WS_SCS) + ((size_t)bh * T + t0) * 4;
    const bf16* VS = (const bf16*)(a.ws + WS_VS) + ((size_t)b * T + t0) * 512 + h * 64;
    float* YA = (float*)(a.ws + WS_YA) + ((size_t)b * T + t0) * 512 + h * 64;
    float* FSb = (float*)(a.ws + WS_FS) + (size_t)bh * NSEG * 128 * 64;
    constexpr int NCH = SEGLEN / SC_CH;
    const int n16 = lane & 15, g = lane >> 4;
    const bool ident = !PASSC && wave >= 4;
    const bool active = PASSC ? (wave < 4) : true;
    const int row = 16 * (wave & 3) + n16;
    f32x4 Sf[4];
#pragma unroll
    for (int i = 0; i < 4; ++i) Sf[i] = (f32x4){0.f, 0.f, 0.f, 0.f};
    __syncthreads();
    if constexpr (PASSC) {
        if (active && seg > 0) { const float* SIp = (const float*)(a.ws + WS_SI) + ((size_t)(bh * NSEG + seg) * 64 + row) * 64 + 4 * g;
#pragma unroll
            for (int t4 = 0; t4 < 4; ++t4) Sf[t4] = *(const f32x4*)(SIp + 16 * t4); }
    } else if (ident) {
#pragma unroll
        for (int i = 0; i < 4; ++i)
#pragma unroll
            for (int e = 0; e < 4; ++e) Sf[i][e] = (16 * i + 4 * g + e == row) ? 1.f : 0.f;
    }
    u32x4 mreg[2], breg, kreg; u32x4 vreg = {0u, 0u, 0u, 0u}; f32x4 sreg;
    auto gload = [&](int c) {
        const u32x4* src = (const u32x4*)(SCN + (size_t)c * SC_CH * 320);
        { const int st = tid / 24, q = tid - st * 24; mreg[0] = src[st * 40 + q]; }
        if (tid < 256) { const int jj = 512 + tid, st = jj / 24, q = jj - st * 24; mreg[1] = src[st * 40 + q];
            const int s2 = tid >> 3, e8 = tid & 7; breg = src[s2 * 40 + 24 + e8]; kreg = src[s2 * 40 + 32 + e8]; }
        if (tid < 256) vreg = *(const u32x4*)(VS + (size_t)(c * SC_CH + (tid >> 3)) * 512 + (tid & 7) * 8);
        else if (tid < 288) sreg = *(const f32x4*)(SCS + (size_t)(c * SC_CH + (tid - 256)) * 4);
    };
    auto lwrite = [&](int c) {
        LAS unsigned char* bp = lds + (c & 1) * SC_BUF;
#pragma unroll
        for (int i = 0; i < 2; ++i) { const int jj = tid + 512 * i;
            if (jj < 768) { const int st = jj / 24, q = jj - st * 24, arr = q >> 3, e8 = q & 7; const u32x4 w = mreg[i];
                LAS unsigned char* d = bp + st * SC_STEP;
                if (arr < 2) { *(LAS u32x4*)(d + 256 + arr * 128 + e8 * 16) = w; }
                else { f32x4 lo, hi;
                    lo[0] = bflo(w.x); lo[1] = bfhi(w.x); lo[2] = bflo(w.y); lo[3] = bfhi(w.y); hi[0] = bflo(w.z); hi[1] = bfhi(w.z); hi[2] = bflo(w.w); hi[3] = bfhi(w.w);
                    lo = 1.0f - lo; hi = 1.0f - hi;
                    LAS f32x4* df = (LAS f32x4*)(d + e8 * 32); df[0] = lo; df[1] = hi; } } }
        if (tid < 256) { const int s2 = tid >> 3, e8 = tid & 7; LAS u32x4* d = (LAS u32x4*)(bp + s2 * SC_STEP + 512 + e8 * 64);
            const unsigned bw[4] = {breg.x, breg.y, breg.z, breg.w}, kw[4] = {kreg.x, kreg.y, kreg.z, kreg.w};
#pragma unroll
            for (int pq = 0; pq < 4; ++pq) { const unsigned blo = bw[pq] & 0xffffu, bhi = bw[pq] >> 16, klo = kw[pq] & 0xffffu, khi = kw[pq] >> 16;
                u32x4 o; o.x = klo | (blo << 16); o.y = blo; o.z = khi | (bhi << 16); o.w = bhi; d[pq] = o; } }
        if (tid < 256) { const u32x4 w = vreg; f32x4 lo, hi;
            lo[0] = bflo(w.x); lo[1] = bfhi(w.x); lo[2] = bflo(w.y); lo[3] = bfhi(w.y); hi[0] = bflo(w.z); hi[1] = bfhi(w.z); hi[2] = bflo(w.w); hi[3] = bfhi(w.w);
            LAS f32x4* d = (LAS f32x4*)(lds + SC_VOFF + (c & 1) * (SC_CH * 64 * 4) + tid * 32); d[0] = lo; d[1] = hi; }
        else if (tid < 288) { *(LAS f32x4*)(lds + SC_SOFF + (c & 1) * (SC_CH * 16) + (tid - 256) * 16) = sreg; }
    };
    gload(0); lwrite(0); gload(1);
    __syncthreads();
    LAS float* ybuf = (LAS float*)(lds + SC_ROWB + 16384);
    const int lt_ = tid - 256, ms = (lt_ >> 3) & 31, mr8 = (lt_ & 7) * 8;
    f32x4 gng0 = {}, gng1 = {}, gnb0 = {}, gnb1 = {};
    if constexpr (PASSC) { if (wave >= 4) { const float* gp = a.in[15] + lq_l * 512 + h * 64 + mr8; const float* bp2 = a.in[16] + lq_l * 512 + h * 64 + mr8;
        gng0 = *(const f32x4*)gp; gng1 = *(const f32x4*)(gp + 4); gnb0 = *(const f32x4*)bp2; gnb1 = *(const f32x4*)(bp2 + 4); } }
    auto ymerge = [&](int cc) {
        const LAS float* yp = ybuf + (cc & 1) * (SC_CH * 64) + ms * 64 + mr8;
        const f32x4 y0 = *(const LAS f32x4*)yp, y1 = *(const LAS f32x4*)(yp + 4);
        const size_t m = (size_t)b * T + t0 + cc * SC_CH + ms;
        const u32x4 vv = *(const u32x4*)((const bf16*)(a.ws + WS_VS) + m * 512 + h * 64 + mr8);
        const u32x4 gg = *(const u32x4*)((const bf16*)(a.ws + WS_PB) + m * LDB + 1536 + h * 64 + mr8);
        const float rkr = SCS[(size_t)(cc * SC_CH + ms) * 4 + 2];
        float sm = (y0[0] + y0[1]) + (y0[2] + y0[3]) + (y1[0] + y1[1]) + (y1[2] + y1[3]);
        sm += __uint_as_float(__builtin_amdgcn_update_dpp(0, __float_as_uint(sm), 0xB1, 0xF, 0xF, true));
        sm += __uint_as_float(__builtin_amdgcn_update_dpp(0, __float_as_uint(sm), 0x4E, 0xF, 0xF, true));
        sm += __uint_as_float(__builtin_amdgcn_update_dpp(0, __float_as_uint(sm), 0x141, 0xF, 0xF, true));
        const float mean = sm * (1.f / 64.f);
        const f32x4 d0 = y0 - mean, d1 = y1 - mean;
        float sv = (d0[0] * d0[0] + d0[1] * d0[1]) + (d0[2] * d0[2] + d0[3] * d0[3]) + (d1[0] * d1[0] + d1[1] * d1[1]) + (d1[2] * d1[2] + d1[3] * d1[3]);
        sv += __uint_as_float(__builtin_amdgcn_update_dpp(0, __float_as_uint(sv), 0xB1, 0xF, 0xF, true));
        sv += __uint_as_float(__builtin_amdgcn_update_dpp(0, __float_as_uint(sv), 0x4E, 0xF, 0xF, true));
        sv += __uint_as_float(__builtin_amdgcn_update_dpp(0, __float_as_uint(sv), 0x141, 0xF, 0xF, true));
        const float rs = rsqrtf(sv * (1.f / 64.f) + GN_EPS);
        const f32x4 v0 = {bflo(vv.x), bfhi(vv.x), bflo(vv.y), bfhi(vv.y)}, v1 = {bflo(vv.z), bfhi(vv.z), bflo(vv.w), bfhi(vv.w)};
        const f32x4 g0 = {bflo(gg.x), bfhi(gg.x), bflo(gg.y), bfhi(gg.y)}, g1 = {bflo(gg.z), bfhi(gg.z), bflo(gg.w), bfhi(gg.w)};
        const f32x4 o0 = (d0 * rs * gng0 + gnb0 + v0 * rkr) * g0, o1 = (d1 * rs * gng1 + gnb1 + v1 * rkr) * g1;
        u32x4 ow; ow.x = pk2(o0[0], o0[1]); ow.y = pk2(o0[2], o0[3]); ow.z = pk2(o1[0], o1[1]); ow.w = pk2(o1[2], o1[3]);
        *(u32x4*)((bf16*)(a.ws + WS_YM) + m * D + h * 64 + mr8) = ow;
    };
    for (int c = 0; c < NCH; ++c) {
        if (c + 1 < NCH) lwrite(c + 1);
        if (c + 2 < NCH) gload(c + 2);
        if constexpr (PASSC) { if (c > 0 && wave >= 4) ymerge(c - 1); }
        if (active) {
            const LAS unsigned char* bp = lds + (c & 1) * SC_BUF;
            const LAS float* vb = (const LAS float*)(lds + SC_VOFF + (c & 1) * (SC_CH * 64 * 4)) + row;
            const LAS float* sb = (const LAS float*)(lds + SC_SOFF + (c & 1) * (SC_CH * 16));
#define SC_DECL(X) u32x2 X##a0, X##a1, X##a2, X##a3, X##r0, X##r1, X##r2, X##r3; float X##v; f32x2 X##s
#define SC_LD(X, sidx) do { const LAS unsigned char* p_ = bp + (sidx) * SC_STEP + 256 + g * 8; \
                X##a0 = *(const LAS u32x2*)(p_); X##a1 = *(const LAS u32x2*)(p_ + 32); X##a2 = *(const LAS u32x2*)(p_ + 64); X##a3 = *(const LAS u32x2*)(p_ + 96); \
                if constexpr (PASSC) { X##r0 = *(const LAS u32x2*)(p_ + 128); X##r1 = *(const LAS u32x2*)(p_ + 160); X##r2 = *(const LAS u32x2*)(p_ + 192); X##r3 = *(const LAS u32x2*)(p_ + 224); X##s = *(const LAS f32x2*)(sb + (sidx) * 4); } \
                X##v = ident ? 0.f : vb[(sidx) * 64]; } while (0)
#define SC_STEPM(X, Y, sidx, ldnext) do { const LAS unsigned char* p_ = bp + (sidx) * SC_STEP; \
                const f32x4 w0_ = *(const LAS f32x4*)(p_ + g * 16), w1_ = *(const LAS f32x4*)(p_ + 64 + g * 16), w2_ = *(const LAS f32x4*)(p_ + 128 + g * 16), w3_ = *(const LAS f32x4*)(p_ + 192 + g * 16); \
                const s16x4 f0_ = *(const LAS s16x4*)(p_ + 512 + n16 * 8), f1_ = *(const LAS s16x4*)(p_ + 640 + n16 * 8), f2_ = *(const LAS s16x4*)(p_ + 768 + n16 * 8), f3_ = *(const LAS s16x4*)(p_ + 896 + n16 * 8); \
                if (ldnext) SC_LD(Y, (sidx) + 1); \
                u32x4 sb0, sb1; \
                sb0.x = cvtpk(Sf[0][0], Sf[0][1]); sb0.y = cvtpk(Sf[0][2], Sf[0][3]); sb0.z = cvtpk(Sf[1][0], Sf[1][1]); sb0.w = cvtpk(Sf[1][2], Sf[1][3]); \
                sb1.x = cvtpk(Sf[2][0], Sf[2][1]); sb1.y = cvtpk(Sf[2][2], Sf[2][3]); sb1.z = cvtpk(Sf[3][0], Sf[3][1]); sb1.w = cvtpk(Sf[3][2], Sf[3][3]); \
                const bf16x8 B0 = __builtin_bit_cast(bf16x8, sb0), B1 = __builtin_bit_cast(bf16x8, sb1); \
                const bf16x8 A0 = __builtin_bit_cast(bf16x8, (u32x4){X##a0.x, X##a0.y, X##a1.x, X##a1.y}), A1 = __builtin_bit_cast(bf16x8, (u32x4){X##a2.x, X##a2.y, X##a3.x, X##a3.y}); \
                const f32x4m z4 = {0.f, 0.f, 0.f, 0.f}; f32x4m accy0 = z4, accy1 = z4; \
                const f32x4m acc0 = __builtin_amdgcn_mfma_f32_16x16x32_bf16(A0, B0, z4, 0, 0, 0); \
                const f32x4m acc1 = __builtin_amdgcn_mfma_f32_16x16x32_bf16(A1, B1, z4, 0, 0, 0); \
                if constexpr (PASSC) { const bf16x8 R0 = __builtin_bit_cast(bf16x8, (u32x4){X##r0.x, X##r0.y, X##r1.x, X##r1.y}); accy0 = __builtin_amdgcn_mfma_f32_16x16x32_bf16(R0, B0, z4, 0, 0, 0); \
                    const bf16x8 R1 = __builtin_bit_cast(bf16x8, (u32x4){X##r2.x, X##r2.y, X##r3.x, X##r3.y}); accy1 = __builtin_amdgcn_mfma_f32_16x16x32_bf16(R1, B1, z4, 0, 0, 0); } \
                const f32x4 c0_ = Sf[0] * w0_, c1_ = Sf[1] * w1_, c2_ = Sf[2] * w2_, c3_ = Sf[3] * w3_; \
                const float sa = acc0[0] + acc1[0]; \
                u32x2 bu; bu.x = (__float_as_uint(X##v) >> 16) | (cvtpk(0.f, -sa) & 0xffff0000u); bu.y = 0u; \
                if (g != 0) { bu.x = 0u; bu.y = 0u; } \
                const s16x4 Bu = __builtin_bit_cast(s16x4, bu); \
                Sf[0] = __builtin_amdgcn_mfma_f32_16x16x16bf16_1k(f0_, Bu, c0_, 0, 0, 0); Sf[1] = __builtin_amdgcn_mfma_f32_16x16x16bf16_1k(f1_, Bu, c1_, 0, 0, 0); \
                Sf[2] = __builtin_amdgcn_mfma_f32_16x16x16bf16_1k(f2_, Bu, c2_, 0, 0, 0); Sf[3] = __builtin_amdgcn_mfma_f32_16x16x16bf16_1k(f3_, Bu, c3_, 0, 0, 0); \
                if constexpr (PASSC) { const float y = (accy0[0] + accy1[0]) - sa * X##s.x + X##v * X##s.y; ybuf[(c & 1) * (SC_CH * 64) + (sidx) * 64 + row] = y; } } while (0)
            SC_DECL(oA); SC_DECL(oB);
            SC_LD(oA, 0);
#pragma unroll 1
            for (int s = 0; s < SC_CH; s += 2) {
                SC_STEPM(oA, oB, s, true);
                __builtin_amdgcn_sched_barrier(0);
                SC_STEPM(oB, oA, s + 1, (s + 2 < SC_CH));
                __builtin_amdgcn_sched_barrier(0);
            }
#undef SC_DECL
#undef SC_LD
#undef SC_STEPM
        }
        __syncthreads();
    }
    if constexpr (PASSC) { if (wave >= 4) ymerge(NCH - 1); }
    if constexpr (!PASSC) { float* fp = FSb + ((size_t)seg * 128 + (ident ? 64 : 0) + row) * 64 + 4 * g;
#pragma unroll
        for (int t4 = 0; t4 < 4; ++t4) *(f32x4*)(fp + 16 * t4) = Sf[t4];
        volatile LAS unsigned* lastf = (volatile LAS unsigned*)(lds + 140064);
        __threadfence();
        __syncthreads();
        if (tid == 0) lastf[0] = atomicAdd(cntp, 1u);
        __syncthreads();
        if (lastf[0] == (unsigned)(NSEG - 2)) {
            __threadfence();
            LAS float* rowb = (LAS float*)(lds + SC_ROWB);
            LAS float* pbuf = (LAS float*)lds;
            float* SIb = (float*)(a.ws + WS_SI) + (size_t)bh * NSEG * 64 * 64;
            const int crow_ = tid >> 3, kq = (tid & 7) * 8;
            f32x4 c0 = {0.f, 0.f, 0.f, 0.f}, c1 = c0, pr0, pr1;
            { const float* Pk = FSb + ((size_t)0 * 128 + 64 + crow_) * 64 + kq; pr0 = __builtin_nontemporal_load((const f32x4*)Pk); pr1 = __builtin_nontemporal_load((const f32x4*)(Pk + 4)); }
            for (int k = 0; k < NSEG - 1; ++k) {
                const float* Uk = FSb + ((size_t)k * 128 + crow_) * 64 + kq;
                f32x4 a0 = __builtin_nontemporal_load((const f32x4*)Uk), a1 = __builtin_nontemporal_load((const f32x4*)(Uk + 4));
                *(LAS f32x4*)(rowb + crow_ * 64 + kq) = c0; *(LAS f32x4*)(rowb + crow_ * 64 + kq + 4) = c1;
                *(LAS f32x4*)(pbuf + crow_ * 64 + kq) = pr0; *(LAS f32x4*)(pbuf + crow_ * 64 + kq + 4) = pr1;
                __syncthreads();
                if (k + 2 < NSEG) { const float* Pn = FSb + ((size_t)(k + 1) * 128 + 64 + crow_) * 64 + kq; pr0 = __builtin_nontemporal_load((const f32x4*)Pn); pr1 = __builtin_nontemporal_load((const f32x4*)(Pn + 4)); }
                if (k > 0) {
#pragma unroll 4
                    for (int jj = 0; jj < 64; ++jj) { const float sj = rowb[crow_ * 64 + jj]; a0 += *(const LAS f32x4*)(pbuf + jj * 64 + kq) * sj; a1 += *(const LAS f32x4*)(pbuf + jj * 64 + kq + 4) * sj; } }
                c0 = a0; c1 = a1;
                float* sp_ = SIb + ((size_t)(k + 1) * 64 + crow_) * 64 + kq; *(f32x4*)sp_ = c0; *(f32x4*)(sp_ + 4) = c1;
                __syncthreads();
            }
        }
    }
}

typedef short v4i16_t __attribute__((ext_vector_type(4)));
__device__ __forceinline__ s16x4 vtr(const LAS unsigned char* p) { return __builtin_bit_cast(s16x4, __builtin_amdgcn_ds_read_tr16_b64_v4i16((LAS v4i16_t*)p)); }
constexpr int AT_KS = 0, AT_VS = 9216, AT_BIAS = 18432, AT_WSF = 18688, AT_FLAG = 19712, AT_TASK = 140000;
__device__ __forceinline__ void attn_unit(const Args& a, LAS unsigned char* lds, int l, int bh, int qb, int tid, int lane, int wid) {
    const int b = bh >> 3, h = bh & 7, r32 = lane & 31, hi = lane >> 5;
    const int q0 = qb * 256;
    bf16* PB = (bf16*)(a.ws + WS_PB);
    const float* cumh = (const float*)(a.ws + WS_CUM) + (size_t)bh * T;
    const float kmax = ((const float*)(a.ws + WS_CTL))[CW_KMAX + 16 * l + bh];
    const size_t rowbase = (size_t)b * T;
    const bf16* Qp = PB + (rowbase + q0 + wid * 32 + r32) * LDB + h * 64;
    bf16x8 qr[4]; float qs = 0.f;
#pragma unroll
    for (int d0 = 0; d0 < 4; ++d0) { const u32x4 w = *(const u32x4*)(Qp + d0 * 16 + hi * 8); qr[d0] = __builtin_bit_cast(bf16x8, w);
        qs += bflo(w.x) * bflo(w.x) + bfhi(w.x) * bfhi(w.x) + bflo(w.y) * bflo(w.y) + bfhi(w.y) * bfhi(w.y) + bflo(w.z) * bflo(w.z) + bfhi(w.z) * bfhi(w.z) + bflo(w.w) * bflo(w.w) + bfhi(w.w) * bfhi(w.w); }
    qs += __shfl_xor(qs, 32);
    const float qbound = sqrtf(qs) * kmax * 1.01f + 0.01f;
    LAS float* offL = (LAS float*)(lds + 20480);
    { __syncthreads();
      if (wid == 0) { const float* cs = (const float*)(a.ws + WS_CSUM) + bh * 256; const int ntile = qb * 4 + 4;
          f32x4 v4 = {0.f, 0.f, 0.f, 0.f};
#pragma unroll
          for (int i = 0; i < 4; ++i) if (4 * lane + i < ntile) v4[i] = cs[4 * lane + i];
          const float tot = (v4[0] + v4[1]) + (v4[2] + v4[3]); float inc = tot;
#pragma unroll
          for (int o = 1; o < 64; o <<= 1) { const float up = __shfl_up(inc, o); if (lane >= o) inc += up; }
          float ex = inc - tot;
          offL[4 * lane] = ex; ex += v4[0]; offL[4 * lane + 1] = ex; ex += v4[1]; offL[4 * lane + 2] = ex; ex += v4[2]; offL[4 * lane + 3] = ex; }
      __syncthreads(); }
    const float ref = cumh[q0 + 255] + offL[(q0 + 255) >> 6];
    const int srow = tid >> 3, sch = tid & 7;
    const bf16* Kg = PB + rowbase * LDB + 512 + h * 64 + sch * 8; const bf16* Vg = Kg + 512;
    LAS unsigned char* Ks = lds + AT_KS; LAS unsigned char* Vs = lds + AT_VS; LAS float* biasL = (LAS float*)(lds + AT_BIAS);
    LAS float* wsf = (LAS float*)(lds + AT_WSF) + wid * 32; volatile LAS unsigned* flag = (volatile LAS unsigned*)(lds + AT_FLAG);
    if (tid < 3) flag[tid] = 0u;
    float m = -INFINITY, lsum = 0.f; f32x16 o0 = {}, o1 = {};
    u32x4 kreg, vreg; float breg = 0.f, bnx = 0.f;
    int j = qb * 4 + 3;
    { kreg = *(const u32x4*)(Kg + (size_t)(64 * j + srow) * LDB); vreg = *(const u32x4*)(Vg + (size_t)(64 * j + srow) * LDB);
      if (tid < 64) breg = (ref - (cumh[64 * j + tid] + offL[j])) * L2E; bnx = j > 0 ? (ref - (cumh[64 * j - 1] + offL[j - 1])) * L2E : 0.f; }
    const int q4 = (lane & 15) >> 2, p4 = lane & 3, blk = (lane >> 4) & 1;
    const int qrow = q0 + wid * 32 + r32;
    int it = 0;
    __syncthreads();
    for (;;) {
        *(LAS u32x4*)(Ks + srow * 144 + sch * 16) = kreg; *(LAS u32x4*)(Vs + srow * 144 + sch * 16) = vreg; if (tid < 64) biasL[tid] = breg;
        const float bnx_cur = bnx;
        __syncthreads();
        if (j > 0) { const int jn = j - 1;
            kreg = *(const u32x4*)(Kg + (size_t)(64 * jn + srow) * LDB); vreg = *(const u32x4*)(Vg + (size_t)(64 * jn + srow) * LDB);
            if (tid < 64) breg = (ref - (cumh[64 * jn + tid] + offL[jn])) * L2E; bnx = jn > 0 ? (ref - (cumh[64 * jn - 1] + offL[jn - 1])) * L2E : 0.f; }
        if (64 * j <= q0 + 32 * wid + 31) {
            f32x16 p0 = {}, p1 = {};
#pragma unroll
            for (int d0 = 0; d0 < 4; ++d0) {
                const bf16x8 k0 = *(const LAS bf16x8*)(Ks + r32 * 144 + d0 * 32 + hi * 16);
                const bf16x8 k1 = *(const LAS bf16x8*)(Ks + (32 + r32) * 144 + d0 * 32 + hi * 16);
                p0 = __builtin_amdgcn_mfma_f32_32x32x16_bf16(k0, qr[d0], p0, 0, 0, 0);
                p1 = __builtin_amdgcn_mfma_f32_32x32x16_bf16(k1, qr[d0], p1, 0, 0, 0); }
#pragma unroll
            for (int g = 0; g < 4; ++g) { const f32x4 b0 = *(const LAS f32x4*)(biasL + 8 * g + 4 * hi), b1 = *(const LAS f32x4*)(biasL + 32 + 8 * g + 4 * hi);
#pragma unroll
                for (int e = 0; e < 4; ++e) { p0[4 * g + e] += b0[e]; p1[4 * g + e] += b1[e]; } }
            if (64 * j + 63 > q0 + 32 * wid) {
#pragma unroll
                for (int r = 0; r < 16; ++r) { const int kv = 64 * j + crow(r, hi); if (kv > qrow) p0[r] = -INFINITY; if (kv + 32 > qrow) p1[r] = -INFINITY; } }
            float mx = fmaxf(p0[0], p1[0]);
#pragma unroll
            for (int r = 1; r < 16; ++r) mx = fmaxf(mx, fmaxf(p0[r], p1[r]));
            mx = fmaxf(mx, __shfl_xor(mx, 32));
            const float mnew = fmaxf(m, mx); const float f = __builtin_amdgcn_exp2f(m - mnew); m = mnew;
            float rs = 0.f;
#pragma unroll
            for (int r = 0; r < 16; ++r) { p0[r] = __builtin_amdgcn_exp2f(p0[r] - mnew); p1[r] = __builtin_amdgcn_exp2f(p1[r] - mnew); rs += p0[r] + p1[r]; }
            lsum = lsum * f + rs;
            if (__any(f != 1.f)) {
                if (hi == 0) wsf[r32] = f;
                asm volatile("s_waitcnt lgkmcnt(0)" ::: "memory");
#pragma unroll
                for (int r = 0; r < 16; ++r) { const float fr = wsf[crow(r, hi)]; o0[r] *= fr; o1[r] *= fr; }
            }
            u32x4 pw[4];
            pw[0] = (u32x4){cvtpk(p0[0], p0[1]), cvtpk(p0[2], p0[3]), cvtpk(p0[4], p0[5]), cvtpk(p0[6], p0[7])};
            pw[1] = (u32x4){cvtpk(p0[8], p0[9]), cvtpk(p0[10], p0[11]), cvtpk(p0[12], p0[13]), cvtpk(p0[14], p0[15])};
            pw[2] = (u32x4){cvtpk(p1[0], p1[1]), cvtpk(p1[2], p1[3]), cvtpk(p1[4], p1[5]), cvtpk(p1[6], p1[7])};
            pw[3] = (u32x4){cvtpk(p1[8], p1[9]), cvtpk(p1[10], p1[11]), cvtpk(p1[12], p1[13]), cvtpk(p1[14], p1[15])};
#pragma unroll
            for (int s = 0; s < 4; ++s) { const int kvb = 16 * (s & 1) + 32 * (s >> 1);
                const LAS unsigned char* va = Vs + (kvb + 4 * hi + q4) * 144 + (16 * blk + 4 * p4) * 2;
                const s16x4 l0 = vtr(va), h0 = vtr(va + 8 * 144), l1 = vtr(va + 64), h1 = vtr(va + 8 * 144 + 64);
                const bf16x8 vf0 = {l0[0], l0[1], l0[2], l0[3], h0[0], h0[1], h0[2], h0[3]}, vf1 = {l1[0], l1[1], l1[2], l1[3], h1[0], h1[1], h1[2], h1[3]};
                const bf16x8 pa = __builtin_bit_cast(bf16x8, pw[s]);
                o0 = __builtin_amdgcn_mfma_f32_32x32x16_bf16(pa, vf0, o0, 0, 0, 0);
                o1 = __builtin_amdgcn_mfma_f32_32x32x16_bf16(pa, vf1, o1, 0, 0, 0); }
        }
        if (j == 0) break;
        const bool need = (qbound + bnx_cur > m - 40.f);
        if (tid == 0) flag[(it + 1) % 3] = 0u;
        if (__any(need) && lane == 0) flag[it % 3] = 1u;
        __syncthreads();
        const unsigned cont = flag[it % 3];
        if (!cont) break;
        --j; ++it;
    }
    lsum += __shfl_xor(lsum, 32);
    if (hi == 0) wsf[r32] = 1.f / lsum;
    asm volatile("s_waitcnt lgkmcnt(0)" ::: "memory");
    bf16* Ow = (bf16*)(a.ws + WS_YM) + (rowbase + q0 + wid * 32) * D + 512 + h * 64 + r32;
    const bf16* Gw = PB + (rowbase + q0 + wid * 32) * LDB + 2048 + h * 64 + r32;
#pragma unroll
    for (int r = 0; r < 16; ++r) { const float inv = wsf[crow(r, hi)]; bf16* op = Ow + (size_t)crow(r, hi) * D; const bf16* gp = Gw + (size_t)crow(r, hi) * LDB;
        op[0] = (bf16)f2bf(o0[r] * inv * bf2f(gp[0])); op[32] = (bf16)f2bf(o1[r] * inv * bf2f(gp[32])); }
    __syncthreads();
}
__device__ __forceinline__ void p3a_phase(const Args& a, LAS unsigned char* lds, int l, int tid, int lane, int wave) {
    unsigned* ctr = (unsigned*)(a.ws + WS_CTL) + CW_QUEUE + 64 * l;
    volatile LAS unsigned* task = (volatile LAS unsigned*)(lds + AT_TASK);
    for (;;) {
        __syncthreads();
        if (tid == 0) task[0] = atomicAdd(ctr, 1u);
        __syncthreads();
        const unsigned tk = task[0];
        if (tk >= 240u + 1024u) break;
        int t2 = tid; asm volatile("" : "+v"(t2)); const int lane2 = t2 & 63;
        if (tk < 240u) { scan_task<false>(a, lds, (int)(tk / 15u), (int)(tk % 15u), t2, lane2, wave, (unsigned*)(a.ws + WS_CTL) + CW_QUEUE + 2048 + 64 * l + (tk / 15u), l); }
        else { const unsigned u = tk - 240u; attn_unit(a, lds, l, (int)(u & 15), 63 - (int)(u >> 4), t2, lane2, wave); }
    }
}
__device__ __forceinline__ void p3b_phase(const Args& a, LAS unsigned char* lds, int l, int tid, int lane, int wave) {
    unsigned* ctr = (unsigned*)(a.ws + WS_CTL) + CW_QUEUE + 512 + 64 * l;
    volatile LAS unsigned* task = (volatile LAS unsigned*)(lds + AT_TASK);
    for (;;) {
        __syncthreads();
        if (tid == 0) task[0] = atomicAdd(ctr, 1u);
        __syncthreads();
        const unsigned tk = task[0];
        if (tk >= 256u) break;
        scan_task<true>(a, lds, (int)(tk >> 4), (int)(tk & 15), tid, lane, wave, nullptr, l);
    }
}

__device__ __forceinline__ float red16m(float x) {
    x += __uint_as_float(__builtin_amdgcn_update_dpp(0, __float_as_uint(x), 0xB1, 0xF, 0xF, true));
    x += __uint_as_float(__builtin_amdgcn_update_dpp(0, __float_as_uint(x), 0x4E, 0xF, 0xF, true));
    x += __uint_as_float(__builtin_amdgcn_update_dpp(0, __float_as_uint(x), 0x141, 0xF, 0xF, true));
    x += __uint_as_float(__builtin_amdgcn_update_dpp(0, __float_as_uint(x), 0x140, 0xF, 0xF, true));
    return x;
}
__device__ __forceinline__ void merge_phase(const Args& a, int l, int tid, int lane, int wave, int G) {
    const float* YA = (const float*)(a.ws + WS_YA); const bf16* VS = (const bf16*)(a.ws + WS_VS); const bf16* PB = (const bf16*)(a.ws + WS_PB);
    const bf16* PVo = (const bf16*)(a.ws + WS_PV);
    const float* SCS = (const float*)(a.ws + WS_SCS); bf16* YM = (bf16*)(a.ws + WS_YM);
    const int hd = 4 * (wave & 1) + (lane >> 4), c0 = hd * 64 + 4 * (lane & 15), tsub = wave >> 1;
    const f32x4 gg = *(const f32x4*)(a.in[15] + l * 512 + c0), gb = *(const f32x4*)(a.in[16] + l * 512 + c0);
    constexpr int MT = 4;
    for (int mb = blockIdx.x * (4 * MT); mb < M; mb += G * (4 * MT)) {
        f32x4 ya[MT]; u32x2 vv[MT], g1[MT], g2[MT], yb[MT]; float rkr[MT], mean[MT], var[MT];
#pragma unroll
        for (int u = 0; u < MT; ++u) { const int m = mb + 4 * u + tsub; const int b = m >= T ? 1 : 0, t = m - b * T;
            ya[u] = *(const f32x4*)(YA + (size_t)m * 512 + c0); vv[u] = *(const u32x2*)(VS + (size_t)m * 512 + c0);
            g1[u] = *(const u32x2*)(PB + (size_t)m * LDB + 1536 + c0); g2[u] = *(const u32x2*)(PB + (size_t)m * LDB + 2048 + c0);
            yb[u] = *(const u32x2*)(PVo + (size_t)m * LDV + c0);
            rkr[u] = SCS[((size_t)(b * 8 + hd) * T + t) * 4 + 2]; }
#pragma unroll
        for (int u = 0; u < MT; ++u) mean[u] = red16m((ya[u][0] + ya[u][1]) + (ya[u][2] + ya[u][3])) * (1.f / 64.f);
#pragma unroll
        for (int u = 0; u < MT; ++u) { const f32x4 d = ya[u] - mean[u]; var[u] = red16m((d[0] * d[0] + d[1] * d[1]) + (d[2] * d[2] + d[3] * d[3])) * (1.f / 64.f); }
#pragma unroll
        for (int u = 0; u < MT; ++u) { const int m = mb + 4 * u + tsub; const float rs = rsqrtf(var[u] + GN_EPS);
            f32x4 v4 = {bflo(vv[u].x), bfhi(vv[u].x), bflo(vv[u].y), bfhi(vv[u].y)};
            f32x4 ga = {bflo(g1[u].x), bfhi(g1[u].x), bflo(g1[u].y), bfhi(g1[u].y)}, gbv = {bflo(g2[u].x), bfhi(g2[u].x), bflo(g2[u].y), bfhi(g2[u].y)};
            f32x4 y2 = {bflo(yb[u].x), bfhi(yb[u].x), bflo(yb[u].y), bfhi(yb[u].y)};
            const f32x4 yn = ((ya[u] - mean[u]) * rs * gg + gb + v4 * rkr[u]) * ga; const f32x4 yo = y2 * gbv;
            u32x2 o1 = {pk2(yn[0], yn[1]), pk2(yn[2], yn[3])}, o2 = {pk2(yo[0], yo[1]), pk2(yo[2], yo[3])};
            *(u32x2*)(YM + (size_t)m * D + c0) = o1; *(u32x2*)(YM + (size_t)m * D + 512 + c0) = o2; }
    }
}

#define XB_TMO      128
#define XB_XCNT(j)  (256  + 64 * (j))
#define XB_XSUB(j)  (1280 + 64 * (j))
#define XB_XGEN(j)  (2304 + 64 * (j))
#define XB_TOP      3328
#define XB_TOPGEN   3392
#define XCD_BAR_WORDS 3456
#define XB_SPIN_CAP (1u << 18)

__device__ __forceinline__ unsigned xb_ld(unsigned* p)              { return __hip_atomic_load(p, __ATOMIC_RELAXED, __HIP_MEMORY_SCOPE_AGENT); }
__device__ __forceinline__ unsigned xb_add(unsigned* p, unsigned v) { return __hip_atomic_fetch_add(p, v, __ATOMIC_RELAXED, __HIP_MEMORY_SCOPE_AGENT); }
__device__ __forceinline__ unsigned xb_xcc_id() { return (unsigned)__builtin_amdgcn_s_getreg((3 << 11) | 20) & 0xFu; }
#define XB_SPIN(cond, bar) do { unsigned _sp = 0; while (cond) { __builtin_amdgcn_s_sleep(1); \
    if ((++_sp & 255u) == 0u) { if (xb_ld(&(bar)[XB_TMO])) break; if (_sp > XB_SPIN_CAP) { atomicAdd(&(bar)[XB_TMO], 1u); break; } } } } while (0)

struct XcdBarrier {
    unsigned* bar; unsigned x;
    volatile LAS unsigned* st;
};

__device__ __forceinline__ XcdBarrier xcd_barrier_post(unsigned* bar, volatile LAS unsigned* st) {
    XcdBarrier b; b.bar = bar; b.x = xb_xcc_id(); b.st = st;
    if (threadIdx.x == 0) (void)xb_add(&bar[XB_XCNT(b.x)], 1u);
    return b;
}
__device__ __forceinline__ void xcd_barrier_complete(unsigned* bar, unsigned x, unsigned& nloc, unsigned& nx) {
    const unsigned G = gridDim.x * gridDim.y * gridDim.z;
    unsigned sum, cnt, mine, sp = 0u;
    for (;;) {
        sum = 0u; cnt = 0u; mine = 0u;
#pragma unroll
        for (unsigned j = 0; j < 16; ++j) { const unsigned c = xb_ld(&bar[XB_XCNT(j)]); sum += c; cnt += (c > 0u) ? 1u : 0u; mine = (j == x) ? c : mine; }
        if (sum == G) break;
        __builtin_amdgcn_s_sleep(1);
        if ((++sp & 255u) == 0u) { if (xb_ld(&bar[XB_TMO])) break; if (sp > XB_SPIN_CAP) { atomicAdd(&bar[XB_TMO], 1u); break; } }
    }
    nloc = mine > 0u ? mine : 1u; nx = cnt > 0u ? cnt : 1u;
}

__device__ __forceinline__ void xcd_barrier(const XcdBarrier& b) {
    asm volatile("s_waitcnt vmcnt(0)" ::: "memory");
    __syncthreads();
    if (threadIdx.x == 0) {
        unsigned* bar = b.bar;
        __builtin_amdgcn_s_waitcnt(0);
        unsigned nloc = b.st[0], nx = b.st[1];
        if (nloc == 0u) { xcd_barrier_complete(bar, b.x, nloc, nx); b.st[0] = nloc; b.st[1] = nx; }
        const unsigned old = xb_add(&bar[XB_XSUB(b.x)], 1u);
        const unsigned gen = old / nloc;
        if (old + 1u == (gen + 1u) * nloc) {
            __builtin_amdgcn_fence(__ATOMIC_RELEASE, "agent");
            asm volatile("s_waitcnt vmcnt(0)" ::: "memory");
            const unsigned og = xb_add(&bar[XB_TOP], 1u);
            const unsigned tg = og / nx;
            if (og + 1u == (tg + 1u) * nx) xb_add(&bar[XB_TOPGEN], 1u);
            else XB_SPIN(xb_ld(&bar[XB_TOPGEN]) == tg, bar);
            __builtin_amdgcn_fence(__ATOMIC_ACQUIRE, "agent");
            xb_add(&bar[XB_XGEN(b.x)], 1u);
            asm volatile("s_waitcnt vmcnt(0)" ::: "memory");
        } else {
            XB_SPIN(xb_ld(&bar[XB_XGEN(b.x)]) == gen, bar);
            __builtin_amdgcn_fence(__ATOMIC_ACQUIRE, "agent");
            asm volatile("s_waitcnt vmcnt(0)" ::: "memory");
        }
    }
    __syncthreads();
}

#ifndef N_LAUNCH_MODE
#define N_LAUNCH_MODE 1
#endif
template <int MASK, bool COOP> __device__ __forceinline__ void run_phases(const Args& a, LAS unsigned char* lds, int l0, int l1) {
    const int G = gridDim.x;
#define LAUNDER() int tid = threadIdx.x; asm volatile("" : "+v"(tid)); const int lane = tid & 63, wave = __builtin_amdgcn_readfirstlane(tid >> 6); (void)lane; (void)wave
    float* hbuf = a.out;
    const float* mod = (const float*)(a.ws + WS_CTL) + CW_MOD;
    bf16* XN = (bf16*)(a.ws + WS_XN);
    XcdBarrier xbar; xbar.bar = nullptr; xbar.x = 0; xbar.st = nullptr;
    if constexpr (COOP) {
        volatile LAS unsigned* st = (volatile LAS unsigned*)(lds + 140128);
        if (threadIdx.x < 2) st[threadIdx.x] = 0u;
        __syncthreads();
        xbar = xcd_barrier_post((unsigned*)(a.ws + WS_CTL) + CW_BAR, st);
    }
    int nsync = 0;
#define GSYNC() do { if constexpr (COOP) { if (nsync++ == 0) cg::this_grid().sync(); else xcd_barrier(xbar); } } while (0)
    if constexpr (MASK & 1) { LAUNDER(); p0a(a, lds, tid, lane, wave, G); GSYNC(); }
    if constexpr (MASK & 2) { LAUNDER(); ln_rows(a.in[0], a.in[2], a.in[3], hbuf, XN, mod, lane, wave, G); GSYNC(); }
#pragma unroll 1
    for (int l = l0; l < l1; ++l) {
        for (int rep = 0; rep < ((PROBE_REP & 4) ? 2 : 1); ++rep)
        if constexpr (MASK & 4) { pg8::Gemm g{XN, (const bf16*)(a.ws + WS_WIN) + (size_t)l * NPROJ * 1024, M, NPROJ, 1024}; pg8::StaticOrder S; S.init(M, NPROJ, G, (int)blockIdx.x);
          EpiProj E{(bf16*)(a.ws + WS_PA), (bf16*)(a.ws + WS_PV), (bf16*)(a.ws + WS_PB)};
          pg8::gemm_phase<EpiProj, pg8::StaticOrder, true, true>(lds, g, S, E); GSYNC(); }
        for (int rep = 0; rep < ((PROBE_REP & 8) ? 2 : 1); ++rep)
        if constexpr (MASK & 8) { LAUNDER(); prep_phase(a, lds, l, tid, lane, wave, G); GSYNC(); }
        if constexpr (MASK & 16) { { LAUNDER(); p3a_phase(a, lds, l, tid, lane, wave); } GSYNC(); { LAUNDER(); p3b_phase(a, lds, l, tid, lane, wave); } GSYNC(); }
        if constexpr (MASK & 64) { pg8::Gemm g{(const bf16*)(a.ws + WS_YM), (const bf16*)(a.ws + WS_WOUT) + (size_t)l * 1024 * 1024, M, D, D}; pg8::StaticOrder S; S.init(M, D, G, (int)blockIdx.x);
          EpiOut E{hbuf, mod + l * 2 * 3072};
          pg8::gemm_phase<EpiOut, pg8::StaticOrder, true, true>(lds, g, S, E); GSYNC(); }
        if constexpr (MASK & 128) { LAUNDER(); ln_rows(hbuf, a.in[19] + l * D, a.in[20] + l * D, hbuf, XN, (l + 1 < DEPTH) ? mod + (l + 1) * 2 * 3072 : nullptr, lane, wave, G);
          if (l + 1 < l1) GSYNC(); }
    }
#undef GSYNC
#undef LAUNDER
}
#ifndef FMASK
#define FMASK 0xFF
#endif
#if N_LAUNCH_MODE == 1
__global__ void __launch_bounds__(512, 2) hymba_fwd(Args a) {
    extern __shared__ __attribute__((aligned(16))) unsigned char lds_raw[];
    run_phases<FMASK, true>(a, (LAS unsigned char*)lds_raw, 0, DEPTH);
}
#else
template <int MASK> __global__ void __launch_bounds__(512, 2) hymba_phase(Args a, int l) {
    extern __shared__ __attribute__((aligned(16))) unsigned char lds_raw[];
    run_phases<MASK, false>(a, (LAS unsigned char*)lds_raw, l, l + 1);
}
template <int MASK> static void launch_phase(const Args& a, int l, hipStream_t stream) {
    static bool attr = false;
    if (!attr) { (void)hipFuncSetAttribute((const void*)hymba_phase<MASK>, hipFuncAttributeMaxDynamicSharedMemorySize, LDS_BYTES); attr = true; }
    hipLaunchKernelGGL(hymba_phase<MASK>, dim3(256), dim3(512), LDS_BYTES, stream, a, l);
}
#endif

extern "C" void kernel_launch(void* const* d_in, const int* in_sizes, int n_in, void* d_out, int out_size, void* d_ws, size_t ws_size, hipStream_t stream) {
    if (n_in != 21 || ws_size < WS_END) { fprintf(stderr, "kernel_launch: unexpected n_in %d / ws %zu\n", n_in, ws_size); return; }
    (void)hipMemsetAsync((char*)d_ws + WS_CTL, 0, CTL_ZERO_BYTES, stream);
    Args a{};
    for (int i = 0; i < 21; ++i) a.in[i] = (const float*)d_in[i];
    a.out = (float*)d_out; a.ws = (unsigned char*)d_ws;
#if N_LAUNCH_MODE == 1
    static int grid = 0;
    if (grid == 0) {
        int dev = 0, cus = 0, per_cu = 0;
        (void)hipGetDevice(&dev); (void)hipDeviceGetAttribute(&cus, hipDeviceAttributeMultiprocessorCount, dev);
        (void)hipFuncSetAttribute((const void*)hymba_fwd, hipFuncAttributeMaxDynamicSharedMemorySize, LDS_BYTES);
        (void)hipOccupancyMaxActiveBlocksPerMultiprocessor(&per_cu, (const void*)hymba_fwd, 512, LDS_BYTES);
        if (per_cu < 1) per_cu = 1;
        (void)hipGetLastError();
        grid = cus * per_cu;
    }
    void* args[] = {&a};
    hipError_t e = hipLaunchCooperativeKernel((const void*)hymba_fwd, dim3(grid), dim3(512), args, LDS_BYTES, stream);
    if (e != hipSuccess) fprintf(stderr, "cooperative launch failed: %s (grid %d)\n", hipGetErrorString(e), grid);
#else
    launch_phase<1>(a, 0, stream); launch_phase<2>(a, 0, stream);
    for (int l = 0; l < DEPTH; ++l) { launch_phase<4>(a, l, stream); launch_phase<8>(a, l, stream); launch_phase<16>(a, l, stream); launch_phase<32>(a, l, stream); launch_phase<64>(a, l, stream); launch_phase<128>(a, l, stream); }
#endif
}
```

```cpp
#include <hip/hip_runtime.h>
#include <cstdio>
#include <cstdint>
namespace pg8 {
#define PG8_LAS __attribute__((address_space(3)))
typedef unsigned short bf16_t;
typedef short bf16x8 __attribute__((ext_vector_type(8)));
typedef float f32x4 __attribute__((ext_vector_type(4)));
typedef unsigned u32x4 __attribute__((ext_vector_type(4)));
constexpr int BM = 256, BK = 64, HALF = 128, HTB = HALF * BK * 2  , STAGE_BYTES = 8 * HTB, NXCD = 8, WGM = 8;

__host__ __device__ __forceinline__ int lds_byte(int r, int c) { const int st = (r >> 4) * 2 + (c >> 5), rr = r & 15, cc = c & 31, ob = rr * 64 + cc * 2; return st * 1024 + (ob ^ (((ob >> 9) & 1) << 5)); }
__host__ __device__ __forceinline__ void stage_rc(int b, int& R, int& C) { const int st = b / 1024, sb = b % 1024, swz = sb ^ (((sb >> 9) & 1) << 5); R = (st >> 1) * 16 + swz / 64; C = (st & 1) * 32 + (swz % 64) / 2; }
__host__ __device__ __forceinline__ int perm32(int rho) { const int n = rho >> 4, i = rho & 15; return 8 * (i >> 2) + 4 * n + (i & 3); }

struct Unit { int pm, pn; };
struct Gemm { const bf16_t* A; const bf16_t* Bt; int M, N, K; };

struct StaticOrder {
    int nM, nN, nwg, G, c;
    __host__ __device__ void init(int M, int N, int G_, int c_) { nM = M / BM; nN = N / BM; nwg = nM * nN; G = G_; c = c_; }
    __host__ __device__ bool next(int i, Unit& u) const {
        const long L = (long)i * G + c; if (L >= nwg) return false;
        int wgid = (int)L; { const int q = nwg / NXCD, r = nwg % NXCD, xcd = wgid % NXCD, off = wgid / NXCD; wgid = (xcd < r ? xcd * (q + 1) : r * (q + 1) + (xcd - r) * q) + off; }
        const int nig = WGM * nN, gid = wgid / nig, fm = gid * WGM, gsz = (nM - fm) < WGM ? (nM - fm) : WGM;
        u.pm = fm + ((wgid % nig) % gsz); u.pn = (wgid % nig) / gsz; return true;
    }
    __device__ __forceinline__ void a_ready(const Unit&) const {}
    __device__ __forceinline__ void done(const Unit&) const {}
};

__device__ __forceinline__ unsigned cvt_pk_bf16(float lo, float hi) { unsigned r; asm volatile("v_cvt_pk_bf16_f32 %0, %1, %2" : "=v"(r) : "v"(lo), "v"(hi)); return r; }
typedef float f32x2 __attribute__((ext_vector_type(2)));
__device__ __forceinline__ f32x2 gelu_pk(f32x2 v) {
    const f32x2 av = __builtin_elementwise_abs(v), d = av * 0.2316418882f + 1.0f;
    f32x2 t; t.x = __builtin_amdgcn_rcpf(d.x); t.y = __builtin_amdgcn_rcpf(d.y);
    f32x2 q = t * 0.5307027145f + (-0.7265760135f); q = q * t + 0.7107068705f; q = q * t + (-0.142248368f); q = q * t + 0.127414796f; q = q * t;
    const f32x2 s = (v * v) * (-0.72134752044f);
    f32x2 e; e.x = __builtin_amdgcn_exp2f(s.x); e.y = __builtin_amdgcn_exp2f(s.y);
    const f32x2 m = v * (q * e), r = v - m;
    f32x2 o; o.x = v.x < 0.f ? m.x : r.x; o.y = v.y < 0.f ? m.y : r.y; return o;
}

template <int ACT  > struct EpiBf16 {
    static constexpr bool PERM = true, AFTER_DRAIN = false; static_assert(ACT == 0 || ACT == 1, "EpiBf16: ACT is 0 (none) or 1 (gelu_pk)");
    bf16_t* O; int ldc; const float* bias; int split_cols; size_t split_stride; float scale0;
    __device__ __forceinline__ void operator()(const f32x4 (&acc)[2][2][4][2], const Unit& u, int wr, int wc, int fr, int fq) const {
        const int row0 = u.pm * BM + wr * 64 + fr; int colt = u.pn * BM; bf16_t* base = O;
        float sc = 1.f; if (split_cols) { const int t = colt / split_cols; base += (size_t)t * split_stride; colt -= t * split_cols; if (t == 0) sc = scale0; }
        const int col0 = colt + wc * 32 + 8 * fq, bcol0 = u.pn * BM + wc * 32 + 8 * fq;
        f32x4 bv[2][2];
#pragma unroll
        for (int bj = 0; bj < 2; ++bj)
#pragma unroll
            for (int n = 0; n < 2; ++n) bv[bj][n] = bias ? *(const f32x4*)(bias + bcol0 + bj * HALF + 4 * n) : (f32x4){0.f, 0.f, 0.f, 0.f};
#pragma unroll
        for (int ai = 0; ai < 2; ++ai)
#pragma unroll
            for (int m = 0; m < 4; ++m) { bf16_t* rowp = base + (size_t)(row0 + ai * HALF + m * 16) * ldc + col0;
#pragma unroll
                for (int bj = 0; bj < 2; ++bj) { f32x4 v0 = acc[ai][bj][m][0] + bv[bj][0], v1 = acc[ai][bj][m][1] + bv[bj][1];
                    if (ACT == 1) { f32x2 a = gelu_pk((f32x2){v0[0], v0[1]}), b = gelu_pk((f32x2){v0[2], v0[3]}), c = gelu_pk((f32x2){v1[0], v1[1]}), d = gelu_pk((f32x2){v1[2], v1[3]});
                        v0 = (f32x4){a.x, a.y, b.x, b.y}; v1 = (f32x4){c.x, c.y, d.x, d.y}; }
                    v0 = v0 * sc; v1 = v1 * sc; u32x4 w; w.x = cvt_pk_bf16(v0[0], v0[1]); w.y = cvt_pk_bf16(v0[2], v0[3]); w.z = cvt_pk_bf16(v1[0], v1[1]); w.w = cvt_pk_bf16(v1[2], v1[3]);
                    *(u32x4*)(rowp + bj * HALF) = w; } }
    }
};

template <class Epi, class Sched, bool ALIGN_EPI = false, bool SP2 = false>
__device__ __forceinline__ void gemm_phase(PG8_LAS unsigned char* lds, const Gemm g, const Sched& S, const Epi& E) {
    int tid = threadIdx.x; asm volatile("" : "+v"(tid));
    const int wid = __builtin_amdgcn_readfirstlane(tid >> 6), lane = tid & 63, wr = wid >> 2, wc = wid & 3, fr = lane & 15, fq = lane >> 4;
    const int K = g.K, nt = K / BK;
    unsigned voffA[2], voffB[2];
#pragma unroll
    for (int i = 0; i < 2; ++i) { int R, C; stage_rc(tid * 16 + i * 8192, R, C); const int Rb = Epi::PERM ? ((R & ~31) + perm32(R & 31)) : R;
        voffA[i] = (unsigned)(R * K + C) * 2u; voffB[i] = (unsigned)(Rb * K + C) * 2u; }
    const size_t kstep = (size_t)(BK * 2);
    const size_t hstep = (size_t)HALF * K * 2;
    const size_t tstep = 2 * hstep;
    const unsigned ldsw = (unsigned)wid * 1024u;
    const int aoff = lds_byte(wr * 64 + fr, fq * 8), boff = lds_byte(wc * 32 + fr, fq * 8);
#define PG8_SA(b, h) (((b) * 2 + (h)) * HTB)
#define PG8_SB(b, h) ((4 + (b) * 2 + (h)) * HTB)
#define PG8_STAGE(bufoff, gbase, voff) do { _Pragma("unroll") for (int _i = 0; _i < 2; ++_i) \
        __builtin_amdgcn_global_load_lds((const unsigned*)((const char*)(gbase) + (voff)[_i]), (PG8_LAS unsigned*)(lds + (bufoff) + ldsw + _i * 8192), 16, 0, 0); } while (0)
#define PG8_LDA(dst, b, h) do { _Pragma("unroll") for (int m = 0; m < 4; ++m) _Pragma("unroll") for (int k = 0; k < 2; ++k) dst[m][k] = *(const PG8_LAS bf16x8*)(lds + PG8_SA(b, h) + aoff + m * 2048 + k * 1024); } while (0)
#define PG8_LDB(dst, b, h) do { _Pragma("unroll") for (int n = 0; n < 2; ++n) _Pragma("unroll") for (int k = 0; k < 2; ++k) dst[n][k] = *(const PG8_LAS bf16x8*)(lds + PG8_SB(b, h) + boff + n * 2048 + k * 1024); } while (0)
#define PG8_MMA(ai, bj, At, Bt) do { __builtin_amdgcn_s_setprio(1); _Pragma("unroll") for (int m = 0; m < 4; ++m) _Pragma("unroll") for (int n = 0; n < 2; ++n) _Pragma("unroll") for (int k = 0; k < 2; ++k) \
        acc[ai][bj][m][n] = __builtin_amdgcn_mfma_f32_16x16x32_bf16(Bt[n][k], At[m][k], acc[ai][bj][m][n], 0, 0, 0); __builtin_amdgcn_s_setprio(0); } while (0)
#define PG8_WAIT_V(n) asm volatile("s_waitcnt vmcnt(" #n ")" ::: "memory")
#define PG8_WAIT_L(n) asm volatile("s_waitcnt lgkmcnt(" #n ")" ::: "memory")
#define PG8_BAR __builtin_amdgcn_s_barrier()
#define PG8_SCHED __builtin_amdgcn_sched_barrier(0)
    Unit cur, nxt; int ui = 0;
    if (!S.next(0, cur)) return;
    f32x4 acc[2][2][4][2];
#pragma unroll
    for (int a = 0; a < 2; ++a)
#pragma unroll
        for (int b = 0; b < 2; ++b)
#pragma unroll
            for (int m = 0; m < 4; ++m)
#pragma unroll
                for (int n = 0; n < 2; ++n) acc[a][b][m][n] = (f32x4){0.f, 0.f, 0.f, 0.f};
    bf16x8 At[4][2], B0[2][2], B1[2][2];
    const char* cA = (const char*)g.A + (size_t)cur.pm * tstep; const char* cB = (const char*)g.Bt + (size_t)cur.pn * tstep;
    S.a_ready(cur);
    if constexpr (SP2) {
        PG8_STAGE(PG8_SB(0, 0), cB, voffB); PG8_STAGE(PG8_SB(0, 1), cB + hstep, voffB); PG8_STAGE(PG8_SA(0, 0), cA, voffA); PG8_STAGE(PG8_SA(0, 1), cA + hstep, voffA);
        if (wr == 1) PG8_BAR;
        PG8_WAIT_V(2); PG8_BAR;
        PG8_STAGE(PG8_SB(1, 0), cB + kstep, voffB); PG8_STAGE(PG8_SA(1, 0), cA + kstep, voffA); PG8_STAGE(PG8_SB(1, 1), cB + hstep + kstep, voffB);
        PG8_WAIT_V(6); PG8_BAR;
    } else {
        PG8_STAGE(PG8_SB(0, 0), cB, voffB); PG8_STAGE(PG8_SA(0, 0), cA, voffA); PG8_STAGE(PG8_SB(0, 1), cB + hstep, voffB); PG8_STAGE(PG8_SA(0, 1), cA + hstep, voffA);
        if (wr == 1) PG8_BAR;
        PG8_WAIT_V(4); PG8_BAR;
        PG8_STAGE(PG8_SB(1, 0), cB + kstep, voffB); PG8_STAGE(PG8_SA(1, 0), cA + kstep, voffA); PG8_STAGE(PG8_SB(1, 1), cB + hstep + kstep, voffB);
        PG8_WAIT_V(6); PG8_BAR;
    }
    for (;;) {
        const bool has_next = S.next(ui + 1, nxt);
        const char* nA = has_next ? (const char*)g.A + (size_t)nxt.pm * tstep : cA; const char* nB = has_next ? (const char*)g.Bt + (size_t)nxt.pn * tstep : cB;
        for (int t = 0; t < nt; t += 2) {
            const bool last = (t == nt - 2);
            const char* a1 = cA + (size_t)(t + 1) * kstep;
            const char* a2 = last ? nA : cA + (size_t)(t + 2) * kstep; const char* b2 = last ? nB : cB + (size_t)(t + 2) * kstep;
            const char* a3 = a2 + kstep; const char* b3 = b2 + kstep;
            if (last && has_next) S.a_ready(nxt);
            if constexpr (SP2) {
            PG8_LDB(B0, 0, 0); PG8_LDB(B1, 0, 1); PG8_SCHED; PG8_LDA(At, 0, 0); PG8_STAGE(PG8_SA(1, 1), a1 + hstep, voffA);
            PG8_WAIT_V(8); PG8_WAIT_L(0); PG8_BAR; PG8_MMA(0, 0, At, B0); PG8_MMA(0, 1, At, B1); PG8_BAR; PG8_SCHED;
            PG8_LDA(At, 0, 1); PG8_STAGE(PG8_SB(0, 0), b2, voffB); PG8_STAGE(PG8_SB(0, 1), b2 + hstep, voffB); PG8_STAGE(PG8_SA(0, 0), a2, voffA);
            PG8_WAIT_V(8); PG8_WAIT_L(0); PG8_BAR; PG8_MMA(1, 0, At, B0); PG8_MMA(1, 1, At, B1); PG8_BAR; PG8_SCHED;
            PG8_LDB(B0, 1, 0); PG8_LDB(B1, 1, 1); PG8_SCHED; PG8_LDA(At, 1, 0); PG8_STAGE(PG8_SA(0, 1), a2 + hstep, voffA);
            PG8_WAIT_V(8); PG8_WAIT_L(0); PG8_BAR; PG8_MMA(0, 0, At, B0); PG8_MMA(0, 1, At, B1); PG8_BAR; PG8_SCHED;
            PG8_LDA(At, 1, 1); PG8_STAGE(PG8_SB(1, 0), b3, voffB); PG8_STAGE(PG8_SB(1, 1), b3 + hstep, voffB); PG8_STAGE(PG8_SA(1, 0), a3, voffA);
            PG8_WAIT_V(8); PG8_WAIT_L(0); PG8_BAR; PG8_MMA(1, 0, At, B0); PG8_MMA(1, 1, At, B1); PG8_BAR; PG8_SCHED;
            } else {
            PG8_LDB(B0, 0, 0); PG8_SCHED; PG8_LDA(At, 0, 0); PG8_STAGE(PG8_SA(1, 1), a1 + hstep, voffA);
            PG8_WAIT_L(8); PG8_BAR; PG8_WAIT_L(0); PG8_MMA(0, 0, At, B0); PG8_BAR; PG8_SCHED;
            PG8_LDB(B1, 0, 1); PG8_STAGE(PG8_SB(0, 0), b2, voffB);
            PG8_BAR; PG8_WAIT_L(0); PG8_MMA(0, 1, At, B1); PG8_BAR;
            PG8_LDA(At, 0, 1); PG8_STAGE(PG8_SA(0, 0), a2, voffA);
            PG8_BAR; PG8_WAIT_L(0); PG8_MMA(1, 0, At, B0); PG8_BAR; PG8_SCHED;
            PG8_STAGE(PG8_SB(0, 1), b2 + hstep, voffB);
            PG8_WAIT_V(6); PG8_BAR; PG8_MMA(1, 1, At, B1); PG8_BAR;
            PG8_LDB(B0, 1, 0); PG8_SCHED; PG8_LDA(At, 1, 0); PG8_STAGE(PG8_SA(0, 1), a2 + hstep, voffA);
            PG8_WAIT_L(8); PG8_BAR; PG8_WAIT_L(0); PG8_MMA(0, 0, At, B0); PG8_BAR; PG8_SCHED;
            PG8_LDB(B1, 1, 1); PG8_STAGE(PG8_SB(1, 0), b3, voffB);
            PG8_BAR; PG8_WAIT_L(0); PG8_MMA(0, 1, At, B1); PG8_BAR;
            PG8_LDA(At, 1, 1); PG8_STAGE(PG8_SA(1, 0), a3, voffA);
            PG8_BAR; PG8_WAIT_L(0); PG8_MMA(1, 0, At, B0); PG8_BAR; PG8_SCHED;
            PG8_STAGE(PG8_SB(1, 1), b3 + hstep, voffB);
            PG8_WAIT_V(6); PG8_BAR; PG8_MMA(1, 1, At, B1); PG8_BAR;
            }
        }
        if constexpr (ALIGN_EPI) { if (wr == 0) PG8_BAR; }
        if constexpr (!Epi::AFTER_DRAIN) { E(acc, cur, wr, wc, fr, fq); S.done(cur); }
        if (!has_next) break;
#pragma unroll
        for (int a = 0; a < 2; ++a)
#pragma unroll
            for (int b = 0; b < 2; ++b)
#pragma unroll
                for (int m = 0; m < 4; ++m)
#pragma unroll
                    for (int n = 0; n < 2; ++n) acc[a][b][m][n] = (f32x4){0.f, 0.f, 0.f, 0.f};
        cur = nxt; cA = nA; cB = nB; ++ui;
        if constexpr (ALIGN_EPI) { if (wr == 1) PG8_BAR; }
    }
    PG8_WAIT_V(0);
    if constexpr (!ALIGN_EPI) { if (wr == 0) PG8_BAR; }
    PG8_BAR;
    if constexpr (Epi::AFTER_DRAIN) { E.fused(acc, cur, wr, wc, fr, fq, lds, wid, lane); S.done(cur); }
#undef PG8_SA
#undef PG8_SB
#undef PG8_STAGE
#undef PG8_LDA
#undef PG8_LDB
#undef PG8_MMA
#undef PG8_WAIT_V
#undef PG8_WAIT_L
#undef PG8_BAR
#undef PG8_SCHED
}
}
#include <hip/hip_cooperative_groups.h>
namespace cg = cooperative_groups;
#define LAS __attribute__((address_space(3)))
typedef unsigned short bf16;
typedef float f32x4 __attribute__((ext_vector_type(4)));
typedef float f32x2 __attribute__((ext_vector_type(2)));
typedef float f32x16 __attribute__((ext_vector_type(16)));
typedef short bf16x8 __attribute__((ext_vector_type(8)));
typedef short s16x4 __attribute__((ext_vector_type(4)));
typedef unsigned u32x4 __attribute__((ext_vector_type(4)));
typedef unsigned u32x2 __attribute__((ext_vector_type(2)));
typedef __bf16 bf16x2_t __attribute__((ext_vector_type(2)));

constexpr int BATCH = 2, T = 16384, D = 1024, M = BATCH * T, DEPTH = 2;
constexpr int NPROJ = 4352, NSRC = 4232;
constexpr int LDA = 1280, LDV = 512, LDB = 2560;
constexpr float LN_EPS = 1e-5f, GN_EPS = 64e-5f;
constexpr float DN_ALPHA = 1.41421356237f;
constexpr float C2 = 0.125f * 1.4426950408889634f;
constexpr float L2E = 1.4426950408889634f;
constexpr size_t MiB = 1u << 20;
constexpr size_t WS_CTL = 0, CTL_ZERO_BYTES = 1 * MiB;
constexpr size_t WS_WIN = 2 * MiB, WS_WOUT = 20 * MiB, WS_CUM = 24 * MiB, WS_SCS = 25 * MiB, WS_SCN = 30 * MiB;
constexpr size_t WS_XN = WS_SCN;
constexpr size_t WS_CSUM = 29 * MiB + 512 * 1024;
constexpr size_t WS_LORA = 29 * MiB;
constexpr size_t WS_PA = 190 * MiB, WS_YA = WS_PA, WS_YM = WS_PA  , WS_PV = 270 * MiB, WS_PB = 302 * MiB, WS_VS = 462 * MiB, WS_FS = 494 * MiB, WS_SI = 502 * MiB, WS_END = 506 * MiB;
constexpr int CW_QUEUE = 64;
constexpr int CW_KMAX = 1024;
constexpr int CW_BAR = 4096;
constexpr int CW_MOD = 16384;
constexpr int LDS_BYTES = 147456;
#ifndef PROBE_REP
#define PROBE_REP 0
#endif

__device__ __forceinline__ unsigned f2bf(float f) { unsigned u = __builtin_bit_cast(unsigned, f); return (u + 0x7fffu + ((u >> 16) & 1u)) >> 16; }
__device__ __forceinline__ unsigned pk2(float lo, float hi) { return f2bf(lo) | (f2bf(hi) << 16); }
__device__ __forceinline__ float bf2f(unsigned short v) { return __uint_as_float(((unsigned)v) << 16); }
__device__ __forceinline__ float bflo(unsigned w) { return __uint_as_float(w << 16); }
__device__ __forceinline__ float bfhi(unsigned w) { return __uint_as_float(w & 0xffff0000u); }
__device__ __forceinline__ unsigned cvtpk(float lo, float hi) { f32x2 v = {lo, hi}; bf16x2_t b = __builtin_convertvector(v, bf16x2_t); return __builtin_bit_cast(unsigned, b); }
__device__ __forceinline__ float row16_sum(float x) {
    x += __uint_as_float(__builtin_amdgcn_update_dpp(0, __float_as_uint(x), 0xB1, 0xF, 0xF, true));
    x += __uint_as_float(__builtin_amdgcn_update_dpp(0, __float_as_uint(x), 0x4E, 0xF, 0xF, true));
    x += __uint_as_float(__builtin_amdgcn_update_dpp(0, __float_as_uint(x), 0x141, 0xF, 0xF, true));
    x += __uint_as_float(__builtin_amdgcn_update_dpp(0, __float_as_uint(x), 0x140, 0xF, 0xF, true));
    return x;
}
__device__ __forceinline__ float wave_sum(float v) { v = row16_sum(v); v += __shfl_xor(v, 16); v += __shfl_xor(v, 32); return v; }
__device__ __forceinline__ float fast_sigmoid(float x) { return __builtin_amdgcn_rcpf(1.f + __expf(-x)); }

struct Args { const float* in[21]; float* out; unsigned char* ws; };

struct EpiProj {
    static constexpr bool PERM = true, AFTER_DRAIN = false;
    bf16 *PA, *PVb, *PB;
    __device__ __forceinline__ void operator()(const pg8::f32x4 (&acc)[2][2][4][2], const pg8::Unit& u, int wr, int wc, int fr, int fq) const {
        const int row0 = u.pm * 256 + wr * 64 + fr; const int pn = u.pn;
        bf16* base; int ldc, colt; float sc = 1.f; bool act = false;
        if (pn < 4) { base = PA; ldc = LDA; colt = pn * 256; }
        else if (pn < 6) { base = PVb; ldc = LDV; colt = (pn - 4) * 256; }
        else if (pn == 6) { base = PA; ldc = LDA; colt = 1024; }
        else { base = PB; ldc = LDB; colt = (pn - 7) * 256; if (pn < 9) sc = C2; if (pn >= 13) act = true; }
        const int col0 = colt + wc * 32 + 8 * fq;
#pragma unroll
        for (int ai = 0; ai < 2; ++ai)
#pragma unroll
            for (int m = 0; m < 4; ++m) { bf16* rowp = base + (size_t)(row0 + ai * 128 + m * 16) * ldc + col0;
#pragma unroll
                for (int bj = 0; bj < 2; ++bj) { pg8::f32x4 v0 = acc[ai][bj][m][0], v1 = acc[ai][bj][m][1];
                    if (act) {
#pragma unroll
                        for (int e = 0; e < 4; ++e) { v0[e] = v0[e] * fast_sigmoid(v0[e]); v1[e] = v1[e] * fast_sigmoid(v1[e]); } }
                    v0 = v0 * sc; v1 = v1 * sc; u32x4 w; w.x = cvtpk(v0[0], v0[1]); w.y = cvtpk(v0[2], v0[3]); w.z = cvtpk(v1[0], v1[1]); w.w = cvtpk(v1[2], v1[3]);
                    *(u32x4*)(rowp + bj * 128) = w; } }
    }
};
struct EpiOut {
    static constexpr bool PERM = false, AFTER_DRAIN = false;
    float* hz; const float* modl;
    __device__ __forceinline__ void operator()(const pg8::f32x4 (&acc)[2][2][4][2], const pg8::Unit& u, int wr, int wc, int fr, int fq) const {
        const int col0 = u.pn * 256 + wc * 32 + 4 * fq; const int b = (u.pm * 256) >= T ? 1 : 0; const float* gate = modl + b * 3072 + 2048;
#pragma unroll
        for (int bj = 0; bj < 2; ++bj)
#pragma unroll
            for (int n = 0; n < 2; ++n) { const int c = col0 + bj * 128 + n * 16; const f32x4 g = *(const f32x4*)(gate + c) + 1.0f;
#pragma unroll
                for (int ai = 0; ai < 2; ++ai)
#pragma unroll
                    for (int m = 0; m < 4; ++m) { const int r = u.pm * 256 + ai * 128 + wr * 64 + m * 16 + fr; float* p = hz + (size_t)r * D + c;
                        const f32x4 hx = *(const f32x4*)p; f32x4 a; a[0] = acc[ai][bj][m][n][0]; a[1] = acc[ai][bj][m][n][1]; a[2] = acc[ai][bj][m][n][2]; a[3] = acc[ai][bj][m][n][3];
                        *(f32x4*)p = hx * DN_ALPHA + g * a; } }
    }
};

__device__ __forceinline__ int win_map(int n) { if (n < 1664) return n; if (n < 1672) return 3200 + n - 1664; if (n < 1792) return -1; if (n < 3328) return n - 128; return n - 120; }
template <bool MAP> __device__ __forceinline__ void transpose_item(const float* W, int Nsrc, int Ndst, bf16* WT, LAS float* scr, int item, int lane) {
    const int nblk = Ndst / 32, kb = item / nblk, nb = item % nblk, k0 = 64 * kb, n0 = 32 * nb;
    const int src = MAP ? win_map(n0 + (lane & 31)) : n0 + (lane & 31);
#pragma unroll 8
    for (int i = 0; i < 32; ++i) { const int kk = 2 * i + (lane >> 5); scr[kk * 33 + (lane & 31)] = src >= 0 ? W[(size_t)(k0 + kk) * Nsrc + src] : 0.f; }
    asm volatile("s_waitcnt lgkmcnt(0)" ::: "memory");
    const int c = lane & 7;
#pragma unroll
    for (int j = 0; j < 4; ++j) { const int n = (lane >> 3) + 8 * j; const LAS float* s = scr + (8 * c) * 33 + n;
        u32x4 o; o.x = pk2(s[0 * 33], s[1 * 33]); o.y = pk2(s[2 * 33], s[3 * 33]); o.z = pk2(s[4 * 33], s[5 * 33]); o.w = pk2(s[6 * 33], s[7 * 33]);
        *(u32x4*)(WT + (size_t)(n0 + n) * 1024 + k0 + 8 * c) = o; }
    asm volatile("s_waitcnt lgkmcnt(0)" ::: "memory");
}
__device__ __forceinline__ void p0a(const Args& a, LAS unsigned char* lds, int tid, int lane, int wave, int G) {
    LAS float* scr = (LAS float*)(lds + wave * 16384);
    const int gw = blockIdx.x * 8 + wave, NGW = G * 8;
    constexpr int I_IN = 16 * (NPROJ / 32), I_OUT = 16 * 32;
    for (int it = gw; it < 2 * (I_IN + I_OUT); it += NGW) {
        int r = it; const int l = r / (I_IN + I_OUT); r -= l * (I_IN + I_OUT);
        if (r < I_IN) transpose_item<true>(a.in[6] + (size_t)l * 1024 * NSRC, NSRC, NPROJ, (bf16*)(a.ws + WS_WIN) + (size_t)l * NPROJ * 1024, scr, r, lane);
        else transpose_item<false>(a.in[18] + (size_t)l * 1024 * 1024, 1024, 1024, (bf16*)(a.ws + WS_WOUT) + (size_t)l * 1024 * 1024, scr, r - I_IN, lane);
    }
    { bf16* LT = (bf16*)(a.ws + WS_LORA);
      for (int w = blockIdx.x * 512 + tid; w < 2 * 2 * 512 * 64; w += G * 512) { const int k = w & 63, n = (w >> 6) & 511, which = (w >> 15) & 1, l = w >> 16;
          const float* src = (which ? a.in[11] : a.in[9]) + (size_t)l * 64 * 512; LT[w] = (bf16)f2bf(src[k * 512 + n]); } }
    float* mod = (float*)(a.ws + WS_CTL) + CW_MOD;
    const float* cvec = a.in[1];
    for (int w = blockIdx.x * 512 + tid; w < 2 * 16 * 3072; w += G * 512) {
        const int j = w % 3072, sl = (w / 3072) % 16, l = w / (3072 * 16);
        const float* wa = a.in[4] + (size_t)l * 1024 * 3072 + (size_t)(sl * 64) * 3072 + j;
        float s0 = 0.f, s1 = 0.f;
#pragma unroll 8
        for (int i = 0; i < 64; ++i) { const float wv = wa[(size_t)i * 3072]; s0 += cvec[sl * 64 + i] * wv; s1 += cvec[1024 + sl * 64 + i] * wv; }
        if (sl == 0) { const float bb = a.in[5][l * 3072 + j]; s0 += bb; s1 += bb; }
        atomicAdd(mod + (l * 2 + 0) * 3072 + j, s0); atomicAdd(mod + (l * 2 + 1) * 3072 + j, s1);
    }
}
__device__ __forceinline__ void ln_rows(const float* src, const float* g, const float* bb, float* dst, bf16* xn, const float* modn, int lane, int wave, int G) {
    const int gw = blockIdx.x * 8 + wave, NGW = G * 8;
    f32x4 gv[4], bv[4];
#pragma unroll
    for (int j = 0; j < 4; ++j) { gv[j] = ((const f32x4*)g)[lane + 64 * j]; bv[j] = ((const f32x4*)bb)[lane + 64 * j]; }
    for (int m0 = gw * 2; m0 < M; m0 += NGW * 2) {
        f32x4 v[2][4]; float s[2], s2[2];
#pragma unroll
        for (int u = 0; u < 2; ++u) { const f32x4* xr = (const f32x4*)(src + (size_t)(m0 + u) * D) + lane; s[u] = 0.f;
#pragma unroll
            for (int j = 0; j < 4; ++j) { v[u][j] = xr[64 * j]; s[u] += (v[u][j].x + v[u][j].y) + (v[u][j].z + v[u][j].w); } }
#pragma unroll
        for (int u = 0; u < 2; ++u) s[u] = row16_sum(s[u]);
#pragma unroll
        for (int o = 16; o < 64; o <<= 1) {
#pragma unroll
            for (int u = 0; u < 2; ++u) s[u] += __shfl_xor(s[u], o); }
#pragma unroll
        for (int u = 0; u < 2; ++u) { const float mean = s[u] * (1.f / D); s2[u] = 0.f;
#pragma unroll
            for (int j = 0; j < 4; ++j) { v[u][j] = v[u][j] - mean; s2[u] += (v[u][j].x * v[u][j].x + v[u][j].y * v[u][j].y) + (v[u][j].z * v[u][j].z + v[u][j].w * v[u][j].w); } }
#pragma unroll
        for (int u = 0; u < 2; ++u) s2[u] = row16_sum(s2[u]);
#pragma unroll
        for (int o = 16; o < 64; o <<= 1) {
#pragma unroll
            for (int u = 0; u < 2; ++u) s2[u] += __shfl_xor(s2[u], o); }
#pragma unroll
        for (int u = 0; u < 2; ++u) { const int m = m0 + u;
            const float rstd = 1.f / sqrtf(s2[u] * (1.f / D) + LN_EPS);
            f32x4* o = (f32x4*)(dst + (size_t)m * D) + lane;
            const int b = m >= T ? 1 : 0;
#pragma unroll
            for (int j = 0; j < 4; ++j) { const f32x4 hv = v[u][j] * rstd * gv[j] + bv[j]; o[64 * j] = hv;
                if (modn) { const f32x4 sh = ((const f32x4*)(modn + b * 3072))[lane + 64 * j], sc = ((const f32x4*)(modn + b * 3072 + 1024))[lane + 64 * j];
                    const f32x4 y = hv * (sc + 1.0f) + sh; u32x2 w; w.x = pk2(y.x, y.y); w.y = pk2(y.z, y.w);
                    *((u32x2*)(xn + (size_t)m * D) + lane + 64 * j) = w; } } }
    }
}
__device__ __forceinline__ int crow(int r, int hi) { return (r & 3) + 8 * (r >> 2) + 4 * hi; }
__device__ __forceinline__ float tanh_fast(float x) { const float e = __expf(2.f * x); return 1.f - 2.f * __builtin_amdgcn_rcpf(e + 1.f); }
__device__ __forceinline__ void cum_kmax(const Args& a, LAS unsigned char* lds, int l, int bh, int tid, int lane, int wave) {
    const int b = bh >> 3, h = bh & 7;
    const bf16* PA = (const bf16*)(a.ws + WS_PA); const bf16* PB = (const bf16*)(a.ws + WS_PB);
    float* cum = (float*)(a.ws + WS_CUM) + (size_t)bh * T;
    const float bf = a.in[17][l * 8 + h];
    LAS float* red = (LAS float*)lds;
    const int t0 = tid * 32;
    float s = 0.f, kmx = 0.f;
#pragma unroll 1
    for (int i = 0; i < 32; ++i) { const size_t m = (size_t)b * T + t0 + i;
        const float z = bf2f(PA[m * LDA + 1152 + h]) + bf;
        const float lf = fminf(z, 0.f) - log1pf(__expf(-fabsf(z)));
        s += lf; cum[t0 + i] = s;
        const u32x4* kr = (const u32x4*)(PB + m * LDB + 512 + h * 64); float q = 0.f;
#pragma unroll
        for (int c = 0; c < 8; ++c) { const u32x4 w = kr[c];
            q += bflo(w.x) * bflo(w.x) + bfhi(w.x) * bfhi(w.x) + bflo(w.y) * bflo(w.y) + bfhi(w.y) * bfhi(w.y) + bflo(w.z) * bflo(w.z) + bfhi(w.z) * bfhi(w.z) + bflo(w.w) * bflo(w.w) + bfhi(w.w) * bfhi(w.w); }
        kmx = fmaxf(kmx, q); }
    red[tid] = s;
#pragma unroll
    for (int o = 1; o < 64; o <<= 1) kmx = fmaxf(kmx, __shfl_xor(kmx, o));
    if (lane == 0) red[512 + wave] = kmx;
    __syncthreads();
    if (tid == 0) { float run = 0.f; for (int i = 0; i < 512; ++i) { const float v = red[i]; red[i] = run; run += v; }
        float k = 0.f; for (int i = 0; i < 8; ++i) k = fmaxf(k, red[512 + i]);
        ((float*)(a.ws + WS_CTL))[CW_KMAX + 16 * l + bh] = sqrtf(k); }
    __syncthreads();
    const float off = red[tid];
#pragma unroll 1
    for (int i = 0; i < 32; ++i) cum[t0 + i] += off;
    __syncthreads();
}
__device__ __forceinline__ void prep_phase(const Args& a, LAS unsigned char* lds, int l, int tid, int lane, int wave, int G) {
    const bf16* PA = (const bf16*)(a.ws + WS_PA); const bf16* PV = (const bf16*)(a.ws + WS_PV);
    bf16* SCN = (bf16*)(a.ws + WS_SCN); float* SCS = (float*)(a.ws + WS_SCS); bf16* VS = (bf16*)(a.ws + WS_VS);
    LAS unsigned char* lowL = lds;
    LAS bf16* CL = (LAS bf16*)(lds + 16384);
    const int c = tid, h = wave, r32 = lane & 31, hi = lane >> 5;
    const bf16* LT = (const bf16*)(a.ws + WS_LORA) + (size_t)l * 2 * 512 * 64;
    const float* mix = a.in[7] + l * 1664;
    const int qc = tid & 127, tsel = tid >> 7, c4 = 4 * qc, hq = qc >> 4;
    const f32x4 mix_r = *(const f32x4*)(mix + c4), mix_k = *(const f32x4*)(mix + 512 + c4), mix_v = *(const f32x4*)(mix + 1024 + c4);
    const int ftok = tid >> 3, fi0 = (tid & 7) * 16;
    f32x4 mlow[4];
#pragma unroll
    for (int q = 0; q < 4; ++q) mlow[q] = *(const f32x4*)(mix + 1536 + fi0 + 4 * q);
    const f32x4 w0c = *(const f32x4*)(a.in[8] + l * 512 + c4), a0c = *(const f32x4*)(a.in[10] + l * 512 + c4), kkc = *(const f32x4*)(a.in[12] + l * 512 + c4), kac = *(const f32x4*)(a.in[13] + l * 512 + c4), rkc = *(const f32x4*)(a.in[14] + l * 512 + c4);
    unsigned* pq = (unsigned*)(a.ws + WS_CTL) + CW_QUEUE + 1024 + 64 * l;
    volatile LAS unsigned* ptask = (volatile LAS unsigned*)(lds + 140000);
    for (;;) {
        __syncthreads();
        if (tid == 0) ptask[0] = atomicAdd(pq, 1u);
        __syncthreads();
        const unsigned ptk = ptask[0];
        if (ptk >= (unsigned)(M / 64)) break;
        const int chunk = (int)ptk;
        const int m0 = chunk * 64, b = m0 >= T ? 1 : 0, t0 = m0 - b * T; const int bh = b * 8 + h;
        LAS float* lfL = (LAS float*)(lds + 81920); LAS float* kqL = (LAS float*)(lds + 83968);
        { const int tkn = tid >> 3, hd = tid & 7; const size_t m = (size_t)m0 + tkn;
          const float z = bf2f(PA[m * LDA + 1152 + hd]) + a.in[17][l * 8 + hd];
          lfL[hd * 64 + tkn] = fminf(z, 0.f) - __logf(1.f + __expf(-fabsf(z)));
          const u32x4* kr = (const u32x4*)((const bf16*)(a.ws + WS_PB) + m * LDB + 512 + hd * 64); float q = 0.f;
#pragma unroll
          for (int cc = 0; cc < 8; ++cc) { const u32x4 w = kr[cc];
              q += bflo(w.x) * bflo(w.x) + bfhi(w.x) * bfhi(w.x) + bflo(w.y) * bflo(w.y) + bfhi(w.y) * bfhi(w.y) + bflo(w.z) * bflo(w.z) + bfhi(w.z) * bfhi(w.z) + bflo(w.w) * bflo(w.w) + bfhi(w.w) * bfhi(w.w); }
          kqL[hd * 64 + tkn] = q; }
        { const int m = m0 + ftok, t = t0 + ftok;
          const u32x4* cp = (const u32x4*)(PA + (size_t)m * LDA + 1024 + fi0);
          const u32x4 c0 = cp[0], c1 = cp[1]; u32x4 p0 = {0u, 0u, 0u, 0u}, p1 = p0;
          if (t > 0) { const u32x4* pp = (const u32x4*)(PA + (size_t)(m - 1) * LDA + 1024 + fi0); p0 = pp[0]; p1 = pp[1]; }
          float cur[16], prv[16];
          cur[0] = bflo(c0.x); cur[1] = bfhi(c0.x); cur[2] = bflo(c0.y); cur[3] = bfhi(c0.y); cur[4] = bflo(c0.z); cur[5] = bfhi(c0.z); cur[6] = bflo(c0.w); cur[7] = bfhi(c0.w);
          cur[8] = bflo(c1.x); cur[9] = bfhi(c1.x); cur[10] = bflo(c1.y); cur[11] = bfhi(c1.y); cur[12] = bflo(c1.z); cur[13] = bfhi(c1.z); cur[14] = bflo(c1.w); cur[15] = bfhi(c1.w);
          prv[0] = bflo(p0.x); prv[1] = bfhi(p0.x); prv[2] = bflo(p0.y); prv[3] = bfhi(p0.y); prv[4] = bflo(p0.z); prv[5] = bfhi(p0.z); prv[6] = bflo(p0.w); prv[7] = bfhi(p0.w);
          prv[8] = bflo(p1.x); prv[9] = bfhi(p1.x); prv[10] = bflo(p1.y); prv[11] = bfhi(p1.y); prv[12] = bflo(p1.z); prv[13] = bfhi(p1.z); prv[14] = bflo(p1.w); prv[15] = bfhi(p1.w);
#pragma unroll
          for (int q = 0; q < 16; ++q) { float val = cur[q] + (prv[q] - cur[q]) * mlow[q >> 2][q & 3]; if (fi0 < 64) val = tanh_fast(val); cur[q] = val; }
          u32x4 o0 = {cvtpk(cur[0], cur[1]), cvtpk(cur[2], cur[3]), cvtpk(cur[4], cur[5]), cvtpk(cur[6], cur[7])};
          u32x4 o1 = {cvtpk(cur[8], cur[9]), cvtpk(cur[10], cur[11]), cvtpk(cur[12], cur[13]), cvtpk(cur[14], cur[15])};
          const int ch = 2 * (tid & 7);
          *(LAS u32x4*)(lowL + ftok * 256 + ((ch ^ (ftok & 7)) << 4)) = o0; *(LAS u32x4*)(lowL + ftok * 256 + (((ch + 1) ^ (ftok & 7)) << 4)) = o1; }
        __syncthreads();
        if (tid < 8) { float run = 0.f, kmx = 0.f;
            for (int tt = 0; tt < 64; ++tt) { run += lfL[tid * 64 + tt]; lfL[tid * 64 + tt] = run; kmx = fmaxf(kmx, kqL[tid * 64 + tt]); }
            ((float*)(a.ws + WS_CSUM))[(b * 8 + tid) * 256 + (t0 >> 6)] = run;
            atomicMax((unsigned*)(a.ws + WS_CTL) + CW_KMAX + 16 * l + b * 8 + tid, __float_as_uint(sqrtf(kmx))); }
#pragma unroll 1
        for (int tr = 0; tr < 2; ++tr) {
            { f32x16 Cw0 = {}, Cw1 = {}, Ca0 = {}, Ca1 = {};
              const int trow = 32 * tr + r32;
              bf16x8 Bw[2][4], Ba[2][4];
#pragma unroll
              for (int tc = 0; tc < 2; ++tc)
#pragma unroll
                for (int sx = 0; sx < 4; ++sx) { const int n = 64 * h + 32 * tc + r32;
                    Bw[tc][sx] = __builtin_bit_cast(bf16x8, *(const u32x4*)(LT + (size_t)n * 64 + 16 * sx + 8 * hi));
                    Ba[tc][sx] = __builtin_bit_cast(bf16x8, *(const u32x4*)(LT + 512 * 64 + (size_t)n * 64 + 16 * sx + 8 * hi)); }
#pragma unroll
              for (int sx = 0; sx < 4; ++sx) {
                  const bf16x8 Aw = *(const LAS bf16x8*)(lowL + trow * 256 + (((2 * sx + hi) ^ (trow & 7)) << 4));
                  const bf16x8 Aa = *(const LAS bf16x8*)(lowL + trow * 256 + (((8 + 2 * sx + hi) ^ (trow & 7)) << 4));
                  Cw0 = __builtin_amdgcn_mfma_f32_32x32x16_bf16(Aw, Bw[0][sx], Cw0, 0, 0, 0); Cw1 = __builtin_amdgcn_mfma_f32_32x32x16_bf16(Aw, Bw[1][sx], Cw1, 0, 0, 0);
                  Ca0 = __builtin_amdgcn_mfma_f32_32x32x16_bf16(Aa, Ba[0][sx], Ca0, 0, 0, 0); Ca1 = __builtin_amdgcn_mfma_f32_32x32x16_bf16(Aa, Ba[1][sx], Ca1, 0, 0, 0); }
#pragma unroll
              for (int r = 0; r < 16; ++r) { LAS bf16* row = CL + crow(r, hi) * 1024 + 64 * h + r32;
                  row[0] = (bf16)f2bf(Cw0[r]); row[32] = (bf16)f2bf(Cw1[r]); row[512] = (bf16)f2bf(Ca0[r]); row[544] = (bf16)f2bf(Ca1[r]); } }
            __syncthreads();
#define UNP4(dst, u2) do { dst[0] = bflo(u2.x); dst[1] = bfhi(u2.x); dst[2] = bflo(u2.y); dst[3] = bfhi(u2.y); } while (0)
#pragma unroll 1
            for (int g = 0; g < 4; ++g) {
                const int tl0 = g * 8 + 2 * tsel, mg = m0 + 32 * tr + tl0, tg = t0 + 32 * tr + tl0;
                u32x2 rr_[3], rk_[3], rv_[3];
#pragma unroll
                for (int u = 0; u < 3; ++u) { const int m = mg - 1 + u;
                    if (u > 0 || tg > 0) { rr_[u] = *(const u32x2*)(PA + (size_t)m * LDA + c4); rk_[u] = *(const u32x2*)(PA + (size_t)m * LDA + 512 + c4); rv_[u] = *(const u32x2*)(PV + (size_t)m * LDV + c4); }
                    else { rr_[u] = (u32x2){0u, 0u}; rk_[u] = rr_[u]; rv_[u] = rr_[u]; } }
                f32x4 fr[3], fk[3], fv[3];
#pragma unroll
                for (int u = 0; u < 3; ++u) { UNP4(fr[u], rr_[u]); UNP4(fk[u], rk_[u]); UNP4(fv[u], rv_[u]); }
                f32x4 r4[2], kkr[2], kp[2], vv[2], av[2], omw[2]; float red[8];
#pragma unroll
                for (int u = 0; u < 2; ++u) {
                    r4[u] = fr[u + 1] + (fr[u] - fr[u + 1]) * mix_r; const f32x4 k4 = fk[u + 1] + (fk[u] - fk[u + 1]) * mix_k; vv[u] = fv[u + 1] + (fv[u] - fv[u + 1]) * mix_v;
                    const u32x2 cw = *(const LAS u32x2*)(CL + (tl0 + u) * 1024 + c4), ca = *(const LAS u32x2*)(CL + (tl0 + u) * 1024 + 512 + c4);
                    f32x4 wl, al; UNP4(wl, cw); UNP4(al, ca); wl = wl + w0c; al = al + a0c;
#pragma unroll
                    for (int e = 0; e < 4; ++e) { const float z = -wl[e]; const float sp = fmaxf(z, 0.f) + __logf(1.f + __expf(-fabsf(z)));
                        const float ee = __expf(-sp - 0.5f); omw[u][e] = 1.f - __expf(-ee); av[u][e] = fast_sigmoid(al[e]); }
                    kkr[u] = k4 * kkc; kp[u] = k4 * ((av[u] - 1.0f) * kac + 1.0f);
                    const f32x4 q0 = kkr[u] * kkr[u], q1 = kkr[u] * av[u] * r4[u], q2 = kp[u] * r4[u], q3 = r4[u] * kp[u] * rkc;
                    red[u] = (q0[0] + q0[1]) + (q0[2] + q0[3]); red[2 + u] = (q1[0] + q1[1]) + (q1[2] + q1[3]); red[4 + u] = (q2[0] + q2[1]) + (q2[2] + q2[3]); red[6 + u] = (q3[0] + q3[1]) + (q3[2] + q3[3]);
                }
#pragma unroll
                for (int i = 0; i < 8; ++i) red[i] = row16_sum(red[i]);
#pragma unroll
                for (int u = 0; u < 2; ++u) {
                    const float inv = 1.f / fmaxf(sqrtf(red[u]), 1e-12f);
                    const f32x4 kk = kkr[u] * inv, bbv = kk * av[u], wr = (1.0f - omw[u]) * r4[u];
                    const int bhq = b * 8 + hq;
                    bf16* rec = SCN + ((size_t)bhq * T + tg + u) * 320 + (c4 & 63);
                    *(u32x2*)(rec) = (u32x2){pk2(kk[0], kk[1]), pk2(kk[2], kk[3])}; *(u32x2*)(rec + 64) = (u32x2){pk2(wr[0], wr[1]), pk2(wr[2], wr[3])};
                    *(u32x2*)(rec + 128) = (u32x2){pk2(omw[u][0], omw[u][1]), pk2(omw[u][2], omw[u][3])}; *(u32x2*)(rec + 192) = (u32x2){pk2(bbv[0], bbv[1]), pk2(bbv[2], bbv[3])};
                    *(u32x2*)(rec + 256) = (u32x2){pk2(kp[u][0], kp[u][1]), pk2(kp[u][2], kp[u][3])};
                    *(u32x2*)(VS + (size_t)(mg + u) * 512 + c4) = (u32x2){pk2(vv[u][0], vv[u][1]), pk2(vv[u][2], vv[u][3])};
                    if ((lane & 15) == 0) { f32x4 sc = {red[2 + u] * inv, red[4 + u], red[6 + u], 0.f}; *(f32x4*)(SCS + ((size_t)bhq * T + tg + u) * 4) = sc; }
                }
            }
#undef UNP4
            __syncthreads();
        }
        { const int tkn = tid >> 3, hd = tid & 7; ((float*)(a.ws + WS_CUM))[(size_t)(b * 8 + hd) * T + t0 + tkn] = lfL[hd * 64 + tkn]; }
    }
    __syncthreads();
}

__device__ __forceinline__ float dppf(float x, const int ctrl_sel) {
    unsigned u = __float_as_uint(x), r;
    if (ctrl_sel == 0) r = __builtin_amdgcn_update_dpp(0, u, 0xB1, 0xF, 0xF, true);
    else if (ctrl_sel == 1) r = __builtin_amdgcn_update_dpp(0, u, 0x4E, 0xF, 0xF, true);
    else r = __builtin_amdgcn_update_dpp(0, u, 0x141, 0xF, 0xF, true);
    return __uint_as_float(r);
}
__device__ __forceinline__ float red8(float x) { x += dppf(x, 0); x += dppf(x, 1); x += dppf(x, 2); return x; }
constexpr int SC_CH = 32, SC_STEP = 1024, SC_BUF = SC_CH * SC_STEP, SC_VOFF = 2 * SC_BUF, SC_SOFF = SC_VOFF + 2 * SC_CH * 64 * 4, SC_ROWB = SC_SOFF + 2 * SC_CH * 16;
constexpr int NSEG = 16, SEGLEN = T / NSEG;
typedef float f32x4m __attribute__((ext_vector_type(4)));
template <bool PASSC> __device__ __forceinline__ void scan_task(const Args& a, LAS unsigned char* lds, int bh, int seg, int tid, int lane, int wave, unsigned* cntp, int lq_l) {
    const int b = bh >> 3, h = bh & 7;
    const int t0 = seg * SEGLEN;
    const bf16* SCN = (const bf16*)(a.ws + WS_SCN) + ((size_t)bh * T + t0) * 320;
    const float* SCS = (const float*)(a.ws + WS_SCS) + ((size_t)bh * T + t0) * 4;
    const bf16* VS = (const bf16*)(a.ws + WS_VS) + ((size_t)b * T + t0) * 512 + h * 64;
    float* YA = (float*)(a.ws + WS_YA) + ((size_t)b * T + t0) * 512 + h * 64;
    float* FSb = (float*)(a.ws + WS_FS) + (size_t)bh * NSEG * 128 * 64;
    constexpr int NCH = SEGLEN / SC_CH;
    const int n16 = lane & 15, g = lane >> 4;
    const bool ident = !PASSC && wave >= 4;
    const bool active = PASSC ? (wave < 4) : true;
    const int row = 16 * (wave & 3) + n16;
    f32x4 Sf[4];
#pragma unroll
    for (int i = 0; i < 4; ++i) Sf[i] = (f32x4){0.f, 0.f, 0.f, 0.f};
    __syncthreads();
    if constexpr (PASSC) {
        if (active && seg > 0) { const float* SIp = (const float*)(a.ws + WS_SI) + ((size_t)(bh * NSEG + seg) * 64 + row) * 64 + 4 * g;
#pragma unroll
            for (int t4 = 0; t4 < 4; ++t4) Sf[t4] = *(const f32x4*)(SIp + 16 * t4); }
    } else if (ident) {
#pragma unroll
        for (int i = 0; i < 4; ++i)
#pragma unroll
            for (int e = 0; e < 4; ++e) Sf[i][e] = (16 * i + 4 * g + e == row) ? 1.f : 0.f;
    }
    u32x4 mreg[2], breg, kreg; u32x4 vreg = {0u, 0u, 0u, 0u}; f32x4 sreg;
    auto gload = [&](int c) {
        const u32x4* src = (const u32x4*)(SCN + (size_t)c * SC_CH * 320);
        { const int st = tid / 24, q = tid - st * 24; mreg[0] = src[st * 40 + q]; }
        if (tid < 256) { const int jj = 512 + tid, st = jj / 24, q = jj - st * 24; mreg[1] = src[st * 40 + q];
            const int s2 = tid >> 3, e8 = tid & 7; breg = src[s2 * 40 + 24 + e8]; kreg = src[s2 * 40 + 32 + e8]; }
        if (tid < 256) vreg = *(const u32x4*)(VS + (size_t)(c * SC_CH + (tid >> 3)) * 512 + (tid & 7) * 8);
        else if (tid < 288) sreg = *(const f32x4*)(SCS + (size_t)(c * SC_CH + (tid - 256)) * 4);
    };
    auto lwrite = [&](int c) {
        LAS unsigned char* bp = lds + (c & 1) * SC_BUF;
#pragma unroll
        for (int i = 0; i < 2; ++i) { const int jj = tid + 512 * i;
            if (jj < 768) { const int st = jj / 24, q = jj - st * 24, arr = q >> 3, e8 = q & 7; const u32x4 w = mreg[i];
                LAS unsigned char* d = bp + st * SC_STEP;
                if (arr < 2) { *(LAS u32x4*)(d + 256 + arr * 128 + e8 * 16) = w; }
                else { f32x4 lo, hi;
                    lo[0] = bflo(w.x); lo[1] = bfhi(w.x); lo[2] = bflo(w.y); lo[3] = bfhi(w.y); hi[0] = bflo(w.z); hi[1] = bfhi(w.z); hi[2] = bflo(w.w); hi[3] = bfhi(w.w);
                    lo = 1.0f - lo; hi = 1.0f - hi;
                    LAS f32x4* df = (LAS f32x4*)(d + e8 * 32); df[0] = lo; df[1] = hi; } } }
        if (tid < 256) { const int s2 = tid >> 3, e8 = tid & 7; LAS u32x4* d = (LAS u32x4*)(bp + s2 * SC_STEP + 512 + e8 * 64);
            const unsigned bw[4] = {breg.x, breg.y, breg.z, breg.w}, kw[4] = {kreg.x, kreg.y, kreg.z, kreg.w};
#pragma unroll
            for (int pq = 0; pq < 4; ++pq) { const unsigned blo = bw[pq] & 0xffffu, bhi = bw[pq] >> 16, klo = kw[pq] & 0xffffu, khi = kw[pq] >> 16;
                u32x4 o; o.x = klo | (blo << 16); o.y = blo; o.z = khi | (bhi << 16); o.w = bhi; d[pq] = o; } }
        if (tid < 256) { const u32x4 w = vreg; f32x4 lo, hi;
            lo[0] = bflo(w.x); lo[1] = bfhi(w.x); lo[2] = bflo(w.y); lo[3] = bfhi(w.y); hi[0] = bflo(w.z); hi[1] = bfhi(w.z); hi[2] = bflo(w.w); hi[3] = bfhi(w.w);
            LAS f32x4* d = (LAS f32x4*)(lds + SC_VOFF + (c & 1) * (SC_CH * 64 * 4) + tid * 32); d[0] = lo; d[1] = hi; }
        else if (tid < 288) { *(LAS f32x4*)(lds + SC_SOFF + (c & 1) * (SC_CH * 16) + (tid - 256) * 16) = sreg; }
    };
    gload(0); lwrite(0); gload(1);
    __syncthreads();
    LAS float* ybuf = (LAS float*)(lds + SC_ROWB + 16384);
    const int lt_ = tid - 256, ms = (lt_ >> 3) & 31, mr8 = (lt_ & 7) * 8;
    f32x4 gng0 = {}, gng1 = {}, gnb0 = {}, gnb1 = {};
    if constexpr (PASSC) { if (wave >= 4) { const float* gp = a.in[15] + lq_l * 512 + h * 64 + mr8; const float* bp2 = a.in[16] + lq_l * 512 + h * 64 + mr8;
        gng0 = *(const f32x4*)gp; gng1 = *(const f32x4*)(gp + 4); gnb0 = *(const f32x4*)bp2; gnb1 = *(const f32x4*)(bp2 + 4); } }
    auto ymerge = [&](int cc) {
        const LAS float* yp = ybuf + (cc & 1) * (SC_CH * 64) + ms * 64 + mr8;
        const f32x4 y0 = *(const LAS f32x4*)yp, y1 = *(const LAS f32x4*)(yp + 4);
        const size_t m = (size_t)b * T + t0 + cc * SC_CH + ms;
        const u32x4 vv = *(const u32x4*)((const bf16*)(a.ws + WS_VS) + m * 512 + h * 64 + mr8);
        const u32x4 gg = *(const u32x4*)((const bf16*)(a.ws + WS_PB) + m * LDB + 1536 + h * 64 + mr8);
        const float rkr = SCS[(size_t)(cc * SC_CH + ms) * 4 + 2];
        float sm = (y0[0] + y0[1]) + (y0[2] + y0[3]) + (y1[0] + y1[1]) + (y1[2] + y1[3]);
        sm += __uint_as_float(__builtin_amdgcn_update_dpp(0, __float_as_uint(sm), 0xB1, 0xF, 0xF, true));
        sm += __uint_as_float(__builtin_amdgcn_update_dpp(0, __float_as_uint(sm), 0x4E, 0xF, 0xF, true));
        sm += __uint_as_float(__builtin_amdgcn_update_dpp(0, __float_as_uint(sm), 0x141, 0xF, 0xF, true));
        const float mean = sm * (1.f / 64.f);
        const f32x4 d0 = y0 - mean, d1 = y1 - mean;
        float sv = (d0[0] * d0[0] + d0[1] * d0[1]) + (d0[2] * d0[2] + d0[3] * d0[3]) + (d1[0] * d1[0] + d1[1] * d1[1]) + (d1[2] * d1[2] + d1[3] * d1[3]);
        sv += __uint_as_float(__builtin_amdgcn_update_dpp(0, __float_as_uint(sv), 0xB1, 0xF, 0xF, true));
        sv += __uint_as_float(__builtin_amdgcn_update_dpp(0, __float_as_uint(sv), 0x4E, 0xF, 0xF, true));
        sv += __uint_as_float(__builtin_amdgcn_update_dpp(0, __float_as_uint(sv), 0x141, 0xF, 0xF, true));
        const float rs = rsqrtf(sv * (1.f / 64.f) + GN_EPS);
        const f32x4 v0 = {bflo(vv.x), bfhi(vv.x), bflo(vv.y), bfhi(vv.y)}, v1 = {bflo(vv.z), bfhi(vv.z), bflo(vv.w), bfhi(vv.w)};
        const f32x4 g0 = {bflo(gg.x), bfhi(gg.x), bflo(gg.y), bfhi(gg.y)}, g1 = {bflo(gg.z), bfhi(gg.z), bflo(gg.w), bfhi(gg.w)};
        const f32x4 o0 = (d0 * rs * gng0 + gnb0 + v0 * rkr) * g0, o1 = (d1 * rs * gng1 + gnb1 + v1 * rkr) * g1;
        u32x4 ow; ow.x = pk2(o0[0], o0[1]); ow.y = pk2(o0[2], o0[3]); ow.z = pk2(o1[0], o1[1]); ow.w = pk2(o1[2], o1[3]);
        *(u32x4*)((bf16*)(a.ws + WS_YM) + m * D + h * 64 + mr8) = ow;
    };
    for (int c = 0; c < NCH; ++c) {
        if (c + 1 < NCH) lwrite(c + 1);
        if (c + 2 < NCH) gload(c + 2);
        if constexpr (PASSC) { if (c > 0 && wave >= 4) ymerge(c - 1); }
        if (active) {
            const LAS unsigned char* bp = lds + (c & 1) * SC_BUF;
            const LAS float* vb = (const LAS float*)(lds + SC_VOFF + (c & 1) * (SC_CH * 64 * 4)) + row;
            const LAS float* sb = (const LAS float*)(lds + SC_SOFF + (c & 1) * (SC_CH * 16));
#define SC_DECL(X) u32x2 X##a0, X##a1, X##a2, X##a3, X##r0, X##r1, X##r2, X##r3; float X##v; f32x2 X##s
#define SC_LD(X, sidx) do { const LAS unsigned char* p_ = bp + (sidx) * SC_STEP + 256 + g * 8; \
                X##a0 = *(const LAS u32x2*)(p_); X##a1 = *(const LAS u32x2*)(p_ + 32); X##a2 = *(const LAS u32x2*)(p_ + 64); X##a3 = *(const LAS u32x2*)(p_ + 96); \
                if constexpr (PASSC) { X##r0 = *(const LAS u32x2*)(p_ + 128); X##r1 = *(const LAS u32x2*)(p_ + 160); X##r2 = *(const LAS u32x2*)(p_ + 192); X##r3 = *(const LAS u32x2*)(p_ + 224); X##s = *(const LAS f32x2*)(sb + (sidx) * 4); } \
                X##v = ident ? 0.f : vb[(sidx) * 64]; } while (0)
#define SC_STEPM(X, Y, sidx, ldnext) do { const LAS unsigned char* p_ = bp + (sidx) * SC_STEP; \
                const f32x4 w0_ = *(const LAS f32x4*)(p_ + g * 16), w1_ = *(const LAS f32x4*)(p_ + 64 + g * 16), w2_ = *(const LAS f32x4*)(p_ + 128 + g * 16), w3_ = *(const LAS f32x4*)(p_ + 192 + g * 16); \
                const s16x4 f0_ = *(const LAS s16x4*)(p_ + 512 + n16 * 8), f1_ = *(const LAS s16x4*)(p_ + 640 + n16 * 8), f2_ = *(const LAS s16x4*)(p_ + 768 + n16 * 8), f3_ = *(const LAS s16x4*)(p_ + 896 + n16 * 8); \
                if (ldnext) SC_LD(Y, (sidx) + 1); \
                u32x4 sb0, sb1; \
                sb0.x = cvtpk(Sf[0][0], Sf[0][1]); sb0.y = cvtpk(Sf[0][2], Sf[0][3]); sb0.z = cvtpk(Sf[1][0], Sf[1][1]); sb0.w = cvtpk(Sf[1][2], Sf[1][3]); \
                sb1.x = cvtpk(Sf[2][0], Sf[2][1]); sb1.y = cvtpk(Sf[2][2], Sf[2][3]); sb1.z = cvtpk(Sf[3][0], Sf[3][1]); sb1.w = cvtpk(Sf[3][2], Sf[3][3]); \
                const bf16x8 B0 = __builtin_bit_cast(bf16x8, sb0), B1 = __builtin_bit_cast(bf16x8, sb1); \
                const bf16x8 A0 = __builtin_bit_cast(bf16x8, (u32x4){X##a0.x, X##a0.y, X##a1.x, X##a1.y}), A1 = __builtin_bit_cast(bf16x8, (u32x4){X##a2.x, X##a2.y, X##a3.x, X##a3.y}); \
                const f32x4m z4 = {0.f, 0.f, 0.f, 0.f}; f32x4m accy0 = z4, accy1 = z4; \
                const f32x4m acc0 = __builtin_amdgcn_mfma_f32_16x16x32_bf16(A0, B0, z4, 0, 0, 0); \
                const f32x4m acc1 = __builtin_amdgcn_mfma_f32_16x16x32_bf16(A1, B1, z4, 0, 0, 0); \
                if constexpr (PASSC) { const bf16x8 R0 = __builtin_bit_cast(bf16x8, (u32x4){X##r0.x, X##r0.y, X##r1.x, X##r1.y}); accy0 = __builtin_amdgcn_mfma_f32_16x16x32_bf16(R0, B0, z4, 0, 0, 0); \
                    const bf16x8 R1 = __builtin_bit_cast(bf16x8, (u32x4){X##r2.x, X##r2.y, X##r3.x, X##r3.y}); accy1 = __builtin_amdgcn_mfma_f32_16x16x32_bf16(R1, B1, z4, 0, 0, 0); } \
                const f32x4 c0_ = Sf[0] * w0_, c1_ = Sf[1] * w1_, c2_ = Sf[2] * w2_, c3_ = Sf[3] * w3_; \
                const float sa = acc0[0] + acc1[0]; \
                u32x2 bu; bu.x = (__float_as_uint(X##v) >> 16) | (cvtpk(0.f, -sa) & 0xffff0000u); bu.y = 0u; \
                if (g != 0) { bu.x = 0u; bu.y = 0u; } \
                const s16x4 Bu = __builtin_bit_cast(s16x4, bu); \
                Sf[0] = __builtin_amdgcn_mfma_f32_16x16x16bf16_1k(f0_, Bu, c0_, 0, 0, 0); Sf[1] = __builtin_amdgcn_mfma_f32_16x16x16bf16_1k(f1_, Bu, c1_, 0, 0, 0); \
                Sf[2] = __builtin_amdgcn_mfma_f32_16x16x16bf16_1k(f2_, Bu, c2_, 0, 0, 0); Sf[3] = __builtin_amdgcn_mfma_f32_16x16x16bf16_1k(f3_, Bu, c3_, 0, 0, 0); \
                if constexpr (PASSC) { const float y = (accy0[0] + accy1[0]) - sa * X##s.x + X##v * X##s.y; ybuf[(c & 1) * (SC_CH * 64) + (sidx) * 64 + row] = y; } } while (0)
            SC_DECL(oA); SC_DECL(oB);
            SC_LD(oA, 0);
#pragma unroll 1
            for (int s = 0; s < SC_CH; s += 2) {
                SC_STEPM(oA, oB, s, true);
                __builtin_amdgcn_sched_barrier(0);
                SC_STEPM(oB, oA, s + 1, (s + 2 < SC_CH));
                __builtin_amdgcn_sched_barrier(0);
            }
#undef SC_DECL
#undef SC_LD
#undef SC_STEPM
        }
        __syncthreads();
    }
    if constexpr (PASSC) { if (wave >= 4) ymerge(NCH - 1); }
    if constexpr (!PASSC) { float* fp = FSb + ((size_t)seg * 128 + (ident ? 64 : 0) + row) * 64 + 4 * g;
#pragma unroll
        for (int t4 = 0; t4 < 4; ++t4) *(f32x4*)(fp + 16 * t4) = Sf[t4];
        volatile LAS unsigned* lastf = (volatile LAS unsigned*)(lds + 140064);
        __threadfence();
        __syncthreads();
        if (tid == 0) lastf[0] = atomicAdd(cntp, 1u);
        __syncthreads();
        if (lastf[0] == (unsigned)(NSEG - 2)) {
            __threadfence();
            LAS float* rowb = (LAS float*)(lds + SC_ROWB);
            LAS float* pbuf = (LAS float*)lds;
            float* SIb = (float*)(a.ws + WS_SI) + (size_t)bh * NSEG * 64 * 64;
            const int crow_ = tid >> 3, kq = (tid & 7) * 8;
            f32x4 c0 = {0.f, 0.f, 0.f, 0.f}, c1 = c0, pr0, pr1;
            { const float* Pk = FSb + ((size_t)0 * 128 + 64 + crow_) * 64 + kq; pr0 = __builtin_nontemporal_load((const f32x4*)Pk); pr1 = __builtin_nontemporal_load((const f32x4*)(Pk + 4)); }
            for (int k = 0; k < NSEG - 1; ++k) {
                const float* Uk = FSb + ((size_t)k * 128 + crow_) * 64 + kq;
                f32x4 a0 = __builtin_nontemporal_load((const f32x4*)Uk), a1 = __builtin_nontemporal_load((const f32x4*)(Uk + 4));
                *(LAS f32x4*)(rowb + crow_ * 64 + kq) = c0; *(LAS f32x4*)(rowb + crow_ * 64 + kq + 4) = c1;
                *(LAS f32x4*)(pbuf + crow_ * 64 + kq) = pr0; *(LAS f32x4*)(pbuf + crow_ * 64 + kq + 4) = pr1;
                __syncthreads();
                if (k + 2 < NSEG) { const float* Pn = FSb + ((size_t)(k + 1) * 128 + 64 + crow_) * 64 + kq; pr0 = __builtin_nontemporal_load((const f32x4*)Pn); pr1 = __builtin_nontemporal_load((const f32x4*)(Pn + 4)); }
                if (k > 0) {
#pragma unroll 4
                    for (int jj = 0; jj < 64; ++jj) { const float sj = rowb[crow_ * 64 + jj]; a0 += *(const LAS f32x4*)(pbuf + jj * 64 + kq) * sj; a1 += *(const LAS f32x4*)(pbuf + jj * 64 + kq + 4) * sj; } }
                c0 = a0; c1 = a1;
                float* sp_ = SIb + ((size_t)(k + 1) * 64 + crow_) * 64 + kq; *(f32x4*)sp_ = c0; *(f32x4*)(sp_ + 4) = c1;
                __syncthreads();
            }
        }
    }
}

typedef short v4i16_t __attribute__((ext_vector_type(4)));
__device__ __forceinline__ s16x4 vtr(const LAS unsigned char* p) { return __builtin_bit_cast(s16x4, __builtin_amdgcn_ds_read_tr16_b64_v4i16((LAS v4i16_t*)p)); }
constexpr int AT_KS = 0, AT_VS = 9216, AT_BIAS = 18432, AT_WSF = 18688, AT_FLAG = 19712, AT_TASK = 140000;
__device__ __forceinline__ void attn_unit(const Args& a, LAS unsigned char* lds, int l, int bh, int qb, int tid, int lane, int wid) {
    const int b = bh >> 3, h = bh & 7, r32 = lane & 31, hi = lane >> 5;
    const int q0 = qb * 256;
    bf16* PB = (bf16*)(a.ws + WS_PB);
    const float* cumh = (const float*)(a.ws + WS_CUM) + (size_t)bh * T;
    const float kmax = ((const float*)(a.ws + WS_CTL))[CW_KMAX + 16 * l + bh];
    const size_t rowbase = (size_t)b * T;
    const bf16* Qp = PB + (rowbase + q0 + wid * 32 + r32) * LDB + h * 64;
    bf16x8 qr[4]; float qs = 0.f;
#pragma unroll
    for (int d0 = 0; d0 < 4; ++d0) { const u32x4 w = *(const u32x4*)(Qp + d0 * 16 + hi * 8); qr[d0] = __builtin_bit_cast(bf16x8, w);
        qs += bflo(w.x) * bflo(w.x) + bfhi(w.x) * bfhi(w.x) + bflo(w.y) * bflo(w.y) + bfhi(w.y) * bfhi(w.y) + bflo(w.z) * bflo(w.z) + bfhi(w.z) * bfhi(w.z) + bflo(w.w) * bflo(w.w) + bfhi(w.w) * bfhi(w.w); }
    qs += __shfl_xor(qs, 32);
    const float qbound = sqrtf(qs) * kmax * 1.01f + 0.01f;
    LAS float* offL = (LAS float*)(lds + 20480);
    { __syncthreads();
      if (wid == 0) { const float* cs = (const float*)(a.ws + WS_CSUM) + bh * 256; const int ntile = qb * 4 + 4;
          f32x4 v4 = {0.f, 0.f, 0.f, 0.f};
#pragma unroll
          for (int i = 0; i < 4; ++i) if (4 * lane + i < ntile) v4[i] = cs[4 * lane + i];
          const float tot = (v4[0] + v4[1]) + (v4[2] + v4[3]); float inc = tot;
#pragma unroll
          for (int o = 1; o < 64; o <<= 1) { const float up = __shfl_up(inc, o); if (lane >= o) inc += up; }
          float ex = inc - tot;
          offL[4 * lane] = ex; ex += v4[0]; offL[4 * lane + 1] = ex; ex += v4[1]; offL[4 * lane + 2] = ex; ex += v4[2]; offL[4 * lane + 3] = ex; }
      __syncthreads(); }
    const float ref = cumh[q0 + 255] + offL[(q0 + 255) >> 6];
    const int srow = tid >> 3, sch = tid & 7;
    const bf16* Kg = PB + rowbase * LDB + 512 + h * 64 + sch * 8; const bf16* Vg = Kg + 512;
    LAS unsigned char* Ks = lds + AT_KS; LAS unsigned char* Vs = lds + AT_VS; LAS float* biasL = (LAS float*)(lds + AT_BIAS);
    LAS float* wsf = (LAS float*)(lds + AT_WSF) + wid * 32; volatile LAS unsigned* flag = (volatile LAS unsigned*)(lds + AT_FLAG);
    if (tid < 3) flag[tid] = 0u;
    float m = -INFINITY, lsum = 0.f; f32x16 o0 = {}, o1 = {};
    u32x4 kreg, vreg; float breg = 0.f, bnx = 0.f;
    int j = qb * 4 + 3;
    { kreg = *(const u32x4*)(Kg + (size_t)(64 * j + srow) * LDB); vreg = *(const u32x4*)(Vg + (size_t)(64 * j + srow) * LDB);
      if (tid < 64) breg = (ref - (cumh[64 * j + tid] + offL[j])) * L2E; bnx = j > 0 ? (ref - (cumh[64 * j - 1] + offL[j - 1])) * L2E : 0.f; }
    const int q4 = (lane & 15) >> 2, p4 = lane & 3, blk = (lane >> 4) & 1;
    const int qrow = q0 + wid * 32 + r32;
    int it = 0;
    __syncthreads();
    for (;;) {
        *(LAS u32x4*)(Ks + srow * 144 + sch * 16) = kreg; *(LAS u32x4*)(Vs + srow * 144 + sch * 16) = vreg; if (tid < 64) biasL[tid] = breg;
        const float bnx_cur = bnx;
        __syncthreads();
        if (j > 0) { const int jn = j - 1;
            kreg = *(const u32x4*)(Kg + (size_t)(64 * jn + srow) * LDB); vreg = *(const u32x4*)(Vg + (size_t)(64 * jn + srow) * LDB);
            if (tid < 64) breg = (ref - (cumh[64 * jn + tid] + offL[jn])) * L2E; bnx = jn > 0 ? (ref - (cumh[64 * jn - 1] + offL[jn - 1])) * L2E : 0.f; }
        if (64 * j <= q0 + 32 * wid + 31) {
            f32x16 p0 = {}, p1 = {};
#pragma unroll
            for (int d0 = 0; d0 < 4; ++d0) {
                const bf16x8 k0 = *(const LAS bf16x8*)(Ks + r32 * 144 + d0 * 32 + hi * 16);
                const bf16x8 k1 = *(const LAS bf16x8*)(Ks + (32 + r32) * 144 + d0 * 32 + hi * 16);
                p0 = __builtin_amdgcn_mfma_f32_32x32x16_bf16(k0, qr[d0], p0, 0, 0, 0);
                p1 = __builtin_amdgcn_mfma_f32_32x32x16_bf16(k1, qr[d0], p1, 0, 0, 0); }
#pragma unroll
            for (int g = 0; g < 4; ++g) { const f32x4 b0 = *(const LAS f32x4*)(biasL + 8 * g + 4 * hi), b1 = *(const LAS f32x4*)(biasL + 32 + 8 * g + 4 * hi);
#pragma unroll
                for (int e = 0; e < 4; ++e) { p0[4 * g + e] += b0[e]; p1[4 * g + e] += b1[e]; } }
            if (64 * j + 63 > q0 + 32 * wid) {
#pragma unroll
                for (int r = 0; r < 16; ++r) { const int kv = 64 * j + crow(r, hi); if (kv > qrow) p0[r] = -INFINITY; if (kv + 32 > qrow) p1[r] = -INFINITY; } }
            float mx = fmaxf(p0[0], p1[0]);
#pragma unroll
            for (int r = 1; r < 16; ++r) mx = fmaxf(mx, fmaxf(p0[r], p1[r]));
            mx = fmaxf(mx, __shfl_xor(mx, 32));
            const float mnew = fmaxf(m, mx); const float f = __builtin_amdgcn_exp2f(m - mnew); m = mnew;
            float rs = 0.f;
#pragma unroll
            for (int r = 0; r < 16; ++r) { p0[r] = __builtin_amdgcn_exp2f(p0[r] - mnew); p1[r] = __builtin_amdgcn_exp2f(p1[r] - mnew); rs += p0[r] + p1[r]; }
            lsum = lsum * f + rs;
            if (__any(f != 1.f)) {
                if (hi == 0) wsf[r32] = f;
                asm volatile("s_waitcnt lgkmcnt(0)" ::: "memory");
#pragma unroll
                for (int r = 0; r < 16; ++r) { const float fr = wsf[crow(r, hi)]; o0[r] *= fr; o1[r] *= fr; }
            }
            u32x4 pw[4];
            pw[0] = (u32x4){cvtpk(p0[0], p0[1]), cvtpk(p0[2], p0[3]), cvtpk(p0[4], p0[5]), cvtpk(p0[6], p0[7])};
            pw[1] = (u32x4){cvtpk(p0[8], p0[9]), cvtpk(p0[10], p0[11]), cvtpk(p0[12], p0[13]), cvtpk(p0[14], p0[15])};
            pw[2] = (u32x4){cvtpk(p1[0], p1[1]), cvtpk(p1[2], p1[3]), cvtpk(p1[4], p1[5]), cvtpk(p1[6], p1[7])};
            pw[3] = (u32x4){cvtpk(p1[8], p1[9]), cvtpk(p1[10], p1[11]), cvtpk(p1[12], p1[13]), cvtpk(p1[14], p1[15])};
#pragma unroll
            for (int s = 0; s < 4; ++s) { const int kvb = 16 * (s & 1) + 32 * (s >> 1);
                const LAS unsigned char* va = Vs + (kvb + 4 * hi + q4) * 144 + (16 * blk + 4 * p4) * 2;
                const s16x4 l0 = vtr(va), h0 = vtr(va + 8 * 144), l1 = vtr(va + 64), h1 = vtr(va + 8 * 144 + 64);
                const bf16x8 vf0 = {l0[0], l0[1], l0[2], l0[3], h0[0], h0[1], h0[2], h0[3]}, vf1 = {l1[0], l1[1], l1[2], l1[3], h1[0], h1[1], h1[2], h1[3]};
                const bf16x8 pa = __builtin_bit_cast(bf16x8, pw[s]);
                o0 = __builtin_amdgcn_mfma_f32_32x32x16_bf16(pa, vf0, o0, 0, 0, 0);
                o1 = __builtin_amdgcn_mfma_f32_32x32x16_bf16(pa, vf1, o1, 0, 0, 0); }
        }
        if (j == 0) break;
        const bool need = (qbound + bnx_cur > m - 40.f);
        if (tid == 0) flag[(it + 1) % 3] = 0u;
        if (__any(need) && lane == 0) flag[it % 3] = 1u;
        __syncthreads();
        const unsigned cont = flag[it % 3];
        if (!cont) break;
        --j; ++it;
    }
    lsum += __shfl_xor(lsum, 32);
    if (hi == 0) wsf[r32] = 1.f / lsum;
    asm volatile("s_waitcnt lgkmcnt(0)" ::: "memory");
    bf16* Ow = (bf16*)(a.ws + WS_YM) + (rowbase + q0 + wid * 32) * D + 512 + h * 64 + r32;
    const bf16* Gw = PB + (rowbase + q0 + wid * 32) * LDB + 2048 + h * 64 + r32;
#pragma unroll
    for (int r = 0; r < 16; ++r) { const float inv = wsf[crow(r, hi)]; bf16* op = Ow + (size_t)crow(r, hi) * D; const bf16* gp = Gw + (size_t)crow(r, hi) * LDB;
        op[0] = (bf16)f2bf(o0[r] * inv * bf2f(gp[0])); op[32] = (bf16)f2bf(o1[r] * inv * bf2f(gp[32])); }
    __syncthreads();
}
__device__ __forceinline__ void p3a_phase(const Args& a, LAS unsigned char* lds, int l, int tid, int lane, int wave) {
    unsigned* ctr = (unsigned*)(a.ws + WS_CTL) + CW_QUEUE + 64 * l;
    volatile LAS unsigned* task = (volatile LAS unsigned*)(lds + AT_TASK);
    for (;;) {
        __syncthreads();
        if (tid == 0) task[0] = atomicAdd(ctr, 1u);
        __syncthreads();
        const unsigned tk = task[0];
        if (tk >= 240u + 1024u) break;
        int t2 = tid; asm volatile("" : "+v"(t2)); const int lane2 = t2 & 63;
        if (tk < 240u) { scan_task<false>(a, lds, (int)(tk / 15u), (int)(tk % 15u), t2, lane2, wave, (unsigned*)(a.ws + WS_CTL) + CW_QUEUE + 2048 + 64 * l + (tk / 15u), l); }
        else { const unsigned u = tk - 240u; attn_unit(a, lds, l, (int)(u & 15), 63 - (int)(u >> 4), t2, lane2, wave); }
    }
}
__device__ __forceinline__ void p3b_phase(const Args& a, LAS unsigned char* lds, int l, int tid, int lane, int wave) {
    unsigned* ctr = (unsigned*)(a.ws + WS_CTL) + CW_QUEUE + 512 + 64 * l;
    volatile LAS unsigned* task = (volatile LAS unsigned*)(lds + AT_TASK);
    for (;;) {
        __syncthreads();
        if (tid == 0) task[0] = atomicAdd(ctr, 1u);
        __syncthreads();
        const unsigned tk = task[0];
        if (tk >= 256u) break;
        scan_task<true>(a, lds, (int)(tk >> 4), (int)(tk & 15), tid, lane, wave, nullptr, l);
    }
}

__device__ __forceinline__ float red16m(float x) {
    x += __uint_as_float(__builtin_amdgcn_update_dpp(0, __float_as_uint(x), 0xB1, 0xF, 0xF, true));
    x += __uint_as_float(__builtin_amdgcn_update_dpp(0, __float_as_uint(x), 0x4E, 0xF, 0xF, true));
    x += __uint_as_float(__builtin_amdgcn_update_dpp(0, __float_as_uint(x), 0x141, 0xF, 0xF, true));
    x += __uint_as_float(__builtin_amdgcn_update_dpp(0, __float_as_uint(x), 0x140, 0xF, 0xF, true));
    return x;
}
__device__ __forceinline__ void merge_phase(const Args& a, int l, int tid, int lane, int wave, int G) {
    const float* YA = (const float*)(a.ws + WS_YA); const bf16* VS = (const bf16*)(a.ws + WS_VS); const bf16* PB = (const bf16*)(a.ws + WS_PB);
    const bf16* PVo = (const bf16*)(a.ws + WS_PV);
    const float* SCS = (const float*)(a.ws + WS_SCS); bf16* YM = (bf16*)(a.ws + WS_YM);
    const int hd = 4 * (wave & 1) + (lane >> 4), c0 = hd * 64 + 4 * (lane & 15), tsub = wave >> 1;
    const f32x4 gg = *(const f32x4*)(a.in[15] + l * 512 + c0), gb = *(const f32x4*)(a.in[16] + l * 512 + c0);
    constexpr int MT = 4;
    for (int mb = blockIdx.x * (4 * MT); mb < M; mb += G * (4 * MT)) {
        f32x4 ya[MT]; u32x2 vv[MT], g1[MT], g2[MT], yb[MT]; float rkr[MT], mean[MT], var[MT];
#pragma unroll
        for (int u = 0; u < MT; ++u) { const int m = mb + 4 * u + tsub; const int b = m >= T ? 1 : 0, t = m - b * T;
            ya[u] = *(const f32x4*)(YA + (size_t)m * 512 + c0); vv[u] = *(const u32x2*)(VS + (size_t)m * 512 + c0);
            g1[u] = *(const u32x2*)(PB + (size_t)m * LDB + 1536 + c0); g2[u] = *(const u32x2*)(PB + (size_t)m * LDB + 2048 + c0);
            yb[u] = *(const u32x2*)(PVo + (size_t)m * LDV + c0);
            rkr[u] = SCS[((size_t)(b * 8 + hd) * T + t) * 4 + 2]; }
#pragma unroll
        for (int u = 0; u < MT; ++u) mean[u] = red16m((ya[u][0] + ya[u][1]) + (ya[u][2] + ya[u][3])) * (1.f / 64.f);
#pragma unroll
        for (int u = 0; u < MT; ++u) { const f32x4 d = ya[u] - mean[u]; var[u] = red16m((d[0] * d[0] + d[1] * d[1]) + (d[2] * d[2] + d[3] * d[3])) * (1.f / 64.f); }
#pragma unroll
        for (int u = 0; u < MT; ++u) { const int m = mb + 4 * u + tsub; const float rs = rsqrtf(var[u] + GN_EPS);
            f32x4 v4 = {bflo(vv[u].x), bfhi(vv[u].x), bflo(vv[u].y), bfhi(vv[u].y)};
            f32x4 ga = {bflo(g1[u].x), bfhi(g1[u].x), bflo(g1[u].y), bfhi(g1[u].y)}, gbv = {bflo(g2[u].x), bfhi(g2[u].x), bflo(g2[u].y), bfhi(g2[u].y)};
            f32x4 y2 = {bflo(yb[u].x), bfhi(yb[u].x), bflo(yb[u].y), bfhi(yb[u].y)};
            const f32x4 yn = ((ya[u] - mean[u]) * rs * gg + gb + v4 * rkr[u]) * ga; const f32x4 yo = y2 * gbv;
            u32x2 o1 = {pk2(yn[0], yn[1]), pk2(yn[2], yn[3])}, o2 = {pk2(yo[0], yo[1]), pk2(yo[2], yo[3])};
            *(u32x2*)(YM + (size_t)m * D + c0) = o1; *(u32x2*)(YM + (size_t)m * D + 512 + c0) = o2; }
    }
}

#define XB_TMO      128
#define XB_XCNT(j)  (256  + 64 * (j))
#define XB_XSUB(j)  (1280 + 64 * (j))
#define XB_XGEN(j)  (2304 + 64 * (j))
#define XB_TOP      3328
#define XB_TOPGEN   3392
#define XCD_BAR_WORDS 3456
#define XB_SPIN_CAP (1u << 18)

__device__ __forceinline__ unsigned xb_ld(unsigned* p)              { return __hip_atomic_load(p, __ATOMIC_RELAXED, __HIP_MEMORY_SCOPE_AGENT); }
__device__ __forceinline__ unsigned xb_add(unsigned* p, unsigned v) { return __hip_atomic_fetch_add(p, v, __ATOMIC_RELAXED, __HIP_MEMORY_SCOPE_AGENT); }
__device__ __forceinline__ unsigned xb_xcc_id() { return (unsigned)__builtin_amdgcn_s_getreg((3 << 11) | 20) & 0xFu; }
#define XB_SPIN(cond, bar) do { unsigned _sp = 0; while (cond) { __builtin_amdgcn_s_sleep(1); \
    if ((++_sp & 255u) == 0u) { if (xb_ld(&(bar)[XB_TMO])) break; if (_sp > XB_SPIN_CAP) { atomicAdd(&(bar)[XB_TMO], 1u); break; } } } } while (0)

struct XcdBarrier {
    unsigned* bar; unsigned x;
    volatile LAS unsigned* st;
};

__device__ __forceinline__ XcdBarrier xcd_barrier_post(unsigned* bar, volatile LAS unsigned* st) {
    XcdBarrier b; b.bar = bar; b.x = xb_xcc_id(); b.st = st;
    if (threadIdx.x == 0) (void)xb_add(&bar[XB_XCNT(b.x)], 1u);
    return b;
}
__device__ __forceinline__ void xcd_barrier_complete(unsigned* bar, unsigned x, unsigned& nloc, unsigned& nx) {
    const unsigned G = gridDim.x * gridDim.y * gridDim.z;
    unsigned sum, cnt, mine, sp = 0u;
    for (;;) {
        sum = 0u; cnt = 0u; mine = 0u;
#pragma unroll
        for (unsigned j = 0; j < 16; ++j) { const unsigned c = xb_ld(&bar[XB_XCNT(j)]); sum += c; cnt += (c > 0u) ? 1u : 0u; mine = (j == x) ? c : mine; }
        if (sum == G) break;
        __builtin_amdgcn_s_sleep(1);
        if ((++sp & 255u) == 0u) { if (xb_ld(&bar[XB_TMO])) break; if (sp > XB_SPIN_CAP) { atomicAdd(&bar[XB_TMO], 1u); break; } }
    }
    nloc = mine > 0u ? mine : 1u; nx = cnt > 0u ? cnt : 1u;
}

__device__ __forceinline__ void xcd_barrier(const XcdBarrier& b) {
    asm volatile("s_waitcnt vmcnt(0)" ::: "memory");
    __syncthreads();
    if (threadIdx.x == 0) {
        unsigned* bar = b.bar;
        __builtin_amdgcn_s_waitcnt(0);
        unsigned nloc = b.st[0], nx = b.st[1];
        if (nloc == 0u) { xcd_barrier_complete(bar, b.x, nloc, nx); b.st[0] = nloc; b.st[1] = nx; }
        const unsigned old = xb_add(&bar[XB_XSUB(b.x)], 1u);
        const unsigned gen = old / nloc;
        if (old + 1u == (gen + 1u) * nloc) {
            __builtin_amdgcn_fence(__ATOMIC_RELEASE, "agent");
            asm volatile("s_waitcnt vmcnt(0)" ::: "memory");
            const unsigned og = xb_add(&bar[XB_TOP], 1u);
            const unsigned tg = og / nx;
            if (og + 1u == (tg + 1u) * nx) xb_add(&bar[XB_TOPGEN], 1u);
            else XB_SPIN(xb_ld(&bar[XB_TOPGEN]) == tg, bar);
            __builtin_amdgcn_fence(__ATOMIC_ACQUIRE, "agent");
            xb_add(&bar[XB_XGEN(b.x)], 1u);
            asm volatile("s_waitcnt vmcnt(0)" ::: "memory");
        } else {
            XB_SPIN(xb_ld(&bar[XB_XGEN(b.x)]) == gen, bar);
            __builtin_amdgcn_fence(__ATOMIC_ACQUIRE, "agent");
            asm volatile("s_waitcnt vmcnt(0)" ::: "memory");
        }
    }
    __syncthreads();
}

#ifndef N_LAUNCH_MODE
#define N_LAUNCH_MODE 1
#endif
template <int MASK, bool COOP> __device__ __forceinline__ void run_phases(const Args& a, LAS unsigned char* lds, int l0, int l1) {
    const int G = gridDim.x;
#define LAUNDER() int tid = threadIdx.x; asm volatile("" : "+v"(tid)); const int lane = tid & 63, wave = __builtin_amdgcn_readfirstlane(tid >> 6); (void)lane; (void)wave
    float* hbuf = a.out;
    const float* mod = (const float*)(a.ws + WS_CTL) + CW_MOD;
    bf16* XN = (bf16*)(a.ws + WS_XN);
    XcdBarrier xbar; xbar.bar = nullptr; xbar.x = 0; xbar.st = nullptr;
    if constexpr (COOP) {
        volatile LAS unsigned* st = (volatile LAS unsigned*)(lds + 140128);
        if (threadIdx.x < 2) st[threadIdx.x] = 0u;
        __syncthreads();
        xbar = xcd_barrier_post((unsigned*)(a.ws + WS_CTL) + CW_BAR, st);
    }
    int nsync = 0;
#define GSYNC() do { if constexpr (COOP) { if (nsync++ == 0) cg::this_grid().sync(); else xcd_barrier(xbar); } } while (0)
    if constexpr (MASK & 1) { LAUNDER(); p0a(a, lds, tid, lane, wave, G); GSYNC(); }
    if constexpr (MASK & 2) { LAUNDER(); ln_rows(a.in[0], a.in[2], a.in[3], hbuf, XN, mod, lane, wave, G); GSYNC(); }
#pragma unroll 1
    for (int l = l0; l < l1; ++l) {
        for (int rep = 0; rep < ((PROBE_REP & 4) ? 2 : 1); ++rep)
        if constexpr (MASK & 4) { pg8::Gemm g{XN, (const bf16*)(a.ws + WS_WIN) + (size_t)l * NPROJ * 1024, M, NPROJ, 1024}; pg8::StaticOrder S; S.init(M, NPROJ, G, (int)blockIdx.x);
          EpiProj E{(bf16*)(a.ws + WS_PA), (bf16*)(a.ws + WS_PV), (bf16*)(a.ws + WS_PB)};
          pg8::gemm_phase<EpiProj, pg8::StaticOrder, true, true>(lds, g, S, E); GSYNC(); }
        for (int rep = 0; rep < ((PROBE_REP & 8) ? 2 : 1); ++rep)
        if constexpr (MASK & 8) { LAUNDER(); prep_phase(a, lds, l, tid, lane, wave, G); GSYNC(); }
        if constexpr (MASK & 16) { { LAUNDER(); p3a_phase(a, lds, l, tid, lane, wave); } GSYNC(); { LAUNDER(); p3b_phase(a, lds, l, tid, lane, wave); } GSYNC(); }
        if constexpr (MASK & 64) { pg8::Gemm g{(const bf16*)(a.ws + WS_YM), (const bf16*)(a.ws + WS_WOUT) + (size_t)l * 1024 * 1024, M, D, D}; pg8::StaticOrder S; S.init(M, D, G, (int)blockIdx.x);
          EpiOut E{hbuf, mod + l * 2 * 3072};
          pg8::gemm_phase<EpiOut, pg8::StaticOrder, true, true>(lds, g, S, E); GSYNC(); }
        if constexpr (MASK & 128) { LAUNDER(); ln_rows(hbuf, a.in[19] + l * D, a.in[20] + l * D, hbuf, XN, (l + 1 < DEPTH) ? mod + (l + 1) * 2 * 3072 : nullptr, lane, wave, G);
          if (l + 1 < l1) GSYNC(); }
    }
#undef GSYNC
#undef LAUNDER
}
#ifndef FMASK
#define FMASK 0xFF
#endif
#if N_LAUNCH_MODE == 1
__global__ void __launch_bounds__(512, 2) hymba_fwd(Args a) {
    extern __shared__ __attribute__((aligned(16))) unsigned char lds_raw[];
    run_phases<FMASK, true>(a, (LAS unsigned char*)lds_raw, 0, DEPTH);
}
#else
template <int MASK> __global__ void __launch_bounds__(512, 2) hymba_phase(Args a, int l) {
    extern __shared__ __attribute__((aligned(16))) unsigned char lds_raw[];
    run_phases<MASK, false>(a, (LAS unsigned char*)lds_raw, l, l + 1);
}
template <int MASK> static void launch_phase(const Args& a, int l, hipStream_t stream) {
    static bool attr = false;
    if (!attr) { (void)hipFuncSetAttribute((const void*)hymba_phase<MASK>, hipFuncAttributeMaxDynamicSharedMemorySize, LDS_BYTES); attr = true; }
    hipLaunchKernelGGL(hymba_phase<MASK>, dim3(256), dim3(512), LDS_BYTES, stream, a, l);
}
#endif

extern "C" void kernel_launch(void* const* d_in, const int* in_sizes, int n_in, void* d_out, int out_size, void* d_ws, size_t ws_size, hipStream_t stream) {
    if (n_in != 21 || ws_size < WS_END) { fprintf(stderr, "kernel_launch: unexpected n_in %d / ws %zu\n", n_in, ws_size); return; }
    (void)hipMemsetAsync((char*)d_ws + WS_CTL, 0, CTL_ZERO_BYTES, stream);
    Args a{};
    for (int i = 0; i < 21; ++i) a.in[i] = (const float*)d_in[i];
    a.out = (float*)d_out; a.ws = (unsigned char*)d_ws;
#if N_LAUNCH_MODE == 1
    static int grid = 0;
    if (grid == 0) {
        int dev = 0, cus = 0, per_cu = 0;
        (void)hipGetDevice(&dev); (void)hipDeviceGetAttribute(&cus, hipDeviceAttributeMultiprocessorCount, dev);
        (void)hipFuncSetAttribute((const void*)hymba_fwd, hipFuncAttributeMaxDynamicSharedMemorySize, LDS_BYTES);
        (void)hipOccupancyMaxActiveBlocksPerMultiprocessor(&per_cu, (const void*)hymba_fwd, 512, LDS_BYTES);
        if (per_cu < 1) per_cu = 1;
        (void)hipGetLastError();
        grid = cus * per_cu;
    }
    void* args[] = {&a};
    hipError_t e = hipLaunchCooperativeKernel((const void*)hymba_fwd, dim3(grid), dim3(512), args, LDS_BYTES, stream);
    if (e != hipSuccess) fprintf(stderr, "cooperative launch failed: %s (grid %d)\n", hipGetErrorString(e), grid);
#else
    launch_phase<1>(a, 0, stream); launch_phase<2>(a, 0, stream);
    for (int l = 0; l < DEPTH; ++l) { launch_phase<4>(a, l, stream); launch_phase<8>(a, l, stream); launch_phase<16>(a, l, stream); launch_phase<32>(a, l, stream); launch_phase<64>(a, l, stream); launch_phase<128>(a, l, stream); }
#endif
}
```

```cpp
#include <hip/hip_runtime.h>
#include <cstdio>
#include <cstdint>
namespace pg8 {
#define PG8_LAS __attribute__((address_space(3)))
typedef unsigned short bf16_t;
typedef short bf16x8 __attribute__((ext_vector_type(8)));
typedef float f32x4 __attribute__((ext_vector_type(4)));
typedef unsigned u32x4 __attribute__((ext_vector_type(4)));
constexpr int BM = 256, BK = 64, HALF = 128, HTB = HALF * BK * 2  , STAGE_BYTES = 8 * HTB, NXCD = 8, WGM = 8;

__host__ __device__ __forceinline__ int lds_byte(int r, int c) { const int st = (r >> 4) * 2 + (c >> 5), rr = r & 15, cc = c & 31, ob = rr * 64 + cc * 2; return st * 1024 + (ob ^ (((ob >> 9) & 1) << 5)); }
__host__ __device__ __forceinline__ void stage_rc(int b, int& R, int& C) { const int st = b / 1024, sb = b % 1024, swz = sb ^ (((sb >> 9) & 1) << 5); R = (st >> 1) * 16 + swz / 64; C = (st & 1) * 32 + (swz % 64) / 2; }
__host__ __device__ __forceinline__ int perm32(int rho) { const int n = rho >> 4, i = rho & 15; return 8 * (i >> 2) + 4 * n + (i & 3); }

struct Unit { int pm, pn; };
struct Gemm { const bf16_t* A; const bf16_t* Bt; int M, N, K; };

struct StaticOrder {
    int nM, nN, nwg, G, c;
    __host__ __device__ void init(int M, int N, int G_, int c_) { nM = M / BM; nN = N / BM; nwg = nM * nN; G = G_; c = c_; }
    __host__ __device__ bool next(int i, Unit& u) const {
        const long L = (long)i * G + c; if (L >= nwg) return false;
        int wgid = (int)L; { const int q = nwg / NXCD, r = nwg % NXCD, xcd = wgid % NXCD, off = wgid / NXCD; wgid = (xcd < r ? xcd * (q + 1) : r * (q + 1) + (xcd - r) * q) + off; }
        const int nig = WGM * nN, gid = wgid / nig, fm = gid * WGM, gsz = (nM - fm) < WGM ? (nM - fm) : WGM;
        u.pm = fm + ((wgid % nig) % gsz); u.pn = (wgid % nig) / gsz; return true;
    }
    __device__ __forceinline__ void a_ready(const Unit&) const {}
    __device__ __forceinline__ void done(const Unit&) const {}
};

__device__ __forceinline__ unsigned cvt_pk_bf16(float lo, float hi) { unsigned r; asm volatile("v_cvt_pk_bf16_f32 %0, %1, %2" : "=v"(r) : "v"(lo), "v"(hi)); return r; }
typedef float f32x2 __attribute__((ext_vector_type(2)));
__device__ __forceinline__ f32x2 gelu_pk(f32x2 v) {
    const f32x2 av = __builtin_elementwise_abs(v), d = av * 0.2316418882f + 1.0f;
    f32x2 t; t.x = __builtin_amdgcn_rcpf(d.x); t.y = __builtin_amdgcn_rcpf(d.y);
    f32x2 q = t * 0.5307027145f + (-0.7265760135f); q = q * t + 0.7107068705f; q = q * t + (-0.142248368f); q = q * t + 0.127414796f; q = q * t;
    const f32x2 s = (v * v) * (-0.72134752044f);
    f32x2 e; e.x = __builtin_amdgcn_exp2f(s.x); e.y = __builtin_amdgcn_exp2f(s.y);
    const f32x2 m = v * (q * e), r = v - m;
    f32x2 o; o.x = v.x < 0.f ? m.x : r.x; o.y = v.y < 0.f ? m.y : r.y; return o;
}

template <int ACT  > struct EpiBf16 {
    static constexpr bool PERM = true, AFTER_DRAIN = false; static_assert(ACT == 0 || ACT == 1, "EpiBf16: ACT is 0 (none) or 1 (gelu_pk)");
    bf16_t* O; int ldc; const float* bias; int split_cols; size_t split_stride; float scale0;
    __device__ __forceinline__ void operator()(const f32x4 (&acc)[2][2][4][2], const Unit& u, int wr, int wc, int fr, int fq) const {
        const int row0 = u.pm * BM + wr * 64 + fr; int colt = u.pn * BM; bf16_t* base = O;
        float sc = 1.f; if (split_cols) { const int t = colt / split_cols; base += (size_t)t * split_stride; colt -= t * split_cols; if (t == 0) sc = scale0; }
        const int col0 = colt + wc * 32 + 8 * fq, bcol0 = u.pn * BM + wc * 32 + 8 * fq;
        f32x4 bv[2][2];
#pragma unroll
        for (int bj = 0; bj < 2; ++bj)
#pragma unroll
            for (int n = 0; n < 2; ++n) bv[bj][n] = bias ? *(const f32x4*)(bias + bcol0 + bj * HALF + 4 * n) : (f32x4){0.f, 0.f, 0.f, 0.f};
#pragma unroll
        for (int ai = 0; ai < 2; ++ai)
#pragma unroll
            for (int m = 0; m < 4; ++m) { bf16_t* rowp = base + (size_t)(row0 + ai * HALF + m * 16) * ldc + col0;
#pragma unroll
                for (int bj = 0; bj < 2; ++bj) { f32x4 v0 = acc[ai][bj][m][0] + bv[bj][0], v1 = acc[ai][bj][m][1] + bv[bj][1];
                    if (ACT == 1) { f32x2 a = gelu_pk((f32x2){v0[0], v0[1]}), b = gelu_pk((f32x2){v0[2], v0[3]}), c = gelu_pk((f32x2){v1[0], v1[1]}), d = gelu_pk((f32x2){v1[2], v1[3]});
                        v0 = (f32x4){a.x, a.y, b.x, b.y}; v1 = (f32x4){c.x, c.y, d.x, d.y}; }
                    v0 = v0 * sc; v1 = v1 * sc; u32x4 w; w.x = cvt_pk_bf16(v0[0], v0[1]); w.y = cvt_pk_bf16(v0[2], v0[3]); w.z = cvt_pk_bf16(v1[0], v1[1]); w.w = cvt_pk_bf16(v1[2], v1[3]);
                    *(u32x4*)(rowp + bj * HALF) = w; } }
    }
};

template <class Epi, class Sched, bool ALIGN_EPI = false, bool SP2 = false>
__device__ __forceinline__ void gemm_phase(PG8_LAS unsigned char* lds, const Gemm g, const Sched& S, const Epi& E) {
    int tid = threadIdx.x; asm volatile("" : "+v"(tid));
    const int wid = __builtin_amdgcn_readfirstlane(tid >> 6), lane = tid & 63, wr = wid >> 2, wc = wid & 3, fr = lane & 15, fq = lane >> 4;
    const int K = g.K, nt = K / BK;
    unsigned voffA[2], voffB[2];
#pragma unroll
    for (int i = 0; i < 2; ++i) { int R, C; stage_rc(tid * 16 + i * 8192, R, C); const int Rb = Epi::PERM ? ((R & ~31) + perm32(R & 31)) : R;
        voffA[i] = (unsigned)(R * K + C) * 2u; voffB[i] = (unsigned)(Rb * K + C) * 2u; }
    const size_t kstep = (size_t)(BK * 2);
    const size_t hstep = (size_t)HALF * K * 2;
    const size_t tstep = 2 * hstep;
    const unsigned ldsw = (unsigned)wid * 1024u;
    const int aoff = lds_byte(wr * 64 + fr, fq * 8), boff = lds_byte(wc * 32 + fr, fq * 8);
#define PG8_SA(b, h) (((b) * 2 + (h)) * HTB)
#define PG8_SB(b, h) ((4 + (b) * 2 + (h)) * HTB)
#define PG8_STAGE(bufoff, gbase, voff) do { _Pragma("unroll") for (int _i = 0; _i < 2; ++_i) \
        __builtin_amdgcn_global_load_lds((const unsigned*)((const char*)(gbase) + (voff)[_i]), (PG8_LAS unsigned*)(lds + (bufoff) + ldsw + _i * 8192), 16, 0, 0); } while (0)
#define PG8_LDA(dst, b, h) do { _Pragma("unroll") for (int m = 0; m < 4; ++m) _Pragma("unroll") for (int k = 0; k < 2; ++k) dst[m][k] = *(const PG8_LAS bf16x8*)(lds + PG8_SA(b, h) + aoff + m * 2048 + k * 1024); } while (0)
#define PG8_LDB(dst, b, h) do { _Pragma("unroll") for (int n = 0; n < 2; ++n) _Pragma("unroll") for (int k = 0; k < 2; ++k) dst[n][k] = *(const PG8_LAS bf16x8*)(lds + PG8_SB(b, h) + boff + n * 2048 + k * 1024); } while (0)
#define PG8_MMA(ai, bj, At, Bt) do { __builtin_amdgcn_s_setprio(1); _Pragma("unroll") for (int m = 0; m < 4; ++m) _Pragma("unroll") for (int n = 0; n < 2; ++n) _Pragma("unroll") for (int k = 0; k < 2; ++k) \
        acc[ai][bj][m][n] = __builtin_amdgcn_mfma_f32_16x16x32_bf16(Bt[n][k], At[m][k], acc[ai][bj][m][n], 0, 0, 0); __builtin_amdgcn_s_setprio(0); } while (0)
#define PG8_WAIT_V(n) asm volatile("s_waitcnt vmcnt(" #n ")" ::: "memory")
#define PG8_WAIT_L(n) asm volatile("s_waitcnt lgkmcnt(" #n ")" ::: "memory")
#define PG8_BAR __builtin_amdgcn_s_barrier()
#define PG8_SCHED __builtin_amdgcn_sched_barrier(0)
    Unit cur, nxt; int ui = 0;
    if (!S.next(0, cur)) return;
    f32x4 acc[2][2][4][2];
#pragma unroll
    for (int a = 0; a < 2; ++a)
#pragma unroll
        for (int b = 0; b < 2; ++b)
#pragma unroll
            for (int m = 0; m < 4; ++m)
#pragma unroll
                for (int n = 0; n < 2; ++n) acc[a][b][m][n] = (f32x4){0.f, 0.f, 0.f, 0.f};
    bf16x8 At[4][2], B0[2][2], B1[2][2];
    const char* cA = (const char*)g.A + (size_t)cur.pm * tstep; const char* cB = (const char*)g.Bt + (size_t)cur.pn * tstep;
    S.a_ready(cur);
    if constexpr (SP2) {
        PG8_STAGE(PG8_SB(0, 0), cB, voffB); PG8_STAGE(PG8_SB(0, 1), cB + hstep, voffB); PG8_STAGE(PG8_SA(0, 0), cA, voffA); PG8_STAGE(PG8_SA(0, 1), cA + hstep, voffA);
        if (wr == 1) PG8_BAR;
        PG8_WAIT_V(2); PG8_BAR;
        PG8_STAGE(PG8_SB(1, 0), cB + kstep, voffB); PG8_STAGE(PG8_SA(1, 0), cA + kstep, voffA); PG8_STAGE(PG8_SB(1, 1), cB + hstep + kstep, voffB);
        PG8_WAIT_V(6); PG8_BAR;
    } else {
        PG8_STAGE(PG8_SB(0, 0), cB, voffB); PG8_STAGE(PG8_SA(0, 0), cA, voffA); PG8_STAGE(PG8_SB(0, 1), cB + hstep, voffB); PG8_STAGE(PG8_SA(0, 1), cA + hstep, voffA);
        if (wr == 1) PG8_BAR;
        PG8_WAIT_V(4); PG8_BAR;
        PG8_STAGE(PG8_SB(1, 0), cB + kstep, voffB); PG8_STAGE(PG8_SA(1, 0), cA + kstep, voffA); PG8_STAGE(PG8_SB(1, 1), cB + hstep + kstep, voffB);
        PG8_WAIT_V(6); PG8_BAR;
    }
    for (;;) {
        const bool has_next = S.next(ui + 1, nxt);
        const char* nA = has_next ? (const char*)g.A + (size_t)nxt.pm * tstep : cA; const char* nB = has_next ? (const char*)g.Bt + (size_t)nxt.pn * tstep : cB;
        for (int t = 0; t < nt; t += 2) {
            const bool last = (t == nt - 2);
            const char* a1 = cA + (size_t)(t + 1) * kstep;
            const char* a2 = last ? nA : cA + (size_t)(t + 2) * kstep; const char* b2 = last ? nB : cB + (size_t)(t + 2) * kstep;
            const char* a3 = a2 + kstep; const char* b3 = b2 + kstep;
            if (last && has_next) S.a_ready(nxt);
            if constexpr (SP2) {
            PG8_LDB(B0, 0, 0); PG8_LDB(B1, 0, 1); PG8_SCHED; PG8_LDA(At, 0, 0); PG8_STAGE(PG8_SA(1, 1), a1 + hstep, voffA);
            PG8_WAIT_V(8); PG8_WAIT_L(0); PG8_BAR; PG8_MMA(0, 0, At, B0); PG8_MMA(0, 1, At, B1); PG8_BAR; PG8_SCHED;
            PG8_LDA(At, 0, 1); PG8_STAGE(PG8_SB(0, 0), b2, voffB); PG8_STAGE(PG8_SB(0, 1), b2 + hstep, voffB); PG8_STAGE(PG8_SA(0, 0), a2, voffA);
            PG8_WAIT_V(8); PG8_WAIT_L(0); PG8_BAR; PG8_MMA(1, 0, At, B0); PG8_MMA(1, 1, At, B1); PG8_BAR; PG8_SCHED;
            PG8_LDB(B0, 1, 0); PG8_LDB(B1, 1, 1); PG8_SCHED; PG8_LDA(At, 1, 0); PG8_STAGE(PG8_SA(0, 1), a2 + hstep, voffA);
            PG8_WAIT_V(8); PG8_WAIT_L(0); PG8_BAR; PG8_MMA(0, 0, At, B0); PG8_MMA(0, 1, At, B1); PG8_BAR; PG8_SCHED;
            PG8_LDA(At, 1, 1); PG8_STAGE(PG8_SB(1, 0), b3, voffB); PG8_STAGE(PG8_SB(1, 1), b3 + hstep, voffB); PG8_STAGE(PG8_SA(1, 0), a3, voffA);
            PG8_WAIT_V(8); PG8_WAIT_L(0); PG8_BAR; PG8_MMA(1, 0, At, B0); PG8_MMA(1, 1, At, B1); PG8_BAR; PG8_SCHED;
            } else {
            PG8_LDB(B0, 0, 0); PG8_SCHED; PG8_LDA(At, 0, 0); PG8_STAGE(PG8_SA(1, 1), a1 + hstep, voffA);
            PG8_WAIT_L(8); PG8_BAR; PG8_WAIT_L(0); PG8_MMA(0, 0, At, B0); PG8_BAR; PG8_SCHED;
            PG8_LDB(B1, 0, 1); PG8_STAGE(PG8_SB(0, 0), b2, voffB);
            PG8_BAR; PG8_WAIT_L(0); PG8_MMA(0, 1, At, B1); PG8_BAR;
            PG8_LDA(At, 0, 1); PG8_STAGE(PG8_SA(0, 0), a2, voffA);
            PG8_BAR; PG8_WAIT_L(0); PG8_MMA(1, 0, At, B0); PG8_BAR; PG8_SCHED;
            PG8_STAGE(PG8_SB(0, 1), b2 + hstep, voffB);
            PG8_WAIT_V(6); PG8_BAR; PG8_MMA(1, 1, At, B1); PG8_BAR;
            PG8_LDB(B0, 1, 0); PG8_SCHED; PG8_LDA(At, 1, 0); PG8_STAGE(PG8_SA(0, 1), a2 + hstep, voffA);
            PG8_WAIT_L(8); PG8_BAR; PG8_WAIT_L(0); PG8_MMA(0, 0, At, B0); PG8_BAR; PG8_SCHED;
            PG8_LDB(B1, 1, 1); PG8_STAGE(PG8_SB(1, 0), b3, voffB);
            PG8_BAR; PG8_WAIT_L(0); PG8_MMA(0, 1, At, B1); PG8_BAR;
            PG8_LDA(At, 1, 1); PG8_STAGE(PG8_SA(1, 0), a3, voffA);
            PG8_BAR; PG8_WAIT_L(0); PG8_MMA(1, 0, At, B0); PG8_BAR; PG8_SCHED;
            PG8_STAGE(PG8_SB(1, 1), b3 + hstep, voffB);
            PG8_WAIT_V(6); PG8_BAR; PG8_MMA(1, 1, At, B1); PG8_BAR;
            }
        }
        if constexpr (ALIGN_EPI) { if (wr == 0) PG8_BAR; }
        if constexpr (!Epi::AFTER_DRAIN) { E(acc, cur, wr, wc, fr, fq); S.done(cur); }
        if (!has_next) break;
#pragma unroll
        for (int a = 0; a < 2; ++a)
#pragma unroll
            for (int b = 0; b < 2; ++b)
#pragma unroll
                for (int m = 0; m < 4; ++m)
#pragma unroll
                    for (int n = 0; n < 2; ++n) acc[a][b][m][n] = (f32x4){0.f, 0.f, 0.f, 0.f};
        cur = nxt; cA = nA; cB = nB; ++ui;
        if constexpr (ALIGN_EPI) { if (wr == 1) PG8_BAR; }
    }
    PG8_WAIT_V(0);
    if constexpr (!ALIGN_EPI) { if (wr == 0) PG8_BAR; }
    PG8_BAR;
    if constexpr (Epi::AFTER_DRAIN) { E.fused(acc, cur, wr, wc, fr, fq, lds, wid, lane); S.done(cur); }
#undef PG8_SA
#undef PG8_SB
#undef PG8_STAGE
#undef PG8_LDA
#undef PG8_LDB
#undef PG8_MMA
#undef PG8_WAIT_V
#undef PG8_WAIT_L
#undef PG8_BAR
#undef PG8_SCHED
}
}
#include <hip/hip_cooperative_groups.h>
namespace cg = cooperative_groups;
#define LAS __attribute__((address_space(3)))
typedef unsigned short bf16;
typedef float f32x4 __attribute__((ext_vector_type(4)));
typedef float f32x2 __attribute__((ext_vector_type(2)));
typedef float f32x16 __attribute__((ext_vector_type(16)));
typedef short bf16x8 __attribute__((ext_vector_type(8)));
typedef short s16x4 __attribute__((ext_vector_type(4)));
typedef unsigned u32x4 __attribute__((ext_vector_type(4)));
typedef unsigned u32x2 __attribute__((ext_vector_type(2)));
typedef __bf16 bf16x2_t __attribute__((ext_vector_type(2)));

constexpr int BATCH = 2, T = 16384, D = 1024, M = BATCH * T, DEPTH = 2;
constexpr int NPROJ = 4352, NSRC = 4232;
constexpr int LDA = 1280, LDV = 512, LDB = 2560;
constexpr float LN_EPS = 1e-5f, GN_EPS = 64e-5f;
constexpr float DN_ALPHA = 1.41421356237f;
constexpr float C2 = 0.125f * 1.4426950408889634f;
constexpr float L2E = 1.4426950408889634f;
constexpr size_t MiB = 1u << 20;
constexpr size_t WS_CTL = 0, CTL_ZERO_BYTES = 1 * MiB;
constexpr size_t WS_WIN = 2 * MiB, WS_WOUT = 20 * MiB, WS_CUM = 24 * MiB, WS_SCS = 25 * MiB, WS_SCN = 30 * MiB;
constexpr size_t WS_XN = WS_SCN;
constexpr size_t WS_CSUM = 29 * MiB + 512 * 1024;
constexpr size_t WS_LORA = 29 * MiB;
constexpr size_t WS_PA = 190 * MiB, WS_YA = WS_PA, WS_YM = WS_PA  , WS_PV = 270 * MiB, WS_PB = 302 * MiB, WS_VS = 462 * MiB, WS_FS = 494 * MiB, WS_SI = 502 * MiB, WS_END = 506 * MiB;
constexpr int CW_QUEUE = 64;
constexpr int CW_KMAX = 1024;
constexpr int CW_BAR = 4096;
constexpr int CW_MOD = 16384;
constexpr int LDS_BYTES = 147456;
#ifndef PROBE_REP
#define PROBE_REP 0
#endif

__device__ __forceinline__ unsigned f2bf(float f) { unsigned u = __builtin_bit_cast(unsigned, f); return (u + 0x7fffu + ((u >> 16) & 1u)) >> 16; }
__device__ __forceinline__ unsigned pk2(float lo, float hi) { return f2bf(lo) | (f2bf(hi) << 16); }
__device__ __forceinline__ float bf2f(unsigned short v) { return __uint_as_float(((unsigned)v) << 16); }
__device__ __forceinline__ float bflo(unsigned w) { return __uint_as_float(w << 16); }
__device__ __forceinline__ float bfhi(unsigned w) { return __uint_as_float(w & 0xffff0000u); }
__device__ __forceinline__ unsigned cvtpk(float lo, float hi) { f32x2 v = {lo, hi}; bf16x2_t b = __builtin_convertvector(v, bf16x2_t); return __builtin_bit_cast(unsigned, b); }
__device__ __forceinline__ float row16_sum(float x) {
    x += __uint_as_float(__builtin_amdgcn_update_dpp(0, __float_as_uint(x), 0xB1, 0xF, 0xF, true));
    x += __uint_as_float(__builtin_amdgcn_update_dpp(0, __float_as_uint(x), 0x4E, 0xF, 0xF, true));
    x += __uint_as_float(__builtin_amdgcn_update_dpp(0, __float_as_uint(x), 0x141, 0xF, 0xF, true));
    x += __uint_as_float(__builtin_amdgcn_update_dpp(0, __float_as_uint(x), 0x140, 0xF, 0xF, true));
    return x;
}
__device__ __forceinline__ float wave_sum(float v) { v = row16_sum(v); v += __shfl_xor(v, 16); v += __shfl_xor(v, 32); return v; }
__device__ __forceinline__ float fast_sigmoid(float x) { return __builtin_amdgcn_rcpf(1.f + __expf(-x)); }

struct Args { const float* in[21]; float* out; unsigned char* ws; };

struct EpiProj {
    static constexpr bool PERM = true, AFTER_DRAIN = false;
    bf16 *PA, *PVb, *PB;
    __device__ __forceinline__ void operator()(const pg8::f32x4 (&acc)[2][2][4][2], const pg8::Unit& u, int wr, int wc, int fr, int fq) const {
        const int row0 = u.pm * 256 + wr * 64 + fr; const int pn = u.pn;
        bf16* base; int ldc, colt; float sc = 1.f; bool act = false;
        if (pn < 4) { base = PA; ldc = LDA; colt = pn * 256; }
        else if (pn < 6) { base = PVb; ldc = LDV; colt = (pn - 4) * 256; }
        else if (pn == 6) { base = PA; ldc = LDA; colt = 1024; }
        else { base = PB; ldc = LDB; colt = (pn - 7) * 256; if (pn < 9) sc = C2; if (pn >= 13) act = true; }
        const int col0 = colt + wc * 32 + 8 * fq;
#pragma unroll
        for (int ai = 0; ai < 2; ++ai)
#pragma unroll
            for (int m = 0; m < 4; ++m) { bf16* rowp = base + (size_t)(row0 + ai * 128 + m * 16) * ldc + col0;
#pragma unroll
                for (int bj = 0; bj < 2; ++bj) { pg8::f32x4 v0 = acc[ai][bj][m][0], v1 = acc[ai][bj][m][1];
                    if (act) {
#pragma unroll
                        for (int e = 0; e < 4; ++e) { v0[e] = v0[e] * fast_sigmoid(v0[e]); v1[e] = v1[e] * fast_sigmoid(v1[e]); } }
                    v0 = v0 * sc; v1 = v1 * sc; u32x4 w; w.x = cvtpk(v0[0], v0[1]); w.y = cvtpk(v0[2], v0[3]); w.z = cvtpk(v1[0], v1[1]); w.w = cvtpk(v1[2], v1[3]);
                    *(u32x4*)(rowp + bj * 128) = w; } }
    }
};
struct EpiOut {
    static constexpr bool PERM = false, AFTER_DRAIN = false;
    float* hz; const float* modl;
    __device__ __forceinline__ void operator()(const pg8::f32x4 (&acc)[2][2][4][2], const pg8::Unit& u, int wr, int wc, int fr, int fq) const {
        const int col0 = u.pn * 256 + wc * 32 + 4 * fq; const int b = (u.pm * 256) >= T ? 1 : 0; const float* gate = modl + b * 3072 + 2048;
#pragma unroll
        for (int bj = 0; bj < 2; ++bj)
#pragma unroll
            for (int n = 0; n < 2; ++n) { const int c = col0 + bj * 128 + n * 16; const f32x4 g = *(const f32x4*)(gate + c) + 1.0f;
#pragma unroll
                for (int ai = 0; ai < 2; ++ai)
#pragma unroll
                    for (int m = 0; m < 4; ++m) { const int r = u.pm * 256 + ai * 128 + wr * 64 + m * 16 + fr; float* p = hz + (size_t)r * D + c;
                        const f32x4 hx = *(const f32x4*)p; f32x4 a; a[0] = acc[ai][bj][m][n][0]; a[1] = acc[ai][bj][m][n][1]; a[2] = acc[ai][bj][m][n][2]; a[3] = acc[ai][bj][m][n][3];
                        *(f32x4*)p = hx * DN_ALPHA + g * a; } }
    }
};

__device__ __forceinline__ int win_map(int n) { if (n < 1664) return n; if (n < 1672) return 3200 + n - 1664; if (n < 1792) return -1; if (n < 3328) return n - 128; return n - 120; }
template <bool MAP> __device__ __forceinline__ void transpose_item(const float* W, int Nsrc, int Ndst, bf16* WT, LAS float* scr, int item, int lane) {
    const int nblk = Ndst / 32, kb = item / nblk, nb = item % nblk, k0 = 64 * kb, n0 = 32 * nb;
    const int src = MAP ? win_map(n0 + (lane & 31)) : n0 + (lane & 31);
#pragma unroll 8
    for (int i = 0; i < 32; ++i) { const int kk = 2 * i + (lane >> 5); scr[kk * 33 + (lane & 31)] = src >= 0 ? W[(size_t)(k0 + kk) * Nsrc + src] : 0.f; }
    asm volatile("s_waitcnt lgkmcnt(0)" ::: "memory");
    const int c = lane & 7;
#pragma unroll
    for (int j = 0; j < 4; ++j) { const int n = (lane >> 3) + 8 * j; const LAS float* s = scr + (8 * c) * 33 + n;
        u32x4 o; o.x = pk2(s[0 * 33], s[1 * 33]); o.y = pk2(s[2 * 33], s[3 * 33]); o.z = pk2(s[4 * 33], s[5 * 33]); o.w = pk2(s[6 * 33], s[7 * 33]);
        *(u32x4*)(WT + (size_t)(n0 + n) * 1024 + k0 + 8 * c) = o; }
    asm volatile("s_waitcnt lgkmcnt(0)" ::: "memory");
}
__device__ __forceinline__ void p0a(const Args& a, LAS unsigned char* lds, int tid, int lane, int wave, int G) {
    LAS float* scr = (LAS float*)(lds + wave * 16384);
    const int gw = blockIdx.x * 8 + wave, NGW = G * 8;
    constexpr int I_IN = 16 * (NPROJ / 32), I_OUT = 16 * 32;
    for (int it = gw; it < 2 * (I_IN + I_OUT); it += NGW) {
        int r = it; const int l = r / (I_IN + I_OUT); r -= l * (I_IN + I_OUT);
        if (r < I_IN) transpose_item<true>(a.in[6] + (size_t)l * 1024 * NSRC, NSRC, NPROJ, (bf16*)(a.ws + WS_WIN) + (size_t)l * NPROJ * 1024, scr, r, lane);
        else transpose_item<false>(a.in[18] + (size_t)l * 1024 * 1024, 1024, 1024, (bf16*)(a.ws + WS_WOUT) + (size_t)l * 1024 * 1024, scr, r - I_IN, lane);
    }
    { bf16* LT = (bf16*)(a.ws + WS_LORA);
      for (int w = blockIdx.x * 512 + tid; w < 2 * 2 * 512 * 64; w += G * 512) { const int k = w & 63, n = (w >> 6) & 511, which = (w >> 15) & 1, l = w >> 16;
          const float* src = (which ? a.in[11] : a.in[9]) + (size_t)l * 64 * 512; LT[w] = (bf16)f2bf(src[k * 512 + n]); } }
    float* mod = (float*)(a.ws + WS_CTL) + CW_MOD;
    const float* cvec = a.in[1];
    for (int w = blockIdx.x * 512 + tid; w < 2 * 16 * 3072; w += G * 512) {
        const int j = w % 3072, sl = (w / 3072) % 16, l = w / (3072 * 16);
        const float* wa = a.in[4] + (size_t)l * 1024 * 3072 + (size_t)(sl * 64) * 3072 + j;
        float s0 = 0.f, s1 = 0.f;
#pragma unroll 8
        for (int i = 0; i < 64; ++i) { const float wv = wa[(size_t)i * 3072]; s0 += cvec[sl * 64 + i] * wv; s1 += cvec[1024 + sl * 64 + i] * wv; }
        if (sl == 0) { const float bb = a.in[5][l * 3072 + j]; s0 += bb; s1 += bb; }
        atomicAdd(mod + (l * 2 + 0) * 3072 + j, s0); atomicAdd(mod + (l * 2 + 1) * 3072 + j, s1);
    }
}
__device__ __forceinline__ void ln_rows(const float* src, const float* g, const float* bb, float* dst, bf16* xn, const float* modn, int lane, int wave, int G) {
    const int gw = blockIdx.x * 8 + wave, NGW = G * 8;
    f32x4 gv[4], bv[4];
#pragma unroll
    for (int j = 0; j < 4; ++j) { gv[j] = ((const f32x4*)g)[lane + 64 * j]; bv[j] = ((const f32x4*)bb)[lane + 64 * j]; }
    for (int m0 = gw * 2; m0 < M; m0 += NGW * 2) {
        f32x4 v[2][4]; float s[2], s2[2];
#pragma unroll
        for (int u = 0; u < 2; ++u) { const f32x4* xr = (const f32x4*)(src + (size_t)(m0 + u) * D) + lane; s[u] = 0.f;
#pragma unroll
            for (int j = 0; j < 4; ++j) { v[u][j] = xr[64 * j]; s[u] += (v[u][j].x + v[u][j].y) + (v[u][j].z + v[u][j].w); } }
#pragma unroll
        for (int u = 0; u < 2; ++u) s[u] = row16_sum(s[u]);
#pragma unroll
        for (int o = 16; o < 64; o <<= 1) {
#pragma unroll
            for (int u = 0; u < 2; ++u) s[u] += __shfl_xor(s[u], o); }
#pragma unroll
        for (int u = 0; u < 2; ++u) { const float mean = s[u] * (1.f / D); s2[u] = 0.f;
#pragma unroll
            for (int j = 0; j < 4; ++j) { v[u][j] = v[u][j] - mean; s2[u] += (v[u][j].x * v[u][j].x + v[u][j].y * v[u][j].y) + (v[u][j].z * v[u][j].z + v[u][j].w * v[u][j].w); } }
#pragma unroll
        for (int u = 0; u < 2; ++u) s2[u] = row16_sum(s2[u]);
#pragma unroll
        for (int o = 16; o < 64; o <<= 1) {
#pragma unroll
            for (int u = 0; u < 2; ++u) s2[u] += __shfl_xor(s2[u], o); }
#pragma unroll
        for (int u = 0; u < 2; ++u) { const int m = m0 + u;
            const float rstd = 1.f / sqrtf(s2[u] * (1.f / D) + LN_EPS);
            f32x4* o = (f32x4*)(dst + (size_t)m * D) + lane;
            const int b = m >= T ? 1 : 0;
#pragma unroll
            for (int j = 0; j < 4; ++j) { const f32x4 hv = v[u][j] * rstd * gv[j] + bv[j]; o[64 * j] = hv;
                if (modn) { const f32x4 sh = ((const f32x4*)(modn + b * 3072))[lane + 64 * j], sc = ((const f32x4*)(modn + b * 3072 + 1024))[lane + 64 * j];
                    const f32x4 y = hv * (sc + 1.0f) + sh; u32x2 w; w.x = pk2(y.x, y.y); w.y = pk2(y.z, y.w);
                    *((u32x2*)(xn + (size_t)m * D) + lane + 64 * j) = w; } } }
    }
}
__device__ __forceinline__ int crow(int r, int hi) { return (r & 3) + 8 * (r >> 2) + 4 * hi; }
__device__ __forceinline__ float tanh_fast(float x) { const float e = __expf(2.f * x); return 1.f - 2.f * __builtin_amdgcn_rcpf(e + 1.f); }
__device__ __forceinline__ void cum_kmax(const Args& a, LAS unsigned char* lds, int l, int bh, int tid, int lane, int wave) {
    const int b = bh >> 3, h = bh & 7;
    const bf16* PA = (const bf16*)(a.ws + WS_PA); const bf16* PB = (const bf16*)(a.ws + WS_PB);
    float* cum = (float*)(a.ws + WS_CUM) + (size_t)bh * T;
    const float bf = a.in[17][l * 8 + h];
    LAS float* red = (LAS float*)lds;
    const int t0 = tid * 32;
    float s = 0.f, kmx = 0.f;
#pragma unroll 1
    for (int i = 0; i < 32; ++i) { const size_t m = (size_t)b * T + t0 + i;
        const float z = bf2f(PA[m * LDA + 1152 + h]) + bf;
        const float lf = fminf(z, 0.f) - log1pf(__expf(-fabsf(z)));
        s += lf; cum[t0 + i] = s;
        const u32x4* kr = (const u32x4*)(PB + m * LDB + 512 + h * 64); float q = 0.f;
#pragma unroll
        for (int c = 0; c < 8; ++c) { const u32x4 w = kr[c];
            q += bflo(w.x) * bflo(w.x) + bfhi(w.x) * bfhi(w.x) + bflo(w.y) * bflo(w.y) + bfhi(w.y) * bfhi(w.y) + bflo(w.z) * bflo(w.z) + bfhi(w.z) * bfhi(w.z) + bflo(w.w) * bflo(w.w) + bfhi(w.w) * bfhi(w.w); }
        kmx = fmaxf(kmx, q); }
    red[tid] = s;
#pragma unroll
    for (int o = 1; o < 64; o <<= 1) kmx = fmaxf(kmx, __shfl_xor(kmx, o));
    if (lane == 0) red[512 + wave] = kmx;
    __syncthreads();
    if (tid == 0) { float run = 0.f; for (int i = 0; i < 512; ++i) { const float v = red[i]; red[i] = run; run += v; }
        float k = 0.f; for (int i = 0; i < 8; ++i) k = fmaxf(k, red[512 + i]);
        ((float*)(a.ws + WS_CTL))[CW_KMAX + 16 * l + bh] = sqrtf(k); }
    __syncthreads();
    const float off = red[tid];
#pragma unroll 1
    for (int i = 0; i < 32; ++i) cum[t0 + i] += off;
    __syncthreads();
}
__device__ __forceinline__ void prep_phase(const Args& a, LAS unsigned char* lds, int l, int tid, int lane, int wave, int G) {
    const bf16* PA = (const bf16*)(a.ws + WS_PA); const bf16* PV = (const bf16*)(a.ws + WS_PV);
    bf16* SCN = (bf16*)(a.ws + WS_SCN); float* SCS = (float*)(a.ws + WS_SCS); bf16* VS = (bf16*)(a.ws + WS_VS);
    LAS unsigned char* lowL = lds;
    LAS bf16* CL = (LAS bf16*)(lds + 16384);
    const int c = tid, h = wave, r32 = lane & 31, hi = lane >> 5;
    const bf16* LT = (const bf16*)(a.ws + WS_LORA) + (size_t)l * 2 * 512 * 64;
    const float* mix = a.in[7] + l * 1664;
    const int qc = tid & 127, tsel = tid >> 7, c4 = 4 * qc, hq = qc >> 4;
    const f32x4 mix_r = *(const f32x4*)(mix + c4), mix_k = *(const f32x4*)(mix + 512 + c4), mix_v = *(const f32x4*)(mix + 1024 + c4);
    const int ftok = tid >> 3, fi0 = (tid & 7) * 16;
    f32x4 mlow[4];
#pragma unroll
    for (int q = 0; q < 4; ++q) mlow[q] = *(const f32x4*)(mix + 1536 + fi0 + 4 * q);
    const f32x4 w0c = *(const f32x4*)(a.in[8] + l * 512 + c4), a0c = *(const f32x4*)(a.in[10] + l * 512 + c4), kkc = *(const f32x4*)(a.in[12] + l * 512 + c4), kac = *(const f32x4*)(a.in[13] + l * 512 + c4), rkc = *(const f32x4*)(a.in[14] + l * 512 + c4);
    unsigned* pq = (unsigned*)(a.ws + WS_CTL) + CW_QUEUE + 1024 + 64 * l;
    volatile LAS unsigned* ptask = (volatile LAS unsigned*)(lds + 140000);
    for (;;) {
        __syncthreads();
        if (tid == 0) ptask[0] = atomicAdd(pq, 1u);
        __syncthreads();
        const unsigned ptk = ptask[0];
        if (ptk >= (unsigned)(M / 64)) break;
        const int chunk = (int)ptk;
        const int m0 = chunk * 64, b = m0 >= T ? 1 : 0, t0 = m0 - b * T; const int bh = b * 8 + h;
        LAS float* lfL = (LAS float*)(lds + 81920); LAS float* kqL = (LAS float*)(lds + 83968);
        { const int tkn = tid >> 3, hd = tid & 7; const size_t m = (size_t)m0 + tkn;
          const float z = bf2f(PA[m * LDA + 1152 + hd]) + a.in[17][l * 8 + hd];
          lfL[hd * 64 + tkn] = fminf(z, 0.f) - __logf(1.f + __expf(-fabsf(z)));
          const u32x4* kr = (const u32x4*)((const bf16*)(a.ws + WS_PB) + m * LDB + 512 + hd * 64); float q = 0.f;
#pragma unroll
          for (int cc = 0; cc < 8; ++cc) { const u32x4 w = kr[cc];
              q += bflo(w.x) * bflo(w.x) + bfhi(w.x) * bfhi(w.x) + bflo(w.y) * bflo(w.y) + bfhi(w.y) * bfhi(w.y) + bflo(w.z) * bflo(w.z) + bfhi(w.z) * bfhi(w.z) + bflo(w.w) * bflo(w.w) + bfhi(w.w) * bfhi(w.w); }
          kqL[hd * 64 + tkn] = q; }
        { const int m = m0 + ftok, t = t0 + ftok;
          const u32x4* cp = (const u32x4*)(PA + (size_t)m * LDA + 1024 + fi0);
          const u32x4 c0 = cp[0], c1 = cp[1]; u32x4 p0 = {0u, 0u, 0u, 0u}, p1 = p0;
          if (t > 0) { const u32x4* pp = (const u32x4*)(PA + (size_t)(m - 1) * LDA + 1024 + fi0); p0 = pp[0]; p1 = pp[1]; }
          float cur[16], prv[16];
          cur[0] = bflo(c0.x); cur[1] = bfhi(c0.x); cur[2] = bflo(c0.y); cur[3] = bfhi(c0.y); cur[4] = bflo(c0.z); cur[5] = bfhi(c0.z); cur[6] = bflo(c0.w); cur[7] = bfhi(c0.w);
          cur[8] = bflo(c1.x); cur[9] = bfhi(c1.x); cur[10] = bflo(c1.y); cur[11] = bfhi(c1.y); cur[12] = bflo(c1.z); cur[13] = bfhi(c1.z); cur[14] = bflo(c1.w); cur[15] = bfhi(c1.w);
          prv[0] = bflo(p0.x); prv[1] = bfhi(p0.x); prv[2] = bflo(p0.y); prv[3] = bfhi(p0.y); prv[4] = bflo(p0.z); prv[5] = bfhi(p0.z); prv[6] = bflo(p0.w); prv[7] = bfhi(p0.w);
          prv[8] = bflo(p1.x); prv[9] = bfhi(p1.x); prv[10] = bflo(p1.y); prv[11] = bfhi(p1.y); prv[12] = bflo(p1.z); prv[13] = bfhi(p1.z); prv[14] = bflo(p1.w); prv[15] = bfhi(p1.w);
#pragma unroll
          for (int q = 0; q < 16; ++q) { float val = cur[q] + (prv[q] - cur[q]) * mlow[q >> 2][q & 3]; if (fi0 < 64) val = tanh_fast(val); cur[q] = val; }
          u32x4 o0 = {cvtpk(cur[0], cur[1]), cvtpk(cur[2], cur[3]), cvtpk(cur[4], cur[5]), cvtpk(cur[6], cur[7])};
          u32x4 o1 = {cvtpk(cur[8], cur[9]), cvtpk(cur[10], cur[11]), cvtpk(cur[12], cur[13]), cvtpk(cur[14], cur[15])};
          const int ch = 2 * (tid & 7);
          *(LAS u32x4*)(lowL + ftok * 256 + ((ch ^ (ftok & 7)) << 4)) = o0; *(LAS u32x4*)(lowL + ftok * 256 + (((ch + 1) ^ (ftok & 7)) << 4)) = o1; }
        __syncthreads();
        if (tid < 8) { float run = 0.f, kmx = 0.f;
            for (int tt = 0; tt < 64; ++tt) { run += lfL[tid * 64 + tt]; lfL[tid * 64 + tt] = run; kmx = fmaxf(kmx, kqL[tid * 64 + tt]); }
            ((float*)(a.ws + WS_CSUM))[(b * 8 + tid) * 256 + (t0 >> 6)] = run;
            atomicMax((unsigned*)(a.ws + WS_CTL) + CW_KMAX + 16 * l + b * 8 + tid, __float_as_uint(sqrtf(kmx))); }
#pragma unroll 1
        for (int tr = 0; tr < 2; ++tr) {
            { f32x16 Cw0 = {}, Cw1 = {}, Ca0 = {}, Ca1 = {};
              const int trow = 32 * tr + r32;
              bf16x8 Bw[2][4], Ba[2][4];
#pragma unroll
              for (int tc = 0; tc < 2; ++tc)
#pragma unroll
                for (int sx = 0; sx < 4; ++sx) { const int n = 64 * h + 32 * tc + r32;
                    Bw[tc][sx] = __builtin_bit_cast(bf16x8, *(const u32x4*)(LT + (size_t)n * 64 + 16 * sx + 8 * hi));
                    Ba[tc][sx] = __builtin_bit_cast(bf16x8, *(const u32x4*)(LT + 512 * 64 + (size_t)n * 64 + 16 * sx + 8 * hi)); }
#pragma unroll
              for (int sx = 0; sx < 4; ++sx) {
                  const bf16x8 Aw = *(const LAS bf16x8*)(lowL + trow * 256 + (((2 * sx + hi) ^ (trow & 7)) << 4));
                  const bf16x8 Aa = *(const LAS bf16x8*)(lowL + trow * 256 + (((8 + 2 * sx + hi) ^ (trow & 7)) << 4));
                  Cw0 = __builtin_amdgcn_mfma_f32_32x32x16_bf16(Aw, Bw[0][sx], Cw0, 0, 0, 0); Cw1 = __builtin_amdgcn_mfma_f32_32x32x16_bf16(Aw, Bw[1][sx], Cw1, 0, 0, 0);
                  Ca0 = __builtin_amdgcn_mfma_f32_32x32x16_bf16(Aa, Ba[0][sx], Ca0, 0, 0, 0); Ca1 = __builtin_amdgcn_mfma_f32_32x32x16_bf16(Aa, Ba[1][sx], Ca1, 0, 0, 0); }
#pragma unroll
              for (int r = 0; r < 16; ++r) { LAS bf16* row = CL + crow(r, hi) * 1024 + 64 * h + r32;
                  row[0] = (bf16)f2bf(Cw0[r]); row[32] = (bf16)f2bf(Cw1[r]); row[512] = (bf16)f2bf(Ca0[r]); row[544] = (bf16)f2bf(Ca1[r]); } }
            __syncthreads();
#define UNP4(dst, u2) do { dst[0] = bflo(u2.x); dst[1] = bfhi(u2.x); dst[2] = bflo(u2.y); dst[3] = bfhi(u2.y); } while (0)
#pragma unroll 1
            for (int g = 0; g < 4; ++g) {
                const int tl0 = g * 8 + 2 * tsel, mg = m0 + 32 * tr + tl0, tg = t0 + 32 * tr + tl0;
                u32x2 rr_[3], rk_[3], rv_[3];
#pragma unroll
                for (int u = 0; u < 3; ++u) { const int m = mg - 1 + u;
                    if (u > 0 || tg > 0) { rr_[u] = *(const u32x2*)(PA + (size_t)m * LDA + c4); rk_[u] = *(const u32x2*)(PA + (size_t)m * LDA + 512 + c4); rv_[u] = *(const u32x2*)(PV + (size_t)m * LDV + c4); }
                    else { rr_[u] = (u32x2){0u, 0u}; rk_[u] = rr_[u]; rv_[u] = rr_[u]; } }
                f32x4 fr[3], fk[3], fv[3];
#pragma unroll
                for (int u = 0; u < 3; ++u) { UNP4(fr[u], rr_[u]); UNP4(fk[u], rk_[u]); UNP4(fv[u], rv_[u]); }
                f32x4 r4[2], kkr[2], kp[2], vv[2], av[2], omw[2]; float red[8];
#pragma unroll
                for (int u = 0; u < 2; ++u) {
                    r4[u] = fr[u + 1] + (fr[u] - fr[u + 1]) * mix_r; const f32x4 k4 = fk[u + 1] + (fk[u] - fk[u + 1]) * mix_k; vv[u] = fv[u + 1] + (fv[u] - fv[u + 1]) * mix_v;
                    const u32x2 cw = *(const LAS u32x2*)(CL + (tl0 + u) * 1024 + c4), ca = *(const LAS u32x2*)(CL + (tl0 + u) * 1024 + 512 + c4);
                    f32x4 wl, al; UNP4(wl, cw); UNP4(al, ca); wl = wl + w0c; al = al + a0c;
#pragma unroll
                    for (int e = 0; e < 4; ++e) { const float z = -wl[e]; const float sp = fmaxf(z, 0.f) + __logf(1.f + __expf(-fabsf(z)));
                        const float ee = __expf(-sp - 0.5f); omw[u][e] = 1.f - __expf(-ee); av[u][e] = fast_sigmoid(al[e]); }
                    kkr[u] = k4 * kkc; kp[u] = k4 * ((av[u] - 1.0f) * kac + 1.0f);
                    const f32x4 q0 = kkr[u] * kkr[u], q1 = kkr[u] * av[u] * r4[u], q2 = kp[u] * r4[u], q3 = r4[u] * kp[u] * rkc;
                    red[u] = (q0[0] + q0[1]) + (q0[2] + q0[3]); red[2 + u] = (q1[0] + q1[1]) + (q1[2] + q1[3]); red[4 + u] = (q2[0] + q2[1]) + (q2[2] + q2[3]); red[6 + u] = (q3[0] + q3[1]) + (q3[2] + q3[3]);
                }
#pragma unroll
                for (int i = 0; i < 8; ++i) red[i] = row16_sum(red[i]);
#pragma unroll
                for (int u = 0; u < 2; ++u) {
                    const float inv = 1.f / fmaxf(sqrtf(red[u]), 1e-12f);
                    const f32x4 kk = kkr[u] * inv, bbv = kk * av[u], wr = (1.0f - omw[u]) * r4[u];
                    const int bhq = b * 8 + hq;
                    bf16* rec = SCN + ((size_t)bhq * T + tg + u) * 320 + (c4 & 63);
                    *(u32x2*)(rec) = (u32x2){pk2(kk[0], kk[1]), pk2(kk[2], kk[3])}; *(u32x2*)(rec + 64) = (u32x2){pk2(wr[0], wr[1]), pk2(wr[2], wr[3])};
                    *(u32x2*)(rec + 128) = (u32x2){pk2(omw[u][0], omw[u][1]), pk2(omw[u][2], omw[u][3])}; *(u32x2*)(rec + 192) = (u32x2){pk2(bbv[0], bbv[1]), pk2(bbv[2], bbv[3])};
                    *(u32x2*)(rec + 256) = (u32x2){pk2(kp[u][0], kp[u][1]), pk2(kp[u][2], kp[u][3])};
                    *(u32x2*)(VS + (size_t)(mg + u) * 512 + c4) = (u32x2){pk2(vv[u][0], vv[u][1]), pk2(vv[u][2], vv[u][3])};
                    if ((lane & 15) == 0) { f32x4 sc = {red[2 + u] * inv, red[4 + u], red[6 + u], 0.f}; *(f32x4*)(SCS + ((size_t)bhq * T + tg + u) * 4) = sc; }
                }
            }
#undef UNP4
            __syncthreads();
        }
        { const int tkn = tid >> 3, hd = tid & 7; ((float*)(a.ws + WS_CUM))[(size_t)(b * 8 + hd) * T + t0 + tkn] = lfL[hd * 64 + tkn]; }
    }
    __syncthreads();
}

__device__ __forceinline__ float dppf(float x, const int ctrl_sel) {
    unsigned u = __float_as_uint(x), r;
    if (ctrl_sel == 0) r = __builtin_amdgcn_update_dpp(0, u, 0xB1, 0xF, 0xF, true);
    else if (ctrl_sel == 1) r = __builtin_amdgcn_update_dpp(0, u, 0x4E, 0xF, 0xF, true);
    else r = __builtin_amdgcn_update_dpp(0, u, 0x141, 0xF, 0xF, true);
    return __uint_as_float(r);
}
__device__ __forceinline__ float red8(float x) { x += dppf(x, 0); x += dppf(x, 1); x += dppf(x, 2); return x; }
constexpr int SC_CH = 32, SC_STEP = 1024, SC_BUF = SC_CH * SC_STEP, SC_VOFF = 2 * SC_BUF, SC_SOFF = SC_VOFF + 2 * SC_CH * 64 * 4, SC_ROWB = SC_SOFF + 2 * SC_CH * 16;
constexpr int NSEG = 16, SEGLEN = T / NSEG;
typedef float f32x4m __attribute__((ext_vector_type(4)));
template <bool PASSC> __device__ __forceinline__ void scan_task(const Args& a, LAS unsigned char* lds, int bh, int seg, int tid, int lane, int wave, unsigned* cntp, int lq_l) {
    const int b = bh >> 3, h = bh & 7;
    const int t0 = seg * SEGLEN;
    const bf16* SCN = (const bf16*)(a.ws + WS_SCN) + ((size_t)bh * T + t0) * 320;
    const float* SCS = (const float*)(a.ws + WS_SCS) + ((size_t)bh * T + t0) * 4;
    const bf16* VS = (const bf16*)(a.ws + WS_VS) + ((size_t)b * T + t0) * 512 + h * 64;
    float* YA = (float*)(a.ws + WS_YA) + ((size_t)b * T + t0) * 512 + h * 64;
    float* FSb = (float*)(a.ws + WS_FS) + (size_t)bh * NSEG * 128 * 64;
    constexpr int NCH = SEGLEN / SC_CH;
    const int n16 = lane & 15, g = lane >> 4;
    const bool ident = !PASSC && wave >= 4;
    const bool active = PASSC ? (wave < 4) : true;
    const int row = 16 * (wave & 3) + n16;
    f32x4 Sf[4];
#pragma unroll
    for (int i = 0; i < 4; ++i) Sf[i] = (f32x4){0.f, 0.f, 0.f, 0.f};
    __syncthreads();
    if constexpr (PASSC) {
        if (active && seg > 0) { const float* SIp = (const float*)(a.ws + WS_SI) + ((size_t)(bh * NSEG + seg) * 64 + row) * 64 + 4 * g;
#pragma unroll
            for (int t4 = 0; t4 < 4; ++t4) Sf[t4] = *(const f32x4*)(SIp + 16 * t4); }
    } else if (ident) {
#pragma unroll
        for (int i = 0; i < 4; ++i)
#pragma unroll
            for (int e = 0; e < 4; ++e) Sf[i][e] = (16 * i + 4 * g + e == row) ? 1.f : 0.f;
    }
    u32x4 mreg[2], breg, kreg; u32x4 vreg = {0u, 0u, 0u, 0u}; f32x4 sreg;
    auto gload = [&](int c) {
        const u32x4* src = (const u32x4*)(SCN + (size_t)c * SC_CH * 320);
        { const int st = tid / 24, q = tid - st * 24; mreg[0] = src[st * 40 + q]; }
        if (tid < 256) { const int jj = 512 + tid, st = jj / 24, q = jj - st * 24; mreg[1] = src[st * 40 + q];
            const int s2 = tid >> 3, e8 = tid & 7; breg = src[s2 * 40 + 24 + e8]; kreg = src[s2 * 40 + 32 + e8]; }
        if (tid < 256) vreg = *(const u32x4*)(VS + (size_t)(c * SC_CH + (tid >> 3)) * 512 + (tid & 7) * 8);
        else if (tid < 288) sreg = *(const f32x4*)(SCS + (size_t)(c * SC_CH + (tid - 256)) * 4);
    };
    auto lwrite = [&](int c) {
        LAS unsigned char* bp = lds + (c & 1) * SC_BUF;
#pragma unroll
        for (int i = 0; i < 2; ++i) { const int jj = tid + 512 * i;
            if (jj < 768) { const int st = jj / 24, q = jj - st * 24, arr = q >> 3, e8 = q & 7; const u32x4 w = mreg[i];
                LAS unsigned char* d = bp + st * SC_STEP;
                if (arr < 2) { *(LAS u32x4*)(d + 256 + arr * 128 + e8 * 16) = w; }
                else { f32x4 lo, hi;
                    lo[0] = bflo(w.x); lo[1] = bfhi(w.x); lo[2] = bflo(w.y); lo[3] = bfhi(w.y); hi[0] = bflo(w.z); hi[1] = bfhi(w.z); hi[2] = bflo(w.w); hi[3] = bfhi(w.w);
                    lo = 1.0f - lo; hi = 1.0f - hi;
                    LAS f32x4* df = (LAS f32x4*)(d + e8 * 32); df[0] = lo; df[1] = hi; } } }
        if (tid < 256) { const int s2 = tid >> 3, e8 = tid & 7; LAS u32x4* d = (LAS u32x4*)(bp + s2 * SC_STEP + 512 + e8 * 64);
            const unsigned bw[4] = {breg.x, breg.y, breg.z, breg.w}, kw[4] = {kreg.x, kreg.y, kreg.z, kreg.w};
#pragma unroll
            for (int pq = 0; pq < 4; ++pq) { const unsigned blo = bw[pq] & 0xffffu, bhi = bw[pq] >> 16, klo = kw[pq] & 0xffffu, khi = kw[pq] >> 16;
                u32x4 o; o.x = klo | (blo << 16); o.y = blo; o.z = khi | (bhi << 16); o.w = bhi; d[pq] = o; } }
        if (tid < 256) { const u32x4 w = vreg; f32x4 lo, hi;
            lo[0] = bflo(w.x); lo[1] = bfhi(w.x); lo[2] = bflo(w.y); lo[3] = bfhi(w.y); hi[0] = bflo(w.z); hi[1] = bfhi(w.z); hi[2] = bflo(w.w); hi[3] = bfhi(w.w);
            LAS f32x4* d = (LAS f32x4*)(lds + SC_VOFF + (c & 1) * (SC_CH * 64 * 4) + tid * 32); d[0] = lo; d[1] = hi; }
        else if (tid < 288) { *(LAS f32x4*)(lds + SC_SOFF + (c & 1) * (SC_CH * 16) + (tid - 256) * 16) = sreg; }
    };
    gload(0); lwrite(0); gload(1);
    __syncthreads();
    LAS float* ybuf = (LAS float*)(lds + SC_ROWB + 16384);
    const int lt_ = tid - 256, ms = (lt_ >> 3) & 31, mr8 = (lt_ & 7) * 8;
    f32x4 gng0 = {}, gng1 = {}, gnb0 = {}, gnb1 = {};
    if constexpr (PASSC) { if (wave >= 4) { const float* gp = a.in[15] + lq_l * 512 + h * 64 + mr8; const float* bp2 = a.in[16] + lq_l * 512 + h * 64 + mr8;
        gng0 = *(const f32x4*)gp; gng1 = *(const f32x4*)(gp + 4); gnb0 = *(const f32x4*)bp2; gnb1 = *(const f32x4*)(bp2 + 4); } }
    auto ymerge = [&](int cc) {
        const LAS float* yp = ybuf + (cc & 1) * (SC_CH * 64) + ms * 64 + mr8;
        const f32x4 y0 = *(const LAS f32x4*)yp, y1 = *(const LAS f32x4*)(yp + 4);
        const size_t m = (size_t)b * T + t0 + cc * SC_CH + ms;
        const u32x4 vv = *(const u32x4*)((const bf16*)(a.ws + WS_VS) + m * 512 + h * 64 + mr8);
        const u32x4 gg = *(const u32x4*)((const bf16*)(a.ws + WS_PB) + m * LDB + 1536 + h * 64 + mr8);
        const float rkr = SCS[(size_t)(cc * SC_CH + ms) * 4 + 2];
        float sm = (y0[0] + y0[1]) + (y0[2] + y0[3]) + (y1[0] + y1[1]) + (y1[2] + y1[3]);
        sm += __uint_as_float(__builtin_amdgcn_update_dpp(0, __float_as_uint(sm), 0xB1, 0xF, 0xF, true));
        sm += __uint_as_float(__builtin_amdgcn_update_dpp(0, __float_as_uint(sm), 0x4E, 0xF, 0xF, true));
        sm += __uint_as_float(__builtin_amdgcn_update_dpp(0, __float_as_uint(sm), 0x141, 0xF, 0xF, true));
        const float mean = sm * (1.f / 64.f);
        const f32x4 d0 = y0 - mean, d1 = y1 - mean;
        float sv = (d0[0] * d0[0] + d0[1] * d0[1]) + (d0[2] * d0[2] + d0[3] * d0[3]) + (d1[0] * d1[0] + d1[1] * d1[1]) + (d1[2] * d1[2] + d1[3] * d1[3]);
        sv += __uint_as_float(__builtin_amdgcn_update_dpp(0, __float_as_uint(sv), 0xB1, 0xF, 0xF, true));
        sv += __uint_as_float(__builtin_amdgcn_update_dpp(0, __float_as_uint(sv), 0x4E, 0xF, 0xF, true));
        sv += __uint_as_float(__builtin_amdgcn_update_dpp(0, __float_as_uint(sv), 0x141, 0xF, 0xF, true));
        const float rs = rsqrtf(sv * (1.f / 64.f) + GN_EPS);
        const f32x4 v0 = {bflo(vv.x), bfhi(vv.x), bflo(vv.y), bfhi(vv.y)}, v1 = {bflo(vv.z), bfhi(vv.z), bflo(vv.w), bfhi(vv.w)};
        const f32x4 g0 = {bflo(gg.x), bfhi(gg.x), bflo(gg.y), bfhi(gg.y)}, g1 = {bflo(gg.z), bfhi(gg.z), bflo(gg.w), bfhi(gg.w)};
        const f32x4 o0 = (d0 * rs * gng0 + gnb0 + v0 * rkr) * g0, o1 = (d1 * rs * gng1 + gnb1 + v1 * rkr) * g1;
        u32x4 ow; ow.x = pk2(o0[0], o0[1]); ow.y = pk2(o0[2], o0[3]); ow.z = pk2(o1[0], o1[1]); ow.w = pk2(o1[2], o1[3]);
        *(u32x4*)((bf16*)(a.ws + WS_YM) + m * D + h * 64 + mr8) = ow;
    };
    for (int c = 0; c < NCH; ++c) {
        if (c + 1 < NCH) lwrite(c + 1);
        if (c + 2 < NCH) gload(c + 2);
        if constexpr (PASSC) { if (c > 0 && wave >= 4) ymerge(c - 1); }
        if (active) {
            if constexpr (PASSC) __builtin_amdgcn_s_setprio(2);
            const LAS unsigned char* bp = lds + (c & 1) * SC_BUF;
            const LAS float* vb = (const LAS float*)(lds + SC_VOFF + (c & 1) * (SC_CH * 64 * 4)) + row;
            const LAS float* sb = (const LAS float*)(lds + SC_SOFF + (c & 1) * (SC_CH * 16));
#define SC_DECL(X) u32x2 X##a0, X##a1, X##a2, X##a3, X##r0, X##r1, X##r2, X##r3; float X##v; f32x2 X##s
#define SC_LD(X, sidx) do { const LAS unsigned char* p_ = bp + (sidx) * SC_STEP + 256 + g * 8; \
                X##a0 = *(const LAS u32x2*)(p_); X##a1 = *(const LAS u32x2*)(p_ + 32); X##a2 = *(const LAS u32x2*)(p_ + 64); X##a3 = *(const LAS u32x2*)(p_ + 96); \
                if constexpr (PASSC) { X##r0 = *(const LAS u32x2*)(p_ + 128); X##r1 = *(const LAS u32x2*)(p_ + 160); X##r2 = *(const LAS u32x2*)(p_ + 192); X##r3 = *(const LAS u32x2*)(p_ + 224); X##s = *(const LAS f32x2*)(sb + (sidx) * 4); } \
                X##v = ident ? 0.f : vb[(sidx) * 64]; } while (0)
#define SC_STEPM(X, Y, sidx, ldnext) do { const LAS unsigned char* p_ = bp + (sidx) * SC_STEP; \
                const f32x4 w0_ = *(const LAS f32x4*)(p_ + g * 16), w1_ = *(const LAS f32x4*)(p_ + 64 + g * 16), w2_ = *(const LAS f32x4*)(p_ + 128 + g * 16), w3_ = *(const LAS f32x4*)(p_ + 192 + g * 16); \
                const s16x4 f0_ = *(const LAS s16x4*)(p_ + 512 + n16 * 8), f1_ = *(const LAS s16x4*)(p_ + 640 + n16 * 8), f2_ = *(const LAS s16x4*)(p_ + 768 + n16 * 8), f3_ = *(const LAS s16x4*)(p_ + 896 + n16 * 8); \
                if (ldnext) SC_LD(Y, (sidx) + 1); \
                u32x4 sb0, sb1; \
                sb0.x = cvtpk(Sf[0][0], Sf[0][1]); sb0.y = cvtpk(Sf[0][2], Sf[0][3]); sb0.z = cvtpk(Sf[1][0], Sf[1][1]); sb0.w = cvtpk(Sf[1][2], Sf[1][3]); \
                sb1.x = cvtpk(Sf[2][0], Sf[2][1]); sb1.y = cvtpk(Sf[2][2], Sf[2][3]); sb1.z = cvtpk(Sf[3][0], Sf[3][1]); sb1.w = cvtpk(Sf[3][2], Sf[3][3]); \
                const bf16x8 B0 = __builtin_bit_cast(bf16x8, sb0), B1 = __builtin_bit_cast(bf16x8, sb1); \
                const bf16x8 A0 = __builtin_bit_cast(bf16x8, (u32x4){X##a0.x, X##a0.y, X##a1.x, X##a1.y}), A1 = __builtin_bit_cast(bf16x8, (u32x4){X##a2.x, X##a2.y, X##a3.x, X##a3.y}); \
                const f32x4m z4 = {0.f, 0.f, 0.f, 0.f}; f32x4m accy0 = z4, accy1 = z4; \
                const f32x4m acc0 = __builtin_amdgcn_mfma_f32_16x16x32_bf16(A0, B0, z4, 0, 0, 0); \
                const f32x4m acc1 = __builtin_amdgcn_mfma_f32_16x16x32_bf16(A1, B1, z4, 0, 0, 0); \
                if constexpr (PASSC) { const bf16x8 R0 = __builtin_bit_cast(bf16x8, (u32x4){X##r0.x, X##r0.y, X##r1.x, X##r1.y}); accy0 = __builtin_amdgcn_mfma_f32_16x16x32_bf16(R0, B0, z4, 0, 0, 0); \
                    const bf16x8 R1 = __builtin_bit_cast(bf16x8, (u32x4){X##r2.x, X##r2.y, X##r3.x, X##r3.y}); accy1 = __builtin_amdgcn_mfma_f32_16x16x32_bf16(R1, B1, z4, 0, 0, 0); } \
                const f32x4 c0_ = Sf[0] * w0_, c1_ = Sf[1] * w1_, c2_ = Sf[2] * w2_, c3_ = Sf[3] * w3_; \
                const float sa = acc0[0] + acc1[0]; \
                u32x2 bu; bu.x = (__float_as_uint(X##v) >> 16) | (cvtpk(0.f, -sa) & 0xffff0000u); bu.y = 0u; \
                if (g != 0) { bu.x = 0u; bu.y = 0u; } \
                const s16x4 Bu = __builtin_bit_cast(s16x4, bu); \
                Sf[0] = __builtin_amdgcn_mfma_f32_16x16x16bf16_1k(f0_, Bu, c0_, 0, 0, 0); Sf[1] = __builtin_amdgcn_mfma_f32_16x16x16bf16_1k(f1_, Bu, c1_, 0, 0, 0); \
                Sf[2] = __builtin_amdgcn_mfma_f32_16x16x16bf16_1k(f2_, Bu, c2_, 0, 0, 0); Sf[3] = __builtin_amdgcn_mfma_f32_16x16x16bf16_1k(f3_, Bu, c3_, 0, 0, 0); \
                if constexpr (PASSC) { const float y = (accy0[0] + accy1[0]) - sa * X##s.x + X##v * X##s.y; ybuf[(c & 1) * (SC_CH * 64) + (sidx) * 64 + row] = y; } } while (0)
            SC_DECL(oA); SC_DECL(oB);
            SC_LD(oA, 0);
#pragma unroll 1
            for (int s = 0; s < SC_CH; s += 2) {
                SC_STEPM(oA, oB, s, true);
                __builtin_amdgcn_sched_barrier(0);
                SC_STEPM(oB, oA, s + 1, (s + 2 < SC_CH));
                __builtin_amdgcn_sched_barrier(0);
            }
            if constexpr (PASSC) __builtin_amdgcn_s_setprio(0);
#undef SC_DECL
#undef SC_LD
#undef SC_STEPM
        }
        __syncthreads();
    }
    if constexpr (PASSC) { if (wave >= 4) ymerge(NCH - 1); }
    if constexpr (!PASSC) { float* fp = FSb + ((size_t)seg * 128 + (ident ? 64 : 0) + row) * 64 + 4 * g;
#pragma unroll
        for (int t4 = 0; t4 < 4; ++t4) *(f32x4*)(fp + 16 * t4) = Sf[t4];
        volatile LAS unsigned* lastf = (volatile LAS unsigned*)(lds + 140064);
        __threadfence();
        __syncthreads();
        if (tid == 0) lastf[0] = atomicAdd(cntp, 1u);
        __syncthreads();
        if (lastf[0] == (unsigned)(NSEG - 2)) {
            __threadfence();
            LAS float* rowb = (LAS float*)(lds + SC_ROWB);
            LAS float* pbuf = (LAS float*)lds;
            float* SIb = (float*)(a.ws + WS_SI) + (size_t)bh * NSEG * 64 * 64;
            const int crow_ = tid >> 3, kq = (tid & 7) * 8;
            f32x4 c0 = {0.f, 0.f, 0.f, 0.f}, c1 = c0, pr0, pr1;
            { const float* Pk = FSb + ((size_t)0 * 128 + 64 + crow_) * 64 + kq; pr0 = __builtin_nontemporal_load((const f32x4*)Pk); pr1 = __builtin_nontemporal_load((const f32x4*)(Pk + 4)); }
            for (int k = 0; k < NSEG - 1; ++k) {
                const float* Uk = FSb + ((size_t)k * 128 + crow_) * 64 + kq;
                f32x4 a0 = __builtin_nontemporal_load((const f32x4*)Uk), a1 = __builtin_nontemporal_load((const f32x4*)(Uk + 4));
                *(LAS f32x4*)(rowb + crow_ * 64 + kq) = c0; *(LAS f32x4*)(rowb + crow_ * 64 + kq + 4) = c1;
                *(LAS f32x4*)(pbuf + crow_ * 64 + kq) = pr0; *(LAS f32x4*)(pbuf + crow_ * 64 + kq + 4) = pr1;
                __syncthreads();
                if (k + 2 < NSEG) { const float* Pn = FSb + ((size_t)(k + 1) * 128 + 64 + crow_) * 64 + kq; pr0 = __builtin_nontemporal_load((const f32x4*)Pn); pr1 = __builtin_nontemporal_load((const f32x4*)(Pn + 4)); }
                if (k > 0) {
#pragma unroll 4
                    for (int jj = 0; jj < 64; ++jj) { const float sj = rowb[crow_ * 64 + jj]; a0 += *(const LAS f32x4*)(pbuf + jj * 64 + kq) * sj; a1 += *(const LAS f32x4*)(pbuf + jj * 64 + kq + 4) * sj; } }
                c0 = a0; c1 = a1;
                float* sp_ = SIb + ((size_t)(k + 1) * 64 + crow_) * 64 + kq; *(f32x4*)sp_ = c0; *(f32x4*)(sp_ + 4) = c1;
                __syncthreads();
            }
        }
    }
}

typedef short v4i16_t __attribute__((ext_vector_type(4)));
__device__ __forceinline__ s16x4 vtr(const LAS unsigned char* p) { return __builtin_bit_cast(s16x4, __builtin_amdgcn_ds_read_tr16_b64_v4i16((LAS v4i16_t*)p)); }
constexpr int AT_KS = 0, AT_VS = 9216, AT_BIAS = 18432, AT_WSF = 18688, AT_FLAG = 19712, AT_TASK = 140000;
__device__ __forceinline__ void attn_unit(const Args& a, LAS unsigned char* lds, int l, int bh, int qb, int tid, int lane, int wid) {
    const int b = bh >> 3, h = bh & 7, r32 = lane & 31, hi = lane >> 5;
    const int q0 = qb * 256;
    bf16* PB = (bf16*)(a.ws + WS_PB);
    const float* cumh = (const float*)(a.ws + WS_CUM) + (size_t)bh * T;
    const float kmax = ((const float*)(a.ws + WS_CTL))[CW_KMAX + 16 * l + bh];
    const size_t rowbase = (size_t)b * T;
    const bf16* Qp = PB + (rowbase + q0 + wid * 32 + r32) * LDB + h * 64;
    bf16x8 qr[4]; float qs = 0.f;
#pragma unroll
    for (int d0 = 0; d0 < 4; ++d0) { const u32x4 w = *(const u32x4*)(Qp + d0 * 16 + hi * 8); qr[d0] = __builtin_bit_cast(bf16x8, w);
        qs += bflo(w.x) * bflo(w.x) + bfhi(w.x) * bfhi(w.x) + bflo(w.y) * bflo(w.y) + bfhi(w.y) * bfhi(w.y) + bflo(w.z) * bflo(w.z) + bfhi(w.z) * bfhi(w.z) + bflo(w.w) * bflo(w.w) + bfhi(w.w) * bfhi(w.w); }
    qs += __shfl_xor(qs, 32);
    const float qbound = sqrtf(qs) * kmax * 1.01f + 0.01f;
    LAS float* offL = (LAS float*)(lds + 20480);
    { __syncthreads();
      if (wid == 0) { const float* cs = (const float*)(a.ws + WS_CSUM) + bh * 256; const int ntile = qb * 4 + 4;
          f32x4 v4 = {0.f, 0.f, 0.f, 0.f};
#pragma unroll
          for (int i = 0; i < 4; ++i) if (4 * lane + i < ntile) v4[i] = cs[4 * lane + i];
          const float tot = (v4[0] + v4[1]) + (v4[2] + v4[3]); float inc = tot;
#pragma unroll
          for (int o = 1; o < 64; o <<= 1) { const float up = __shfl_up(inc, o); if (lane >= o) inc += up; }
          float ex = inc - tot;
          offL[4 * lane] = ex; ex += v4[0]; offL[4 * lane + 1] = ex; ex += v4[1]; offL[4 * lane + 2] = ex; ex += v4[2]; offL[4 * lane + 3] = ex; }
      __syncthreads(); }
    const float ref = cumh[q0 + 255] + offL[(q0 + 255) >> 6];
    const int srow = tid >> 3, sch = tid & 7;
    const bf16* Kg = PB + rowbase * LDB + 512 + h * 64 + sch * 8; const bf16* Vg = Kg + 512;
    LAS unsigned char* Ks = lds + AT_KS; LAS unsigned char* Vs = lds + AT_VS; LAS float* biasL = (LAS float*)(lds + AT_BIAS);
    LAS float* wsf = (LAS float*)(lds + AT_WSF) + wid * 32; volatile LAS unsigned* flag = (volatile LAS unsigned*)(lds + AT_FLAG);
    if (tid < 3) flag[tid] = 0u;
    float m = -INFINITY, lsum = 0.f; f32x16 o0 = {}, o1 = {};
    u32x4 kreg, vreg; float breg = 0.f, bnx = 0.f;
    int j = qb * 4 + 3;
    { kreg = *(const u32x4*)(Kg + (size_t)(64 * j + srow) * LDB); vreg = *(const u32x4*)(Vg + (size_t)(64 * j + srow) * LDB);
      if (tid < 64) breg = (ref - (cumh[64 * j + tid] + offL[j])) * L2E; bnx = j > 0 ? (ref - (cumh[64 * j - 1] + offL[j - 1])) * L2E : 0.f; }
    const int q4 = (lane & 15) >> 2, p4 = lane & 3, blk = (lane >> 4) & 1;
    const int qrow = q0 + wid * 32 + r32;
    int it = 0;
    __syncthreads();
    for (;;) {
        *(LAS u32x4*)(Ks + srow * 144 + sch * 16) = kreg; *(LAS u32x4*)(Vs + srow * 144 + sch * 16) = vreg; if (tid < 64) biasL[tid] = breg;
        const float bnx_cur = bnx;
        __syncthreads();
        if (j > 0) { const int jn = j - 1;
            kreg = *(const u32x4*)(Kg + (size_t)(64 * jn + srow) * LDB); vreg = *(const u32x4*)(Vg + (size_t)(64 * jn + srow) * LDB);
            if (tid < 64) breg = (ref - (cumh[64 * jn + tid] + offL[jn])) * L2E; bnx = jn > 0 ? (ref - (cumh[64 * jn - 1] + offL[jn - 1])) * L2E : 0.f; }
        if (64 * j <= q0 + 32 * wid + 31) {
            f32x16 p0 = {}, p1 = {};
#pragma unroll
            for (int d0 = 0; d0 < 4; ++d0) {
                const bf16x8 k0 = *(const LAS bf16x8*)(Ks + r32 * 144 + d0 * 32 + hi * 16);
                const bf16x8 k1 = *(const LAS bf16x8*)(Ks + (32 + r32) * 144 + d0 * 32 + hi * 16);
                p0 = __builtin_amdgcn_mfma_f32_32x32x16_bf16(k0, qr[d0], p0, 0, 0, 0);
                p1 = __builtin_amdgcn_mfma_f32_32x32x16_bf16(k1, qr[d0], p1, 0, 0, 0); }
#pragma unroll
            for (int g = 0; g < 4; ++g) { const f32x4 b0 = *(const LAS f32x4*)(biasL + 8 * g + 4 * hi), b1 = *(const LAS f32x4*)(biasL + 32 + 8 * g + 4 * hi);
#pragma unroll
                for (int e = 0; e < 4; ++e) { p0[4 * g + e] += b0[e]; p1[4 * g + e] += b1[e]; } }
            if (64 * j + 63 > q0 + 32 * wid) {
#pragma unroll
                for (int r = 0; r < 16; ++r) { const int kv = 64 * j + crow(r, hi); if (kv > qrow) p0[r] = -INFINITY; if (kv + 32 > qrow) p1[r] = -INFINITY; } }
            float mx = fmaxf(p0[0], p1[0]);
#pragma unroll
            for (int r = 1; r < 16; ++r) mx = fmaxf(mx, fmaxf(p0[r], p1[r]));
            mx = fmaxf(mx, __shfl_xor(mx, 32));
            const float mnew = fmaxf(m, mx); const float f = __builtin_amdgcn_exp2f(m - mnew); m = mnew;
            float rs = 0.f;
#pragma unroll
            for (int r = 0; r < 16; ++r) { p0[r] = __builtin_amdgcn_exp2f(p0[r] - mnew); p1[r] = __builtin_amdgcn_exp2f(p1[r] - mnew); rs += p0[r] + p1[r]; }
            lsum = lsum * f + rs;
            if (__any(f != 1.f)) {
                if (hi == 0) wsf[r32] = f;
                asm volatile("s_waitcnt lgkmcnt(0)" ::: "memory");
#pragma unroll
                for (int r = 0; r < 16; ++r) { const float fr = wsf[crow(r, hi)]; o0[r] *= fr; o1[r] *= fr; }
            }
            u32x4 pw[4];
            pw[0] = (u32x4){cvtpk(p0[0], p0[1]), cvtpk(p0[2], p0[3]), cvtpk(p0[4], p0[5]), cvtpk(p0[6], p0[7])};
            pw[1] = (u32x4){cvtpk(p0[8], p0[9]), cvtpk(p0[10], p0[11]), cvtpk(p0[12], p0[13]), cvtpk(p0[14], p0[15])};
            pw[2] = (u32x4){cvtpk(p1[0], p1[1]), cvtpk(p1[2], p1[3]), cvtpk(p1[4], p1[5]), cvtpk(p1[6], p1[7])};
            pw[3] = (u32x4){cvtpk(p1[8], p1[9]), cvtpk(p1[10], p1[11]), cvtpk(p1[12], p1[13]), cvtpk(p1[14], p1[15])};
#pragma unroll
            for (int s = 0; s < 4; ++s) { const int kvb = 16 * (s & 1) + 32 * (s >> 1);
                const LAS unsigned char* va = Vs + (kvb + 4 * hi + q4) * 144 + (16 * blk + 4 * p4) * 2;
                const s16x4 l0 = vtr(va), h0 = vtr(va + 8 * 144), l1 = vtr(va + 64), h1 = vtr(va + 8 * 144 + 64);
                const bf16x8 vf0 = {l0[0], l0[1], l0[2], l0[3], h0[0], h0[1], h0[2], h0[3]}, vf1 = {l1[0], l1[1], l1[2], l1[3], h1[0], h1[1], h1[2], h1[3]};
                const bf16x8 pa = __builtin_bit_cast(bf16x8, pw[s]);
                o0 = __builtin_amdgcn_mfma_f32_32x32x16_bf16(pa, vf0, o0, 0, 0, 0);
                o1 = __builtin_amdgcn_mfma_f32_32x32x16_bf16(pa, vf1, o1, 0, 0, 0); }
        }
        if (j == 0) break;
        const bool need = (qbound + bnx_cur > m - 40.f);
        if (tid == 0) flag[(it + 1) % 3] = 0u;
        if (__any(need) && lane == 0) flag[it % 3] = 1u;
        __syncthreads();
        const unsigned cont = flag[it % 3];
        if (!cont) break;
        --j; ++it;
    }
    lsum += __shfl_xor(lsum, 32);
    if (hi == 0) wsf[r32] = 1.f / lsum;
    asm volatile("s_waitcnt lgkmcnt(0)" ::: "memory");
    bf16* Ow = (bf16*)(a.ws + WS_YM) + (rowbase + q0 + wid * 32) * D + 512 + h * 64 + r32;
    const bf16* Gw = PB + (rowbase + q0 + wid * 32) * LDB + 2048 + h * 64 + r32;
#pragma unroll
    for (int r = 0; r < 16; ++r) { const float inv = wsf[crow(r, hi)]; bf16* op = Ow + (size_t)crow(r, hi) * D; const bf16* gp = Gw + (size_t)crow(r, hi) * LDB;
        op[0] = (bf16)f2bf(o0[r] * inv * bf2f(gp[0])); op[32] = (bf16)f2bf(o1[r] * inv * bf2f(gp[32])); }
    __syncthreads();
}
__device__ __forceinline__ void p3a_phase(const Args& a, LAS unsigned char* lds, int l, int tid, int lane, int wave) {
    unsigned* ctr = (unsigned*)(a.ws + WS_CTL) + CW_QUEUE + 64 * l;
    volatile LAS unsigned* task = (volatile LAS unsigned*)(lds + AT_TASK);
    for (;;) {
        __syncthreads();
        if (tid == 0) task[0] = atomicAdd(ctr, 1u);
        __syncthreads();
        const unsigned tk = task[0];
        if (tk >= 240u + 1024u) break;
        int t2 = tid; asm volatile("" : "+v"(t2)); const int lane2 = t2 & 63;
        if (tk < 240u) { scan_task<false>(a, lds, (int)(tk / 15u), (int)(tk % 15u), t2, lane2, wave, (unsigned*)(a.ws + WS_CTL) + CW_QUEUE + 2048 + 64 * l + (tk / 15u), l); }
        else { const unsigned u = tk - 240u; attn_unit(a, lds, l, (int)(u & 15), 63 - (int)(u >> 4), t2, lane2, wave); }
    }
}
__device__ __forceinline__ void p3b_phase(const Args& a, LAS unsigned char* lds, int l, int tid, int lane, int wave) {
    unsigned* ctr = (unsigned*)(a.ws + WS_CTL) + CW_QUEUE + 512 + 64 * l;
    volatile LAS unsigned* task = (volatile LAS unsigned*)(lds + AT_TASK);
    for (;;) {
        __syncthreads();
        if (tid == 0) task[0] = atomicAdd(ctr, 1u);
        __syncthreads();
        const unsigned tk = task[0];
        if (tk >= 256u) break;
        scan_task<true>(a, lds, (int)(tk >> 4), (int)(tk & 15), tid, lane, wave, nullptr, l);
    }
}

__device__ __forceinline__ float red16m(float x) {
    x += __uint_as_float(__builtin_amdgcn_update_dpp(0, __float_as_uint(x), 0xB1, 0xF, 0xF, true));
    x += __uint_as_float(__builtin_amdgcn_update_dpp(0, __float_as_uint(x), 0x4E, 0xF, 0xF, true));
    x += __uint_as_float(__builtin_amdgcn_update_dpp(0, __float_as_uint(x), 0x141, 0xF, 0xF, true));
    x += __uint_as_float(__builtin_amdgcn_update_dpp(0, __float_as_uint(x), 0x140, 0xF, 0xF, true));
    return x;
}
__device__ __forceinline__ void merge_phase(const Args& a, int l, int tid, int lane, int wave, int G) {
    const float* YA = (const float*)(a.ws + WS_YA); const bf16* VS = (const bf16*)(a.ws + WS_VS); const bf16* PB = (const bf16*)(a.ws + WS_PB);
    const bf16* PVo = (const bf16*)(a.ws + WS_PV);
    const float* SCS = (const float*)(a.ws + WS_SCS); bf16* YM = (bf16*)(a.ws + WS_YM);
    const int hd = 4 * (wave & 1) + (lane >> 4), c0 = hd * 64 + 4 * (lane & 15), tsub = wave >> 1;
    const f32x4 gg = *(const f32x4*)(a.in[15] + l * 512 + c0), gb = *(const f32x4*)(a.in[16] + l * 512 + c0);
    constexpr int MT = 4;
    for (int mb = blockIdx.x * (4 * MT); mb < M; mb += G * (4 * MT)) {
        f32x4 ya[MT]; u32x2 vv[MT], g1[MT], g2[MT], yb[MT]; float rkr[MT], mean[MT], var[MT];
#pragma unroll
        for (int u = 0; u < MT; ++u) { const int m = mb + 4 * u + tsub; const int b = m >= T ? 1 : 0, t = m - b * T;
            ya[u] = *(const f32x4*)(YA + (size_t)m * 512 + c0); vv[u] = *(const u32x2*)(VS + (size_t)m * 512 + c0);
            g1[u] = *(const u32x2*)(PB + (size_t)m * LDB + 1536 + c0); g2[u] = *(const u32x2*)(PB + (size_t)m * LDB + 2048 + c0);
            yb[u] = *(const u32x2*)(PVo + (size_t)m * LDV + c0);
            rkr[u] = SCS[((size_t)(b * 8 + hd) * T + t) * 4 + 2]; }
#pragma unroll
        for (int u = 0; u < MT; ++u) mean[u] = red16m((ya[u][0] + ya[u][1]) + (ya[u][2] + ya[u][3])) * (1.f / 64.f);
#pragma unroll
        for (int u = 0; u < MT; ++u) { const f32x4 d = ya[u] - mean[u]; var[u] = red16m((d[0] * d[0] + d[1] * d[1]) + (d[2] * d[2] + d[3] * d[3])) * (1.f / 64.f); }
#pragma unroll
        for (int u = 0; u < MT; ++u) { const int m = mb + 4 * u + tsub; const float rs = rsqrtf(var[u] + GN_EPS);
            f32x4 v4 = {bflo(vv[u].x), bfhi(vv[u].x), bflo(vv[u].y), bfhi(vv[u].y)};
            f32x4 ga = {bflo(g1[u].x), bfhi(g1[u].x), bflo(g1[u].y), bfhi(g1[u].y)}, gbv = {bflo(g2[u].x), bfhi(g2[u].x), bflo(g2[u].y), bfhi(g2[u].y)};
            f32x4 y2 = {bflo(yb[u].x), bfhi(yb[u].x), bflo(yb[u].y), bfhi(yb[u].y)};
            const f32x4 yn = ((ya[u] - mean[u]) * rs * gg + gb + v4 * rkr[u]) * ga; const f32x4 yo = y2 * gbv;
            u32x2 o1 = {pk2(yn[0], yn[1]), pk2(yn[2], yn[3])}, o2 = {pk2(yo[0], yo[1]), pk2(yo[2], yo[3])};
            *(u32x2*)(YM + (size_t)m * D + c0) = o1; *(u32x2*)(YM + (size_t)m * D + 512 + c0) = o2; }
    }
}

#define XB_TMO      128
#define XB_XCNT(j)  (256  + 64 * (j))
#define XB_XSUB(j)  (1280 + 64 * (j))
#define XB_XGEN(j)  (2304 + 64 * (j))
#define XB_TOP      3328
#define XB_TOPGEN   3392
#define XCD_BAR_WORDS 3456
#define XB_SPIN_CAP (1u << 18)

__device__ __forceinline__ unsigned xb_ld(unsigned* p)              { return __hip_atomic_load(p, __ATOMIC_RELAXED, __HIP_MEMORY_SCOPE_AGENT); }
__device__ __forceinline__ unsigned xb_add(unsigned* p, unsigned v) { return __hip_atomic_fetch_add(p, v, __ATOMIC_RELAXED, __HIP_MEMORY_SCOPE_AGENT); }
__device__ __forceinline__ unsigned xb_xcc_id() { return (unsigned)__builtin_amdgcn_s_getreg((3 << 11) | 20) & 0xFu; }
#define XB_SPIN(cond, bar) do { unsigned _sp = 0; while (cond) { __builtin_amdgcn_s_sleep(1); \
    if ((++_sp & 255u) == 0u) { if (xb_ld(&(bar)[XB_TMO])) break; if (_sp > XB_SPIN_CAP) { atomicAdd(&(bar)[XB_TMO], 1u); break; } } } } while (0)

struct XcdBarrier {
    unsigned* bar; unsigned x;
    volatile LAS unsigned* st;
};

__device__ __forceinline__ XcdBarrier xcd_barrier_post(unsigned* bar, volatile LAS unsigned* st) {
    XcdBarrier b; b.bar = bar; b.x = xb_xcc_id(); b.st = st;
    if (threadIdx.x == 0) (void)xb_add(&bar[XB_XCNT(b.x)], 1u);
    return b;
}
__device__ __forceinline__ void xcd_barrier_complete(unsigned* bar, unsigned x, unsigned& nloc, unsigned& nx) {
    const unsigned G = gridDim.x * gridDim.y * gridDim.z;
    unsigned sum, cnt, mine, sp = 0u;
    for (;;) {
        sum = 0u; cnt = 0u; mine = 0u;
#pragma unroll
        for (unsigned j = 0; j < 16; ++j) { const unsigned c = xb_ld(&bar[XB_XCNT(j)]); sum += c; cnt += (c > 0u) ? 1u : 0u; mine = (j == x) ? c : mine; }
        if (sum == G) break;
        __builtin_amdgcn_s_sleep(1);
        if ((++sp & 255u) == 0u) { if (xb_ld(&bar[XB_TMO])) break; if (sp > XB_SPIN_CAP) { atomicAdd(&bar[XB_TMO], 1u); break; } }
    }
    nloc = mine > 0u ? mine : 1u; nx = cnt > 0u ? cnt : 1u;
}

__device__ __forceinline__ void xcd_barrier(const XcdBarrier& b) {
    asm volatile("s_waitcnt vmcnt(0)" ::: "memory");
    __syncthreads();
    if (threadIdx.x == 0) {
        unsigned* bar = b.bar;
        __builtin_amdgcn_s_waitcnt(0);
        unsigned nloc = b.st[0], nx = b.st[1];
        if (nloc == 0u) { xcd_barrier_complete(bar, b.x, nloc, nx); b.st[0] = nloc; b.st[1] = nx; }
        const unsigned old = xb_add(&bar[XB_XSUB(b.x)], 1u);
        const unsigned gen = old / nloc;
        if (old + 1u == (gen + 1u) * nloc) {
            __builtin_amdgcn_fence(__ATOMIC_RELEASE, "agent");
            asm volatile("s_waitcnt vmcnt(0)" ::: "memory");
            const unsigned og = xb_add(&bar[XB_TOP], 1u);
            const unsigned tg = og / nx;
            if (og + 1u == (tg + 1u) * nx) xb_add(&bar[XB_TOPGEN], 1u);
            else XB_SPIN(xb_ld(&bar[XB_TOPGEN]) == tg, bar);
            __builtin_amdgcn_fence(__ATOMIC_ACQUIRE, "agent");
            xb_add(&bar[XB_XGEN(b.x)], 1u);
            asm volatile("s_waitcnt vmcnt(0)" ::: "memory");
        } else {
            XB_SPIN(xb_ld(&bar[XB_XGEN(b.x)]) == gen, bar);
            __builtin_amdgcn_fence(__ATOMIC_ACQUIRE, "agent");
            asm volatile("s_waitcnt vmcnt(0)" ::: "memory");
        }
    }
    __syncthreads();
}

#ifndef N_LAUNCH_MODE
#define N_LAUNCH_MODE 1
#endif
template <int MASK, bool COOP> __device__ __forceinline__ void run_phases(const Args& a, LAS unsigned char* lds, int l0, int l1) {
    const int G = gridDim.x;
#define LAUNDER() int tid = threadIdx.x; asm volatile("" : "+v"(tid)); const int lane = tid & 63, wave = __builtin_amdgcn_readfirstlane(tid >> 6); (void)lane; (void)wave
    float* hbuf = a.out;
    const float* mod = (const float*)(a.ws + WS_CTL) + CW_MOD;
    bf16* XN = (bf16*)(a.ws + WS_XN);
    XcdBarrier xbar; xbar.bar = nullptr; xbar.x = 0; xbar.st = nullptr;
    if constexpr (COOP) {
        volatile LAS unsigned* st = (volatile LAS unsigned*)(lds + 140128);
        if (threadIdx.x < 2) st[threadIdx.x] = 0u;
        __syncthreads();
        xbar = xcd_barrier_post((unsigned*)(a.ws + WS_CTL) + CW_BAR, st);
    }
    int nsync = 0;
#define GSYNC() do { if constexpr (COOP) { if (nsync++ == 0) cg::this_grid().sync(); else xcd_barrier(xbar); } } while (0)
    if constexpr (MASK & 1) { LAUNDER(); p0a(a, lds, tid, lane, wave, G); GSYNC(); }
    if constexpr (MASK & 2) { LAUNDER(); ln_rows(a.in[0], a.in[2], a.in[3], hbuf, XN, mod, lane, wave, G); GSYNC(); }
#pragma unroll 1
    for (int l = l0; l < l1; ++l) {
        for (int rep = 0; rep < ((PROBE_REP & 4) ? 2 : 1); ++rep)
        if constexpr (MASK & 4) { pg8::Gemm g{XN, (const bf16*)(a.ws + WS_WIN) + (size_t)l * NPROJ * 1024, M, NPROJ, 1024}; pg8::StaticOrder S; S.init(M, NPROJ, G, (int)blockIdx.x);
          EpiProj E{(bf16*)(a.ws + WS_PA), (bf16*)(a.ws + WS_PV), (bf16*)(a.ws + WS_PB)};
          pg8::gemm_phase<EpiProj, pg8::StaticOrder, true, true>(lds, g, S, E); GSYNC(); }
        for (int rep = 0; rep < ((PROBE_REP & 8) ? 2 : 1); ++rep)
        if constexpr (MASK & 8) { LAUNDER(); prep_phase(a, lds, l, tid, lane, wave, G); GSYNC(); }
        if constexpr (MASK & 16) { { LAUNDER(); p3a_phase(a, lds, l, tid, lane, wave); } GSYNC(); { LAUNDER(); p3b_phase(a, lds, l, tid, lane, wave); } GSYNC(); }
        if constexpr (MASK & 64) { pg8::Gemm g{(const bf16*)(a.ws + WS_YM), (const bf16*)(a.ws + WS_WOUT) + (size_t)l * 1024 * 1024, M, D, D}; pg8::StaticOrder S; S.init(M, D, G, (int)blockIdx.x);
          EpiOut E{hbuf, mod + l * 2 * 3072};
          pg8::gemm_phase<EpiOut, pg8::StaticOrder, true, true>(lds, g, S, E); GSYNC(); }
        if constexpr (MASK & 128) { LAUNDER(); ln_rows(hbuf, a.in[19] + l * D, a.in[20] + l * D, hbuf, XN, (l + 1 < DEPTH) ? mod + (l + 1) * 2 * 3072 : nullptr, lane, wave, G);
          if (l + 1 < l1) GSYNC(); }
    }
#undef GSYNC
#undef LAUNDER
}
#ifndef FMASK
#define FMASK 0xFF
#endif
#if N_LAUNCH_MODE == 1
__global__ void __launch_bounds__(512, 2) hymba_fwd(Args a) {
    extern __shared__ __attribute__((aligned(16))) unsigned char lds_raw[];
    run_phases<FMASK, true>(a, (LAS unsigned char*)lds_raw, 0, DEPTH);
}
#else
template <int MASK> __global__ void __launch_bounds__(512, 2) hymba_phase(Args a, int l) {
    extern __shared__ __attribute__((aligned(16))) unsigned char lds_raw[];
    run_phases<MASK, false>(a, (LAS unsigned char*)lds_raw, l, l + 1);
}
template <int MASK> static void launch_phase(const Args& a, int l, hipStream_t stream) {
    static bool attr = false;
    if (!attr) { (void)hipFuncSetAttribute((const void*)hymba_phase<MASK>, hipFuncAttributeMaxDynamicSharedMemorySize, LDS_BYTES); attr = true; }
    hipLaunchKernelGGL(hymba_phase<MASK>, dim3(256), dim3(512), LDS_BYTES, stream, a, l);
}
#endif

extern "C" void kernel_launch(void* const* d_in, const int* in_sizes, int n_in, void* d_out, int out_size, void* d_ws, size_t ws_size, hipStream_t stream) {
    if (n_in != 21 || ws_size < WS_END) { fprintf(stderr, "kernel_launch: unexpected n_in %d / ws %zu\n", n_in, ws_size); return; }
    (void)hipMemsetAsync((char*)d_ws + WS_CTL, 0, CTL_ZERO_BYTES, stream);
    Args a{};
    for (int i = 0; i < 21; ++i) a.in[i] = (const float*)d_in[i];
    a.out = (float*)d_out; a.ws = (unsigned char*)d_ws;
#if N_LAUNCH_MODE == 1
    static int grid = 0;
    if (grid == 0) {
        int dev = 0, cus = 0, per_cu = 0;
        (void)hipGetDevice(&dev); (void)hipDeviceGetAttribute(&cus, hipDeviceAttributeMultiprocessorCount, dev);
        (void)hipFuncSetAttribute((const void*)hymba_fwd, hipFuncAttributeMaxDynamicSharedMemorySize, LDS_BYTES);
        (void)hipOccupancyMaxActiveBlocksPerMultiprocessor(&per_cu, (const void*)hymba_fwd, 512, LDS_BYTES);
        if (per_cu < 1) per_cu = 1;
        (void)hipGetLastError();
        grid = cus * per_cu;
    }
    void* args[] = {&a};
    hipError_t e = hipLaunchCooperativeKernel((const void*)hymba_fwd, dim3(grid), dim3(512), args, LDS_BYTES, stream);
    if (e != hipSuccess) fprintf(stderr, "cooperative launch failed: %s (grid %d)\n", hipGetErrorString(e), grid);
#else
    launch_phase<1>(a, 0, stream); launch_phase<2>(a, 0, stream);
    for (int l = 0; l < DEPTH; ++l) { launch_phase<4>(a, l, stream); launch_phase<8>(a, l, stream); launch_phase<16>(a, l, stream); launch_phase<32>(a, l, stream); launch_phase<64>(a, l, stream); launch_phase<128>(a, l, stream); }
#endif
}
```
